# Optimizing an MI355X kernel written in HIP

```python
import jax, jax.numpy as jnp
from jax import lax
import numpy as np

D_MODEL = 1024
BATCH = 8
SEQ = 2048
DEPTH = 1
DEC_BATCH = 32
DEC_SEQ = 64
PAST_LEN = 4096

CHUNK = 64
Q_BLOCK = 128
FOX_HEADS = 8
FOX_DIM = 64
MLA_HEADS = 8
MLA_NOPE = 64
MLA_ROPE = 32
MLA_VDIM = 64
Q_LORA = 384
KV_LORA = 256
D_FF = 2816
CONV_W = 3
ROPE_THETA = 10000.0
EPS = 1e-6
NEG = -1e30

FOX_W = FOX_HEADS * FOX_DIM
MLA_W = MLA_HEADS * MLA_VDIM
D_MIX = FOX_W + MLA_W
IN_SIZES = [FOX_W, FOX_W, FOX_W, FOX_HEADS, Q_LORA, KV_LORA, MLA_ROPE]
D_IN = sum(IN_SIZES)
IN_SPLIT_POINTS = [int(s) for s in np.cumsum(IN_SIZES)[:-1]]

kernel_name = "fox_mla_hybrid_convffn_stream_step"


def rmsnorm(x, g):
    xf = x.astype(jnp.float32)
    y = xf * lax.rsqrt(jnp.mean(xf * xf, axis=-1, keepdims=True) + EPS)
    return (y * g.astype(jnp.float32)).astype(x.dtype)


def rope(x, pos):
    half = MLA_ROPE // 2
    inv = ROPE_THETA ** (-jnp.arange(half, dtype=jnp.float32) / half)
    ang = pos.astype(jnp.float32)[:, None] * inv[None, :]
    cos = jnp.cos(ang)[:, None, :]
    sin = jnp.sin(ang)[:, None, :]
    xf = x.astype(jnp.float32)
    x1, x2 = xf[..., :half], xf[..., half:]
    return jnp.concatenate([x1 * cos - x2 * sin, x1 * sin + x2 * cos], axis=-1).astype(x.dtype)


def over_query_blocks(attend, q_side, q_pos):
    T = q_pos.shape[0]
    blk = min(Q_BLOCK, T)
    nb = T // blk

    def split(a):
        return jnp.moveaxis(a.reshape(a.shape[0], nb, blk, *a.shape[2:]), 1, 0)

    xs = (tuple(split(a) for a in q_side), q_pos.reshape(nb, blk))
    out = lax.map(lambda b: attend(*b[0], b[1]), xs)
    out = jnp.moveaxis(out, 0, 1)
    return out.reshape(out.shape[0], T, *out.shape[3:])


def fox_attend(q, k, v, fq, fk, q_pos, k_pos):
    s = jnp.einsum('bqhd,bkhd->bhqk', q, k, preferred_element_type=jnp.float32) * (FOX_DIM ** -0.5)
    s = s + jnp.transpose(fq, (0, 2, 1))[:, :, :, None] - jnp.transpose(fk, (0, 2, 1))[:, :, None, :]
    mask = k_pos[None, :] <= q_pos[:, None]
    p = jax.nn.softmax(jnp.where(mask, s, NEG), axis=-1)
    return jnp.einsum('bhqk,bkhd->bqhd', p.astype(v.dtype), v)


def mla_attend(q_lat, q_rope, q_pos, c_kv, k_rope, k_pos, w_uv):
    s = (jnp.einsum('bqhc,bkc->bhqk', q_lat, c_kv, preferred_element_type=jnp.float32)
         + jnp.einsum('bqhr,bkr->bhqk', q_rope, k_rope, preferred_element_type=jnp.float32))
    s = s * ((MLA_NOPE + MLA_ROPE) ** -0.5)
    mask = (k_pos // CHUNK)[None, :] <= (q_pos // CHUNK)[:, None]
    p = jax.nn.softmax(jnp.where(mask, s, NEG), axis=-1)
    o_lat = jnp.einsum('bhqk,bkc->bqhc', p.astype(c_kv.dtype), c_kv)
    return jnp.einsum('bqhc,chd->bqhd', o_lat, w_uv)


def layer(x, past, lp):
    (g_attn, w_in, b_f, g_q, w_q_up, g_kv, w_uk, w_uv, w_out,
     g_ffn, w_up, conv_w, conv_b, w_down) = lp
    pk, pv, plogf, pc, pkr, pconv = past
    B, T, _ = x.shape
    P = pk.shape[1]
    q_pos = P + jnp.arange(T, dtype=jnp.int32)
    k_pos = jnp.arange(P + T, dtype=jnp.int32)

    h = rmsnorm(x, g_attn)
    z = h @ w_in
    q, k, v, f_lin, q_c, c_kv, k_r = jnp.split(z, IN_SPLIT_POINTS, axis=-1)

    q = q.reshape(B, T, FOX_HEADS, FOX_DIM)
    k = k.reshape(B, T, FOX_HEADS, FOX_DIM)
    v = v.reshape(B, T, FOX_HEADS, FOX_DIM)
    logf = jax.nn.log_sigmoid(f_lin.astype(jnp.float32) + b_f.astype(jnp.float32))
    plogf32 = plogf.astype(jnp.float32)
    f_past = jnp.cumsum(plogf32, axis=1)
    f_new = jnp.sum(plogf32, axis=1, keepdims=True) + jnp.cumsum(logf, axis=1)
    f_keys = jnp.concatenate([f_past, f_new], axis=1)
    k_all = jnp.concatenate([pk.astype(k.dtype), k], axis=1)
    v_all = jnp.concatenate([pv.astype(v.dtype), v], axis=1)
    fox = over_query_blocks(
        lambda qb, fb, pb: fox_attend(qb, k_all, v_all, fb, f_keys, pb, k_pos),
        (q, f_new), q_pos)

    q_full = (rmsnorm(q_c, g_q) @ w_q_up).reshape(B, T, MLA_HEADS, MLA_NOPE + MLA_ROPE)
    q_nope = q_full[..., :MLA_NOPE]
    q_rope = rope(q_full[..., MLA_NOPE:], q_pos)
    q_lat = jnp.einsum('bthd,chd->bthc', q_nope, w_uk)
    c_kv = rmsnorm(c_kv, g_kv)
    k_r = rope(k_r[:, :, None, :], q_pos)[:, :, 0, :]
    c_all = jnp.concatenate([pc.astype(c_kv.dtype), c_kv], axis=1)
    kr_all = jnp.concatenate([pkr.astype(k_r.dtype), k_r], axis=1)
    mla = over_query_blocks(
        lambda lb, rb, pb: mla_attend(lb, rb, pb, c_all, kr_all, k_pos, w_uv),
        (q_lat, q_rope), q_pos)

    mixed = jnp.concatenate([fox.reshape(B, T, FOX_W), mla.reshape(B, T, MLA_W)], axis=-1)
    x = x + mixed @ w_out

    u = rmsnorm(x, g_ffn) @ w_up
    up = jnp.concatenate([pconv.astype(u.dtype), u], axis=1)
    uc = conv_b + sum(conv_w[j] * up[:, j:j + T] for j in range(CONV_W))
    gate, val = jnp.split(uc, 2, axis=-1)
    x = x + (jax.nn.silu(gate) * val) @ w_down
    conv_new = up[:, -(CONV_W - 1):]
    return x, (k, v, logf, c_kv, k_r, conv_new)


def setup_inputs(seed: int = 0) -> dict:
    key = jax.random.key(seed)
    ks = jax.random.split(key, 32)
    f32 = jnp.float32
    nrm = lambda k, s: jax.random.normal(k, s, f32)
    return {
        "x_prompt": nrm(ks[0], (BATCH, SEQ, D_MODEL)),
        "x_sample": nrm(ks[1], (DEC_BATCH, DEC_SEQ, D_MODEL)),
        "cache_fox_k": nrm(ks[2], (DEPTH, DEC_BATCH, PAST_LEN, FOX_HEADS, FOX_DIM)),
        "cache_fox_v": nrm(ks[3], (DEPTH, DEC_BATCH, PAST_LEN, FOX_HEADS, FOX_DIM)),
        "cache_fox_logf": jax.nn.log_sigmoid(2.0 + 0.5 * nrm(ks[4], (DEPTH, DEC_BATCH, PAST_LEN, FOX_HEADS))),
        "cache_mla_latent": nrm(ks[5], (DEPTH, DEC_BATCH, PAST_LEN, KV_LORA)),
        "cache_mla_krope": nrm(ks[6], (DEPTH, DEC_BATCH, PAST_LEN, MLA_ROPE)),
        "state_ffn_conv": nrm(ks[7], (DEPTH, DEC_BATCH, CONV_W - 1, 2 * D_FF)),
        "attn_norm": 1.0 + 0.05 * nrm(ks[8], (DEPTH, D_MODEL)),
        "w_in": nrm(ks[9], (DEPTH, D_MODEL, D_IN)) * D_MODEL ** -0.5,
        "b_forget": 2.0 + 0.5 * nrm(ks[10], (DEPTH, FOX_HEADS)),
        "q_norm": 1.0 + 0.05 * nrm(ks[11], (DEPTH, Q_LORA)),
        "w_q_up": nrm(ks[12], (DEPTH, Q_LORA, MLA_HEADS * (MLA_NOPE + MLA_ROPE))) * Q_LORA ** -0.5,
        "kv_norm": 1.0 + 0.05 * nrm(ks[13], (DEPTH, KV_LORA)),
        "w_uk": nrm(ks[14], (DEPTH, KV_LORA, MLA_HEADS, MLA_NOPE)) * KV_LORA ** -0.5,
        "w_uv": nrm(ks[15], (DEPTH, KV_LORA, MLA_HEADS, MLA_VDIM)) * KV_LORA ** -0.5,
        "w_out": nrm(ks[16], (DEPTH, D_MIX, D_MODEL)) * D_MIX ** -0.5,
        "ffn_norm": 1.0 + 0.05 * nrm(ks[17], (DEPTH, D_MODEL)),
        "w_up": nrm(ks[18], (DEPTH, D_MODEL, 2 * D_FF)) * D_MODEL ** -0.5,
        "conv_w": nrm(ks[19], (DEPTH, CONV_W, 2 * D_FF)) * CONV_W ** -0.5,
        "conv_b": 0.01 * nrm(ks[20], (DEPTH, 2 * D_FF)),
        "w_down": nrm(ks[21], (DEPTH, D_FF, D_MODEL)) * D_FF ** -0.5,
        "final_norm": 1.0 + 0.05 * nrm(ks[22], (D_MODEL,)),
    }


def reference(x_prompt, x_sample, cache_fox_k, cache_fox_v, cache_fox_logf, cache_mla_latent,
              cache_mla_krope, state_ffn_conv, attn_norm, w_in, b_forget, q_norm, w_q_up, kv_norm,
              w_uk, w_uv, w_out, ffn_norm, w_up, conv_w, conv_b, w_down, final_norm):
    hp, hs = x_prompt, x_sample
    Bp = x_prompt.shape[0]
    dt = x_prompt.dtype
    new_p, new_s = [], []
    for l in range(DEPTH):
        lp = (attn_norm[l], w_in[l], b_forget[l], q_norm[l], w_q_up[l], kv_norm[l], w_uk[l], w_uv[l],
              w_out[l], ffn_norm[l], w_up[l], conv_w[l], conv_b[l], w_down[l])
        no_past = (jnp.zeros((Bp, 0, FOX_HEADS, FOX_DIM), dt), jnp.zeros((Bp, 0, FOX_HEADS, FOX_DIM), dt),
                   jnp.zeros((Bp, 0, FOX_HEADS), jnp.float32), jnp.zeros((Bp, 0, KV_LORA), dt),
                   jnp.zeros((Bp, 0, MLA_ROPE), dt), jnp.zeros((Bp, CONV_W - 1, 2 * D_FF), dt))
        hp, st_p = layer(hp, no_past, lp)
        past = (cache_fox_k[l], cache_fox_v[l], cache_fox_logf[l], cache_mla_latent[l],
                cache_mla_krope[l], state_ffn_conv[l])
        hs, st_s = layer(hs, past, lp)
        new_p.append(st_p)
        new_s.append(st_s)
    y_prompt = rmsnorm(hp, final_norm)
    y_sample = rmsnorm(hs, final_norm)
    fox_k_p, fox_v_p, fox_logf_p, mla_latent_p, mla_krope_p, ffn_conv_p = [jnp.stack(f) for f in zip(*new_p)]
    fox_k_s, fox_v_s, fox_logf_s, mla_latent_s, mla_krope_s, ffn_conv_s = [jnp.stack(f) for f in zip(*new_s)]
    return (y_prompt, y_sample,
            fox_k_p, fox_v_p, fox_logf_p, mla_latent_p, mla_krope_p, ffn_conv_p,
            fox_k_s, fox_v_s, fox_logf_s, mla_latent_s, mla_krope_s, ffn_conv_s)
```

```cpp
#include <hip/hip_runtime.h>
#include <cstdio>
#include <cstdint>
namespace pg8 {
#define PG8_LAS __attribute__((address_space(3)))
typedef unsigned short bf16_t;
typedef short bf16x8 __attribute__((ext_vector_type(8)));
typedef float f32x4 __attribute__((ext_vector_type(4)));
typedef unsigned u32x4 __attribute__((ext_vector_type(4)));
constexpr int BM = 256, BK = 64, HALF = 128, HTB = HALF * BK * 2  , STAGE_BYTES = 8 * HTB, NXCD = 8, WGM = 8;

__host__ __device__ __forceinline__ int lds_byte(int r, int c) { const int st = (r >> 4) * 2 + (c >> 5), rr = r & 15, cc = c & 31, ob = rr * 64 + cc * 2; return st * 1024 + (ob ^ (((ob >> 9) & 1) << 5)); }
__host__ __device__ __forceinline__ void stage_rc(int b, int& R, int& C) { const int st = b / 1024, sb = b % 1024, swz = sb ^ (((sb >> 9) & 1) << 5); R = (st >> 1) * 16 + swz / 64; C = (st & 1) * 32 + (swz % 64) / 2; }
__host__ __device__ __forceinline__ int perm32(int rho) { const int n = rho >> 4, i = rho & 15; return 8 * (i >> 2) + 4 * n + (i & 3); }

struct Unit { int pm, pn, k0, nkt, sl; };
struct Gemm { const bf16_t* A; const bf16_t* Bt; int M, N, K; };

struct StaticOrder {
    int nM, nN, nwg, G, c, nkt;
    __host__ __device__ void init(int M, int N, int K, int G_, int c_) { nM = M / BM; nN = N / BM; nwg = nM * nN; G = G_; c = c_; nkt = K / BK; }
    __host__ __device__ bool next(int i, Unit& u) const {
        const long L = (long)i * G + c; if (L >= nwg) return false;
        int wgid = (int)L; { const int q = nwg / NXCD, r = nwg % NXCD, xcd = wgid % NXCD, off = wgid / NXCD; wgid = (xcd < r ? xcd * (q + 1) : r * (q + 1) + (xcd - r) * q) + off; }
        const int nig = WGM * nN, gid = wgid / nig, fm = gid * WGM, gsz = (nM - fm) < WGM ? (nM - fm) : WGM;
        u.pm = fm + ((wgid % nig) % gsz); u.pn = (wgid % nig) / gsz; u.k0 = 0; u.nkt = nkt; u.sl = -1; return true;
    }
    __device__ __forceinline__ void a_ready(const Unit&) const {}
    __device__ __forceinline__ void done(const Unit&) const {}
};

template <class Epi, class Sched, bool ALIGN_EPI = false, bool SP2 = false>
__device__ __forceinline__ void gemm_phase(PG8_LAS unsigned char* lds, const Gemm g, const Sched& S, const Epi& E) {
    const int tid = threadIdx.x, wid = __builtin_amdgcn_readfirstlane(tid >> 6), lane = tid & 63, wr = wid >> 2, wc = wid & 3, fr = lane & 15, fq = lane >> 4;
    const int K = g.K;
    unsigned voffA[2], voffB[2];
#pragma unroll
    for (int i = 0; i < 2; ++i) { int R, C; stage_rc(tid * 16 + i * 8192, R, C); const int Rb = Epi::PERM ? ((R & ~31) + perm32(R & 31)) : R;
        voffA[i] = (unsigned)(R * K + C) * 2u; voffB[i] = (unsigned)(Rb * K + C) * 2u; }
    const size_t kstep = (size_t)(BK * 2);
    const size_t hstep = (size_t)HALF * K * 2;
    const size_t tstep = 2 * hstep;
    const unsigned ldsw = (unsigned)wid * 1024u;
    const int aoff = lds_byte(wr * 64 + fr, fq * 8), boff = lds_byte(wc * 32 + fr, fq * 8);
#define PG8_SA(b, h) (((b) * 2 + (h)) * HTB)
#define PG8_SB(b, h) ((4 + (b) * 2 + (h)) * HTB)
#define PG8_STAGE(bufoff, gbase, voff) do { _Pragma("unroll") for (int _i = 0; _i < 2; ++_i) \
        __builtin_amdgcn_global_load_lds((const unsigned*)((const char*)(gbase) + (voff)[_i]), (PG8_LAS unsigned*)(lds + (bufoff) + ldsw + _i * 8192), 16, 0, 0); } while (0)
#define PG8_LDA(dst, b, h) do { _Pragma("unroll") for (int m = 0; m < 4; ++m) _Pragma("unroll") for (int k = 0; k < 2; ++k) dst[m][k] = *(const PG8_LAS bf16x8*)(lds + PG8_SA(b, h) + aoff + m * 2048 + k * 1024); } while (0)
#define PG8_LDB(dst, b, h) do { _Pragma("unroll") for (int n = 0; n < 2; ++n) _Pragma("unroll") for (int k = 0; k < 2; ++k) dst[n][k] = *(const PG8_LAS bf16x8*)(lds + PG8_SB(b, h) + boff + n * 2048 + k * 1024); } while (0)
#define PG8_MMA(ai, bj, At, Bt) do { __builtin_amdgcn_s_setprio(1); _Pragma("unroll") for (int m = 0; m < 4; ++m) _Pragma("unroll") for (int n = 0; n < 2; ++n) _Pragma("unroll") for (int k = 0; k < 2; ++k) \
        acc[ai][bj][m][n] = __builtin_amdgcn_mfma_f32_16x16x32_bf16(Bt[n][k], At[m][k], acc[ai][bj][m][n], 0, 0, 0); __builtin_amdgcn_s_setprio(0); } while (0)
#define PG8_WAIT_V(n) asm volatile("s_waitcnt vmcnt(" #n ")" ::: "memory")
#define PG8_WAIT_L(n) asm volatile("s_waitcnt lgkmcnt(" #n ")" ::: "memory")
#define PG8_BAR __builtin_amdgcn_s_barrier()
#define PG8_SCHED __builtin_amdgcn_sched_barrier(0)
    Unit cur{}, nxt{}; int ui = 0;
    if (!S.next(0, cur)) return;
    f32x4 acc[2][2][4][2];
#pragma unroll
    for (int a = 0; a < 2; ++a)
#pragma unroll
        for (int b = 0; b < 2; ++b)
#pragma unroll
            for (int m = 0; m < 4; ++m)
#pragma unroll
                for (int n = 0; n < 2; ++n) acc[a][b][m][n] = (f32x4){0.f, 0.f, 0.f, 0.f};
    bf16x8 At[4][2], B0[2][2], B1[2][2];
    const char* cA = (const char*)g.A + (size_t)cur.pm * tstep + (size_t)cur.k0 * kstep; const char* cB = (const char*)g.Bt + (size_t)cur.pn * tstep + (size_t)cur.k0 * kstep;
    S.a_ready(cur);
    if constexpr (SP2) {
        PG8_STAGE(PG8_SB(0, 0), cB, voffB); PG8_STAGE(PG8_SB(0, 1), cB + hstep, voffB); PG8_STAGE(PG8_SA(0, 0), cA, voffA); PG8_STAGE(PG8_SA(0, 1), cA + hstep, voffA);
        if (wr == 1) PG8_BAR;
        PG8_WAIT_V(2); PG8_BAR;
        PG8_STAGE(PG8_SB(1, 0), cB + kstep, voffB); PG8_STAGE(PG8_SA(1, 0), cA + kstep, voffA); PG8_STAGE(PG8_SB(1, 1), cB + hstep + kstep, voffB);
        PG8_WAIT_V(6); PG8_BAR;
    } else {
        PG8_STAGE(PG8_SB(0, 0), cB, voffB); PG8_STAGE(PG8_SA(0, 0), cA, voffA); PG8_STAGE(PG8_SB(0, 1), cB + hstep, voffB); PG8_STAGE(PG8_SA(0, 1), cA + hstep, voffA);
        if (wr == 1) PG8_BAR;
        PG8_WAIT_V(4); PG8_BAR;
        PG8_STAGE(PG8_SB(1, 0), cB + kstep, voffB); PG8_STAGE(PG8_SA(1, 0), cA + kstep, voffA); PG8_STAGE(PG8_SB(1, 1), cB + hstep + kstep, voffB);
        PG8_WAIT_V(6); PG8_BAR;
    }
    for (;;) {
        const bool has_next = S.next(ui + 1, nxt);
        const char* nA = has_next ? (const char*)g.A + (size_t)nxt.pm * tstep + (size_t)nxt.k0 * kstep : cA; const char* nB = has_next ? (const char*)g.Bt + (size_t)nxt.pn * tstep + (size_t)nxt.k0 * kstep : cB;
        const int nt = cur.nkt;
        for (int t = 0; t < nt; t += 2) {
            const bool last = (t == nt - 2);
            const char* a1 = cA + (size_t)(t + 1) * kstep;
            const char* a2 = last ? nA : cA + (size_t)(t + 2) * kstep; const char* b2 = last ? nB : cB + (size_t)(t + 2) * kstep;
            const char* a3 = a2 + kstep; const char* b3 = b2 + kstep;
            if (last && has_next) S.a_ready(nxt);
            if constexpr (SP2) {
            PG8_LDB(B0, 0, 0); PG8_LDB(B1, 0, 1); PG8_SCHED; PG8_LDA(At, 0, 0); PG8_STAGE(PG8_SA(1, 1), a1 + hstep, voffA);
            PG8_WAIT_V(8); PG8_WAIT_L(0); PG8_BAR; PG8_MMA(0, 0, At, B0); PG8_MMA(0, 1, At, B1); PG8_BAR; PG8_SCHED;
            PG8_LDA(At, 0, 1); PG8_STAGE(PG8_SB(0, 0), b2, voffB); PG8_STAGE(PG8_SB(0, 1), b2 + hstep, voffB); PG8_STAGE(PG8_SA(0, 0), a2, voffA);
            PG8_WAIT_V(8); PG8_WAIT_L(0); PG8_BAR; PG8_MMA(1, 0, At, B0); PG8_MMA(1, 1, At, B1); PG8_BAR; PG8_SCHED;
            PG8_LDB(B0, 1, 0); PG8_LDB(B1, 1, 1); PG8_SCHED; PG8_LDA(At, 1, 0); PG8_STAGE(PG8_SA(0, 1), a2 + hstep, voffA);
            PG8_WAIT_V(8); PG8_WAIT_L(0); PG8_BAR; PG8_MMA(0, 0, At, B0); PG8_MMA(0, 1, At, B1); PG8_BAR; PG8_SCHED;
            PG8_LDA(At, 1, 1); PG8_STAGE(PG8_SB(1, 0), b3, voffB); PG8_STAGE(PG8_SB(1, 1), b3 + hstep, voffB); PG8_STAGE(PG8_SA(1, 0), a3, voffA);
            PG8_WAIT_V(8); PG8_WAIT_L(0); PG8_BAR; PG8_MMA(1, 0, At, B0); PG8_MMA(1, 1, At, B1); PG8_BAR; PG8_SCHED;
            } else {
            PG8_LDB(B0, 0, 0); PG8_SCHED; PG8_LDA(At, 0, 0); PG8_STAGE(PG8_SA(1, 1), a1 + hstep, voffA);
            PG8_WAIT_L(8); PG8_BAR; PG8_WAIT_L(0); PG8_MMA(0, 0, At, B0); PG8_BAR; PG8_SCHED;
            PG8_LDB(B1, 0, 1); PG8_STAGE(PG8_SB(0, 0), b2, voffB);
            PG8_BAR; PG8_WAIT_L(0); PG8_MMA(0, 1, At, B1); PG8_BAR;
            PG8_LDA(At, 0, 1); PG8_STAGE(PG8_SA(0, 0), a2, voffA);
            PG8_BAR; PG8_WAIT_L(0); PG8_MMA(1, 0, At, B0); PG8_BAR; PG8_SCHED;
            PG8_STAGE(PG8_SB(0, 1), b2 + hstep, voffB);
            PG8_WAIT_V(6); PG8_BAR; PG8_MMA(1, 1, At, B1); PG8_BAR;
            PG8_LDB(B0, 1, 0); PG8_SCHED; PG8_LDA(At, 1, 0); PG8_STAGE(PG8_SA(0, 1), a2 + hstep, voffA);
            PG8_WAIT_L(8); PG8_BAR; PG8_WAIT_L(0); PG8_MMA(0, 0, At, B0); PG8_BAR; PG8_SCHED;
            PG8_LDB(B1, 1, 1); PG8_STAGE(PG8_SB(1, 0), b3, voffB);
            PG8_BAR; PG8_WAIT_L(0); PG8_MMA(0, 1, At, B1); PG8_BAR;
            PG8_LDA(At, 1, 1); PG8_STAGE(PG8_SA(1, 0), a3, voffA);
            PG8_BAR; PG8_WAIT_L(0); PG8_MMA(1, 0, At, B0); PG8_BAR; PG8_SCHED;
            PG8_STAGE(PG8_SB(1, 1), b3 + hstep, voffB);
            PG8_WAIT_V(6); PG8_BAR; PG8_MMA(1, 1, At, B1); PG8_BAR;
            }
        }
        if constexpr (ALIGN_EPI) { if (wr == 0) PG8_BAR; }
        if constexpr (!Epi::AFTER_DRAIN) { E(acc, cur, wr, wc, fr, fq); S.done(cur); }
        if (!has_next) break;
#pragma unroll
        for (int a = 0; a < 2; ++a)
#pragma unroll
            for (int b = 0; b < 2; ++b)
#pragma unroll
                for (int m = 0; m < 4; ++m)
#pragma unroll
                    for (int n = 0; n < 2; ++n) acc[a][b][m][n] = (f32x4){0.f, 0.f, 0.f, 0.f};
        cur = nxt; cA = nA; cB = nB; ++ui;
        if constexpr (ALIGN_EPI) { if (wr == 1) PG8_BAR; }
    }
    PG8_WAIT_V(0);
    if constexpr (!ALIGN_EPI) { if (wr == 0) PG8_BAR; }
    PG8_BAR;
    if constexpr (Epi::AFTER_DRAIN) { E.fused(acc, cur, wr, wc, fr, fq, lds, wid, lane); S.done(cur); }
#undef PG8_SA
#undef PG8_SB
#undef PG8_STAGE
#undef PG8_LDA
#undef PG8_LDB
#undef PG8_MMA
#undef PG8_WAIT_V
#undef PG8_WAIT_L
#undef PG8_BAR
#undef PG8_SCHED
}
}

#define LAS __attribute__((address_space(3)))
typedef unsigned short bf16;
typedef short bf16x8 __attribute__((ext_vector_type(8)));
typedef short s16x4 __attribute__((ext_vector_type(4)));
typedef float f32x4 __attribute__((ext_vector_type(4)));
typedef float f32x2 __attribute__((ext_vector_type(2)));
typedef float f32x16 __attribute__((ext_vector_type(16)));
typedef unsigned u32x4 __attribute__((ext_vector_type(4)));
typedef unsigned u32x2 __attribute__((ext_vector_type(2)));

constexpr int DM = 1024, SEQ = 2048, NBP = 8, DSEQ = 64, NBS = 32, PAST = 4096;
constexpr int TP = NBP * SEQ, TS = NBS * DSEQ, TOK = TP + TS;
constexpr int NPAST = NBS * PAST;
constexpr int KVS = PAST + DSEQ;
constexpr int DIN = 2216, NZ = 2304, ZW = 640;
constexpr int DFF = 2816, DFF2 = 5632;
constexpr float LOG2E = 1.4426950408889634f;
constexpr float EPS = 1e-6f;
constexpr int NTHREADS = 512, NWAVES = 8;
constexpr int LDS_BYTES = 147456;

constexpr size_t O_YP = 0, O_YS = O_YP + (size_t)TP * DM, O_KP = O_YS + (size_t)TS * DM, O_VP = O_KP + (size_t)TP * 512, O_LFP = O_VP + (size_t)TP * 512,
                 O_LATP = O_LFP + (size_t)TP * 8, O_KRP = O_LATP + (size_t)TP * 256, O_CVP = O_KRP + (size_t)TP * 32, O_KS = O_CVP + (size_t)NBP * 2 * DFF2,
                 O_VS = O_KS + (size_t)TS * 512, O_LFS = O_VS + (size_t)TS * 512, O_LATS = O_LFS + (size_t)TS * 8, O_KRS = O_LATS + (size_t)TS * 256,
                 O_CVS = O_KRS + (size_t)TS * 32, O_END = O_CVS + (size_t)NBS * 2 * DFF2;

constexpr size_t MiB = 1u << 20;
constexpr size_t WS_CTL = 0, CTL_BYTES = 16384;
constexpr size_t WS_WIN = 1 * MiB, WS_WQ = 6 * MiB, WS_WKV = 7 * MiB, WS_WOUT = 8 * MiB, WS_WUP = 10 * MiB, WS_WDOWN = 21 * MiB, WS_CS = 27 * MiB,
                 WS_FS = 28 * MiB, WS_FP = 33 * MiB, WS_H = 34 * MiB, WS_QFOX = 70 * MiB, WS_KNEW = 88 * MiB, WS_VNEW = 106 * MiB, WS_ZBUF = 124 * MiB,
                 WS_QCN = 169 * MiB, WS_LATNEW = 183 * MiB, WS_KRNEW = 192 * MiB, WS_QMLA = 194 * MiB, WS_KVNEW = 221 * MiB, WS_MIXED = 257 * MiB,
                 WS_X1 = 293 * MiB, WS_X2 = 124 * MiB  , WS_LATPAST = 365 * MiB, WS_KRPAST = 429 * MiB, WS_KPAST = 437 * MiB,
                 WS_VPAST = 565 * MiB, WS_SLAB = 565 * MiB  , WS_KVPAST = 693 * MiB, WS_EDGE = 693 * MiB  , WS_ACT = 437 * MiB  , WS_WQA = 949 * MiB, WS_QLAT = 951 * MiB, WS_ROWSS = 959 * MiB  , WS_END = 961 * MiB;

struct Args {
    const float* in[23];
    float* out;
    unsigned char* ws;
};

__device__ __forceinline__ unsigned pk2(float lo, float hi) { typedef __bf16 bf2 __attribute__((ext_vector_type(2))); f32x2 v = {lo, hi}; bf2 b = __builtin_convertvector(v, bf2); return __builtin_bit_cast(unsigned, b); }
__device__ __forceinline__ float bflo(unsigned w) { return __builtin_bit_cast(float, w << 16); }
__device__ __forceinline__ float bfhi(unsigned w) { return __builtin_bit_cast(float, w & 0xffff0000u); }
__device__ __forceinline__ float wave_sum(float v) {
#pragma unroll
    for (int o = 1; o < 64; o <<= 1) v += __shfl_xor(v, o);
    return v;
}
__device__ __forceinline__ void st_bf4(bf16* p, f32x4 v) { *(u32x2*)p = (u32x2){pk2(v.x, v.y), pk2(v.z, v.w)}; }
__device__ __forceinline__ void lds_wait() { asm volatile("s_waitcnt lgkmcnt(0)" ::: "memory"); }
__device__ __forceinline__ float fast_exp2(float x) { return __builtin_amdgcn_exp2f(x); }

#define XB_TMO      128
#define XB_XCNT(j)  (256  + 64 * (j))
#define XB_XSUB(j)  (1280 + 64 * (j))
#define XB_XGEN(j)  (2304 + 64 * (j))
#define XB_TOP      3328
#define XB_TOPGEN   3392
#define XCD_BAR_WORDS 3456
#define XB_SPIN_CAP (1u << 18)

__device__ __forceinline__ unsigned xb_ld(unsigned* p)              { return __hip_atomic_load(p, __ATOMIC_RELAXED, __HIP_MEMORY_SCOPE_AGENT); }
__device__ __forceinline__ unsigned xb_add(unsigned* p, unsigned v) { return __hip_atomic_fetch_add(p, v, __ATOMIC_RELAXED, __HIP_MEMORY_SCOPE_AGENT); }
__device__ __forceinline__ unsigned xb_xcc_id() { return (unsigned)__builtin_amdgcn_s_getreg((3 << 11) | 20) & 0xFu; }
#define XB_SPIN(cond, bar) do { unsigned _sp = 0; while (cond) { __builtin_amdgcn_s_sleep(1); \
    if ((++_sp & 255u) == 0u) { if (xb_ld(&(bar)[XB_TMO])) break; if (_sp > XB_SPIN_CAP) { atomicAdd(&(bar)[XB_TMO], 1u); break; } } } } while (0)

struct XcdBarrier {
    unsigned* bar; unsigned x;
    volatile LAS unsigned* st;
};

__device__ __forceinline__ XcdBarrier xcd_barrier_post(unsigned* bar, volatile LAS unsigned* st) {
    XcdBarrier b; b.bar = bar; b.x = xb_xcc_id(); b.st = st;
    if (threadIdx.x == 0) (void)xb_add(&bar[XB_XCNT(b.x)], 1u);
    return b;
}
__device__ __forceinline__ void xcd_barrier_complete(unsigned* bar, unsigned x, unsigned& nloc, unsigned& nx) {
    const unsigned G = gridDim.x * gridDim.y * gridDim.z;
    unsigned sum, cnt, mine, sp = 0u;
    for (;;) {
        sum = 0u; cnt = 0u; mine = 0u;
#pragma unroll
        for (unsigned j = 0; j < 16; ++j) { const unsigned c = xb_ld(&bar[XB_XCNT(j)]); sum += c; cnt += (c > 0u) ? 1u : 0u; mine = (j == x) ? c : mine; }
        if (sum == G) break;
        __builtin_amdgcn_s_sleep(1);
        if ((++sp & 255u) == 0u) { if (xb_ld(&bar[XB_TMO])) break; if (sp > XB_SPIN_CAP) { atomicAdd(&bar[XB_TMO], 1u); break; } }
    }
    nloc = mine > 0u ? mine : 1u; nx = cnt > 0u ? cnt : 1u;
}

__device__ __forceinline__ void xcd_barrier(const XcdBarrier& b) {
    asm volatile("s_waitcnt vmcnt(0)" ::: "memory");
    __syncthreads();
    if (threadIdx.x == 0) {
        unsigned* bar = b.bar;
        __builtin_amdgcn_s_waitcnt(0);
        unsigned nloc = b.st[0], nx = b.st[1];
        if (nloc == 0u) { xcd_barrier_complete(bar, b.x, nloc, nx); b.st[0] = nloc; b.st[1] = nx; }
        const unsigned old = xb_add(&bar[XB_XSUB(b.x)], 1u);
        const unsigned gen = old / nloc;
        if (old + 1u == (gen + 1u) * nloc) {
            __builtin_amdgcn_fence(__ATOMIC_RELEASE, "agent");
            asm volatile("s_waitcnt vmcnt(0)" ::: "memory");
            const unsigned og = xb_add(&bar[XB_TOP], 1u);
            const unsigned tg = og / nx;
            if (og + 1u == (tg + 1u) * nx) xb_add(&bar[XB_TOPGEN], 1u);
            else XB_SPIN(xb_ld(&bar[XB_TOPGEN]) == tg, bar);
            __builtin_amdgcn_fence(__ATOMIC_ACQUIRE, "agent");
            xb_add(&bar[XB_XGEN(b.x)], 1u);
            asm volatile("s_waitcnt vmcnt(0)" ::: "memory");
        } else {
            XB_SPIN(xb_ld(&bar[XB_XGEN(b.x)]) == gen, bar);
            __builtin_amdgcn_fence(__ATOMIC_ACQUIRE, "agent");
            asm volatile("s_waitcnt vmcnt(0)" ::: "memory");
        }
    }
    __syncthreads();
}

template <int MODE> __device__ __forceinline__ int srccol(int n) {
    if (MODE == 0) return n;
    if (MODE == 2) return ((n & 16) ? DFF : 0) + 16 * (n >> 5) + (n & 15);
    if (n < 1536) return n;
    if (n < 1920) return 1544 + (n - 1536);
    if (n < 2176) return 1928 + (n - 1920);
    if (n < 2208) return 2184 + (n - 2176);
    if (n < 2216) return 1536 + (n - 2208);
    return -1;
}
template <int MODE>
__device__ __forceinline__ void tr_item(const float* W, int K, int Nsrc, int Ndst, bf16* WT, int row_off, LAS float* scr, int item, int lane) {
    const int nblk = Ndst / 32, kb = item / nblk, nb = item % nblk, k0 = 64 * kb, n0 = 32 * nb;
    const int sc = srccol<MODE>(n0 + (lane & 31));
#pragma unroll 8
    for (int i = 0; i < 32; ++i) { const int kk = 2 * i + (lane >> 5); scr[kk * 33 + (lane & 31)] = sc >= 0 ? W[(size_t)(k0 + kk) * Nsrc + sc] : 0.f; }
    lds_wait();
    const int c = lane & 7;
#pragma unroll
    for (int j = 0; j < 4; ++j) { const int n = (lane >> 3) + 8 * j; const LAS float* s = scr + (8 * c) * 33 + n;
        u32x4 o; o.x = pk2(s[0 * 33], s[1 * 33]); o.y = pk2(s[2 * 33], s[3 * 33]); o.z = pk2(s[4 * 33], s[5 * 33]); o.w = pk2(s[6 * 33], s[7 * 33]);
        *(u32x4*)(WT + (size_t)(row_off + n0 + n) * K + k0 + 8 * c) = o; }
    lds_wait();
}
template <bool OUTF>
__device__ __forceinline__ void rms_row(const float* xrow, const float* g, void* orow, int lane, const float* slab = nullptr, int nslab = 0, size_t slab_stride = 0) {
    const f32x4* xr = (const f32x4*)xrow + lane; const f32x4* gr = (const f32x4*)g + lane;
    f32x4 v[4]; float s = 0.f;
#pragma unroll
    for (int j = 0; j < 4; ++j) v[j] = xr[64 * j];
    for (int k = 0; k < nslab; ++k) { const f32x4* sr = (const f32x4*)(slab + (size_t)k * slab_stride) + lane;
#pragma unroll
        for (int j = 0; j < 4; ++j) v[j] += sr[64 * j]; }
#pragma unroll
    for (int j = 0; j < 4; ++j) { s += (v[j].x * v[j].x + v[j].y * v[j].y) + (v[j].z * v[j].z + v[j].w * v[j].w); }
    const float rstd = rsqrtf(wave_sum(s) * (1.f / DM) + EPS);
#pragma unroll
    for (int j = 0; j < 4; ++j) { const f32x4 gv = gr[64 * j]; const f32x4 o = v[j] * rstd * gv;
        if (OUTF) ((f32x4*)orow)[64 * j + lane] = o;
        else ((u32x2*)orow)[64 * j + lane] = (u32x2){pk2(o.x, o.y), pk2(o.z, o.w)}; }
}
__device__ __forceinline__ void cvt_stream(const float* src, bf16* dst, size_t n4, size_t gtid, size_t gthreads) {
    size_t i = gtid;
    for (; i + 7 * gthreads < n4; i += 8 * gthreads) {
        f32x4 v[8];
#pragma unroll
        for (int k = 0; k < 8; ++k) v[k] = __builtin_nontemporal_load((const f32x4*)src + i + k * gthreads);
#pragma unroll
        for (int k = 0; k < 8; ++k) ((u32x2*)dst)[i + k * gthreads] = (u32x2){pk2(v[k].x, v[k].y), pk2(v[k].z, v[k].w)};
    }
    for (; i < n4; i += gthreads) { const f32x4 v = ((const f32x4*)src)[i]; ((u32x2*)dst)[i] = (u32x2){pk2(v.x, v.y), pk2(v.z, v.w)}; }
}
__device__ __forceinline__ float wave_incl_scan(float v, int lane) {
#pragma unroll
    for (int o = 1; o < 64; o <<= 1) { const float t = __shfl_up(v, o); if (lane >= o) v += t; }
    return v;
}

template <int NCH>
__device__ __forceinline__ void scan_seq(const float* src, float* dst, float base, int lane, LAS float* scr) {
    float v[NCH];
#pragma unroll
    for (int c = 0; c < NCH; ++c) v[c] = src[(size_t)(64 * c + lane) * 8];
#pragma unroll
    for (int c = 0; c < NCH; ++c) { v[c] = wave_incl_scan(v[c], lane); if (lane == 63) scr[c] = v[c]; }
    lds_wait();
    const float st = wave_incl_scan(lane < NCH ? scr[lane] : 0.f, lane);
    lds_wait();
#pragma unroll
    for (int c = 0; c < NCH; ++c) { const float carry = c ? __builtin_bit_cast(float, __builtin_amdgcn_readlane(__builtin_bit_cast(int, st), c ? c - 1 : 0)) : 0.f; dst[64 * c + lane] = (v[c] + carry + base) * LOG2E; }
}
__device__ __forceinline__ void p0_prologue(const Args& A, LAS unsigned char* lds) {
    const int tid = threadIdx.x, lane = tid & 63, wave = tid >> 6;
    const int G = gridDim.x, gw = blockIdx.x * NWAVES + wave, NGW = G * NWAVES;
    unsigned char* ws = A.ws;
    LAS float* scr = (LAS float*)(lds + wave * 16384);
    constexpr int I_IN = (DM / 64) * (NZ / 32), I_Q = (384 / 64) * (768 / 32), I_UK = (256 / 64) * (512 / 32), I_OUT = (DM / 64) * (DM / 32),
                  I_UP = (DM / 64) * (DFF2 / 32), I_DN = (DFF / 64) * (DM / 32);
    constexpr int NITEMS = I_IN + I_Q + 2 * I_UK + I_OUT + I_UP + I_DN;
    for (int it = gw; it < NITEMS; it += NGW) {
        int r = it;
        if (r < I_IN) { tr_item<1>(A.in[9], DM, DIN, NZ, (bf16*)(ws + WS_WIN), 0, scr, r, lane); continue; } r -= I_IN;
        if (r < I_Q) { tr_item<0>(A.in[12], 384, 768, 768, (bf16*)(ws + WS_WQ), 0, scr, r, lane); continue; } r -= I_Q;
        if (r < I_UK) { tr_item<0>(A.in[14], 256, 512, 512, (bf16*)(ws + WS_WKV), 0, scr, r, lane); continue; } r -= I_UK;
        if (r < I_UK) { tr_item<0>(A.in[15], 256, 512, 512, (bf16*)(ws + WS_WKV), 512, scr, r, lane); continue; } r -= I_UK;
        if (r < I_OUT) { tr_item<0>(A.in[16], DM, DM, DM, (bf16*)(ws + WS_WOUT), 0, scr, r, lane); continue; } r -= I_OUT;
        if (r < I_UP) { tr_item<2>(A.in[18], DM, DFF2, DFF2, (bf16*)(ws + WS_WUP), 0, scr, r, lane); continue; } r -= I_UP;
        tr_item<0>(A.in[21], DFF, DM, DM, (bf16*)(ws + WS_WDOWN), 0, scr, r, lane);
    }
    for (int it = gw; it < 8 * 12 * 8; it += NGW) {
        const int h = it / 96, kt = (it % 96) / 8, ct = it % 8; const int r32 = lane & 31, hi2 = lane >> 5;
        const float* wq = A.in[12] + (size_t)(kt * 32 + r32) * 768 + h * 96 + 8 * hi2; const float* uk = A.in[14] + (size_t)(ct * 32 + r32) * 512 + h * 64 + 8 * hi2;
        f32x16 acc = {};
#pragma unroll
        for (int st = 0; st < 4; ++st) {
            const f32x4 a0 = *(const f32x4*)(wq + 16 * st), a1 = *(const f32x4*)(wq + 16 * st + 4), b0 = *(const f32x4*)(uk + 16 * st), b1 = *(const f32x4*)(uk + 16 * st + 4);
            const u32x4 aw = {pk2(a0.x, a0.y), pk2(a0.z, a0.w), pk2(a1.x, a1.y), pk2(a1.z, a1.w)}, bw = {pk2(b0.x, b0.y), pk2(b0.z, b0.w), pk2(b1.x, b1.y), pk2(b1.z, b1.w)};
            acc = __builtin_amdgcn_mfma_f32_32x32x16_bf16(__builtin_bit_cast(bf16x8, aw), __builtin_bit_cast(bf16x8, bw), acc, 0, 0, 0);
        }
        bf16* o = (bf16*)(ws + WS_WQA) + (size_t)(h * 256 + ct * 32 + r32) * 384 + kt * 32 + 4 * hi2;
#pragma unroll
        for (int q = 0; q < 4; ++q) st_bf4(o + 8 * q, (f32x4){acc[4 * q], acc[4 * q + 1], acc[4 * q + 2], acc[4 * q + 3]});
    }
    for (int m = gw; m < TOK; m += NGW) {
        const float* xr = m < TP ? A.in[0] + (size_t)m * DM : A.in[1] + (size_t)(m - TP) * DM;
        rms_row<false>(xr, A.in[8], (bf16*)(ws + WS_H) + (size_t)m * DM, lane);
    }
    {
        const int gt = blockIdx.x * NTHREADS + tid, GT = G * NTHREADS;
        for (int i = gt; i < 2112 * 16; i += GT) {
            const int pidx = i >> 4, k = i & 15; const int pos = pidx < 2048 ? pidx : PAST + (pidx - 2048);
            const float inv = exp2f(-(float)k * (13.287712379549449f / 16.f));
            const float ang = (float)pos * inv;
            const float kq = floorf(ang * 0.15915494309189535f);
            float r = fmaf(-kq, 6.2831854820251465f, ang); r = fmaf(-kq, -1.7484555e-7f, r);
            const float rev = r * 0.15915494309189535f;
            ((f32x2*)(ws + WS_CS))[i] = (f32x2){__builtin_amdgcn_cosf(rev), __builtin_amdgcn_sinf(rev)};
        }
    }
    for (int sq = gw; sq < NBS * 8; sq += NGW) {
        const int b = sq >> 3, h = sq & 7; const float* lf = A.in[4] + (size_t)b * PAST * 8 + h; float* Fo = (float*)(ws + WS_FS) + (size_t)sq * KVS;
        scan_seq<PAST / 64>(lf, Fo, 0.f, lane, scr);
    }
    {
        const size_t gt = (size_t)blockIdx.x * NTHREADS + tid, GT = (size_t)G * NTHREADS;
        cvt_stream(A.in[5], (bf16*)(ws + WS_LATPAST), (size_t)NPAST * 256 / 4, gt, GT);
        cvt_stream(A.in[6], (bf16*)(ws + WS_KRPAST), (size_t)NPAST * 32 / 4, gt, GT);
    }
}

__device__ __forceinline__ void rope4(f32x4& x1, f32x4& x2, const float* cs  ) {
    const f32x4 a = ((const f32x4*)cs)[0], b = ((const f32x4*)cs)[1];
    const f32x4 c = {a.x, a.z, b.x, b.z}, s = {a.y, a.w, b.y, b.w};
    const f32x4 o1 = x1 * c - x2 * s, o2 = x1 * s + x2 * c; x1 = o1; x2 = o2;
}
__device__ __forceinline__ float log_sigmoid(float x) { return fminf(x, 0.f) - log1pf(__expf(-fabsf(x))); }

struct EpiZ {
    static constexpr bool PERM = false, AFTER_DRAIN = false;
    bf16 *qfox, *knew, *vnew, *krnew; float* zbuf; float* out; const float* cs; const float* bfg;
    __device__ __forceinline__ void operator()(const f32x4 (&acc)[2][2][4][2], const pg8::Unit& u, int wr, int wc, int fr, int fq) const {
        const bool smp = u.pm >= TP / 256;
        const int row0 = u.pm * 256 + wr * 64 + fr;
#pragma unroll
        for (int bj = 0; bj < 2; ++bj) {
            const int cg = u.pn * 256 + bj * 128 + wc * 32;
            const int c0 = cg + 4 * fq;
#pragma unroll
            for (int ai = 0; ai < 2; ++ai)
#pragma unroll
                for (int m = 0; m < 4; ++m) {
                    const int row = row0 + ai * 128 + m * 16; const size_t lr = smp ? (size_t)(row - TP) : (size_t)row;
                    f32x4 v0 = acc[ai][bj][m][0], v1 = acc[ai][bj][m][1];
                    if (cg < 512) { const float sc = 0.125f * LOG2E; st_bf4(qfox + (size_t)row * 512 + c0, v0 * sc); st_bf4(qfox + (size_t)row * 512 + c0 + 16, v1 * sc); }
                    else if (cg < 1024) { const int c = c0 - 512; float* o = out + (smp ? O_KS : O_KP) + lr * 512 + c; *(f32x4*)o = v0; *(f32x4*)(o + 16) = v1;
                        st_bf4(knew + (size_t)row * 512 + c, v0); st_bf4(knew + (size_t)row * 512 + c + 16, v1); }
                    else if (cg < 1536) { const int c = c0 - 1024; float* o = out + (smp ? O_VS : O_VP) + lr * 512 + c; *(f32x4*)o = v0; *(f32x4*)(o + 16) = v1;
                        st_bf4(vnew + (size_t)row * 512 + c, v0); st_bf4(vnew + (size_t)row * 512 + c + 16, v1); }
                    else if (cg < 2176) { float* z = zbuf + (size_t)row * ZW + (c0 - 1536); *(f32x4*)z = v0; *(f32x4*)(z + 16) = v1; }
                    else if (cg == 2176) {
                        const int pidx = smp ? 2048 + ((row - TP) & 63) : (row & 2047);
                        rope4(v0, v1, cs + ((size_t)pidx * 16 + 4 * fq) * 2);
                        float* o = out + (smp ? O_KRS : O_KRP) + lr * 32 + 4 * fq; *(f32x4*)o = v0; *(f32x4*)(o + 16) = v1;
                        st_bf4(krnew + (size_t)row * 32 + 4 * fq, v0); st_bf4(krnew + (size_t)row * 32 + 4 * fq + 16, v1);
                    } else if (cg == 2208) {
                        if (fq < 2) { const f32x4 b = *(const f32x4*)(bfg + 4 * fq);
                            f32x4 lf; lf.x = log_sigmoid(v0.x + b.x); lf.y = log_sigmoid(v0.y + b.y); lf.z = log_sigmoid(v0.z + b.z); lf.w = log_sigmoid(v0.w + b.w);
                            *(f32x4*)(out + (smp ? O_LFS : O_LFP) + lr * 8 + 4 * fq) = lf; }
                    }
                }
        }
    }
};
struct EpiBf {
    static constexpr bool PERM = true, AFTER_DRAIN = false;
    bf16* O; int ldc; float sc;
    __device__ __forceinline__ void operator()(const f32x4 (&acc)[2][2][4][2], const pg8::Unit& u, int wr, int wc, int fr, int fq) const {
        const int row0 = u.pm * 256 + wr * 64 + fr;
#pragma unroll
        for (int ai = 0; ai < 2; ++ai)
#pragma unroll
            for (int m = 0; m < 4; ++m) { bf16* rp = O + (size_t)(row0 + ai * 128 + m * 16) * ldc + u.pn * 256 + wc * 32 + 8 * fq;
#pragma unroll
                for (int bj = 0; bj < 2; ++bj) { const f32x4 v0 = acc[ai][bj][m][0] * sc, v1 = acc[ai][bj][m][1] * sc;
                    *(u32x4*)(rp + bj * 128) = (u32x4){pk2(v0.x, v0.y), pk2(v0.z, v0.w), pk2(v1.x, v1.y), pk2(v1.z, v1.w)}; } }
    }
};
constexpr int DN_SL = 8;
template <int NKT  >
struct SplitOrder {
    int G, c;
    __device__ __forceinline__ bool next(int i, pg8::Unit& u) const {
        const int L = i * G + c; if (L >= 256 + 32 * DN_SL) return false;
        const bool full = L < 256; const int r = full ? L : L - 256, x = r & 7, y = r >> 3;
        pg8::Unit t; t.pm = full ? 8 * x + (y & 7) : 64 + x; t.pn = full ? (y >> 3) : (y & 3); const int sl = y >> 2;
        if (NKT == 44) { t.k0 = full ? 0 : (sl < 6 ? 6 * sl : 36 + 4 * (sl - 6)); t.nkt = full ? 44 : (sl < 6 ? 6 : 4); }
        else { t.k0 = full ? 0 : 2 * sl; t.nkt = full ? 16 : 2; }
        t.sl = full ? -1 : sl;
        u = t; return true;
    }
    __device__ __forceinline__ void a_ready(const pg8::Unit&) const {}
    __device__ __forceinline__ void done(const pg8::Unit&) const {}
};
typedef SplitOrder<44> DownOrder;
struct EpiDown {
    static constexpr bool PERM = false, AFTER_DRAIN = false;
    const float* x1; float* x2; float* slab;
    __device__ __forceinline__ void operator()(const f32x4 (&acc)[2][2][4][2], const pg8::Unit& u, int wr, int wc, int fr, int fq) const {
        const int row0 = u.pm * 256 + wr * 64 + fr; const bool part = u.sl >= 0;
#pragma unroll
        for (int ai = 0; ai < 2; ++ai)
#pragma unroll
            for (int m = 0; m < 4; ++m) { const int row = row0 + ai * 128 + m * 16; const int cb = u.pn * 256 + wc * 32 + 4 * fq;
                if (part) { float* op = slab + ((size_t)u.sl * TS + (row - TP)) * DM + cb;
#pragma unroll
                    for (int bj = 0; bj < 2; ++bj)
#pragma unroll
                        for (int n = 0; n < 2; ++n) *(f32x4*)(op + bj * 128 + n * 16) = acc[ai][bj][m][n]; }
                else { const float* bp = x1 + (size_t)row * DM + cb; float* op = x2 + (size_t)row * DM + cb;
#pragma unroll
                    for (int bj = 0; bj < 2; ++bj)
#pragma unroll
                        for (int n = 0; n < 2; ++n) *(f32x4*)(op + bj * 128 + n * 16) = *(const f32x4*)(bp + bj * 128 + n * 16) + acc[ai][bj][m][n]; } }
    }
};
struct EpiOut {
    static constexpr bool PERM = false, AFTER_DRAIN = false;
    const float* b0; const float* b1; float* O; bf16* H; const float* g; float* rowss; float* slab;
    __device__ __forceinline__ void operator()(const f32x4 (&acc)[2][2][4][2], const pg8::Unit& u, int wr, int wc, int fr, int fq) const {
        const int row0 = u.pm * 256 + wr * 64 + fr; const bool smp = u.pm >= TP / 256; const int cb = u.pn * 256 + wc * 32 + 4 * fq;
        if (u.sl >= 0) {
#pragma unroll
            for (int ai = 0; ai < 2; ++ai)
#pragma unroll
                for (int m = 0; m < 4; ++m) { float* sp = slab + ((size_t)u.sl * TS + (row0 + ai * 128 + m * 16 - TP)) * DM + cb;
#pragma unroll
                    for (int bj = 0; bj < 2; ++bj)
#pragma unroll
                        for (int n = 0; n < 2; ++n) *(f32x4*)(sp + bj * 128 + n * 16) = acc[ai][bj][m][n]; }
            return;
        }
        f32x4 gv[2][2];
#pragma unroll
        for (int bj = 0; bj < 2; ++bj)
#pragma unroll
            for (int n = 0; n < 2; ++n) gv[bj][n] = *(const f32x4*)(g + cb + bj * 128 + n * 16);
#pragma unroll
        for (int ai = 0; ai < 2; ++ai)
#pragma unroll
            for (int m = 0; m < 4; ++m) { const int row = row0 + ai * 128 + m * 16;
                const float* bp = (smp ? b1 + (size_t)(row - TP) * DM : b0 + (size_t)row * DM) + cb; float* op = O + (size_t)row * DM + cb; bf16* hp = H + (size_t)row * DM + cb;
                float ss = 0.f;
#pragma unroll
                for (int bj = 0; bj < 2; ++bj)
#pragma unroll
                    for (int n = 0; n < 2; ++n) { const f32x4 x = *(const f32x4*)(bp + bj * 128 + n * 16) + acc[ai][bj][m][n]; *(f32x4*)(op + bj * 128 + n * 16) = x;
                        ss += (x.x * x.x + x.y * x.y) + (x.z * x.z + x.w * x.w); st_bf4(hp + bj * 128 + n * 16, x * gv[bj][n]); }
                ss += __shfl_xor(ss, 16); ss += __shfl_xor(ss, 32);
                if (fq == 0) rowss[(size_t)row * 16 + u.pn * 4 + wc] = ss;
            }
    }
};
struct EpiRes {
    static constexpr bool PERM = false, AFTER_DRAIN = false;
    const float* b0; const float* b1; float* O;
    __device__ __forceinline__ void operator()(const f32x4 (&acc)[2][2][4][2], const pg8::Unit& u, int wr, int wc, int fr, int fq) const {
        const int row0 = u.pm * 256 + wr * 64 + fr; const bool smp = u.pm >= TP / 256;
#pragma unroll
        for (int ai = 0; ai < 2; ++ai)
#pragma unroll
            for (int m = 0; m < 4; ++m) { const int row = row0 + ai * 128 + m * 16; const int cb = u.pn * 256 + wc * 32 + 4 * fq;
                const float* bp = (smp ? b1 + (size_t)(row - TP) * DM : b0 + (size_t)row * DM) + cb; float* op = O + (size_t)row * DM + cb;
#pragma unroll
                for (int bj = 0; bj < 2; ++bj)
#pragma unroll
                    for (int n = 0; n < 2; ++n) *(f32x4*)(op + bj * 128 + n * 16) = *(const f32x4*)(bp + bj * 128 + n * 16) + acc[ai][bj][m][n]; }
    }
};


__device__ __forceinline__ float silu(float g) { return g * __builtin_amdgcn_rcpf(1.f + fast_exp2(-g * LOG2E)); }
template <int CTRL> __device__ __forceinline__ float dpp_mov(float old, float src) {
    return __builtin_bit_cast(float, __builtin_amdgcn_update_dpp(__builtin_bit_cast(int, old), __builtin_bit_cast(int, src), CTRL, 0xf, 0xf, false)); }
__device__ __forceinline__ f32x4 rows_m1(f32x4 cur, f32x4 prev) { f32x4 o;
#pragma unroll
    for (int e = 0; e < 4; ++e) o[e] = dpp_mov<0x111>(dpp_mov<0x121>(0.f, prev[e]), cur[e]);
    return o; }
__device__ __forceinline__ f32x4 rows_m2(f32x4 cur, f32x4 prev) { f32x4 o;
#pragma unroll
    for (int e = 0; e < 4; ++e) o[e] = dpp_mov<0x112>(dpp_mov<0x122>(0.f, prev[e]), cur[e]);
    return o; }
struct EpiGlu {
    static constexpr bool PERM = false, AFTER_DRAIN = false;
    bf16* act; float* edge; const float* cw; const float* cb; const float* rowss;
    __device__ __forceinline__ void operator()(const f32x4 (&acc)[2][2][4][2], const pg8::Unit& u, int wr, int wc, int fr, int fq) const {
        float rstd[2][4];
#pragma unroll
        for (int ai = 0; ai < 2; ++ai)
#pragma unroll
            for (int m = 0; m < 4; ++m) { const f32x4* rp = (const f32x4*)(rowss + (size_t)(u.pm * 256 + ai * 128 + wr * 64 + m * 16 + fr) * 16);
                const f32x4 a = rp[0], b = rp[1], c = rp[2], d = rp[3]; const f32x4 t = (a + b) + (c + d);
                rstd[ai][m] = rsqrtf(((t.x + t.y) + (t.z + t.w)) * (1.f / DM) + EPS); asm volatile("" : "+v"(rstd[ai][m]) :: "memory"); }
#pragma unroll
        for (int bj = 0; bj < 2; ++bj) {
            const int j = 16 * ((u.pn * 256 + bj * 128 + wc * 32) >> 5) + 4 * fq;
            const f32x4 w0g = *(const f32x4*)(cw + j), w1g = *(const f32x4*)(cw + DFF2 + j), w2g = *(const f32x4*)(cw + 2 * DFF2 + j), bg = *(const f32x4*)(cb + j);
            const f32x4 w0v = *(const f32x4*)(cw + DFF + j), w1v = *(const f32x4*)(cw + DFF2 + DFF + j), w2v = *(const f32x4*)(cw + 2 * DFF2 + DFF + j), bv = *(const f32x4*)(cb + DFF + j);
#pragma unroll
            for (int ai = 0; ai < 2; ++ai) {
                const int blk = u.pm * 4 + ai * 2 + wr; const int row0 = blk * 64 + fr;
#pragma unroll
                for (int m = 0; m < 4; ++m) {
                    const f32x4 gc = acc[ai][bj][m][0] * rstd[ai][m], vc = acc[ai][bj][m][1] * rstd[ai][m];
                    const f32x4 gp = acc[ai][bj][m ? m - 1 : 0][0] * rstd[ai][m ? m - 1 : 0], vp = acc[ai][bj][m ? m - 1 : 0][1] * rstd[ai][m ? m - 1 : 0];
                    const f32x4 g1 = rows_m1(gc, gp), g2 = rows_m2(gc, gp), v1 = rows_m1(vc, vp), v2 = rows_m2(vc, vp);
                    const f32x4 g = bg + w0g * g2 + w1g * g1 + w2g * gc, v = bv + w0v * v2 + w1v * v1 + w2v * vc;
                    f32x4 a; a.x = silu(g.x) * v.x; a.y = silu(g.y) * v.y; a.z = silu(g.z) * v.z; a.w = silu(g.w) * v.w;
                    if (m > 0 || fr >= 2) st_bf4(act + (size_t)(row0 + 16 * m) * DFF + j, a);
                    if (m == 0 && fr < 2) { float* e = edge + ((size_t)blk * 4 + fr) * DFF2; *(f32x4*)(e + j) = gc; *(f32x4*)(e + DFF + j) = vc; }
                    if (m == 3 && fr >= 14) { float* e = edge + ((size_t)blk * 4 + 2 + (fr - 14)) * DFF2; *(f32x4*)(e + j) = gc; *(f32x4*)(e + DFF + j) = vc; }
                }
            }
        }
    }
};

__device__ __forceinline__ void p2_postz(const Args& A, LAS unsigned char* lds) {
    const int tid = threadIdx.x, lane = tid & 63, wave = tid >> 6; const int gw = blockIdx.x * NWAVES + wave, NGW = gridDim.x * NWAVES;
    unsigned char* ws = A.ws; const float* zb = (const float*)(ws + WS_ZBUF);
    for (int m = gw; m < TOK; m += NGW) {
        const float* z = zb + (size_t)m * ZW;
        { f32x2 v[3]; float s = 0.f;
#pragma unroll
          for (int j = 0; j < 3; ++j) { v[j] = ((const f32x2*)z)[lane + 64 * j]; s += v[j].x * v[j].x + v[j].y * v[j].y; }
          const float rstd = rsqrtf(wave_sum(s) * (1.f / 384.f) + EPS); unsigned* o = (unsigned*)((bf16*)(ws + WS_QCN) + (size_t)m * 384);
#pragma unroll
          for (int j = 0; j < 3; ++j) { const f32x2 g = ((const f32x2*)A.in[11])[lane + 64 * j]; o[lane + 64 * j] = pk2(v[j].x * rstd * g.x, v[j].y * rstd * g.y); } }
        { const f32x4 v = ((const f32x4*)(z + 384))[lane]; const float s = (v.x * v.x + v.y * v.y) + (v.z * v.z + v.w * v.w);
          const float rstd = rsqrtf(wave_sum(s) * (1.f / 256.f) + EPS); const f32x4 g = ((const f32x4*)A.in[13])[lane]; const f32x4 o = v * rstd * g;
          float* op = A.out + (m < TP ? O_LATP + (size_t)m * 256 : O_LATS + (size_t)(m - TP) * 256); ((f32x4*)op)[lane] = o;
          st_bf4((bf16*)(ws + WS_LATNEW) + (size_t)m * 256 + 4 * lane, o); }
    }
    for (int sq = gw; sq < 64 + 256; sq += NGW) {
        if (sq < 64) { const int b = sq >> 3, h = sq & 7; const float* lf = A.out + O_LFP + (size_t)b * SEQ * 8 + h; float* Fo = (float*)(ws + WS_FP) + (size_t)sq * SEQ; scan_seq<SEQ / 64>(lf, Fo, 0.f, lane, (LAS float*)(lds + wave * 16384)); }
        else { const int s2 = sq - 64, b = s2 >> 3, h = s2 & 7; const float* lf = A.out + O_LFS + (size_t)b * DSEQ * 8 + h; float* Fo = (float*)(ws + WS_FS) + (size_t)s2 * KVS;
            const float base = Fo[PAST - 1]; const float v = wave_incl_scan(lf[(size_t)lane * 8], lane); Fo[PAST + lane] = base + v * LOG2E; }
    }
}

__device__ __forceinline__ f32x4 ld_bf4(const bf16* p) { const u32x2 w = *(const u32x2*)p; return (f32x4){bflo(w.x), bfhi(w.x), bflo(w.y), bfhi(w.y)}; }
__device__ __forceinline__ void p8_fixup(const Args& A) {
    int tid = threadIdx.x; asm volatile("" : "+v"(tid)); const int lane = tid & 63, wave = tid >> 6; const int gw = blockIdx.x * NWAVES + wave, NGW = gridDim.x * NWAVES;
    unsigned char* ws = A.ws; const float* __restrict__ EDGE = (const float*)(ws + WS_EDGE); bf16* __restrict__ ACT = (bf16*)(ws + WS_ACT);
    const float* __restrict__ cw = A.in[19]; const float* __restrict__ cb = A.in[20];
    constexpr int NBLK = TOK / 64, NSTRIP = DFF / 256, NIT = NBLK * NSTRIP;
    for (int it0 = gw; it0 < NIT; it0 += 2 * NGW) {
        f32x4 wg[2][4], wv[2][4], pg[2][2], pv[2][2], cg[2][2], cv[2][2], sg[2][2], sv[2][2]; bool ok[2], last[2], smp[2]; int j0[2], tok0[2], bb[2];
#pragma unroll
        for (int u = 0; u < 2; ++u) {
            const int it = it0 + u * NGW; ok[u] = it < NIT; const int itc = ok[u] ? it : it0;
            const int blk = itc / NSTRIP, strip = itc % NSTRIP; j0[u] = strip * 256 + lane * 4; tok0[u] = blk * 64;
            smp[u] = tok0[u] >= TP; const int T = smp[u] ? DSEQ : SEQ; const int lt = smp[u] ? tok0[u] - TP : tok0[u]; bb[u] = lt / T; const int t0 = lt % T; last[u] = (t0 + 64 == T);
#pragma unroll
            for (int k = 0; k < 3; ++k) { wg[u][k] = *(const f32x4*)(cw + k * DFF2 + j0[u]); wv[u][k] = *(const f32x4*)(cw + k * DFF2 + DFF + j0[u]); }
            wg[u][3] = *(const f32x4*)(cb + j0[u]); wv[u][3] = *(const f32x4*)(cb + DFF + j0[u]);
            const float* pe = (t0 == 0) ? (smp[u] ? A.in[7] + (size_t)bb[u] * 2 * DFF2 : EDGE  ) : EDGE + ((size_t)(blk - 1) * 4 + 2) * DFF2;
            const bool zero = (t0 == 0) && !smp[u];
#pragma unroll
            for (int i = 0; i < 2; ++i) { pg[u][i] = *(const f32x4*)(pe + i * DFF2 + j0[u]); pv[u][i] = *(const f32x4*)(pe + i * DFF2 + DFF + j0[u]);
                if (zero) { pg[u][i] = (f32x4){0.f, 0.f, 0.f, 0.f}; pv[u][i] = (f32x4){0.f, 0.f, 0.f, 0.f}; }
                const float* e = EDGE + ((size_t)blk * 4 + i) * DFF2; cg[u][i] = *(const f32x4*)(e + j0[u]); cv[u][i] = *(const f32x4*)(e + DFF + j0[u]);
                const float* e2 = EDGE + ((size_t)blk * 4 + 2 + i) * DFF2; sg[u][i] = *(const f32x4*)(e2 + j0[u]); sv[u][i] = *(const f32x4*)(e2 + DFF + j0[u]); }
        }
#pragma unroll
        for (int u = 0; u < 2; ++u) if (ok[u]) {
            f32x4 g2 = pg[u][0], g1 = pg[u][1], v2 = pv[u][0], v1 = pv[u][1];
#pragma unroll
            for (int i = 0; i < 2; ++i) {
                const f32x4 gc = cg[u][i], vc = cv[u][i];
                const f32x4 g = wg[u][3] + wg[u][0] * g2 + wg[u][1] * g1 + wg[u][2] * gc, v = wv[u][3] + wv[u][0] * v2 + wv[u][1] * v1 + wv[u][2] * vc;
                f32x4 a; a.x = silu(g.x) * v.x; a.y = silu(g.y) * v.y; a.z = silu(g.z) * v.z; a.w = silu(g.w) * v.w;
                st_bf4(ACT + (size_t)(tok0[u] + i) * DFF + j0[u], a);
                g2 = g1; g1 = gc; v2 = v1; v1 = vc;
            }
            if (last[u]) {
#pragma unroll
                for (int i = 0; i < 2; ++i) { float* o = A.out + (smp[u] ? O_CVS : O_CVP) + ((size_t)bb[u] * 2 + i) * DFF2; *(f32x4*)(o + j0[u]) = sg[u][i]; *(f32x4*)(o + DFF + j0[u]) = sv[u][i]; }
            }
        }
    }
}

struct AttnArgs {
    const bf16* Q; int qstride;
    const void *Ka_past, *Ka_new; int kastride;
    const bf16 *Kb_past, *Kb_new; int kbstride;
    const void *V_past, *V_new; int vstride;
    const float *Fq, *Fk;
    bf16* O; int ostride;
    int P, qpos0, nkv;
    const float* cs;
};
__device__ __forceinline__ int crow(int r, int hi) { return (r & 3) + 8 * (r >> 2) + 4 * hi; }
__device__ __forceinline__ s16x4 tr_read(const LAS unsigned char* p) { typedef short v4i16 __attribute__((ext_vector_type(4))); return __builtin_bit_cast(s16x4, __builtin_amdgcn_ds_read_tr16_b64_v4i16((LAS v4i16*)p)); }

template <int DQK, bool FOX, int QS, int KS, bool F32>
__device__ __forceinline__ void attn_unit(const AttnArgs& a, LAS unsigned char* lds_base) {
    LAS unsigned char* const lds = lds_base;
    static_assert(QS * KS == NWAVES, "8 waves");
    constexpr int KRB = (DQK + 8) * 2, VRB = 144, NKK = DQK / 16;
    constexpr int OFF_V = 64 * KS * KRB, OFF_F = OFF_V + 64 * KS * VRB, OFF_Q = OFF_F + 64 * KS * 4, OFF_END = OFF_Q + QS * NKK * 1024;
    constexpr bool QLDS = KS > 1;
    static_assert(OFF_END <= 131072, "attention LDS");
    int tid = threadIdx.x; asm volatile("" : "+v"(tid));
    const int lane = tid & 63, q32 = lane & 31, hi = lane >> 5; const int wid = __builtin_amdgcn_readfirstlane(tid >> 6);
    const int qs = wid % QS, ks = wid / QS;
    const int NT = (a.nkv + 64 * KS - 1) / (64 * KS);
    const int qmin = a.qpos0 + qs * 32, qpos = qmin + q32;
    bf16x8 qf[NKK];
    { const bf16* qp = a.Q + (size_t)(qs * 32 + q32) * a.qstride + hi * 8;
#pragma unroll
      for (int kk = 0; kk < NKK; ++kk) qf[kk] = *(const bf16x8*)(qp + kk * 16); }
    if (DQK == 96) {
        const int pidx = qpos < SEQ ? qpos : SEQ + (qpos - PAST);
        const f32x4* cp = (const f32x4*)(a.cs + ((size_t)pidx * 16 + 8 * hi) * 2);
        const u32x4 w1 = __builtin_bit_cast(u32x4, qf[NKK - 2]), w2 = __builtin_bit_cast(u32x4, qf[NKK - 1]); u32x4 r1, r2;
#pragma unroll
        for (int j = 0; j < 4; ++j) { const f32x4 c = cp[j];
            const float a0 = bflo(w1[j]), a1 = bfhi(w1[j]), b0 = bflo(w2[j]), b1 = bfhi(w2[j]);
            r1[j] = pk2(a0 * c.x - b0 * c.y, a1 * c.z - b1 * c.w); r2[j] = pk2(a0 * c.y + b0 * c.x, a1 * c.w + b1 * c.z); }
        qf[NKK - 2] = __builtin_bit_cast(bf16x8, r1); qf[NKK - 1] = __builtin_bit_cast(bf16x8, r2);
    }
    LAS unsigned char* qlds = lds + OFF_Q + qs * (NKK * 1024) + lane * 16;
    if (QLDS) {
#pragma unroll
        for (int kk = 0; kk < NKK; ++kk) *(LAS bf16x8*)(qlds + kk * 1024) = qf[kk];
    }
    const float fqv = FOX ? a.Fq[qs * 32 + q32] : 0.f;
    float mrun = -1e30f, lsum = 0.f; f32x16 o0 = {}, o1 = {};
    u32x4 rka[KS], rv[F32 ? 1 : KS]; u32x4 rkb[(DQK == 96) ? (KS + 1) / 2 : 1]; float rf = 0.f;
    f32x4 fka[F32 ? KS : 1][2], fva[F32 ? KS : 1][2];
    const int lrow = tid >> 3, lch = tid & 7;
    const int brow = (tid & 255) >> 2, bch = tid & 3;
    auto load_k = [&](int T) {
        const int jT = T * KS * 64; const bool past = jT < a.P; const size_t r0 = (size_t)(past ? jT : jT - a.P);
        if (F32) { const float* kp = (const float*)(past ? a.Ka_past : a.Ka_new) + (r0 + lrow) * a.kastride + lch * 8;
#pragma unroll
            for (int s = 0; s < KS; ++s) if (jT + s * 64 < a.nkv) { const f32x4* p4 = (const f32x4*)(kp + (size_t)s * 64 * a.kastride); fka[F32 ? s : 0][0] = p4[0]; fka[F32 ? s : 0][1] = p4[1]; } }
        else { const bf16* kp = (const bf16*)(past ? a.Ka_past : a.Ka_new) + (r0 + lrow) * a.kastride + lch * 8;
#pragma unroll
            for (int s = 0; s < KS; ++s) if (jT + s * 64 < a.nkv) rka[s] = *(const u32x4*)(kp + (size_t)s * 64 * a.kastride); }
        if (DQK == 96) { const bf16* bp = (past ? a.Kb_past : a.Kb_new) + (r0 + (tid >> 8) * 64 + brow) * a.kbstride + bch * 8;
#pragma unroll
            for (int i = 0; i < (KS + 1) / 2; ++i) { const int s = 2 * i + (tid >> 8); if (s < KS && jT + s * 64 < a.nkv) rkb[i] = *(const u32x4*)(bp + (size_t)i * 128 * a.kbstride); }
        }
        if (FOX) { const int j = jT + tid; if (tid < 64 * KS && j < a.nkv) rf = a.Fk[j]; }
    };
    auto cvt_k = [&]() {
        if (F32) {
#pragma unroll
            for (int s = 0; s < KS; ++s) { const f32x4 k0 = fka[F32 ? s : 0][0], k1 = fka[F32 ? s : 0][1]; rka[s] = (u32x4){pk2(k0.x, k0.y), pk2(k0.z, k0.w), pk2(k1.x, k1.y), pk2(k1.z, k1.w)}; }
        }
    };
    auto load_v = [&](int T) {
        const int jT = T * KS * 64; const bool past = jT < a.P; const size_t r0 = (size_t)(past ? jT : jT - a.P);
        if (F32) { const float* vp = (const float*)(past ? a.V_past : a.V_new) + (r0 + lrow) * a.vstride + lch * 8;
#pragma unroll
            for (int s = 0; s < KS; ++s) if (jT + s * 64 < a.nkv) { const f32x4* p4 = (const f32x4*)(vp + (size_t)s * 64 * a.vstride); fva[F32 ? s : 0][0] = p4[0]; fva[F32 ? s : 0][1] = p4[1]; } }
        else { const bf16* vp = (const bf16*)(past ? a.V_past : a.V_new) + (r0 + lrow) * a.vstride + lch * 8;
#pragma unroll
            for (int s = 0; s < KS; ++s) if (jT + s * 64 < a.nkv) rv[F32 ? 0 : s] = *(const u32x4*)(vp + (size_t)s * 64 * a.vstride); }
    };
    constexpr bool DB = (KS == 1);
    static_assert(!DB || OFF_Q <= 32768, "double buffer stride");
    auto store_tile = [&](int T) {
        LAS unsigned char* const lds = lds_base + (DB ? (T & 1) * 32768 : 0);
#pragma unroll
        for (int s = 0; s < KS; ++s) { const int j0 = (T * KS + s) * 64;
            if (j0 < a.nkv) {
                *(LAS u32x4*)(lds + (s * 64 + lrow) * KRB + lch * 16) = rka[s];
                if (F32) { const f32x4 v0 = fva[F32 ? s : 0][0], v1 = fva[F32 ? s : 0][1];
                    *(LAS u32x4*)(lds + OFF_V + (s * 64 + lrow) * VRB + lch * 16) = (u32x4){pk2(v0.x, v0.y), pk2(v0.z, v0.w), pk2(v1.x, v1.y), pk2(v1.z, v1.w)}; }
                else *(LAS u32x4*)(lds + OFF_V + (s * 64 + lrow) * VRB + lch * 16) = rv[F32 ? 0 : s]; } }
        if (DQK == 96) {
#pragma unroll
            for (int i = 0; i < (KS + 1) / 2; ++i) { const int s = 2 * i + (tid >> 8); const int j0 = (T * KS + s) * 64;
                if (s < KS && j0 < a.nkv) *(LAS u32x4*)(lds + (s * 64 + brow) * KRB + 128 + bch * 16) = rkb[i]; }
        }
        if (FOX) { if (tid < 64 * KS) *(LAS float*)(lds + OFF_F + tid * 4) = rf; }
    };
    load_k(0); cvt_k(); load_v(0);
    const LAS unsigned char* kbase0 = lds + (ks * 64 + q32) * KRB + hi * 16;
    const LAS unsigned char* vbase0 = lds + OFF_V + (ks * 64 + 4 * hi + ((lane & 15) >> 2)) * VRB + (16 * ((lane >> 4) & 1) + 4 * (lane & 3)) * 2;
    const LAS unsigned char* fbase0 = lds + OFF_F + (ks * 64 + 4 * hi) * 4;
    if (DB) { store_tile(0); __syncthreads(); }
    for (int T = 0; T < NT; ++T) {
        if (!DB) { __syncthreads(); store_tile(T); __syncthreads(); }
        const int bo = DB ? (T & 1) * 32768 : 0;
        const LAS unsigned char* kbase = kbase0 + bo; const LAS unsigned char* vbase = vbase0 + bo; const LAS unsigned char* fbase = fbase0 + bo;
        if (T + 1 < NT) load_k(T + 1);
        __builtin_amdgcn_sched_barrier(0);
        const int tt = T * KS + ks; const int j0 = tt * 64;
        const bool valid = (j0 < a.nkv) && (FOX ? (j0 <= qmin + 31) : (tt <= (qmin >> 6)));
        bf16x8 pb[4];
        if (valid) {
            f32x16 p0 = {}, p1 = {};
#pragma unroll
            for (int kk = 0; kk < NKK; ++kk) {
                const bf16x8 k0 = *(const LAS bf16x8*)(kbase + kk * 32), k1 = *(const LAS bf16x8*)(kbase + 32 * KRB + kk * 32);
                const bf16x8 qv = QLDS ? *(const LAS bf16x8*)(qlds + kk * 1024) : qf[kk];
                p0 = __builtin_amdgcn_mfma_f32_32x32x16_bf16(k0, qv, p0, 0, 0, 0);
                p1 = __builtin_amdgcn_mfma_f32_32x32x16_bf16(k1, qv, p1, 0, 0, 0);
            }
            if (FOX) {
#pragma unroll
                for (int g = 0; g < 4; ++g) { const f32x4 f0 = *(const LAS f32x4*)(fbase + g * 32), f1 = *(const LAS f32x4*)(fbase + 128 + g * 32);
#pragma unroll
                    for (int e = 0; e < 4; ++e) { p0[4 * g + e] += fqv - f0[e]; p1[4 * g + e] += fqv - f1[e]; } }
                if (j0 + 63 > qmin) {
#pragma unroll
                    for (int r = 0; r < 16; ++r) { const int kv = j0 + crow(r, hi); if (kv > qpos) p0[r] = -1e30f; if (kv + 32 > qpos) p1[r] = -1e30f; }
                }
            }
            float mt = fmaxf(p0[0], p1[0]);
#pragma unroll
            for (int r = 1; r < 16; ++r) mt = fmaxf(mt, fmaxf(p0[r], p1[r]));
            mt = fmaxf(mt, __shfl_xor(mt, 32));
            const float mnew = fmaxf(mrun, mt), alpha = fast_exp2(mrun - mnew); mrun = mnew;
            float ps = 0.f;
#pragma unroll
            for (int r = 0; r < 16; ++r) { p0[r] = fast_exp2(p0[r] - mnew); p1[r] = fast_exp2(p1[r] - mnew); ps += p0[r] + p1[r]; }
            lsum = lsum * alpha + ps;
            if (__builtin_amdgcn_ballot_w64(alpha != 1.f)) { o0 = o0 * alpha; o1 = o1 * alpha; }
#pragma unroll
            for (int s = 0; s < 2; ++s) {
                u32x4 w0 = {pk2(p0[8 * s], p0[8 * s + 1]), pk2(p0[8 * s + 2], p0[8 * s + 3]), pk2(p0[8 * s + 4], p0[8 * s + 5]), pk2(p0[8 * s + 6], p0[8 * s + 7])};
                u32x4 w1 = {pk2(p1[8 * s], p1[8 * s + 1]), pk2(p1[8 * s + 2], p1[8 * s + 3]), pk2(p1[8 * s + 4], p1[8 * s + 5]), pk2(p1[8 * s + 6], p1[8 * s + 7])};
                pb[s] = __builtin_bit_cast(bf16x8, w0); pb[2 + s] = __builtin_bit_cast(bf16x8, w1);
            }
        }
        __builtin_amdgcn_sched_barrier(0);
        if (T + 1 < NT) { cvt_k(); load_v(T + 1); }
        __builtin_amdgcn_sched_barrier(0);
        if (valid) {
#pragma unroll
            for (int kst = 0; kst < 4; ++kst) {
                const LAS unsigned char* vp = vbase + 16 * kst * VRB;
                const s16x4 a0l = tr_read(vp), a0h = tr_read(vp + 8 * VRB), a1l = tr_read(vp + 64), a1h = tr_read(vp + 64 + 8 * VRB);
                const bf16x8 A0 = {a0l[0], a0l[1], a0l[2], a0l[3], a0h[0], a0h[1], a0h[2], a0h[3]}, A1 = {a1l[0], a1l[1], a1l[2], a1l[3], a1h[0], a1h[1], a1h[2], a1h[3]};
                o0 = __builtin_amdgcn_mfma_f32_32x32x16_bf16(A0, pb[kst], o0, 0, 0, 0);
                o1 = __builtin_amdgcn_mfma_f32_32x32x16_bf16(A1, pb[kst], o1, 0, 0, 0);
            }
        }
        if (DB) { if (T + 1 < NT) store_tile(T + 1); __syncthreads(); }
    }
    lsum += __shfl_xor(lsum, 32);
    if (KS == 1) {
        const float inv = 1.f / lsum; bf16* op = a.O + (size_t)(qs * 32 + q32) * a.ostride + 4 * hi;
#pragma unroll
        for (int g = 0; g < 4; ++g) { st_bf4(op + 8 * g, (f32x4){o0[4 * g] * inv, o0[4 * g + 1] * inv, o0[4 * g + 2] * inv, o0[4 * g + 3] * inv});
            st_bf4(op + 32 + 8 * g, (f32x4){o1[4 * g] * inv, o1[4 * g + 1] * inv, o1[4 * g + 2] * inv, o1[4 * g + 3] * inv}); }
    } else {
        __syncthreads();
        LAS float* osc = (LAS float*)lds + wid * 2048;
        LAS float* msc = (LAS float*)(lds + 65536) + wid * 32; LAS float* lsc = (LAS float*)(lds + 65536 + 1024) + wid * 32;
#pragma unroll
        for (int r = 0; r < 16; ++r) { osc[r * 64 + lane] = o0[r]; osc[(16 + r) * 64 + lane] = o1[r]; }
        if (hi == 0) { msc[q32] = mrun; lsc[q32] = lsum; }
        __syncthreads();
        if (ks == 0) {
            float mk[KS], M = -1e30f;
#pragma unroll
            for (int k = 0; k < KS; ++k) { mk[k] = ((LAS float*)(lds + 65536))[(k * QS + qs) * 32 + q32]; M = fmaxf(M, mk[k]); }
            float L = 0.f; f32x16 t0 = {}, t1 = {};
#pragma unroll 1
            for (int k = 0; k < KS; ++k) { const float w = fast_exp2(((LAS float*)(lds + 65536))[(k * QS + qs) * 32 + q32] - M); L += w * ((LAS float*)(lds + 65536 + 1024))[(k * QS + qs) * 32 + q32];
                const LAS float* os = (LAS float*)lds + (k * QS + qs) * 2048;
#pragma unroll
                for (int r = 0; r < 16; ++r) { t0[r] += w * os[r * 64 + lane]; t1[r] += w * os[(16 + r) * 64 + lane]; } }
            const float inv = 1.f / L; bf16* op = a.O + (size_t)(qs * 32 + q32) * a.ostride + 4 * hi;
#pragma unroll
            for (int g = 0; g < 4; ++g) { st_bf4(op + 8 * g, (f32x4){t0[4 * g] * inv, t0[4 * g + 1] * inv, t0[4 * g + 2] * inv, t0[4 * g + 3] * inv});
                st_bf4(op + 32 + 8 * g, (f32x4){t1[4 * g] * inv, t1[4 * g + 1] * inv, t1[4 * g + 2] * inv, t1[4 * g + 3] * inv}); }
        }
    }
    __syncthreads();
}


struct Attn2Args {
    const bf16* Q[2]; int qstride;
    const bf16* Ka; int kastride; const bf16* Kb; int kbstride; const bf16* V; int vstride;
    const float* Fk; bf16* O[2]; int ostride; int qpos0[2]; int nkv[2]; const float* cs;
};
template <int DQK, bool FOX, int NG>
__device__ __forceinline__ void attn_unit2(const Attn2Args& a, LAS unsigned char* lds) {
    constexpr int KRB = (DQK + 8) * 2, VRB = 144, NKK = DQK / 16, OFF_V = 64 * KRB, OFF_F = OFF_V + 64 * VRB, BUF = 32768;
    static_assert(OFF_F + 256 <= BUF, "tile buffer");
    int tid = threadIdx.x; asm volatile("" : "+v"(tid));
    const int lane = tid & 63, q32 = lane & 31, hi = lane >> 5; const int wid = __builtin_amdgcn_readfirstlane(tid >> 6);
    int qmin[NG], qpos[NG]; bf16x8 qf[NG][NKK]; float mrun[NG], lsum[NG]; f32x16 o0[NG], o1[NG];
#pragma unroll
    for (int g = 0; g < NG; ++g) {
        qmin[g] = a.qpos0[g] + wid * 32; qpos[g] = qmin[g] + q32; mrun[g] = -1e30f; lsum[g] = 0.f; o0[g] = f32x16{}; o1[g] = f32x16{};
        const bf16* qp = a.Q[g] + (size_t)(wid * 32 + q32) * a.qstride + hi * 8;
#pragma unroll
        for (int kk = 0; kk < NKK; ++kk) qf[g][kk] = *(const bf16x8*)(qp + kk * 16);
        if (DQK == 96) {
            const f32x4* cp = (const f32x4*)(a.cs + ((size_t)qpos[g] * 16 + 8 * hi) * 2);
            const u32x4 w1 = __builtin_bit_cast(u32x4, qf[g][NKK - 2]), w2 = __builtin_bit_cast(u32x4, qf[g][NKK - 1]); u32x4 r1, r2;
#pragma unroll
            for (int j = 0; j < 4; ++j) { const f32x4 c = cp[j]; const float a0 = bflo(w1[j]), a1 = bfhi(w1[j]), b0 = bflo(w2[j]), b1 = bfhi(w2[j]);
                r1[j] = pk2(a0 * c.x - b0 * c.y, a1 * c.z - b1 * c.w); r2[j] = pk2(a0 * c.y + b0 * c.x, a1 * c.w + b1 * c.z); }
            qf[g][NKK - 2] = __builtin_bit_cast(bf16x8, r1); qf[g][NKK - 1] = __builtin_bit_cast(bf16x8, r2);
        }
    }
    const int NT = a.nkv[NG - 1] / 64;
    struct Stage { u32x4 ka, v, kb; float f; }; Stage st0, st1;
    const int lrow = tid >> 3, lch = tid & 7, brow = (tid & 255) >> 2, bch = tid & 3;
    auto load_t = [&](int T, Stage& st) {
        st.ka = *(const u32x4*)(a.Ka + (size_t)(T * 64 + lrow) * a.kastride + lch * 8);
        st.v = *(const u32x4*)(a.V + (size_t)(T * 64 + lrow) * a.vstride + lch * 8);
        if (DQK == 96) { if (tid < 256) st.kb = *(const u32x4*)(a.Kb + (size_t)(T * 64 + brow) * a.kbstride + bch * 8); }
        if (FOX) { if (tid < 64) st.f = a.Fk[T * 64 + tid]; }
    };
    auto store_tile = [&](int T, const Stage& st) {
        LAS unsigned char* b = lds + (T & 1) * BUF;
        *(LAS u32x4*)(b + lrow * KRB + lch * 16) = st.ka; *(LAS u32x4*)(b + OFF_V + lrow * VRB + lch * 16) = st.v;
        if (DQK == 96) { if (tid < 256) *(LAS u32x4*)(b + brow * KRB + 128 + bch * 16) = st.kb; }
        if (FOX) { if (tid < 64) *(LAS float*)(b + OFF_F + tid * 4) = st.f; }
    };
    load_t(0, st0); if (NT > 1) load_t(1, st1);
    const LAS unsigned char* kbase0 = lds + q32 * KRB + hi * 16;
    const LAS unsigned char* vbase0 = lds + OFF_V + (4 * hi + ((lane & 15) >> 2)) * VRB + (16 * ((lane >> 4) & 1) + 4 * (lane & 3)) * 2;
    const LAS unsigned char* fbase0 = lds + OFF_F + (4 * hi) * 4;
    store_tile(0, st0); __syncthreads();
    auto step = [&](int T, Stage& stL  , const Stage& stS  ) {
        const int bo = (T & 1) * BUF; const LAS unsigned char* kbase = kbase0 + bo; const LAS unsigned char* vbase = vbase0 + bo; const LAS unsigned char* fbase = fbase0 + bo;
        if (T + 2 < NT) load_t(T + 2, stL);
        __builtin_amdgcn_sched_barrier(0);
        const int j0 = T * 64; bool valid[NG]; bool any = false;
#pragma unroll
        for (int g = 0; g < NG; ++g) { valid[g] = (j0 < a.nkv[g]) && (FOX ? (j0 <= qmin[g] + 31) : (T <= (qmin[g] >> 6))); any = any || valid[g]; }
        bf16x8 pb[NG][4];
        if (any) {
            f32x16 p0[NG], p1[NG];
            if (FOX) {
                f32x16 b0, b1;
#pragma unroll
                for (int q = 0; q < 4; ++q) { const f32x4 f0 = *(const LAS f32x4*)(fbase + q * 32), f1 = *(const LAS f32x4*)(fbase + 128 + q * 32);
#pragma unroll
                    for (int e = 0; e < 4; ++e) { b0[4 * q + e] = -f0[e]; b1[4 * q + e] = -f1[e]; } }
#pragma unroll
                for (int g = 0; g < NG; ++g) { p0[g] = b0; p1[g] = b1; }
            } else {
#pragma unroll
                for (int g = 0; g < NG; ++g) { p0[g] = f32x16{}; p1[g] = f32x16{}; } }
#pragma unroll
            for (int kk = 0; kk < NKK; ++kk) {
                const bf16x8 k0 = *(const LAS bf16x8*)(kbase + kk * 32), k1 = *(const LAS bf16x8*)(kbase + 32 * KRB + kk * 32);
#pragma unroll
                for (int g = 0; g < NG; ++g) if (valid[g]) {
                    p0[g] = __builtin_amdgcn_mfma_f32_32x32x16_bf16(k0, qf[g][kk], p0[g], 0, 0, 0);
                    p1[g] = __builtin_amdgcn_mfma_f32_32x32x16_bf16(k1, qf[g][kk], p1[g], 0, 0, 0); }
            }
#pragma unroll
            for (int g = 0; g < NG; ++g) if (valid[g]) {
                if (FOX && j0 + 63 > qmin[g]) {
#pragma unroll
                    for (int r = 0; r < 16; ++r) { const int kv = j0 + crow(r, hi); if (kv > qpos[g]) p0[g][r] = -1e30f; if (kv + 32 > qpos[g]) p1[g][r] = -1e30f; }
                }
                float mt = fmaxf(p0[g][0], p1[g][0]);
#pragma unroll
                for (int r = 1; r < 16; ++r) mt = fmaxf(mt, fmaxf(p0[g][r], p1[g][r]));
                mt = fmaxf(mt, __shfl_xor(mt, 32));
                const float mnew = fmaxf(mrun[g], mt), alpha = fast_exp2(mrun[g] - mnew); mrun[g] = mnew;
                float ps = 0.f;
#pragma unroll
                for (int r = 0; r < 16; ++r) { p0[g][r] = fast_exp2(p0[g][r] - mnew); p1[g][r] = fast_exp2(p1[g][r] - mnew); ps += p0[g][r] + p1[g][r]; }
                lsum[g] = lsum[g] * alpha + ps; if (__builtin_amdgcn_ballot_w64(alpha != 1.f)) { o0[g] = o0[g] * alpha; o1[g] = o1[g] * alpha; }
#pragma unroll
                for (int s = 0; s < 2; ++s) {
                    u32x4 w0 = {pk2(p0[g][8 * s], p0[g][8 * s + 1]), pk2(p0[g][8 * s + 2], p0[g][8 * s + 3]), pk2(p0[g][8 * s + 4], p0[g][8 * s + 5]), pk2(p0[g][8 * s + 6], p0[g][8 * s + 7])};
                    u32x4 w1 = {pk2(p1[g][8 * s], p1[g][8 * s + 1]), pk2(p1[g][8 * s + 2], p1[g][8 * s + 3]), pk2(p1[g][8 * s + 4], p1[g][8 * s + 5]), pk2(p1[g][8 * s + 6], p1[g][8 * s + 7])};
                    pb[g][s] = __builtin_bit_cast(bf16x8, w0); pb[g][2 + s] = __builtin_bit_cast(bf16x8, w1);
                }
            }
        }
        if (any) {
#pragma unroll
            for (int kst = 0; kst < 4; ++kst) {
                const LAS unsigned char* vp = vbase + 16 * kst * VRB;
                const s16x4 a0l = tr_read(vp), a0h = tr_read(vp + 8 * VRB), a1l = tr_read(vp + 64), a1h = tr_read(vp + 64 + 8 * VRB);
                const bf16x8 A0 = {a0l[0], a0l[1], a0l[2], a0l[3], a0h[0], a0h[1], a0h[2], a0h[3]}, A1 = {a1l[0], a1l[1], a1l[2], a1l[3], a1h[0], a1h[1], a1h[2], a1h[3]};
#pragma unroll
                for (int g = 0; g < NG; ++g) if (valid[g]) {
                    o0[g] = __builtin_amdgcn_mfma_f32_32x32x16_bf16(A0, pb[g][kst], o0[g], 0, 0, 0);
                    o1[g] = __builtin_amdgcn_mfma_f32_32x32x16_bf16(A1, pb[g][kst], o1[g], 0, 0, 0); }
            }
        }
        if (T + 1 < NT) store_tile(T + 1, stS);
        __syncthreads();
    };
    for (int T = 0; T < NT; T += 2) { step(T, st0, st1); if (T + 1 < NT) step(T + 1, st1, st0); }
#pragma unroll
    for (int g = 0; g < NG; ++g) {
        const float l = lsum[g] + __shfl_xor(lsum[g], 32); const float inv = 1.f / l; bf16* op = a.O[g] + (size_t)(wid * 32 + q32) * a.ostride + 4 * hi;
#pragma unroll
        for (int q = 0; q < 4; ++q) { st_bf4(op + 8 * q, (f32x4){o0[g][4 * q] * inv, o0[g][4 * q + 1] * inv, o0[g][4 * q + 2] * inv, o0[g][4 * q + 3] * inv});
            st_bf4(op + 32 + 8 * q, (f32x4){o1[g][4 * q] * inv, o1[g][4 * q + 1] * inv, o1[g][4 * q + 2] * inv, o1[g][4 * q + 3] * inv}); }
    }
    __syncthreads();
}

struct AbsArgs { const bf16* Qlat; const bf16* Qrope; const bf16 *Lat_past, *Lat_new, *Kr_past, *Kr_new; const bf16* WuvT; bf16* O; const float* cs; };
__device__ __forceinline__ void mla_abs_unit(const AbsArgs& a, LAS unsigned char* lds) {
    constexpr int RB = 592, OFF_Q = 128 * RB, NKK = 18, NT = (KVS + 127) / 128;
    int tid = threadIdx.x; asm volatile("" : "+v"(tid));
    const int lane = tid & 63, q32 = lane & 31, hi = lane >> 5; const int wid = __builtin_amdgcn_readfirstlane(tid >> 6);
    const int qs = wid & 1, ks = wid >> 1;
    LAS unsigned char* qlds = lds + OFF_Q + qs * (NKK * 1024) + lane * 16;
    { const bf16* qp = a.Qlat + (size_t)(qs * 32 + q32) * 2048 + hi * 8;
#pragma unroll
      for (int kk = 0; kk < 16; ++kk) *(LAS bf16x8*)(qlds + kk * 1024) = *(const bf16x8*)(qp + kk * 16);
      const bf16* rp = a.Qrope + (size_t)(qs * 32 + q32) * 768 + hi * 8;
      const u32x4 w1 = *(const u32x4*)rp, w2 = *(const u32x4*)(rp + 16); u32x4 r1, r2;
      const f32x4* cp = (const f32x4*)(a.cs + ((size_t)(SEQ + qs * 32 + q32) * 16 + 8 * hi) * 2);
#pragma unroll
      for (int j = 0; j < 4; ++j) { const f32x4 c = cp[j]; const float a0 = bflo(w1[j]), a1 = bfhi(w1[j]), b0 = bflo(w2[j]), b1 = bfhi(w2[j]);
          r1[j] = pk2(a0 * c.x - b0 * c.y, a1 * c.z - b1 * c.w); r2[j] = pk2(a0 * c.y + b0 * c.x, a1 * c.w + b1 * c.z); }
      *(LAS u32x4*)(qlds + 16 * 1024) = r1; *(LAS u32x4*)(qlds + 17 * 1024) = r2; }
    float mrun = -1e30f, lsum = 0.f; f32x16 o[8] = {};
    u32x4 rl[8], rk;
    const int lrow = tid >> 5, lch = tid & 31, krow = tid >> 2, kch = tid & 3;
    auto load_t = [&](int T) {
        const int jT = T * 128; const bool past = jT < PAST; const size_t r0 = (size_t)(past ? jT : jT - PAST);
        const bf16* lp = (past ? a.Lat_past : a.Lat_new) + (r0 + lrow) * 256 + lch * 8;
#pragma unroll
        for (int i = 0; i < 8; ++i) if (jT + 16 * i < KVS) rl[i] = *(const u32x4*)(lp + (size_t)i * 16 * 256);
        if (jT + krow < KVS) rk = *(const u32x4*)((past ? a.Kr_past : a.Kr_new) + (r0 + krow) * 32 + kch * 8);
    };
    auto store_t = [&](int T) {
        const int jT = T * 128;
#pragma unroll
        for (int i = 0; i < 8; ++i) if (jT + 16 * i < KVS) *(LAS u32x4*)(lds + (lrow + 16 * i) * RB + lch * 16) = rl[i];
        if (jT + krow < KVS) *(LAS u32x4*)(lds + krow * RB + 512 + kch * 16) = rk;
    };
    load_t(0);
    const LAS unsigned char* kbase = lds + (ks * 32 + q32) * RB + hi * 16;
    const LAS unsigned char* vbase = lds + (ks * 32 + 4 * hi + ((lane & 15) >> 2)) * RB + (16 * ((lane >> 4) & 1) + 4 * (lane & 3)) * 2;
    for (int T = 0; T < NT; ++T) {
        __syncthreads();
        store_t(T);
        __syncthreads();
        if (T + 1 < NT) load_t(T + 1);
        __builtin_amdgcn_sched_barrier(0);
        if (T * 128 + ks * 32 < KVS) {
            f32x16 p0 = {}, pq = {};
#pragma unroll
            for (int kk = 0; kk < NKK; kk += 2) {
                const bf16x8 k0 = *(const LAS bf16x8*)(kbase + kk * 32); const bf16x8 qv = *(const LAS bf16x8*)(qlds + kk * 1024);
                const bf16x8 k1 = *(const LAS bf16x8*)(kbase + (kk + 1) * 32); const bf16x8 qw = *(const LAS bf16x8*)(qlds + (kk + 1) * 1024);
                p0 = __builtin_amdgcn_mfma_f32_32x32x16_bf16(k0, qv, p0, 0, 0, 0);
                pq = __builtin_amdgcn_mfma_f32_32x32x16_bf16(k1, qw, pq, 0, 0, 0);
            }
            p0 = p0 + pq;
            float mt = p0[0];
#pragma unroll
            for (int r = 1; r < 16; ++r) mt = fmaxf(mt, p0[r]);
            mt = fmaxf(mt, __shfl_xor(mt, 32));
            const float mnew = fmaxf(mrun, mt), alpha = fast_exp2(mrun - mnew); mrun = mnew;
            float ps = 0.f;
#pragma unroll
            for (int r = 0; r < 16; ++r) { p0[r] = fast_exp2(p0[r] - mnew); ps += p0[r]; }
            lsum = lsum * alpha + ps;
            if (__builtin_amdgcn_ballot_w64(alpha != 1.f)) {
#pragma unroll
                for (int dt = 0; dt < 8; ++dt) o[dt] = o[dt] * alpha; }
            bf16x8 pb[2];
#pragma unroll
            for (int s = 0; s < 2; ++s) {
                u32x4 w0 = {pk2(p0[8 * s], p0[8 * s + 1]), pk2(p0[8 * s + 2], p0[8 * s + 3]), pk2(p0[8 * s + 4], p0[8 * s + 5]), pk2(p0[8 * s + 6], p0[8 * s + 7])};
                pb[s] = __builtin_bit_cast(bf16x8, w0);
            }
#pragma unroll
            for (int kst = 0; kst < 2; ++kst) {
                const LAS unsigned char* vp = vbase + 16 * kst * RB;
#pragma unroll
                for (int dt = 0; dt < 8; ++dt) { const s16x4 al = tr_read(vp + dt * 64), ah = tr_read(vp + dt * 64 + 8 * RB);
                    const bf16x8 Af = {al[0], al[1], al[2], al[3], ah[0], ah[1], ah[2], ah[3]};
                    o[dt] = __builtin_amdgcn_mfma_f32_32x32x16_bf16(Af, pb[kst], o[dt], 0, 0, 0); }
            }
        }
    }
    lsum += __shfl_xor(lsum, 32);
    LAS float* msc = (LAS float*)(lds + 131072 + 4096);
    LAS float* lsc = msc + 256;
#pragma unroll 1
    for (int rnd = 0; rnd < 2; ++rnd) {
        const int half = rnd == 0 ? 2 : 1;
        __syncthreads();
        if (ks >= half && ks < 2 * half) { LAS float* osc = (LAS float*)lds + ((ks - half) * 2 + qs) * 8192;
#pragma unroll
            for (int dt = 0; dt < 8; ++dt)
#pragma unroll
                for (int r = 0; r < 16; ++r) osc[(dt * 16 + r) * 64 + lane] = o[dt][r];
            if (hi == 0) { msc[wid * 32 + q32] = mrun; lsc[wid * 32 + q32] = lsum; } }
        __syncthreads();
        if (ks < half) { const LAS float* osc = (const LAS float*)lds + (ks * 2 + qs) * 8192; const int pw = (ks + half) * 2 + qs;
            const float m2 = msc[pw * 32 + q32], l2 = lsc[pw * 32 + q32]; const float M = fmaxf(mrun, m2), w1 = fast_exp2(mrun - M), w2 = fast_exp2(m2 - M);
            lsum = w1 * lsum + w2 * l2; mrun = M;
#pragma unroll
            for (int dt = 0; dt < 8; ++dt)
#pragma unroll
                for (int r = 0; r < 16; ++r) o[dt][r] = w1 * o[dt][r] + w2 * osc[(dt * 16 + r) * 64 + lane]; }
    }
    if (ks == 0) {
        const float inv = 1.f / lsum; f32x16 t0 = {}, t1 = {};
        const bf16* wrow0 = a.WuvT + (size_t)q32 * 256 + 4 * hi; const bf16* wrow1 = wrow0 + 32 * 256;
#pragma unroll
        for (int sub = 0; sub < 8; ++sub)
#pragma unroll
            for (int s = 0; s < 2; ++s) {
                const u32x4 wv = {pk2(o[sub][8 * s] * inv, o[sub][8 * s + 1] * inv), pk2(o[sub][8 * s + 2] * inv, o[sub][8 * s + 3] * inv), pk2(o[sub][8 * s + 4] * inv, o[sub][8 * s + 5] * inv), pk2(o[sub][8 * s + 6] * inv, o[sub][8 * s + 7] * inv)};
                const bf16x8 Bf = __builtin_bit_cast(bf16x8, wv); const int c0 = 32 * sub + 16 * s;
                const s16x4 a0l = *(const s16x4*)(wrow0 + c0), a0h = *(const s16x4*)(wrow0 + c0 + 8), a1l = *(const s16x4*)(wrow1 + c0), a1h = *(const s16x4*)(wrow1 + c0 + 8);
                const bf16x8 A0 = {a0l[0], a0l[1], a0l[2], a0l[3], a0h[0], a0h[1], a0h[2], a0h[3]}, A1 = {a1l[0], a1l[1], a1l[2], a1l[3], a1h[0], a1h[1], a1h[2], a1h[3]};
                t0 = __builtin_amdgcn_mfma_f32_32x32x16_bf16(A0, Bf, t0, 0, 0, 0);
                t1 = __builtin_amdgcn_mfma_f32_32x32x16_bf16(A1, Bf, t1, 0, 0, 0);
            }
        bf16* op = a.O + (size_t)(qs * 32 + q32) * 1024 + 4 * hi;
#pragma unroll
        for (int g = 0; g < 4; ++g) { st_bf4(op + 8 * g, (f32x4){t0[4 * g], t0[4 * g + 1], t0[4 * g + 2], t0[4 * g + 3]}); st_bf4(op + 32 + 8 * g, (f32x4){t1[4 * g], t1[4 * g + 1], t1[4 * g + 2], t1[4 * g + 3]}); }
    }
    __syncthreads();
}

__device__ __forceinline__ void p4_attention(const Args& A, LAS unsigned char* lds) {
    unsigned char* ws = A.ws; const int G = gridDim.x;
    const bf16* QFOX = (const bf16*)(ws + WS_QFOX); const bf16* KNEW = (const bf16*)(ws + WS_KNEW); const bf16* VNEW = (const bf16*)(ws + WS_VNEW);
    const bf16* QMLA = (const bf16*)(ws + WS_QMLA); const bf16* KVNEW = (const bf16*)(ws + WS_KVNEW);
    const bf16* KRNEW = (const bf16*)(ws + WS_KRNEW); const bf16* KRPAST = (const bf16*)(ws + WS_KRPAST);
    const float* FS = (const float*)(ws + WS_FS); const float* FP = (const float*)(ws + WS_FP); bf16* MIXED = (bf16*)(ws + WS_MIXED);
    const int rot = (blockIdx.x >> 6) & 3;
#pragma unroll 1
    for (int pass = 0; pass < 4; ++pass) {
    const int job = (pass + rot) & 3;
    if (job == 0) {
    for (int p = blockIdx.x; p < 256; p += G) {
        const int bh = p >> 2, s = p & 3, b = bh >> 3, h = bh & 7; const size_t tb = (size_t)b * SEQ;
        Attn2Args a; a.cs = (const float*)(ws + WS_CS); a.qstride = 512; a.Ka = KNEW + tb * 512 + h * 64; a.kastride = 512; a.Kb = nullptr; a.kbstride = 0;
        a.V = VNEW + tb * 512 + h * 64; a.vstride = 512; a.Fk = FP + (size_t)bh * SEQ; a.ostride = 1024;
        for (int i = 0; i < 2; ++i) { const int t0 = 256 * (i ? 7 - s : s); a.Q[i] = QFOX + (tb + t0) * 512 + h * 64; a.O[i] = MIXED + (tb + t0) * 1024 + h * 64; a.qpos0[i] = t0; a.nkv[i] = t0 + 256; }
        attn_unit2<64, true, 2>(a, lds);
    }
    } else if (job == 1) {
    for (int p = blockIdx.x; p < 256; p += G) {
        const int bh = p >> 2, s = 3 - (p & 3), b = bh >> 3, h = bh & 7; const size_t tb = (size_t)b * SEQ;
        Attn2Args a; a.cs = (const float*)(ws + WS_CS); a.qstride = 768; a.Ka = KVNEW + tb * 1024 + h * 64; a.kastride = 1024; a.Kb = KRNEW + tb * 32; a.kbstride = 32;
        a.V = KVNEW + tb * 1024 + 512 + h * 64; a.vstride = 1024; a.Fk = nullptr; a.ostride = 1024;
        for (int i = 0; i < 2; ++i) { const int t0 = 256 * (i ? 7 - s : s); a.Q[0] = QMLA + (tb + t0) * 768 + h * 96; a.O[0] = MIXED + (tb + t0) * 1024 + 512 + h * 64; a.qpos0[0] = t0; a.nkv[0] = t0 + 256;
            a.Q[1] = a.Q[0]; a.O[1] = a.O[0]; a.qpos0[1] = t0; a.nkv[1] = t0 + 256;
            attn_unit2<96, false, 1>(a, lds); }
    }
    } else if (job == 2) {
    for (int p = blockIdx.x; p < 256; p += G) {
        const int b = p >> 3, h = p & 7; const size_t tok0 = (size_t)TP + (size_t)b * DSEQ, pb = (size_t)b * PAST;
        AttnArgs a; a.cs = (const float*)(ws + WS_CS); a.Q = QFOX + tok0 * 512 + h * 64; a.qstride = 512;
        a.Ka_past = A.in[2] + pb * 512 + h * 64; a.Ka_new = A.out + O_KS + (size_t)b * DSEQ * 512 + h * 64; a.kastride = 512; a.Kb_past = a.Kb_new = nullptr; a.kbstride = 0;
        a.V_past = A.in[3] + pb * 512 + h * 64; a.V_new = A.out + O_VS + (size_t)b * DSEQ * 512 + h * 64; a.vstride = 512;
        a.Fq = FS + (size_t)p * KVS + PAST; a.Fk = FS + (size_t)p * KVS; a.O = MIXED + tok0 * 1024 + h * 64; a.ostride = 1024; a.P = PAST; a.qpos0 = PAST; a.nkv = KVS;
        attn_unit<64, true, 2, 4, true>(a, lds);
    }
    } else {
    for (int p = blockIdx.x; p < 256; p += G) {
        const int b = (p & 7) * 4 + (p >> 6), h = (p >> 3) & 7; const size_t tok0 = (size_t)TP + (size_t)b * DSEQ, pb = (size_t)b * PAST;
        AbsArgs a; a.Qlat = (const bf16*)(ws + WS_QLAT) + (size_t)b * DSEQ * 2048 + h * 256; a.Qrope = QMLA + tok0 * 768 + h * 96 + 64;
        a.Lat_past = (const bf16*)(ws + WS_LATPAST) + pb * 256; a.Lat_new = (const bf16*)(ws + WS_LATNEW) + tok0 * 256;
        a.Kr_past = KRPAST + pb * 32; a.Kr_new = KRNEW + tok0 * 32; a.WuvT = (const bf16*)(ws + WS_WKV) + (size_t)(512 + h * 64) * 256;
        a.O = MIXED + tok0 * 1024 + 512 + h * 64; a.cs = (const float*)(ws + WS_CS);
        mla_abs_unit(a, lds);
    }
    }
    }
}

template <class Epi> __device__ __forceinline__ void run_gemm(LAS unsigned char* lds, const bf16* Am, const bf16* Bt, int M, int N, int K, const Epi& E, int cu_shift = 0) {
    pg8::Gemm g{Am, Bt, M, N, K}; pg8::StaticOrder S; S.init(M, N, K, (int)gridDim.x, (int)((blockIdx.x + cu_shift) % gridDim.x));
    pg8::gemm_phase<Epi, pg8::StaticOrder, true, true>(lds, g, S, E);
}

__global__ void __launch_bounds__(NTHREADS, 2) fwd_kernel(Args A, int ph_lo, int ph_hi) {
    extern __shared__ __attribute__((aligned(16))) unsigned char lds_raw[];
    LAS unsigned char* lds = (LAS unsigned char*)lds_raw;
    unsigned char* ws = A.ws;
    if (threadIdx.x < 64) ((LAS unsigned*)(lds + 131072))[threadIdx.x] = 0u;
    __syncthreads();
    XcdBarrier bar = xcd_barrier_post((unsigned*)(ws + WS_CTL), (volatile LAS unsigned*)(lds + 131072 + 32));
#ifndef PH_MASK
#define PH_MASK 0xffff
#endif
#define IN(k) (((PH_MASK >> (k)) & 1) && ph_lo <= (k) && (k) < ph_hi)
#define SEAM(k) do { if (IN(k) && IN((k) + 1)) xcd_barrier(bar); } while (0)
#ifndef REP0
#define REP0 1
#endif
#ifndef REP4
#define REP4 1
#endif
#ifndef REP8
#define REP8 1
#endif
#ifndef REP1
#define REP1 1
#endif
#ifndef REP7
#define REP7 1
#endif
#ifndef REP9
#define REP9 1
#endif
    if (IN(0)) { for (int rep = 0; rep < REP0; ++rep) { p0_prologue(A, lds); __syncthreads(); } }
    SEAM(0);
    if (IN(1)) {
        EpiZ E{(bf16*)(ws + WS_QFOX), (bf16*)(ws + WS_KNEW), (bf16*)(ws + WS_VNEW), (bf16*)(ws + WS_KRNEW), (float*)(ws + WS_ZBUF), A.out, (const float*)(ws + WS_CS), A.in[10]};
        run_gemm(lds, (const bf16*)(ws + WS_H), (const bf16*)(ws + WS_WIN), TOK, NZ, DM, E);
    }
    SEAM(1);
    if (IN(2)) { p2_postz(A, lds); __syncthreads(); }
    SEAM(2);
    if (IN(3)) {
        EpiBf E{(bf16*)(ws + WS_QMLA), 768, 0.10206207261596575f * LOG2E};
        run_gemm(lds, (const bf16*)(ws + WS_QCN), (const bf16*)(ws + WS_WQ), TOK, 768, 384, E);
        EpiBf E2{(bf16*)(ws + WS_KVNEW), 1024, 1.f};
        run_gemm(lds, (const bf16*)(ws + WS_LATNEW), (const bf16*)(ws + WS_WKV), TP, 1024, 256, E2);
        EpiBf E3{(bf16*)(ws + WS_QLAT), 2048, 0.10206207261596575f * LOG2E};
        run_gemm(lds, (const bf16*)(ws + WS_QCN) + (size_t)TP * 384, (const bf16*)(ws + WS_WQA), TS, 2048, 384, E3, 64);
    }
    SEAM(3);
    if (IN(4)) { for (int rep = 0; rep < REP4; ++rep) p4_attention(A, lds); }
    SEAM(4);
    if (IN(5)) {
        pg8::Gemm g{(const bf16*)(ws + WS_MIXED), (const bf16*)(ws + WS_WOUT), TOK, DM, DM}; SplitOrder<16> S{(int)gridDim.x, (int)blockIdx.x};
        EpiOut E{A.in[0], A.in[1], (float*)(ws + WS_X1), (bf16*)(ws + WS_H), A.in[17], (float*)(ws + WS_ROWSS), (float*)(ws + WS_SLAB)};
        pg8::gemm_phase<EpiOut, SplitOrder<16>, true, true>(lds, g, S, E);
    }
    if (IN(5) && IN(7)) xcd_barrier(bar);
    if (IN(5)) {
        int t2 = threadIdx.x; asm volatile("" : "+v"(t2)); const int lane = t2 & 63, gw = blockIdx.x * NWAVES + (t2 >> 6), NGW = gridDim.x * NWAVES;
        for (int r = gw; r < TS; r += NGW) {
            const f32x4* xr = (const f32x4*)(A.in[1] + (size_t)r * DM) + lane; f32x4 v[4];
#pragma unroll
            for (int j = 0; j < 4; ++j) v[j] = xr[64 * j];
#pragma unroll
            for (int k = 0; k < DN_SL; ++k) { const f32x4* sr = (const f32x4*)((const float*)(ws + WS_SLAB) + ((size_t)k * TS + r) * DM) + lane;
#pragma unroll
                for (int j = 0; j < 4; ++j) v[j] += sr[64 * j]; }
            float ss = 0.f; const size_t row = (size_t)TP + r;
#pragma unroll
            for (int j = 0; j < 4; ++j) { ss += (v[j].x * v[j].x + v[j].y * v[j].y) + (v[j].z * v[j].z + v[j].w * v[j].w); ((f32x4*)((float*)(ws + WS_X1) + row * DM))[64 * j + lane] = v[j];
                const f32x4 gq = ((const f32x4*)A.in[17])[64 * j + lane]; const f32x4 o = v[j] * gq; ((u32x2*)((bf16*)(ws + WS_H) + row * DM))[64 * j + lane] = (u32x2){pk2(o.x, o.y), pk2(o.z, o.w)}; }
            ss = wave_sum(ss);
            if (lane < 16) ((float*)(ws + WS_ROWSS))[row * 16 + lane] = lane == 0 ? ss : 0.f;
        }
    }
    if (IN(5) && IN(7)) xcd_barrier(bar);
    if (IN(7)) { EpiGlu E{(bf16*)(ws + WS_ACT), (float*)(ws + WS_EDGE), A.in[19], A.in[20], (const float*)(ws + WS_ROWSS)}; run_gemm(lds, (const bf16*)(ws + WS_H), (const bf16*)(ws + WS_WUP), TOK, DFF2, DM, E); }
    SEAM(7);
    if (IN(8)) p8_fixup(A);
    SEAM(8);
    if (IN(9)) {
        pg8::Gemm g{(const bf16*)(ws + WS_ACT), (const bf16*)(ws + WS_WDOWN), TOK, DM, DFF}; DownOrder S{(int)gridDim.x, (int)blockIdx.x};
        EpiDown E{(const float*)(ws + WS_X1), (float*)(ws + WS_X2), (float*)(ws + WS_SLAB)};
        pg8::gemm_phase<EpiDown, DownOrder, true, true>(lds, g, S, E);
    }
    SEAM(9);
    if (IN(10)) { int t2 = threadIdx.x; asm volatile("" : "+v"(t2)); const int lane = t2 & 63, gw = blockIdx.x * NWAVES + (t2 >> 6), NGW = gridDim.x * NWAVES;
        for (int m = gw; m < TOK; m += NGW) {
            if (m < TP) rms_row<true>((const float*)(ws + WS_X2) + (size_t)m * DM, A.in[22], A.out + (size_t)m * DM, lane);
            else rms_row<true>((const float*)(ws + WS_X1) + (size_t)m * DM, A.in[22], A.out + (size_t)m * DM, lane, (const float*)(ws + WS_SLAB) + (size_t)(m - TP) * DM, DN_SL, (size_t)TS * DM); } }
#undef IN
#undef SEAM
}

#ifndef N_LAUNCHES
#define N_LAUNCHES 1
#endif
extern "C" void kernel_launch(void* const* d_in, const int* in_sizes, int n_in, void* d_out, int out_size, void* d_ws, size_t ws_size, hipStream_t stream) {
    static int grid = 0;
    if (grid == 0) {
        if (n_in != 23 || (size_t)out_size != O_END || ws_size < WS_END) { fprintf(stderr, "kernel_launch: unexpected shapes: n_in %d out %d ws %zu (need %zu)\n", n_in, out_size, ws_size, (size_t)WS_END); grid = -1; return; }
        int dev = 0, cus = 0, per_cu = 0;
        (void)hipGetDevice(&dev); (void)hipDeviceGetAttribute(&cus, hipDeviceAttributeMultiprocessorCount, dev);
        if (hipFuncSetAttribute((const void*)fwd_kernel, hipFuncAttributeMaxDynamicSharedMemorySize, LDS_BYTES) != hipSuccess) { fprintf(stderr, "hipFuncSetAttribute failed\n"); grid = -1; return; }
        if (hipOccupancyMaxActiveBlocksPerMultiprocessor(&per_cu, (const void*)fwd_kernel, NTHREADS, LDS_BYTES) != hipSuccess || per_cu < 1) { fprintf(stderr, "occupancy query: %d\n", per_cu); per_cu = 1; }
        (void)hipGetLastError();
        grid = cus * 1;
    }
    if (grid < 0) return;
    if (hipMemsetAsync((char*)d_ws + WS_CTL, 0, CTL_BYTES, stream) != hipSuccess) { fprintf(stderr, "memset failed\n"); return; }
    Args a{};
    for (int i = 0; i < 23; ++i) a.in[i] = (const float*)d_in[i];
    a.out = (float*)d_out; a.ws = (unsigned char*)d_ws;
    if (N_LAUNCHES == 1) {
        hipLaunchKernelGGL(fwd_kernel, dim3(grid), dim3(NTHREADS), LDS_BYTES, stream, a, 0, 11);
    } else {
        for (int k = 0; k < 11; ++k) hipLaunchKernelGGL(fwd_kernel, dim3(grid), dim3(NTHREADS), LDS_BYTES, stream, a, k, k + 1);
    }
}
```

```cpp
#include <hip/hip_runtime.h>
#include <cstdio>
#include <cstdint>
namespace pg8 {
#define PG8_LAS __attribute__((address_space(3)))
typedef unsigned short bf16_t;
typedef short bf16x8 __attribute__((ext_vector_type(8)));
typedef float f32x4 __attribute__((ext_vector_type(4)));
typedef unsigned u32x4 __attribute__((ext_vector_type(4)));
constexpr int BM = 256, BK = 64, HALF = 128, HTB = HALF * BK * 2  , STAGE_BYTES = 8 * HTB, NXCD = 8, WGM = 8;

__host__ __device__ __forceinline__ int lds_byte(int r, int c) { const int st = (r >> 4) * 2 + (c >> 5), rr = r & 15, cc = c & 31, ob = rr * 64 + cc * 2; return st * 1024 + (ob ^ (((ob >> 9) & 1) << 5)); }
__host__ __device__ __forceinline__ void stage_rc(int b, int& R, int& C) { const int st = b / 1024, sb = b % 1024, swz = sb ^ (((sb >> 9) & 1) << 5); R = (st >> 1) * 16 + swz / 64; C = (st & 1) * 32 + (swz % 64) / 2; }
__host__ __device__ __forceinline__ int perm32(int rho) { const int n = rho >> 4, i = rho & 15; return 8 * (i >> 2) + 4 * n + (i & 3); }

struct Unit { int pm, pn, k0, nkt, sl; };
struct Gemm { const bf16_t* A; const bf16_t* Bt; int M, N, K; };

struct StaticOrder {
    int nM, nN, nwg, G, c, nkt;
    __host__ __device__ void init(int M, int N, int K, int G_, int c_) { nM = M / BM; nN = N / BM; nwg = nM * nN; G = G_; c = c_; nkt = K / BK; }
    __host__ __device__ bool next(int i, Unit& u) const {
        const long L = (long)i * G + c; if (L >= nwg) return false;
        int wgid = (int)L; { const int q = nwg / NXCD, r = nwg % NXCD, xcd = wgid % NXCD, off = wgid / NXCD; wgid = (xcd < r ? xcd * (q + 1) : r * (q + 1) + (xcd - r) * q) + off; }
        const int nig = WGM * nN, gid = wgid / nig, fm = gid * WGM, gsz = (nM - fm) < WGM ? (nM - fm) : WGM;
        u.pm = fm + ((wgid % nig) % gsz); u.pn = (wgid % nig) / gsz; u.k0 = 0; u.nkt = nkt; u.sl = -1; return true;
    }
    __device__ __forceinline__ void a_ready(const Unit&) const {}
    __device__ __forceinline__ void done(const Unit&) const {}
};

template <class Epi, class Sched, bool ALIGN_EPI = false, bool SP2 = false>
__device__ __forceinline__ void gemm_phase(PG8_LAS unsigned char* lds, const Gemm g, const Sched& S, const Epi& E) {
    const int tid = threadIdx.x, wid = __builtin_amdgcn_readfirstlane(tid >> 6), lane = tid & 63, wr = wid >> 2, wc = wid & 3, fr = lane & 15, fq = lane >> 4;
    const int K = g.K;
    unsigned voffA[2], voffB[2];
#pragma unroll
    for (int i = 0; i < 2; ++i) { int R, C; stage_rc(tid * 16 + i * 8192, R, C); const int Rb = Epi::PERM ? ((R & ~31) + perm32(R & 31)) : R;
        voffA[i] = (unsigned)(R * K + C) * 2u; voffB[i] = (unsigned)(Rb * K + C) * 2u; }
    const size_t kstep = (size_t)(BK * 2);
    const size_t hstep = (size_t)HALF * K * 2;
    const size_t tstep = 2 * hstep;
    const unsigned ldsw = (unsigned)wid * 1024u;
    const int aoff = lds_byte(wr * 64 + fr, fq * 8), boff = lds_byte(wc * 32 + fr, fq * 8);
#define PG8_SA(b, h) (((b) * 2 + (h)) * HTB)
#define PG8_SB(b, h) ((4 + (b) * 2 + (h)) * HTB)
#define PG8_STAGE(bufoff, gbase, voff) do { _Pragma("unroll") for (int _i = 0; _i < 2; ++_i) \
        __builtin_amdgcn_global_load_lds((const unsigned*)((const char*)(gbase) + (voff)[_i]), (PG8_LAS unsigned*)(lds + (bufoff) + ldsw + _i * 8192), 16, 0, 0); } while (0)
#define PG8_LDA(dst, b, h) do { _Pragma("unroll") for (int m = 0; m < 4; ++m) _Pragma("unroll") for (int k = 0; k < 2; ++k) dst[m][k] = *(const PG8_LAS bf16x8*)(lds + PG8_SA(b, h) + aoff + m * 2048 + k * 1024); } while (0)
#define PG8_LDB(dst, b, h) do { _Pragma("unroll") for (int n = 0; n < 2; ++n) _Pragma("unroll") for (int k = 0; k < 2; ++k) dst[n][k] = *(const PG8_LAS bf16x8*)(lds + PG8_SB(b, h) + boff + n * 2048 + k * 1024); } while (0)
#define PG8_MMA(ai, bj, At, Bt) do { __builtin_amdgcn_s_setprio(1); _Pragma("unroll") for (int m = 0; m < 4; ++m) _Pragma("unroll") for (int n = 0; n < 2; ++n) _Pragma("unroll") for (int k = 0; k < 2; ++k) \
        acc[ai][bj][m][n] = __builtin_amdgcn_mfma_f32_16x16x32_bf16(Bt[n][k], At[m][k], acc[ai][bj][m][n], 0, 0, 0); __builtin_amdgcn_s_setprio(0); } while (0)
#define PG8_WAIT_V(n) asm volatile("s_waitcnt vmcnt(" #n ")" ::: "memory")
#define PG8_WAIT_L(n) asm volatile("s_waitcnt lgkmcnt(" #n ")" ::: "memory")
#define PG8_BAR __builtin_amdgcn_s_barrier()
#define PG8_SCHED __builtin_amdgcn_sched_barrier(0)
    Unit cur{}, nxt{}; int ui = 0;
    if (!S.next(0, cur)) return;
    f32x4 acc[2][2][4][2];
#pragma unroll
    for (int a = 0; a < 2; ++a)
#pragma unroll
        for (int b = 0; b < 2; ++b)
#pragma unroll
            for (int m = 0; m < 4; ++m)
#pragma unroll
                for (int n = 0; n < 2; ++n) acc[a][b][m][n] = (f32x4){0.f, 0.f, 0.f, 0.f};
    bf16x8 At[4][2], B0[2][2], B1[2][2];
    const char* cA = (const char*)g.A + (size_t)cur.pm * tstep + (size_t)cur.k0 * kstep; const char* cB = (const char*)g.Bt + (size_t)cur.pn * tstep + (size_t)cur.k0 * kstep;
    S.a_ready(cur);
    if constexpr (SP2) {
        PG8_STAGE(PG8_SB(0, 0), cB, voffB); PG8_STAGE(PG8_SB(0, 1), cB + hstep, voffB); PG8_STAGE(PG8_SA(0, 0), cA, voffA); PG8_STAGE(PG8_SA(0, 1), cA + hstep, voffA);
        if (wr == 1) PG8_BAR;
        PG8_WAIT_V(2); PG8_BAR;
        PG8_STAGE(PG8_SB(1, 0), cB + kstep, voffB); PG8_STAGE(PG8_SA(1, 0), cA + kstep, voffA); PG8_STAGE(PG8_SB(1, 1), cB + hstep + kstep, voffB);
        PG8_WAIT_V(6); PG8_BAR;
    } else {
        PG8_STAGE(PG8_SB(0, 0), cB, voffB); PG8_STAGE(PG8_SA(0, 0), cA, voffA); PG8_STAGE(PG8_SB(0, 1), cB + hstep, voffB); PG8_STAGE(PG8_SA(0, 1), cA + hstep, voffA);
        if (wr == 1) PG8_BAR;
        PG8_WAIT_V(4); PG8_BAR;
        PG8_STAGE(PG8_SB(1, 0), cB + kstep, voffB); PG8_STAGE(PG8_SA(1, 0), cA + kstep, voffA); PG8_STAGE(PG8_SB(1, 1), cB + hstep + kstep, voffB);
        PG8_WAIT_V(6); PG8_BAR;
    }
    for (;;) {
        const bool has_next = S.next(ui + 1, nxt);
        const char* nA = has_next ? (const char*)g.A + (size_t)nxt.pm * tstep + (size_t)nxt.k0 * kstep : cA; const char* nB = has_next ? (const char*)g.Bt + (size_t)nxt.pn * tstep + (size_t)nxt.k0 * kstep : cB;
        const int nt = cur.nkt;
        for (int t = 0; t < nt; t += 2) {
            const bool last = (t == nt - 2);
            const char* a1 = cA + (size_t)(t + 1) * kstep;
            const char* a2 = last ? nA : cA + (size_t)(t + 2) * kstep; const char* b2 = last ? nB : cB + (size_t)(t + 2) * kstep;
            const char* a3 = a2 + kstep; const char* b3 = b2 + kstep;
            if (last && has_next) S.a_ready(nxt);
            if constexpr (SP2) {
            PG8_LDB(B0, 0, 0); PG8_LDB(B1, 0, 1); PG8_SCHED; PG8_LDA(At, 0, 0); PG8_STAGE(PG8_SA(1, 1), a1 + hstep, voffA);
            PG8_WAIT_V(8); PG8_WAIT_L(0); PG8_BAR; PG8_MMA(0, 0, At, B0); PG8_MMA(0, 1, At, B1); PG8_BAR; PG8_SCHED;
            PG8_LDA(At, 0, 1); PG8_STAGE(PG8_SB(0, 0), b2, voffB); PG8_STAGE(PG8_SB(0, 1), b2 + hstep, voffB); PG8_STAGE(PG8_SA(0, 0), a2, voffA);
            PG8_WAIT_V(8); PG8_WAIT_L(0); PG8_BAR; PG8_MMA(1, 0, At, B0); PG8_MMA(1, 1, At, B1); PG8_BAR; PG8_SCHED;
            PG8_LDB(B0, 1, 0); PG8_LDB(B1, 1, 1); PG8_SCHED; PG8_LDA(At, 1, 0); PG8_STAGE(PG8_SA(0, 1), a2 + hstep, voffA);
            PG8_WAIT_V(8); PG8_WAIT_L(0); PG8_BAR; PG8_MMA(0, 0, At, B0); PG8_MMA(0, 1, At, B1); PG8_BAR; PG8_SCHED;
            PG8_LDA(At, 1, 1); PG8_STAGE(PG8_SB(1, 0), b3, voffB); PG8_STAGE(PG8_SB(1, 1), b3 + hstep, voffB); PG8_STAGE(PG8_SA(1, 0), a3, voffA);
            PG8_WAIT_V(8); PG8_WAIT_L(0); PG8_BAR; PG8_MMA(1, 0, At, B0); PG8_MMA(1, 1, At, B1); PG8_BAR; PG8_SCHED;
            } else {
            PG8_LDB(B0, 0, 0); PG8_SCHED; PG8_LDA(At, 0, 0); PG8_STAGE(PG8_SA(1, 1), a1 + hstep, voffA);
            PG8_WAIT_L(8); PG8_BAR; PG8_WAIT_L(0); PG8_MMA(0, 0, At, B0); PG8_BAR; PG8_SCHED;
            PG8_LDB(B1, 0, 1); PG8_STAGE(PG8_SB(0, 0), b2, voffB);
            PG8_BAR; PG8_WAIT_L(0); PG8_MMA(0, 1, At, B1); PG8_BAR;
            PG8_LDA(At, 0, 1); PG8_STAGE(PG8_SA(0, 0), a2, voffA);
            PG8_BAR; PG8_WAIT_L(0); PG8_MMA(1, 0, At, B0); PG8_BAR; PG8_SCHED;
            PG8_STAGE(PG8_SB(0, 1), b2 + hstep, voffB);
            PG8_WAIT_V(6); PG8_BAR; PG8_MMA(1, 1, At, B1); PG8_BAR;
            PG8_LDB(B0, 1, 0); PG8_SCHED; PG8_LDA(At, 1, 0); PG8_STAGE(PG8_SA(0, 1), a2 + hstep, voffA);
            PG8_WAIT_L(8); PG8_BAR; PG8_WAIT_L(0); PG8_MMA(0, 0, At, B0); PG8_BAR; PG8_SCHED;
            PG8_LDB(B1, 1, 1); PG8_STAGE(PG8_SB(1, 0), b3, voffB);
            PG8_BAR; PG8_WAIT_L(0); PG8_MMA(0, 1, At, B1); PG8_BAR;
            PG8_LDA(At, 1, 1); PG8_STAGE(PG8_SA(1, 0), a3, voffA);
            PG8_BAR; PG8_WAIT_L(0); PG8_MMA(1, 0, At, B0); PG8_BAR; PG8_SCHED;
            PG8_STAGE(PG8_SB(1, 1), b3 + hstep, voffB);
            PG8_WAIT_V(6); PG8_BAR; PG8_MMA(1, 1, At, B1); PG8_BAR;
            }
        }
        if constexpr (ALIGN_EPI) { if (wr == 0) PG8_BAR; }
        if constexpr (!Epi::AFTER_DRAIN) { E(acc, cur, wr, wc, fr, fq); S.done(cur); }
        if (!has_next) break;
#pragma unroll
        for (int a = 0; a < 2; ++a)
#pragma unroll
            for (int b = 0; b < 2; ++b)
#pragma unroll
                for (int m = 0; m < 4; ++m)
#pragma unroll
                    for (int n = 0; n < 2; ++n) acc[a][b][m][n] = (f32x4){0.f, 0.f, 0.f, 0.f};
        cur = nxt; cA = nA; cB = nB; ++ui;
        if constexpr (ALIGN_EPI) { if (wr == 1) PG8_BAR; }
    }
    PG8_WAIT_V(0);
    if constexpr (!ALIGN_EPI) { if (wr == 0) PG8_BAR; }
    PG8_BAR;
    if constexpr (Epi::AFTER_DRAIN) { E.fused(acc, cur, wr, wc, fr, fq, lds, wid, lane); S.done(cur); }
#undef PG8_SA
#undef PG8_SB
#undef PG8_STAGE
#undef PG8_LDA
#undef PG8_LDB
#undef PG8_MMA
#undef PG8_WAIT_V
#undef PG8_WAIT_L
#undef PG8_BAR
#undef PG8_SCHED
}
}

#define LAS __attribute__((address_space(3)))
typedef unsigned short bf16;
typedef short bf16x8 __attribute__((ext_vector_type(8)));
typedef short s16x4 __attribute__((ext_vector_type(4)));
typedef float f32x4 __attribute__((ext_vector_type(4)));
typedef float f32x2 __attribute__((ext_vector_type(2)));
typedef float f32x16 __attribute__((ext_vector_type(16)));
typedef unsigned u32x4 __attribute__((ext_vector_type(4)));
typedef unsigned u32x2 __attribute__((ext_vector_type(2)));

constexpr int DM = 1024, SEQ = 2048, NBP = 8, DSEQ = 64, NBS = 32, PAST = 4096;
constexpr int TP = NBP * SEQ, TS = NBS * DSEQ, TOK = TP + TS;
constexpr int NPAST = NBS * PAST;
constexpr int KVS = PAST + DSEQ;
constexpr int DIN = 2216, NZ = 2304, ZW = 640;
constexpr int DFF = 2816, DFF2 = 5632;
constexpr float LOG2E = 1.4426950408889634f;
constexpr float EPS = 1e-6f;
constexpr int NTHREADS = 512, NWAVES = 8;
constexpr int LDS_BYTES = 147456;

constexpr size_t O_YP = 0, O_YS = O_YP + (size_t)TP * DM, O_KP = O_YS + (size_t)TS * DM, O_VP = O_KP + (size_t)TP * 512, O_LFP = O_VP + (size_t)TP * 512,
                 O_LATP = O_LFP + (size_t)TP * 8, O_KRP = O_LATP + (size_t)TP * 256, O_CVP = O_KRP + (size_t)TP * 32, O_KS = O_CVP + (size_t)NBP * 2 * DFF2,
                 O_VS = O_KS + (size_t)TS * 512, O_LFS = O_VS + (size_t)TS * 512, O_LATS = O_LFS + (size_t)TS * 8, O_KRS = O_LATS + (size_t)TS * 256,
                 O_CVS = O_KRS + (size_t)TS * 32, O_END = O_CVS + (size_t)NBS * 2 * DFF2;

constexpr size_t MiB = 1u << 20;
constexpr size_t WS_CTL = 0, CTL_BYTES = 16384;
constexpr size_t WS_WIN = 1 * MiB, WS_WQ = 6 * MiB, WS_WKV = 7 * MiB, WS_WOUT = 8 * MiB, WS_WUP = 10 * MiB, WS_WDOWN = 21 * MiB, WS_CS = 27 * MiB,
                 WS_FS = 28 * MiB, WS_FP = 33 * MiB, WS_H = 34 * MiB, WS_QFOX = 70 * MiB, WS_KNEW = 88 * MiB, WS_VNEW = 106 * MiB, WS_ZBUF = 124 * MiB,
                 WS_QCN = 169 * MiB, WS_LATNEW = 183 * MiB, WS_KRNEW = 192 * MiB, WS_QMLA = 194 * MiB, WS_KVNEW = 221 * MiB, WS_MIXED = 257 * MiB,
                 WS_X1 = 293 * MiB, WS_X2 = 124 * MiB  , WS_LATPAST = 365 * MiB, WS_KRPAST = 429 * MiB, WS_KPAST = 437 * MiB,
                 WS_VPAST = 565 * MiB, WS_SLAB = 565 * MiB  , WS_KVPAST = 693 * MiB, WS_EDGE = 693 * MiB  , WS_ACT = 437 * MiB  , WS_WQA = 949 * MiB, WS_QLAT = 951 * MiB, WS_ROWSS = 959 * MiB  , WS_END = 961 * MiB;

struct Args {
    const float* in[23];
    float* out;
    unsigned char* ws;
};

__device__ __forceinline__ unsigned pk2(float lo, float hi) { typedef __bf16 bf2 __attribute__((ext_vector_type(2))); f32x2 v = {lo, hi}; bf2 b = __builtin_convertvector(v, bf2); return __builtin_bit_cast(unsigned, b); }
__device__ __forceinline__ float bflo(unsigned w) { return __builtin_bit_cast(float, w << 16); }
__device__ __forceinline__ float bfhi(unsigned w) { return __builtin_bit_cast(float, w & 0xffff0000u); }
__device__ __forceinline__ float wave_sum(float v) {
#pragma unroll
    for (int o = 1; o < 64; o <<= 1) v += __shfl_xor(v, o);
    return v;
}
__device__ __forceinline__ void st_bf4(bf16* p, f32x4 v) { *(u32x2*)p = (u32x2){pk2(v.x, v.y), pk2(v.z, v.w)}; }
__device__ __forceinline__ void lds_wait() { asm volatile("s_waitcnt lgkmcnt(0)" ::: "memory"); }
__device__ __forceinline__ float fast_exp2(float x) { return __builtin_amdgcn_exp2f(x); }

#define XB_TMO      128
#define XB_XCNT(j)  (256  + 64 * (j))
#define XB_XSUB(j)  (1280 + 64 * (j))
#define XB_XGEN(j)  (2304 + 64 * (j))
#define XB_TOP      3328
#define XB_TOPGEN   3392
#define XCD_BAR_WORDS 3456
#define XB_SPIN_CAP (1u << 18)

__device__ __forceinline__ unsigned xb_ld(unsigned* p)              { return __hip_atomic_load(p, __ATOMIC_RELAXED, __HIP_MEMORY_SCOPE_AGENT); }
__device__ __forceinline__ unsigned xb_add(unsigned* p, unsigned v) { return __hip_atomic_fetch_add(p, v, __ATOMIC_RELAXED, __HIP_MEMORY_SCOPE_AGENT); }
__device__ __forceinline__ unsigned xb_xcc_id() { return (unsigned)__builtin_amdgcn_s_getreg((3 << 11) | 20) & 0xFu; }
#define XB_SPIN(cond, bar) do { unsigned _sp = 0; while (cond) { __builtin_amdgcn_s_sleep(1); \
    if ((++_sp & 255u) == 0u) { if (xb_ld(&(bar)[XB_TMO])) break; if (_sp > XB_SPIN_CAP) { atomicAdd(&(bar)[XB_TMO], 1u); break; } } } } while (0)

struct XcdBarrier {
    unsigned* bar; unsigned x;
    volatile LAS unsigned* st;
};

__device__ __forceinline__ XcdBarrier xcd_barrier_post(unsigned* bar, volatile LAS unsigned* st) {
    XcdBarrier b; b.bar = bar; b.x = xb_xcc_id(); b.st = st;
    if (threadIdx.x == 0) (void)xb_add(&bar[XB_XCNT(b.x)], 1u);
    return b;
}
__device__ __forceinline__ void xcd_barrier_complete(unsigned* bar, unsigned x, unsigned& nloc, unsigned& nx) {
    const unsigned G = gridDim.x * gridDim.y * gridDim.z;
    unsigned sum, cnt, mine, sp = 0u;
    for (;;) {
        sum = 0u; cnt = 0u; mine = 0u;
#pragma unroll
        for (unsigned j = 0; j < 16; ++j) { const unsigned c = xb_ld(&bar[XB_XCNT(j)]); sum += c; cnt += (c > 0u) ? 1u : 0u; mine = (j == x) ? c : mine; }
        if (sum == G) break;
        __builtin_amdgcn_s_sleep(1);
        if ((++sp & 255u) == 0u) { if (xb_ld(&bar[XB_TMO])) break; if (sp > XB_SPIN_CAP) { atomicAdd(&bar[XB_TMO], 1u); break; } }
    }
    nloc = mine > 0u ? mine : 1u; nx = cnt > 0u ? cnt : 1u;
}

__device__ __forceinline__ void xcd_barrier(const XcdBarrier& b) {
    asm volatile("s_waitcnt vmcnt(0)" ::: "memory");
    __syncthreads();
    if (threadIdx.x == 0) {
        unsigned* bar = b.bar;
        __builtin_amdgcn_s_waitcnt(0);
        unsigned nloc = b.st[0], nx = b.st[1];
        if (nloc == 0u) { xcd_barrier_complete(bar, b.x, nloc, nx); b.st[0] = nloc; b.st[1] = nx; }
        const unsigned old = xb_add(&bar[XB_XSUB(b.x)], 1u);
        const unsigned gen = old / nloc;
        if (old + 1u == (gen + 1u) * nloc) {
            __builtin_amdgcn_fence(__ATOMIC_RELEASE, "agent");
            asm volatile("s_waitcnt vmcnt(0)" ::: "memory");
            const unsigned og = xb_add(&bar[XB_TOP], 1u);
            const unsigned tg = og / nx;
            if (og + 1u == (tg + 1u) * nx) xb_add(&bar[XB_TOPGEN], 1u);
            else XB_SPIN(xb_ld(&bar[XB_TOPGEN]) == tg, bar);
            __builtin_amdgcn_fence(__ATOMIC_ACQUIRE, "agent");
            xb_add(&bar[XB_XGEN(b.x)], 1u);
            asm volatile("s_waitcnt vmcnt(0)" ::: "memory");
        } else {
            XB_SPIN(xb_ld(&bar[XB_XGEN(b.x)]) == gen, bar);
            __builtin_amdgcn_fence(__ATOMIC_ACQUIRE, "agent");
            asm volatile("s_waitcnt vmcnt(0)" ::: "memory");
        }
    }
    __syncthreads();
}

template <int MODE> __device__ __forceinline__ int srccol(int n) {
    if (MODE == 0) return n;
    if (MODE == 2) return ((n & 16) ? DFF : 0) + 16 * (n >> 5) + (n & 15);
    if (n < 1536) return n;
    if (n < 1920) return 1544 + (n - 1536);
    if (n < 2176) return 1928 + (n - 1920);
    if (n < 2208) return 2184 + (n - 2176);
    if (n < 2216) return 1536 + (n - 2208);
    return -1;
}
template <int MODE>
__device__ __forceinline__ void tr_item(const float* W, int K, int Nsrc, int Ndst, bf16* WT, int row_off, LAS float* scr, int item, int lane) {
    const int nblk = Ndst / 32, kb = item / nblk, nb = item % nblk, k0 = 64 * kb, n0 = 32 * nb;
    const int sc = srccol<MODE>(n0 + (lane & 31));
#pragma unroll 8
    for (int i = 0; i < 32; ++i) { const int kk = 2 * i + (lane >> 5); scr[kk * 33 + (lane & 31)] = sc >= 0 ? W[(size_t)(k0 + kk) * Nsrc + sc] : 0.f; }
    lds_wait();
    const int c = lane & 7;
#pragma unroll
    for (int j = 0; j < 4; ++j) { const int n = (lane >> 3) + 8 * j; const LAS float* s = scr + (8 * c) * 33 + n;
        u32x4 o; o.x = pk2(s[0 * 33], s[1 * 33]); o.y = pk2(s[2 * 33], s[3 * 33]); o.z = pk2(s[4 * 33], s[5 * 33]); o.w = pk2(s[6 * 33], s[7 * 33]);
        *(u32x4*)(WT + (size_t)(row_off + n0 + n) * K + k0 + 8 * c) = o; }
    lds_wait();
}
template <bool OUTF>
__device__ __forceinline__ void rms_row(const float* xrow, const float* g, void* orow, int lane, const float* slab = nullptr, int nslab = 0, size_t slab_stride = 0) {
    const f32x4* xr = (const f32x4*)xrow + lane; const f32x4* gr = (const f32x4*)g + lane;
    f32x4 v[4]; float s = 0.f;
#pragma unroll
    for (int j = 0; j < 4; ++j) v[j] = xr[64 * j];
    for (int k = 0; k < nslab; ++k) { const f32x4* sr = (const f32x4*)(slab + (size_t)k * slab_stride) + lane;
#pragma unroll
        for (int j = 0; j < 4; ++j) v[j] += sr[64 * j]; }
#pragma unroll
    for (int j = 0; j < 4; ++j) { s += (v[j].x * v[j].x + v[j].y * v[j].y) + (v[j].z * v[j].z + v[j].w * v[j].w); }
    const float rstd = rsqrtf(wave_sum(s) * (1.f / DM) + EPS);
#pragma unroll
    for (int j = 0; j < 4; ++j) { const f32x4 gv = gr[64 * j]; const f32x4 o = v[j] * rstd * gv;
        if (OUTF) ((f32x4*)orow)[64 * j + lane] = o;
        else ((u32x2*)orow)[64 * j + lane] = (u32x2){pk2(o.x, o.y), pk2(o.z, o.w)}; }
}
__device__ __forceinline__ void cvt_stream(const float* src, bf16* dst, size_t n4, size_t gtid, size_t gthreads) {
    size_t i = gtid;
    for (; i + 7 * gthreads < n4; i += 8 * gthreads) {
        f32x4 v[8];
#pragma unroll
        for (int k = 0; k < 8; ++k) v[k] = __builtin_nontemporal_load((const f32x4*)src + i + k * gthreads);
#pragma unroll
        for (int k = 0; k < 8; ++k) ((u32x2*)dst)[i + k * gthreads] = (u32x2){pk2(v[k].x, v[k].y), pk2(v[k].z, v[k].w)};
    }
    for (; i < n4; i += gthreads) { const f32x4 v = ((const f32x4*)src)[i]; ((u32x2*)dst)[i] = (u32x2){pk2(v.x, v.y), pk2(v.z, v.w)}; }
}
__device__ __forceinline__ float wave_incl_scan(float v, int lane) {
#pragma unroll
    for (int o = 1; o < 64; o <<= 1) { const float t = __shfl_up(v, o); if (lane >= o) v += t; }
    return v;
}

template <int NCH>
__device__ __forceinline__ void scan_seq(const float* src, float* dst, float base, int lane, LAS float* scr) {
    float v[NCH];
#pragma unroll
    for (int c = 0; c < NCH; ++c) v[c] = src[(size_t)(64 * c + lane) * 8];
#pragma unroll
    for (int c = 0; c < NCH; ++c) { v[c] = wave_incl_scan(v[c], lane); if (lane == 63) scr[c] = v[c]; }
    lds_wait();
    const float st = wave_incl_scan(lane < NCH ? scr[lane] : 0.f, lane);
    lds_wait();
#pragma unroll
    for (int c = 0; c < NCH; ++c) { const float carry = c ? __builtin_bit_cast(float, __builtin_amdgcn_readlane(__builtin_bit_cast(int, st), c ? c - 1 : 0)) : 0.f; dst[64 * c + lane] = (v[c] + carry + base) * LOG2E; }
}
__device__ __forceinline__ void p0_prologue(const Args& A, LAS unsigned char* lds) {
    const int tid = threadIdx.x, lane = tid & 63, wave = tid >> 6;
    const int G = gridDim.x, gw = blockIdx.x * NWAVES + wave, NGW = G * NWAVES;
    unsigned char* ws = A.ws;
    LAS float* scr = (LAS float*)(lds + wave * 16384);
    constexpr int I_IN = (DM / 64) * (NZ / 32), I_Q = (384 / 64) * (768 / 32), I_UK = (256 / 64) * (512 / 32), I_OUT = (DM / 64) * (DM / 32),
                  I_UP = (DM / 64) * (DFF2 / 32), I_DN = (DFF / 64) * (DM / 32);
    constexpr int NITEMS = I_IN + I_Q + 2 * I_UK + I_OUT + I_UP + I_DN;
    for (int it = gw; it < NITEMS; it += NGW) {
        int r = it;
        if (r < I_IN) { tr_item<1>(A.in[9], DM, DIN, NZ, (bf16*)(ws + WS_WIN), 0, scr, r, lane); continue; } r -= I_IN;
        if (r < I_Q) { tr_item<0>(A.in[12], 384, 768, 768, (bf16*)(ws + WS_WQ), 0, scr, r, lane); continue; } r -= I_Q;
        if (r < I_UK) { tr_item<0>(A.in[14], 256, 512, 512, (bf16*)(ws + WS_WKV), 0, scr, r, lane); continue; } r -= I_UK;
        if (r < I_UK) { tr_item<0>(A.in[15], 256, 512, 512, (bf16*)(ws + WS_WKV), 512, scr, r, lane); continue; } r -= I_UK;
        if (r < I_OUT) { tr_item<0>(A.in[16], DM, DM, DM, (bf16*)(ws + WS_WOUT), 0, scr, r, lane); continue; } r -= I_OUT;
        if (r < I_UP) { tr_item<2>(A.in[18], DM, DFF2, DFF2, (bf16*)(ws + WS_WUP), 0, scr, r, lane); continue; } r -= I_UP;
        tr_item<0>(A.in[21], DFF, DM, DM, (bf16*)(ws + WS_WDOWN), 0, scr, r, lane);
    }
    for (int it = gw; it < 8 * 12 * 8; it += NGW) {
        const int h = it / 96, kt = (it % 96) / 8, ct = it % 8; const int r32 = lane & 31, hi2 = lane >> 5;
        const float* wq = A.in[12] + (size_t)(kt * 32 + r32) * 768 + h * 96 + 8 * hi2; const float* uk = A.in[14] + (size_t)(ct * 32 + r32) * 512 + h * 64 + 8 * hi2;
        f32x16 acc = {};
#pragma unroll
        for (int st = 0; st < 4; ++st) {
            const f32x4 a0 = *(const f32x4*)(wq + 16 * st), a1 = *(const f32x4*)(wq + 16 * st + 4), b0 = *(const f32x4*)(uk + 16 * st), b1 = *(const f32x4*)(uk + 16 * st + 4);
            const u32x4 aw = {pk2(a0.x, a0.y), pk2(a0.z, a0.w), pk2(a1.x, a1.y), pk2(a1.z, a1.w)}, bw = {pk2(b0.x, b0.y), pk2(b0.z, b0.w), pk2(b1.x, b1.y), pk2(b1.z, b1.w)};
            acc = __builtin_amdgcn_mfma_f32_32x32x16_bf16(__builtin_bit_cast(bf16x8, aw), __builtin_bit_cast(bf16x8, bw), acc, 0, 0, 0);
        }
        bf16* o = (bf16*)(ws + WS_WQA) + (size_t)(h * 256 + ct * 32 + r32) * 384 + kt * 32 + 4 * hi2;
#pragma unroll
        for (int q = 0; q < 4; ++q) st_bf4(o + 8 * q, (f32x4){acc[4 * q], acc[4 * q + 1], acc[4 * q + 2], acc[4 * q + 3]});
    }
    for (int m = gw; m < TOK; m += NGW) {
        const float* xr = m < TP ? A.in[0] + (size_t)m * DM : A.in[1] + (size_t)(m - TP) * DM;
        rms_row<false>(xr, A.in[8], (bf16*)(ws + WS_H) + (size_t)m * DM, lane);
    }
    {
        const int gt = blockIdx.x * NTHREADS + tid, GT = G * NTHREADS;
        for (int i = gt; i < 2112 * 16; i += GT) {
            const int pidx = i >> 4, k = i & 15; const int pos = pidx < 2048 ? pidx : PAST + (pidx - 2048);
            const float inv = exp2f(-(float)k * (13.287712379549449f / 16.f));
            const float ang = (float)pos * inv;
            const float kq = floorf(ang * 0.15915494309189535f);
            float r = fmaf(-kq, 6.2831854820251465f, ang); r = fmaf(-kq, -1.7484555e-7f, r);
            const float rev = r * 0.15915494309189535f;
            ((f32x2*)(ws + WS_CS))[i] = (f32x2){__builtin_amdgcn_cosf(rev), __builtin_amdgcn_sinf(rev)};
        }
    }
    for (int sq = (wave == 0 ? (int)blockIdx.x : NBS * 8); sq < NBS * 8; sq += G) {
        const int b = sq >> 3, h = sq & 7; const float* lf = A.in[4] + (size_t)b * PAST * 8 + h; float* Fo = (float*)(ws + WS_FS) + (size_t)sq * KVS;
        scan_seq<PAST / 64>(lf, Fo, 0.f, lane, scr);
    }
    {
        const size_t gt = (size_t)blockIdx.x * NTHREADS + tid, GT = (size_t)G * NTHREADS;
        cvt_stream(A.in[5], (bf16*)(ws + WS_LATPAST), (size_t)NPAST * 256 / 4, gt, GT);
        cvt_stream(A.in[6], (bf16*)(ws + WS_KRPAST), (size_t)NPAST * 32 / 4, gt, GT);
    }
}

__device__ __forceinline__ void rope4(f32x4& x1, f32x4& x2, const float* cs  ) {
    const f32x4 a = ((const f32x4*)cs)[0], b = ((const f32x4*)cs)[1];
    const f32x4 c = {a.x, a.z, b.x, b.z}, s = {a.y, a.w, b.y, b.w};
    const f32x4 o1 = x1 * c - x2 * s, o2 = x1 * s + x2 * c; x1 = o1; x2 = o2;
}
__device__ __forceinline__ float log_sigmoid(float x) { return fminf(x, 0.f) - log1pf(__expf(-fabsf(x))); }

struct EpiZ {
    static constexpr bool PERM = false, AFTER_DRAIN = false;
    bf16 *qfox, *knew, *vnew, *krnew; float* zbuf; float* out; const float* cs; const float* bfg;
    __device__ __forceinline__ void operator()(const f32x4 (&acc)[2][2][4][2], const pg8::Unit& u, int wr, int wc, int fr, int fq) const {
        const bool smp = u.pm >= TP / 256;
        const int row0 = u.pm * 256 + wr * 64 + fr;
#pragma unroll
        for (int bj = 0; bj < 2; ++bj) {
            const int cg = u.pn * 256 + bj * 128 + wc * 32;
            const int c0 = cg + 4 * fq;
#pragma unroll
            for (int ai = 0; ai < 2; ++ai)
#pragma unroll
                for (int m = 0; m < 4; ++m) {
                    const int row = row0 + ai * 128 + m * 16; const size_t lr = smp ? (size_t)(row - TP) : (size_t)row;
                    f32x4 v0 = acc[ai][bj][m][0], v1 = acc[ai][bj][m][1];
                    if (cg < 512) { const float sc = 0.125f * LOG2E; st_bf4(qfox + (size_t)row * 512 + c0, v0 * sc); st_bf4(qfox + (size_t)row * 512 + c0 + 16, v1 * sc); }
                    else if (cg < 1024) { const int c = c0 - 512; float* o = out + (smp ? O_KS : O_KP) + lr * 512 + c; *(f32x4*)o = v0; *(f32x4*)(o + 16) = v1;
                        st_bf4(knew + (size_t)row * 512 + c, v0); st_bf4(knew + (size_t)row * 512 + c + 16, v1); }
                    else if (cg < 1536) { const int c = c0 - 1024; float* o = out + (smp ? O_VS : O_VP) + lr * 512 + c; *(f32x4*)o = v0; *(f32x4*)(o + 16) = v1;
                        st_bf4(vnew + (size_t)row * 512 + c, v0); st_bf4(vnew + (size_t)row * 512 + c + 16, v1); }
                    else if (cg < 2176) { float* z = zbuf + (size_t)row * ZW + (c0 - 1536); *(f32x4*)z = v0; *(f32x4*)(z + 16) = v1; }
                    else if (cg == 2176) {
                        const int pidx = smp ? 2048 + ((row - TP) & 63) : (row & 2047);
                        rope4(v0, v1, cs + ((size_t)pidx * 16 + 4 * fq) * 2);
                        float* o = out + (smp ? O_KRS : O_KRP) + lr * 32 + 4 * fq; *(f32x4*)o = v0; *(f32x4*)(o + 16) = v1;
                        st_bf4(krnew + (size_t)row * 32 + 4 * fq, v0); st_bf4(krnew + (size_t)row * 32 + 4 * fq + 16, v1);
                    } else if (cg == 2208) {
                        if (fq < 2) { const f32x4 b = *(const f32x4*)(bfg + 4 * fq);
                            f32x4 lf; lf.x = log_sigmoid(v0.x + b.x); lf.y = log_sigmoid(v0.y + b.y); lf.z = log_sigmoid(v0.z + b.z); lf.w = log_sigmoid(v0.w + b.w);
                            *(f32x4*)(out + (smp ? O_LFS : O_LFP) + lr * 8 + 4 * fq) = lf; }
                    }
                }
        }
    }
};
struct EpiBf {
    static constexpr bool PERM = true, AFTER_DRAIN = false;
    bf16* O; int ldc; float sc;
    __device__ __forceinline__ void operator()(const f32x4 (&acc)[2][2][4][2], const pg8::Unit& u, int wr, int wc, int fr, int fq) const {
        const int row0 = u.pm * 256 + wr * 64 + fr;
#pragma unroll
        for (int ai = 0; ai < 2; ++ai)
#pragma unroll
            for (int m = 0; m < 4; ++m) { bf16* rp = O + (size_t)(row0 + ai * 128 + m * 16) * ldc + u.pn * 256 + wc * 32 + 8 * fq;
#pragma unroll
                for (int bj = 0; bj < 2; ++bj) { const f32x4 v0 = acc[ai][bj][m][0] * sc, v1 = acc[ai][bj][m][1] * sc;
                    *(u32x4*)(rp + bj * 128) = (u32x4){pk2(v0.x, v0.y), pk2(v0.z, v0.w), pk2(v1.x, v1.y), pk2(v1.z, v1.w)}; } }
    }
};
constexpr int DN_SL = 8;
template <int NKT  >
struct SplitOrder {
    int G, c;
    __device__ __forceinline__ bool next(int i, pg8::Unit& u) const {
        const int L = i * G + c; if (L >= 256 + 32 * DN_SL) return false;
        const bool full = L < 256; const int r = full ? L : L - 256, x = r & 7, y = r >> 3;
        pg8::Unit t; t.pm = full ? 8 * x + (y & 7) : 64 + x; t.pn = full ? (y >> 3) : (y & 3); const int sl = y >> 2;
        if (NKT == 44) { t.k0 = full ? 0 : (sl < 6 ? 6 * sl : 36 + 4 * (sl - 6)); t.nkt = full ? 44 : (sl < 6 ? 6 : 4); }
        else { t.k0 = full ? 0 : 2 * sl; t.nkt = full ? 16 : 2; }
        t.sl = full ? -1 : sl;
        u = t; return true;
    }
    __device__ __forceinline__ void a_ready(const pg8::Unit&) const {}
    __device__ __forceinline__ void done(const pg8::Unit&) const {}
};
typedef SplitOrder<44> DownOrder;
struct EpiDown {
    static constexpr bool PERM = false, AFTER_DRAIN = false;
    const float* x1; float* x2; float* slab;
    __device__ __forceinline__ void operator()(const f32x4 (&acc)[2][2][4][2], const pg8::Unit& u, int wr, int wc, int fr, int fq) const {
        const int row0 = u.pm * 256 + wr * 64 + fr; const bool part = u.sl >= 0;
#pragma unroll
        for (int ai = 0; ai < 2; ++ai)
#pragma unroll
            for (int m = 0; m < 4; ++m) { const int row = row0 + ai * 128 + m * 16; const int cb = u.pn * 256 + wc * 32 + 4 * fq;
                if (part) { float* op = slab + ((size_t)u.sl * TS + (row - TP)) * DM + cb;
#pragma unroll
                    for (int bj = 0; bj < 2; ++bj)
#pragma unroll
                        for (int n = 0; n < 2; ++n) *(f32x4*)(op + bj * 128 + n * 16) = acc[ai][bj][m][n]; }
                else { const float* bp = x1 + (size_t)row * DM + cb; float* op = x2 + (size_t)row * DM + cb;
#pragma unroll
                    for (int bj = 0; bj < 2; ++bj)
#pragma unroll
                        for (int n = 0; n < 2; ++n) *(f32x4*)(op + bj * 128 + n * 16) = *(const f32x4*)(bp + bj * 128 + n * 16) + acc[ai][bj][m][n]; } }
    }
};
struct EpiOut {
    static constexpr bool PERM = false, AFTER_DRAIN = false;
    const float* b0; const float* b1; float* O; bf16* H; const float* g; float* rowss; float* slab;
    __device__ __forceinline__ void operator()(const f32x4 (&acc)[2][2][4][2], const pg8::Unit& u, int wr, int wc, int fr, int fq) const {
        const int row0 = u.pm * 256 + wr * 64 + fr; const bool smp = u.pm >= TP / 256; const int cb = u.pn * 256 + wc * 32 + 4 * fq;
        if (u.sl >= 0) {
#pragma unroll
            for (int ai = 0; ai < 2; ++ai)
#pragma unroll
                for (int m = 0; m < 4; ++m) { float* sp = slab + ((size_t)u.sl * TS + (row0 + ai * 128 + m * 16 - TP)) * DM + cb;
#pragma unroll
                    for (int bj = 0; bj < 2; ++bj)
#pragma unroll
                        for (int n = 0; n < 2; ++n) *(f32x4*)(sp + bj * 128 + n * 16) = acc[ai][bj][m][n]; }
            return;
        }
        f32x4 gv[2][2];
#pragma unroll
        for (int bj = 0; bj < 2; ++bj)
#pragma unroll
            for (int n = 0; n < 2; ++n) gv[bj][n] = *(const f32x4*)(g + cb + bj * 128 + n * 16);
#pragma unroll
        for (int ai = 0; ai < 2; ++ai)
#pragma unroll
            for (int m = 0; m < 4; ++m) { const int row = row0 + ai * 128 + m * 16;
                const float* bp = (smp ? b1 + (size_t)(row - TP) * DM : b0 + (size_t)row * DM) + cb; float* op = O + (size_t)row * DM + cb; bf16* hp = H + (size_t)row * DM + cb;
                float ss = 0.f;
#pragma unroll
                for (int bj = 0; bj < 2; ++bj)
#pragma unroll
                    for (int n = 0; n < 2; ++n) { const f32x4 x = *(const f32x4*)(bp + bj * 128 + n * 16) + acc[ai][bj][m][n]; *(f32x4*)(op + bj * 128 + n * 16) = x;
                        ss += (x.x * x.x + x.y * x.y) + (x.z * x.z + x.w * x.w); st_bf4(hp + bj * 128 + n * 16, x * gv[bj][n]); }
                ss += __shfl_xor(ss, 16); ss += __shfl_xor(ss, 32);
                if (fq == 0) rowss[(size_t)row * 16 + u.pn * 4 + wc] = ss;
            }
    }
};
struct EpiRes {
    static constexpr bool PERM = false, AFTER_DRAIN = false;
    const float* b0; const float* b1; float* O;
    __device__ __forceinline__ void operator()(const f32x4 (&acc)[2][2][4][2], const pg8::Unit& u, int wr, int wc, int fr, int fq) const {
        const int row0 = u.pm * 256 + wr * 64 + fr; const bool smp = u.pm >= TP / 256;
#pragma unroll
        for (int ai = 0; ai < 2; ++ai)
#pragma unroll
            for (int m = 0; m < 4; ++m) { const int row = row0 + ai * 128 + m * 16; const int cb = u.pn * 256 + wc * 32 + 4 * fq;
                const float* bp = (smp ? b1 + (size_t)(row - TP) * DM : b0 + (size_t)row * DM) + cb; float* op = O + (size_t)row * DM + cb;
#pragma unroll
                for (int bj = 0; bj < 2; ++bj)
#pragma unroll
                    for (int n = 0; n < 2; ++n) *(f32x4*)(op + bj * 128 + n * 16) = *(const f32x4*)(bp + bj * 128 + n * 16) + acc[ai][bj][m][n]; }
    }
};


__device__ __forceinline__ float silu(float g) { return g * __builtin_amdgcn_rcpf(1.f + fast_exp2(-g * LOG2E)); }
template <int CTRL> __device__ __forceinline__ float dpp_mov(float old, float src) {
    return __builtin_bit_cast(float, __builtin_amdgcn_update_dpp(__builtin_bit_cast(int, old), __builtin_bit_cast(int, src), CTRL, 0xf, 0xf, false)); }
__device__ __forceinline__ f32x4 rows_m1(f32x4 cur, f32x4 prev) { f32x4 o;
#pragma unroll
    for (int e = 0; e < 4; ++e) o[e] = dpp_mov<0x111>(dpp_mov<0x121>(0.f, prev[e]), cur[e]);
    return o; }
__device__ __forceinline__ f32x4 rows_m2(f32x4 cur, f32x4 prev) { f32x4 o;
#pragma unroll
    for (int e = 0; e < 4; ++e) o[e] = dpp_mov<0x112>(dpp_mov<0x122>(0.f, prev[e]), cur[e]);
    return o; }
struct EpiGlu {
    static constexpr bool PERM = false, AFTER_DRAIN = false;
    bf16* act; float* edge; const float* cw; const float* cb; const float* rowss;
    __device__ __forceinline__ void operator()(const f32x4 (&acc)[2][2][4][2], const pg8::Unit& u, int wr, int wc, int fr, int fq) const {
        float rstd[2][4];
#pragma unroll
        for (int ai = 0; ai < 2; ++ai)
#pragma unroll
            for (int m = 0; m < 4; ++m) { const f32x4* rp = (const f32x4*)(rowss + (size_t)(u.pm * 256 + ai * 128 + wr * 64 + m * 16 + fr) * 16);
                const f32x4 a = rp[0], b = rp[1], c = rp[2], d = rp[3]; const f32x4 t = (a + b) + (c + d);
                rstd[ai][m] = rsqrtf(((t.x + t.y) + (t.z + t.w)) * (1.f / DM) + EPS); asm volatile("" : "+v"(rstd[ai][m]) :: "memory"); }
#pragma unroll
        for (int bj = 0; bj < 2; ++bj) {
            const int j = 16 * ((u.pn * 256 + bj * 128 + wc * 32) >> 5) + 4 * fq;
            const f32x4 w0g = *(const f32x4*)(cw + j), w1g = *(const f32x4*)(cw + DFF2 + j), w2g = *(const f32x4*)(cw + 2 * DFF2 + j), bg = *(const f32x4*)(cb + j);
            const f32x4 w0v = *(const f32x4*)(cw + DFF + j), w1v = *(const f32x4*)(cw + DFF2 + DFF + j), w2v = *(const f32x4*)(cw + 2 * DFF2 + DFF + j), bv = *(const f32x4*)(cb + DFF + j);
#pragma unroll
            for (int ai = 0; ai < 2; ++ai) {
                const int blk = u.pm * 4 + ai * 2 + wr; const int row0 = blk * 64 + fr;
#pragma unroll
                for (int m = 0; m < 4; ++m) {
                    const f32x4 gc = acc[ai][bj][m][0] * rstd[ai][m], vc = acc[ai][bj][m][1] * rstd[ai][m];
                    const f32x4 gp = acc[ai][bj][m ? m - 1 : 0][0] * rstd[ai][m ? m - 1 : 0], vp = acc[ai][bj][m ? m - 1 : 0][1] * rstd[ai][m ? m - 1 : 0];
                    const f32x4 g1 = rows_m1(gc, gp), g2 = rows_m2(gc, gp), v1 = rows_m1(vc, vp), v2 = rows_m2(vc, vp);
                    const f32x4 g = bg + w0g * g2 + w1g * g1 + w2g * gc, v = bv + w0v * v2 + w1v * v1 + w2v * vc;
                    f32x4 a; a.x = silu(g.x) * v.x; a.y = silu(g.y) * v.y; a.z = silu(g.z) * v.z; a.w = silu(g.w) * v.w;
                    if (m > 0 || fr >= 2) st_bf4(act + (size_t)(row0 + 16 * m) * DFF + j, a);
                    if (m == 0 && fr < 2) { float* e = edge + ((size_t)blk * 4 + fr) * DFF2; *(f32x4*)(e + j) = gc; *(f32x4*)(e + DFF + j) = vc; }
                    if (m == 3 && fr >= 14) { float* e = edge + ((size_t)blk * 4 + 2 + (fr - 14)) * DFF2; *(f32x4*)(e + j) = gc; *(f32x4*)(e + DFF + j) = vc; }
                }
            }
        }
    }
};

__device__ __forceinline__ void p2_postz(const Args& A, LAS unsigned char* lds) {
    const int tid = threadIdx.x, lane = tid & 63, wave = tid >> 6; const int gw = blockIdx.x * NWAVES + wave, NGW = gridDim.x * NWAVES;
    unsigned char* ws = A.ws; const float* zb = (const float*)(ws + WS_ZBUF);
    for (int m = gw; m < TOK; m += NGW) {
        const float* z = zb + (size_t)m * ZW;
        { f32x2 v[3]; float s = 0.f;
#pragma unroll
          for (int j = 0; j < 3; ++j) { v[j] = ((const f32x2*)z)[lane + 64 * j]; s += v[j].x * v[j].x + v[j].y * v[j].y; }
          const float rstd = rsqrtf(wave_sum(s) * (1.f / 384.f) + EPS); unsigned* o = (unsigned*)((bf16*)(ws + WS_QCN) + (size_t)m * 384);
#pragma unroll
          for (int j = 0; j < 3; ++j) { const f32x2 g = ((const f32x2*)A.in[11])[lane + 64 * j]; o[lane + 64 * j] = pk2(v[j].x * rstd * g.x, v[j].y * rstd * g.y); } }
        { const f32x4 v = ((const f32x4*)(z + 384))[lane]; const float s = (v.x * v.x + v.y * v.y) + (v.z * v.z + v.w * v.w);
          const float rstd = rsqrtf(wave_sum(s) * (1.f / 256.f) + EPS); const f32x4 g = ((const f32x4*)A.in[13])[lane]; const f32x4 o = v * rstd * g;
          float* op = A.out + (m < TP ? O_LATP + (size_t)m * 256 : O_LATS + (size_t)(m - TP) * 256); ((f32x4*)op)[lane] = o;
          st_bf4((bf16*)(ws + WS_LATNEW) + (size_t)m * 256 + 4 * lane, o); }
    }
    for (int sq = ((gw & 3) == 0 ? (gw >> 2) : 64 + 256); sq < 64 + 256; sq += (NGW >> 2)) {
        if (sq < 64) { const int b = sq >> 3, h = sq & 7; const float* lf = A.out + O_LFP + (size_t)b * SEQ * 8 + h; float* Fo = (float*)(ws + WS_FP) + (size_t)sq * SEQ; scan_seq<SEQ / 64>(lf, Fo, 0.f, lane, (LAS float*)(lds + wave * 16384)); }
        else { const int s2 = sq - 64, b = s2 >> 3, h = s2 & 7; const float* lf = A.out + O_LFS + (size_t)b * DSEQ * 8 + h; float* Fo = (float*)(ws + WS_FS) + (size_t)s2 * KVS;
            const float base = Fo[PAST - 1]; const float v = wave_incl_scan(lf[(size_t)lane * 8], lane); Fo[PAST + lane] = base + v * LOG2E; }
    }
}

__device__ __forceinline__ f32x4 ld_bf4(const bf16* p) { const u32x2 w = *(const u32x2*)p; return (f32x4){bflo(w.x), bfhi(w.x), bflo(w.y), bfhi(w.y)}; }
__device__ __forceinline__ void p8_fixup(const Args& A) {
    int tid = threadIdx.x; asm volatile("" : "+v"(tid)); const int lane = tid & 63, wave = tid >> 6; const int gw = blockIdx.x * NWAVES + wave, NGW = gridDim.x * NWAVES;
    unsigned char* ws = A.ws; const float* __restrict__ EDGE = (const float*)(ws + WS_EDGE); bf16* __restrict__ ACT = (bf16*)(ws + WS_ACT);
    const float* __restrict__ cw = A.in[19]; const float* __restrict__ cb = A.in[20];
    constexpr int NBLK = TOK / 64, NSTRIP = DFF / 256, NIT = NBLK * NSTRIP;
    for (int it0 = gw; it0 < NIT; it0 += 2 * NGW) {
        f32x4 wg[2][4], wv[2][4], pg[2][2], pv[2][2], cg[2][2], cv[2][2], sg[2][2], sv[2][2]; bool ok[2], last[2], smp[2]; int j0[2], tok0[2], bb[2];
#pragma unroll
        for (int u = 0; u < 2; ++u) {
            const int it = it0 + u * NGW; ok[u] = it < NIT; const int itc = ok[u] ? it : it0;
            const int blk = itc / NSTRIP, strip = itc % NSTRIP; j0[u] = strip * 256 + lane * 4; tok0[u] = blk * 64;
            smp[u] = tok0[u] >= TP; const int T = smp[u] ? DSEQ : SEQ; const int lt = smp[u] ? tok0[u] - TP : tok0[u]; bb[u] = lt / T; const int t0 = lt % T; last[u] = (t0 + 64 == T);
#pragma unroll
            for (int k = 0; k < 3; ++k) { wg[u][k] = *(const f32x4*)(cw + k * DFF2 + j0[u]); wv[u][k] = *(const f32x4*)(cw + k * DFF2 + DFF + j0[u]); }
            wg[u][3] = *(const f32x4*)(cb + j0[u]); wv[u][3] = *(const f32x4*)(cb + DFF + j0[u]);
            const float* pe = (t0 == 0) ? (smp[u] ? A.in[7] + (size_t)bb[u] * 2 * DFF2 : EDGE  ) : EDGE + ((size_t)(blk - 1) * 4 + 2) * DFF2;
            const bool zero = (t0 == 0) && !smp[u];
#pragma unroll
            for (int i = 0; i < 2; ++i) { pg[u][i] = *(const f32x4*)(pe + i * DFF2 + j0[u]); pv[u][i] = *(const f32x4*)(pe + i * DFF2 + DFF + j0[u]);
                if (zero) { pg[u][i] = (f32x4){0.f, 0.f, 0.f, 0.f}; pv[u][i] = (f32x4){0.f, 0.f, 0.f, 0.f}; }
                const float* e = EDGE + ((size_t)blk * 4 + i) * DFF2; cg[u][i] = *(const f32x4*)(e + j0[u]); cv[u][i] = *(const f32x4*)(e + DFF + j0[u]);
                const float* e2 = EDGE + ((size_t)blk * 4 + 2 + i) * DFF2; sg[u][i] = *(const f32x4*)(e2 + j0[u]); sv[u][i] = *(const f32x4*)(e2 + DFF + j0[u]); }
        }
#pragma unroll
        for (int u = 0; u < 2; ++u) if (ok[u]) {
            f32x4 g2 = pg[u][0], g1 = pg[u][1], v2 = pv[u][0], v1 = pv[u][1];
#pragma unroll
            for (int i = 0; i < 2; ++i) {
                const f32x4 gc = cg[u][i], vc = cv[u][i];
                const f32x4 g = wg[u][3] + wg[u][0] * g2 + wg[u][1] * g1 + wg[u][2] * gc, v = wv[u][3] + wv[u][0] * v2 + wv[u][1] * v1 + wv[u][2] * vc;
                f32x4 a; a.x = silu(g.x) * v.x; a.y = silu(g.y) * v.y; a.z = silu(g.z) * v.z; a.w = silu(g.w) * v.w;
                st_bf4(ACT + (size_t)(tok0[u] + i) * DFF + j0[u], a);
                g2 = g1; g1 = gc; v2 = v1; v1 = vc;
            }
            if (last[u]) {
#pragma unroll
                for (int i = 0; i < 2; ++i) { float* o = A.out + (smp[u] ? O_CVS : O_CVP) + ((size_t)bb[u] * 2 + i) * DFF2; *(f32x4*)(o + j0[u]) = sg[u][i]; *(f32x4*)(o + DFF + j0[u]) = sv[u][i]; }
            }
        }
    }
}

struct AttnArgs {
    const bf16* Q; int qstride;
    const void *Ka_past, *Ka_new; int kastride;
    const bf16 *Kb_past, *Kb_new; int kbstride;
    const void *V_past, *V_new; int vstride;
    const float *Fq, *Fk;
    bf16* O; int ostride;
    int P, qpos0, nkv;
    const float* cs;
};
__device__ __forceinline__ int crow(int r, int hi) { return (r & 3) + 8 * (r >> 2) + 4 * hi; }
__device__ __forceinline__ s16x4 tr_read(const LAS unsigned char* p) { typedef short v4i16 __attribute__((ext_vector_type(4))); return __builtin_bit_cast(s16x4, __builtin_amdgcn_ds_read_tr16_b64_v4i16((LAS v4i16*)p)); }

template <int DQK, bool FOX, int QS, int KS, bool F32>
__device__ __forceinline__ void attn_unit(const AttnArgs& a, LAS unsigned char* lds_base) {
    LAS unsigned char* const lds = lds_base;
    static_assert(QS * KS == NWAVES, "8 waves");
    constexpr int KRB = (DQK + 8) * 2, VRB = 144, NKK = DQK / 16;
    constexpr int OFF_V = 64 * KS * KRB, OFF_F = OFF_V + 64 * KS * VRB, OFF_Q = OFF_F + 64 * KS * 4, OFF_END = OFF_Q + QS * NKK * 1024;
    constexpr bool QLDS = KS > 1;
    static_assert(OFF_END <= 131072, "attention LDS");
    int tid = threadIdx.x; asm volatile("" : "+v"(tid));
    const int lane = tid & 63, q32 = lane & 31, hi = lane >> 5; const int wid = __builtin_amdgcn_readfirstlane(tid >> 6);
    const int qs = wid % QS, ks = wid / QS;
    const int NT = (a.nkv + 64 * KS - 1) / (64 * KS);
    const int qmin = a.qpos0 + qs * 32, qpos = qmin + q32;
    bf16x8 qf[NKK];
    { const bf16* qp = a.Q + (size_t)(qs * 32 + q32) * a.qstride + hi * 8;
#pragma unroll
      for (int kk = 0; kk < NKK; ++kk) qf[kk] = *(const bf16x8*)(qp + kk * 16); }
    if (DQK == 96) {
        const int pidx = qpos < SEQ ? qpos : SEQ + (qpos - PAST);
        const f32x4* cp = (const f32x4*)(a.cs + ((size_t)pidx * 16 + 8 * hi) * 2);
        const u32x4 w1 = __builtin_bit_cast(u32x4, qf[NKK - 2]), w2 = __builtin_bit_cast(u32x4, qf[NKK - 1]); u32x4 r1, r2;
#pragma unroll
        for (int j = 0; j < 4; ++j) { const f32x4 c = cp[j];
            const float a0 = bflo(w1[j]), a1 = bfhi(w1[j]), b0 = bflo(w2[j]), b1 = bfhi(w2[j]);
            r1[j] = pk2(a0 * c.x - b0 * c.y, a1 * c.z - b1 * c.w); r2[j] = pk2(a0 * c.y + b0 * c.x, a1 * c.w + b1 * c.z); }
        qf[NKK - 2] = __builtin_bit_cast(bf16x8, r1); qf[NKK - 1] = __builtin_bit_cast(bf16x8, r2);
    }
    LAS unsigned char* qlds = lds + OFF_Q + qs * (NKK * 1024) + lane * 16;
    if (QLDS) {
#pragma unroll
        for (int kk = 0; kk < NKK; ++kk) *(LAS bf16x8*)(qlds + kk * 1024) = qf[kk];
    }
    const float fqv = FOX ? a.Fq[qs * 32 + q32] : 0.f;
    float mrun = -1e30f, lsum = 0.f; f32x16 o0 = {}, o1 = {};
    u32x4 rka[KS], rv[F32 ? 1 : KS]; u32x4 rkb[(DQK == 96) ? (KS + 1) / 2 : 1]; float rf = 0.f;
    f32x4 fka[F32 ? KS : 1][2], fva[F32 ? KS : 1][2];
    const int lrow = tid >> 3, lch = tid & 7;
    const int brow = (tid & 255) >> 2, bch = tid & 3;
    auto load_k = [&](int T) {
        const int jT = T * KS * 64; const bool past = jT < a.P; const size_t r0 = (size_t)(past ? jT : jT - a.P);
        if (F32) { const float* kp = (const float*)(past ? a.Ka_past : a.Ka_new) + (r0 + lrow) * a.kastride + lch * 8;
#pragma unroll
            for (int s = 0; s < KS; ++s) if (jT + s * 64 < a.nkv) { const f32x4* p4 = (const f32x4*)(kp + (size_t)s * 64 * a.kastride); fka[F32 ? s : 0][0] = p4[0]; fka[F32 ? s : 0][1] = p4[1]; } }
        else { const bf16* kp = (const bf16*)(past ? a.Ka_past : a.Ka_new) + (r0 + lrow) * a.kastride + lch * 8;
#pragma unroll
            for (int s = 0; s < KS; ++s) if (jT + s * 64 < a.nkv) rka[s] = *(const u32x4*)(kp + (size_t)s * 64 * a.kastride); }
        if (DQK == 96) { const bf16* bp = (past ? a.Kb_past : a.Kb_new) + (r0 + (tid >> 8) * 64 + brow) * a.kbstride + bch * 8;
#pragma unroll
            for (int i = 0; i < (KS + 1) / 2; ++i) { const int s = 2 * i + (tid >> 8); if (s < KS && jT + s * 64 < a.nkv) rkb[i] = *(const u32x4*)(bp + (size_t)i * 128 * a.kbstride); }
        }
        if (FOX) { const int j = jT + tid; if (tid < 64 * KS && j < a.nkv) rf = a.Fk[j]; }
    };
    auto cvt_k = [&]() {
        if (F32) {
#pragma unroll
            for (int s = 0; s < KS; ++s) { const f32x4 k0 = fka[F32 ? s : 0][0], k1 = fka[F32 ? s : 0][1]; rka[s] = (u32x4){pk2(k0.x, k0.y), pk2(k0.z, k0.w), pk2(k1.x, k1.y), pk2(k1.z, k1.w)}; }
        }
    };
    auto load_v = [&](int T) {
        const int jT = T * KS * 64; const bool past = jT < a.P; const size_t r0 = (size_t)(past ? jT : jT - a.P);
        if (F32) { const float* vp = (const float*)(past ? a.V_past : a.V_new) + (r0 + lrow) * a.vstride + lch * 8;
#pragma unroll
            for (int s = 0; s < KS; ++s) if (jT + s * 64 < a.nkv) { const f32x4* p4 = (const f32x4*)(vp + (size_t)s * 64 * a.vstride); fva[F32 ? s : 0][0] = p4[0]; fva[F32 ? s : 0][1] = p4[1]; } }
        else { const bf16* vp = (const bf16*)(past ? a.V_past : a.V_new) + (r0 + lrow) * a.vstride + lch * 8;
#pragma unroll
            for (int s = 0; s < KS; ++s) if (jT + s * 64 < a.nkv) rv[F32 ? 0 : s] = *(const u32x4*)(vp + (size_t)s * 64 * a.vstride); }
    };
    constexpr bool DB = (KS == 1);
    static_assert(!DB || OFF_Q <= 32768, "double buffer stride");
    auto store_tile = [&](int T) {
        LAS unsigned char* const lds = lds_base + (DB ? (T & 1) * 32768 : 0);
#pragma unroll
        for (int s = 0; s < KS; ++s) { const int j0 = (T * KS + s) * 64;
            if (j0 < a.nkv) {
                *(LAS u32x4*)(lds + (s * 64 + lrow) * KRB + lch * 16) = rka[s];
                if (F32) { const f32x4 v0 = fva[F32 ? s : 0][0], v1 = fva[F32 ? s : 0][1];
                    *(LAS u32x4*)(lds + OFF_V + (s * 64 + lrow) * VRB + lch * 16) = (u32x4){pk2(v0.x, v0.y), pk2(v0.z, v0.w), pk2(v1.x, v1.y), pk2(v1.z, v1.w)}; }
                else *(LAS u32x4*)(lds + OFF_V + (s * 64 + lrow) * VRB + lch * 16) = rv[F32 ? 0 : s]; } }
        if (DQK == 96) {
#pragma unroll
            for (int i = 0; i < (KS + 1) / 2; ++i) { const int s = 2 * i + (tid >> 8); const int j0 = (T * KS + s) * 64;
                if (s < KS && j0 < a.nkv) *(LAS u32x4*)(lds + (s * 64 + brow) * KRB + 128 + bch * 16) = rkb[i]; }
        }
        if (FOX) { if (tid < 64 * KS) *(LAS float*)(lds + OFF_F + tid * 4) = rf; }
    };
    load_k(0); cvt_k(); load_v(0);
    const LAS unsigned char* kbase0 = lds + (ks * 64 + q32) * KRB + hi * 16;
    const LAS unsigned char* vbase0 = lds + OFF_V + (ks * 64 + 4 * hi + ((lane & 15) >> 2)) * VRB + (16 * ((lane >> 4) & 1) + 4 * (lane & 3)) * 2;
    const LAS unsigned char* fbase0 = lds + OFF_F + (ks * 64 + 4 * hi) * 4;
    if (DB) { store_tile(0); __syncthreads(); }
    for (int T = 0; T < NT; ++T) {
        if (!DB) { __syncthreads(); store_tile(T); __syncthreads(); }
        const int bo = DB ? (T & 1) * 32768 : 0;
        const LAS unsigned char* kbase = kbase0 + bo; const LAS unsigned char* vbase = vbase0 + bo; const LAS unsigned char* fbase = fbase0 + bo;
        if (T + 1 < NT) load_k(T + 1);
        __builtin_amdgcn_sched_barrier(0);
        const int tt = T * KS + ks; const int j0 = tt * 64;
        const bool valid = (j0 < a.nkv) && (FOX ? (j0 <= qmin + 31) : (tt <= (qmin >> 6)));
        bf16x8 pb[4];
        if (valid) {
            f32x16 p0 = {}, p1 = {};
#pragma unroll
            for (int kk = 0; kk < NKK; ++kk) {
                const bf16x8 k0 = *(const LAS bf16x8*)(kbase + kk * 32), k1 = *(const LAS bf16x8*)(kbase + 32 * KRB + kk * 32);
                const bf16x8 qv = QLDS ? *(const LAS bf16x8*)(qlds + kk * 1024) : qf[kk];
                p0 = __builtin_amdgcn_mfma_f32_32x32x16_bf16(k0, qv, p0, 0, 0, 0);
                p1 = __builtin_amdgcn_mfma_f32_32x32x16_bf16(k1, qv, p1, 0, 0, 0);
            }
            if (FOX) {
#pragma unroll
                for (int g = 0; g < 4; ++g) { const f32x4 f0 = *(const LAS f32x4*)(fbase + g * 32), f1 = *(const LAS f32x4*)(fbase + 128 + g * 32);
#pragma unroll
                    for (int e = 0; e < 4; ++e) { p0[4 * g + e] += fqv - f0[e]; p1[4 * g + e] += fqv - f1[e]; } }
                if (j0 + 63 > qmin) {
#pragma unroll
                    for (int r = 0; r < 16; ++r) { const int kv = j0 + crow(r, hi); if (kv > qpos) p0[r] = -1e30f; if (kv + 32 > qpos) p1[r] = -1e30f; }
                }
            }
            float mt = fmaxf(p0[0], p1[0]);
#pragma unroll
            for (int r = 1; r < 16; ++r) mt = fmaxf(mt, fmaxf(p0[r], p1[r]));
            mt = fmaxf(mt, __shfl_xor(mt, 32));
            const float mnew = fmaxf(mrun, mt), alpha = fast_exp2(mrun - mnew); mrun = mnew;
            float ps = 0.f;
#pragma unroll
            for (int r = 0; r < 16; ++r) { p0[r] = fast_exp2(p0[r] - mnew); p1[r] = fast_exp2(p1[r] - mnew); ps += p0[r] + p1[r]; }
            lsum = lsum * alpha + ps;
            if (__builtin_amdgcn_ballot_w64(alpha != 1.f)) { o0 = o0 * alpha; o1 = o1 * alpha; }
#pragma unroll
            for (int s = 0; s < 2; ++s) {
                u32x4 w0 = {pk2(p0[8 * s], p0[8 * s + 1]), pk2(p0[8 * s + 2], p0[8 * s + 3]), pk2(p0[8 * s + 4], p0[8 * s + 5]), pk2(p0[8 * s + 6], p0[8 * s + 7])};
                u32x4 w1 = {pk2(p1[8 * s], p1[8 * s + 1]), pk2(p1[8 * s + 2], p1[8 * s + 3]), pk2(p1[8 * s + 4], p1[8 * s + 5]), pk2(p1[8 * s + 6], p1[8 * s + 7])};
                pb[s] = __builtin_bit_cast(bf16x8, w0); pb[2 + s] = __builtin_bit_cast(bf16x8, w1);
            }
        }
        __builtin_amdgcn_sched_barrier(0);
        if (T + 1 < NT) { cvt_k(); load_v(T + 1); }
        __builtin_amdgcn_sched_barrier(0);
        if (valid) {
#pragma unroll
            for (int kst = 0; kst < 4; ++kst) {
                const LAS unsigned char* vp = vbase + 16 * kst * VRB;
                const s16x4 a0l = tr_read(vp), a0h = tr_read(vp + 8 * VRB), a1l = tr_read(vp + 64), a1h = tr_read(vp + 64 + 8 * VRB);
                const bf16x8 A0 = {a0l[0], a0l[1], a0l[2], a0l[3], a0h[0], a0h[1], a0h[2], a0h[3]}, A1 = {a1l[0], a1l[1], a1l[2], a1l[3], a1h[0], a1h[1], a1h[2], a1h[3]};
                o0 = __builtin_amdgcn_mfma_f32_32x32x16_bf16(A0, pb[kst], o0, 0, 0, 0);
                o1 = __builtin_amdgcn_mfma_f32_32x32x16_bf16(A1, pb[kst], o1, 0, 0, 0);
            }
        }
        if (DB) { if (T + 1 < NT) store_tile(T + 1); __syncthreads(); }
    }
    lsum += __shfl_xor(lsum, 32);
    if (KS == 1) {
        const float inv = 1.f / lsum; bf16* op = a.O + (size_t)(qs * 32 + q32) * a.ostride + 4 * hi;
#pragma unroll
        for (int g = 0; g < 4; ++g) { st_bf4(op + 8 * g, (f32x4){o0[4 * g] * inv, o0[4 * g + 1] * inv, o0[4 * g + 2] * inv, o0[4 * g + 3] * inv});
            st_bf4(op + 32 + 8 * g, (f32x4){o1[4 * g] * inv, o1[4 * g + 1] * inv, o1[4 * g + 2] * inv, o1[4 * g + 3] * inv}); }
    } else {
        __syncthreads();
        LAS float* osc = (LAS float*)lds + wid * 2048;
        LAS float* msc = (LAS float*)(lds + 65536) + wid * 32; LAS float* lsc = (LAS float*)(lds + 65536 + 1024) + wid * 32;
#pragma unroll
        for (int r = 0; r < 16; ++r) { osc[r * 64 + lane] = o0[r]; osc[(16 + r) * 64 + lane] = o1[r]; }
        if (hi == 0) { msc[q32] = mrun; lsc[q32] = lsum; }
        __syncthreads();
        if (ks == 0) {
            float mk[KS], M = -1e30f;
#pragma unroll
            for (int k = 0; k < KS; ++k) { mk[k] = ((LAS float*)(lds + 65536))[(k * QS + qs) * 32 + q32]; M = fmaxf(M, mk[k]); }
            float L = 0.f; f32x16 t0 = {}, t1 = {};
#pragma unroll 1
            for (int k = 0; k < KS; ++k) { const float w = fast_exp2(((LAS float*)(lds + 65536))[(k * QS + qs) * 32 + q32] - M); L += w * ((LAS float*)(lds + 65536 + 1024))[(k * QS + qs) * 32 + q32];
                const LAS float* os = (LAS float*)lds + (k * QS + qs) * 2048;
#pragma unroll
                for (int r = 0; r < 16; ++r) { t0[r] += w * os[r * 64 + lane]; t1[r] += w * os[(16 + r) * 64 + lane]; } }
            const float inv = 1.f / L; bf16* op = a.O + (size_t)(qs * 32 + q32) * a.ostride + 4 * hi;
#pragma unroll
            for (int g = 0; g < 4; ++g) { st_bf4(op + 8 * g, (f32x4){t0[4 * g] * inv, t0[4 * g + 1] * inv, t0[4 * g + 2] * inv, t0[4 * g + 3] * inv});
                st_bf4(op + 32 + 8 * g, (f32x4){t1[4 * g] * inv, t1[4 * g + 1] * inv, t1[4 * g + 2] * inv, t1[4 * g + 3] * inv}); }
        }
    }
    __syncthreads();
}


struct Attn2Args {
    const bf16* Q[2]; int qstride;
    const bf16* Ka; int kastride; const bf16* Kb; int kbstride; const bf16* V; int vstride;
    const float* Fk; bf16* O[2]; int ostride; int qpos0[2]; int nkv[2]; const float* cs;
};
template <int DQK, bool FOX, int NG>
__device__ __forceinline__ void attn_unit2(const Attn2Args& a, LAS unsigned char* lds) {
    constexpr int KRB = (DQK + 8) * 2, VRB = 144, NKK = DQK / 16, OFF_V = 64 * KRB, OFF_F = OFF_V + 64 * VRB, BUF = 32768;
    static_assert(OFF_F + 256 <= BUF, "tile buffer");
    int tid = threadIdx.x; asm volatile("" : "+v"(tid));
    const int lane = tid & 63, q32 = lane & 31, hi = lane >> 5; const int wid = __builtin_amdgcn_readfirstlane(tid >> 6);
    int qmin[NG], qpos[NG]; bf16x8 qf[NG][NKK]; float mrun[NG], lsum[NG]; f32x16 o0[NG], o1[NG];
#pragma unroll
    for (int g = 0; g < NG; ++g) {
        qmin[g] = a.qpos0[g] + wid * 32; qpos[g] = qmin[g] + q32; mrun[g] = -1e30f; lsum[g] = 0.f; o0[g] = f32x16{}; o1[g] = f32x16{};
        const bf16* qp = a.Q[g] + (size_t)(wid * 32 + q32) * a.qstride + hi * 8;
#pragma unroll
        for (int kk = 0; kk < NKK; ++kk) qf[g][kk] = *(const bf16x8*)(qp + kk * 16);
        if (DQK == 96) {
            const f32x4* cp = (const f32x4*)(a.cs + ((size_t)qpos[g] * 16 + 8 * hi) * 2);
            const u32x4 w1 = __builtin_bit_cast(u32x4, qf[g][NKK - 2]), w2 = __builtin_bit_cast(u32x4, qf[g][NKK - 1]); u32x4 r1, r2;
#pragma unroll
            for (int j = 0; j < 4; ++j) { const f32x4 c = cp[j]; const float a0 = bflo(w1[j]), a1 = bfhi(w1[j]), b0 = bflo(w2[j]), b1 = bfhi(w2[j]);
                r1[j] = pk2(a0 * c.x - b0 * c.y, a1 * c.z - b1 * c.w); r2[j] = pk2(a0 * c.y + b0 * c.x, a1 * c.w + b1 * c.z); }
            qf[g][NKK - 2] = __builtin_bit_cast(bf16x8, r1); qf[g][NKK - 1] = __builtin_bit_cast(bf16x8, r2);
        }
    }
    const int NT = a.nkv[NG - 1] / 64;
    struct Stage { u32x4 ka, v, kb; float f; }; Stage st0, st1;
    const int lrow = tid >> 3, lch = tid & 7, brow = (tid & 255) >> 2, bch = tid & 3;
    auto load_t = [&](int T, Stage& st) {
        st.ka = *(const u32x4*)(a.Ka + (size_t)(T * 64 + lrow) * a.kastride + lch * 8);
        st.v = *(const u32x4*)(a.V + (size_t)(T * 64 + lrow) * a.vstride + lch * 8);
        if (DQK == 96) { if (tid < 256) st.kb = *(const u32x4*)(a.Kb + (size_t)(T * 64 + brow) * a.kbstride + bch * 8); }
        if (FOX) { if (tid < 64) st.f = a.Fk[T * 64 + tid]; }
    };
    auto store_tile = [&](int T, const Stage& st) {
        LAS unsigned char* b = lds + (T & 1) * BUF;
        *(LAS u32x4*)(b + lrow * KRB + lch * 16) = st.ka; *(LAS u32x4*)(b + OFF_V + lrow * VRB + lch * 16) = st.v;
        if (DQK == 96) { if (tid < 256) *(LAS u32x4*)(b + brow * KRB + 128 + bch * 16) = st.kb; }
        if (FOX) { if (tid < 64) *(LAS float*)(b + OFF_F + tid * 4) = st.f; }
    };
    load_t(0, st0); if (NT > 1) load_t(1, st1);
    const LAS unsigned char* kbase0 = lds + q32 * KRB + hi * 16;
    const LAS unsigned char* vbase0 = lds + OFF_V + (4 * hi + ((lane & 15) >> 2)) * VRB + (16 * ((lane >> 4) & 1) + 4 * (lane & 3)) * 2;
    const LAS unsigned char* fbase0 = lds + OFF_F + (4 * hi) * 4;
    store_tile(0, st0); __syncthreads();
    auto step = [&](int T, Stage& stL  , const Stage& stS  ) {
        const int bo = (T & 1) * BUF; const LAS unsigned char* kbase = kbase0 + bo; const LAS unsigned char* vbase = vbase0 + bo; const LAS unsigned char* fbase = fbase0 + bo;
        if (T + 2 < NT) load_t(T + 2, stL);
        __builtin_amdgcn_sched_barrier(0);
        const int j0 = T * 64; bool valid[NG]; bool any = false;
#pragma unroll
        for (int g = 0; g < NG; ++g) { valid[g] = (j0 < a.nkv[g]) && (FOX ? (j0 <= qmin[g] + 31) : (T <= (qmin[g] >> 6))); any = any || valid[g]; }
        bf16x8 pb[NG][4];
        if (any) {
            f32x16 p0[NG], p1[NG];
            if (FOX) {
                f32x16 b0, b1;
#pragma unroll
                for (int q = 0; q < 4; ++q) { const f32x4 f0 = *(const LAS f32x4*)(fbase + q * 32), f1 = *(const LAS f32x4*)(fbase + 128 + q * 32);
#pragma unroll
                    for (int e = 0; e < 4; ++e) { b0[4 * q + e] = -f0[e]; b1[4 * q + e] = -f1[e]; } }
#pragma unroll
                for (int g = 0; g < NG; ++g) { p0[g] = b0; p1[g] = b1; }
            } else {
#pragma unroll
                for (int g = 0; g < NG; ++g) { p0[g] = f32x16{}; p1[g] = f32x16{}; } }
#pragma unroll
            for (int kk = 0; kk < NKK; ++kk) {
                const bf16x8 k0 = *(const LAS bf16x8*)(kbase + kk * 32), k1 = *(const LAS bf16x8*)(kbase + 32 * KRB + kk * 32);
#pragma unroll
                for (int g = 0; g < NG; ++g) if (valid[g]) {
                    p0[g] = __builtin_amdgcn_mfma_f32_32x32x16_bf16(k0, qf[g][kk], p0[g], 0, 0, 0);
                    p1[g] = __builtin_amdgcn_mfma_f32_32x32x16_bf16(k1, qf[g][kk], p1[g], 0, 0, 0); }
            }
#pragma unroll
            for (int g = 0; g < NG; ++g) if (valid[g]) {
                if (FOX && j0 + 63 > qmin[g]) {
#pragma unroll
                    for (int r = 0; r < 16; ++r) { const int kv = j0 + crow(r, hi); if (kv > qpos[g]) p0[g][r] = -1e30f; if (kv + 32 > qpos[g]) p1[g][r] = -1e30f; }
                }
                float mt = fmaxf(p0[g][0], p1[g][0]);
#pragma unroll
                for (int r = 1; r < 16; ++r) mt = fmaxf(mt, fmaxf(p0[g][r], p1[g][r]));
                mt = fmaxf(mt, __shfl_xor(mt, 32));
                const float mnew = fmaxf(mrun[g], mt), alpha = fast_exp2(mrun[g] - mnew); mrun[g] = mnew;
                float ps = 0.f;
#pragma unroll
                for (int r = 0; r < 16; ++r) { p0[g][r] = fast_exp2(p0[g][r] - mnew); p1[g][r] = fast_exp2(p1[g][r] - mnew); ps += p0[g][r] + p1[g][r]; }
                lsum[g] = lsum[g] * alpha + ps; if (__builtin_amdgcn_ballot_w64(alpha != 1.f)) { o0[g] = o0[g] * alpha; o1[g] = o1[g] * alpha; }
#pragma unroll
                for (int s = 0; s < 2; ++s) {
                    u32x4 w0 = {pk2(p0[g][8 * s], p0[g][8 * s + 1]), pk2(p0[g][8 * s + 2], p0[g][8 * s + 3]), pk2(p0[g][8 * s + 4], p0[g][8 * s + 5]), pk2(p0[g][8 * s + 6], p0[g][8 * s + 7])};
                    u32x4 w1 = {pk2(p1[g][8 * s], p1[g][8 * s + 1]), pk2(p1[g][8 * s + 2], p1[g][8 * s + 3]), pk2(p1[g][8 * s + 4], p1[g][8 * s + 5]), pk2(p1[g][8 * s + 6], p1[g][8 * s + 7])};
                    pb[g][s] = __builtin_bit_cast(bf16x8, w0); pb[g][2 + s] = __builtin_bit_cast(bf16x8, w1);
                }
            }
        }
        if (any) {
#pragma unroll
            for (int kst = 0; kst < 4; ++kst) {
                const LAS unsigned char* vp = vbase + 16 * kst * VRB;
                const s16x4 a0l = tr_read(vp), a0h = tr_read(vp + 8 * VRB), a1l = tr_read(vp + 64), a1h = tr_read(vp + 64 + 8 * VRB);
                const bf16x8 A0 = {a0l[0], a0l[1], a0l[2], a0l[3], a0h[0], a0h[1], a0h[2], a0h[3]}, A1 = {a1l[0], a1l[1], a1l[2], a1l[3], a1h[0], a1h[1], a1h[2], a1h[3]};
#pragma unroll
                for (int g = 0; g < NG; ++g) if (valid[g]) {
                    o0[g] = __builtin_amdgcn_mfma_f32_32x32x16_bf16(A0, pb[g][kst], o0[g], 0, 0, 0);
                    o1[g] = __builtin_amdgcn_mfma_f32_32x32x16_bf16(A1, pb[g][kst], o1[g], 0, 0, 0); }
            }
        }
        if (T + 1 < NT) store_tile(T + 1, stS);
        __syncthreads();
    };
    for (int T = 0; T < NT; T += 2) { step(T, st0, st1); if (T + 1 < NT) step(T + 1, st1, st0); }
#pragma unroll
    for (int g = 0; g < NG; ++g) {
        const float l = lsum[g] + __shfl_xor(lsum[g], 32); const float inv = 1.f / l; bf16* op = a.O[g] + (size_t)(wid * 32 + q32) * a.ostride + 4 * hi;
#pragma unroll
        for (int q = 0; q < 4; ++q) { st_bf4(op + 8 * q, (f32x4){o0[g][4 * q] * inv, o0[g][4 * q + 1] * inv, o0[g][4 * q + 2] * inv, o0[g][4 * q + 3] * inv});
            st_bf4(op + 32 + 8 * q, (f32x4){o1[g][4 * q] * inv, o1[g][4 * q + 1] * inv, o1[g][4 * q + 2] * inv, o1[g][4 * q + 3] * inv}); }
    }
    __syncthreads();
}

struct AbsArgs { const bf16* Qlat; const bf16* Qrope; const bf16 *Lat_past, *Lat_new, *Kr_past, *Kr_new; const bf16* WuvT; bf16* O; const float* cs; };
__device__ __forceinline__ void mla_abs_unit(const AbsArgs& a, LAS unsigned char* lds) {
    constexpr int RB = 592, OFF_Q = 128 * RB, NKK = 18, NT = (KVS + 127) / 128;
    int tid = threadIdx.x; asm volatile("" : "+v"(tid));
    const int lane = tid & 63, q32 = lane & 31, hi = lane >> 5; const int wid = __builtin_amdgcn_readfirstlane(tid >> 6);
    const int qs = wid & 1, ks = wid >> 1;
    LAS unsigned char* qlds = lds + OFF_Q + qs * (NKK * 1024) + lane * 16;
    { const bf16* qp = a.Qlat + (size_t)(qs * 32 + q32) * 2048 + hi * 8;
#pragma unroll
      for (int kk = 0; kk < 16; ++kk) *(LAS bf16x8*)(qlds + kk * 1024) = *(const bf16x8*)(qp + kk * 16);
      const bf16* rp = a.Qrope + (size_t)(qs * 32 + q32) * 768 + hi * 8;
      const u32x4 w1 = *(const u32x4*)rp, w2 = *(const u32x4*)(rp + 16); u32x4 r1, r2;
      const f32x4* cp = (const f32x4*)(a.cs + ((size_t)(SEQ + qs * 32 + q32) * 16 + 8 * hi) * 2);
#pragma unroll
      for (int j = 0; j < 4; ++j) { const f32x4 c = cp[j]; const float a0 = bflo(w1[j]), a1 = bfhi(w1[j]), b0 = bflo(w2[j]), b1 = bfhi(w2[j]);
          r1[j] = pk2(a0 * c.x - b0 * c.y, a1 * c.z - b1 * c.w); r2[j] = pk2(a0 * c.y + b0 * c.x, a1 * c.w + b1 * c.z); }
      *(LAS u32x4*)(qlds + 16 * 1024) = r1; *(LAS u32x4*)(qlds + 17 * 1024) = r2; }
    float mrun = -1e30f, lsum = 0.f; f32x16 o[8] = {};
    u32x4 rl[8], rk;
    const int lrow = tid >> 5, lch = tid & 31, krow = tid >> 2, kch = tid & 3;
    auto load_t = [&](int T) {
        const int jT = T * 128; const bool past = jT < PAST; const size_t r0 = (size_t)(past ? jT : jT - PAST);
        const bf16* lp = (past ? a.Lat_past : a.Lat_new) + (r0 + lrow) * 256 + lch * 8;
#pragma unroll
        for (int i = 0; i < 8; ++i) if (jT + 16 * i < KVS) rl[i] = *(const u32x4*)(lp + (size_t)i * 16 * 256);
        if (jT + krow < KVS) rk = *(const u32x4*)((past ? a.Kr_past : a.Kr_new) + (r0 + krow) * 32 + kch * 8);
    };
    auto store_t = [&](int T) {
        const int jT = T * 128;
#pragma unroll
        for (int i = 0; i < 8; ++i) if (jT + 16 * i < KVS) *(LAS u32x4*)(lds + (lrow + 16 * i) * RB + lch * 16) = rl[i];
        if (jT + krow < KVS) *(LAS u32x4*)(lds + krow * RB + 512 + kch * 16) = rk;
    };
    load_t(0);
    const LAS unsigned char* kbase = lds + (ks * 32 + q32) * RB + hi * 16;
    const LAS unsigned char* vbase = lds + (ks * 32 + 4 * hi + ((lane & 15) >> 2)) * RB + (16 * ((lane >> 4) & 1) + 4 * (lane & 3)) * 2;
    for (int T = 0; T < NT; ++T) {
        __syncthreads();
        store_t(T);
        __syncthreads();
        if (T + 1 < NT) load_t(T + 1);
        __builtin_amdgcn_sched_barrier(0);
        if (T * 128 + ks * 32 < KVS) {
            f32x16 p0 = {}, pq = {};
#pragma unroll
            for (int kk = 0; kk < NKK; kk += 2) {
                const bf16x8 k0 = *(const LAS bf16x8*)(kbase + kk * 32); const bf16x8 qv = *(const LAS bf16x8*)(qlds + kk * 1024);
                const bf16x8 k1 = *(const LAS bf16x8*)(kbase + (kk + 1) * 32); const bf16x8 qw = *(const LAS bf16x8*)(qlds + (kk + 1) * 1024);
                p0 = __builtin_amdgcn_mfma_f32_32x32x16_bf16(k0, qv, p0, 0, 0, 0);
                pq = __builtin_amdgcn_mfma_f32_32x32x16_bf16(k1, qw, pq, 0, 0, 0);
            }
            p0 = p0 + pq;
            float mt = p0[0];
#pragma unroll
            for (int r = 1; r < 16; ++r) mt = fmaxf(mt, p0[r]);
            mt = fmaxf(mt, __shfl_xor(mt, 32));
            const float mnew = fmaxf(mrun, mt), alpha = fast_exp2(mrun - mnew); mrun = mnew;
            float ps = 0.f;
#pragma unroll
            for (int r = 0; r < 16; ++r) { p0[r] = fast_exp2(p0[r] - mnew); ps += p0[r]; }
            lsum = lsum * alpha + ps;
            if (__builtin_amdgcn_ballot_w64(alpha != 1.f)) {
#pragma unroll
                for (int dt = 0; dt < 8; ++dt) o[dt] = o[dt] * alpha; }
            bf16x8 pb[2];
#pragma unroll
            for (int s = 0; s < 2; ++s) {
                u32x4 w0 = {pk2(p0[8 * s], p0[8 * s + 1]), pk2(p0[8 * s + 2], p0[8 * s + 3]), pk2(p0[8 * s + 4], p0[8 * s + 5]), pk2(p0[8 * s + 6], p0[8 * s + 7])};
                pb[s] = __builtin_bit_cast(bf16x8, w0);
            }
#pragma unroll
            for (int kst = 0; kst < 2; ++kst) {
                const LAS unsigned char* vp = vbase + 16 * kst * RB;
#pragma unroll
                for (int dt = 0; dt < 8; ++dt) { const s16x4 al = tr_read(vp + dt * 64), ah = tr_read(vp + dt * 64 + 8 * RB);
                    const bf16x8 Af = {al[0], al[1], al[2], al[3], ah[0], ah[1], ah[2], ah[3]};
                    o[dt] = __builtin_amdgcn_mfma_f32_32x32x16_bf16(Af, pb[kst], o[dt], 0, 0, 0); }
            }
        }
    }
    lsum += __shfl_xor(lsum, 32);
    LAS float* msc = (LAS float*)(lds + 131072 + 4096);
    LAS float* lsc = msc + 256;
#pragma unroll 1
    for (int rnd = 0; rnd < 2; ++rnd) {
        const int half = rnd == 0 ? 2 : 1;
        __syncthreads();
        if (ks >= half && ks < 2 * half) { LAS float* osc = (LAS float*)lds + ((ks - half) * 2 + qs) * 8192;
#pragma unroll
            for (int dt = 0; dt < 8; ++dt)
#pragma unroll
                for (int r = 0; r < 16; ++r) osc[(dt * 16 + r) * 64 + lane] = o[dt][r];
            if (hi == 0) { msc[wid * 32 + q32] = mrun; lsc[wid * 32 + q32] = lsum; } }
        __syncthreads();
        if (ks < half) { const LAS float* osc = (const LAS float*)lds + (ks * 2 + qs) * 8192; const int pw = (ks + half) * 2 + qs;
            const float m2 = msc[pw * 32 + q32], l2 = lsc[pw * 32 + q32]; const float M = fmaxf(mrun, m2), w1 = fast_exp2(mrun - M), w2 = fast_exp2(m2 - M);
            lsum = w1 * lsum + w2 * l2; mrun = M;
#pragma unroll
            for (int dt = 0; dt < 8; ++dt)
#pragma unroll
                for (int r = 0; r < 16; ++r) o[dt][r] = w1 * o[dt][r] + w2 * osc[(dt * 16 + r) * 64 + lane]; }
    }
    if (ks == 0) {
        const float inv = 1.f / lsum; f32x16 t0 = {}, t1 = {};
        const bf16* wrow0 = a.WuvT + (size_t)q32 * 256 + 4 * hi; const bf16* wrow1 = wrow0 + 32 * 256;
#pragma unroll
        for (int sub = 0; sub < 8; ++sub)
#pragma unroll
            for (int s = 0; s < 2; ++s) {
                const u32x4 wv = {pk2(o[sub][8 * s] * inv, o[sub][8 * s + 1] * inv), pk2(o[sub][8 * s + 2] * inv, o[sub][8 * s + 3] * inv), pk2(o[sub][8 * s + 4] * inv, o[sub][8 * s + 5] * inv), pk2(o[sub][8 * s + 6] * inv, o[sub][8 * s + 7] * inv)};
                const bf16x8 Bf = __builtin_bit_cast(bf16x8, wv); const int c0 = 32 * sub + 16 * s;
                const s16x4 a0l = *(const s16x4*)(wrow0 + c0), a0h = *(const s16x4*)(wrow0 + c0 + 8), a1l = *(const s16x4*)(wrow1 + c0), a1h = *(const s16x4*)(wrow1 + c0 + 8);
                const bf16x8 A0 = {a0l[0], a0l[1], a0l[2], a0l[3], a0h[0], a0h[1], a0h[2], a0h[3]}, A1 = {a1l[0], a1l[1], a1l[2], a1l[3], a1h[0], a1h[1], a1h[2], a1h[3]};
                t0 = __builtin_amdgcn_mfma_f32_32x32x16_bf16(A0, Bf, t0, 0, 0, 0);
                t1 = __builtin_amdgcn_mfma_f32_32x32x16_bf16(A1, Bf, t1, 0, 0, 0);
            }
        bf16* op = a.O + (size_t)(qs * 32 + q32) * 1024 + 4 * hi;
#pragma unroll
        for (int g = 0; g < 4; ++g) { st_bf4(op + 8 * g, (f32x4){t0[4 * g], t0[4 * g + 1], t0[4 * g + 2], t0[4 * g + 3]}); st_bf4(op + 32 + 8 * g, (f32x4){t1[4 * g], t1[4 * g + 1], t1[4 * g + 2], t1[4 * g + 3]}); }
    }
    __syncthreads();
}

__device__ __forceinline__ void p4_attention(const Args& A, LAS unsigned char* lds) {
    unsigned char* ws = A.ws; const int G = gridDim.x;
    const bf16* QFOX = (const bf16*)(ws + WS_QFOX); const bf16* KNEW = (const bf16*)(ws + WS_KNEW); const bf16* VNEW = (const bf16*)(ws + WS_VNEW);
    const bf16* QMLA = (const bf16*)(ws + WS_QMLA); const bf16* KVNEW = (const bf16*)(ws + WS_KVNEW);
    const bf16* KRNEW = (const bf16*)(ws + WS_KRNEW); const bf16* KRPAST = (const bf16*)(ws + WS_KRPAST);
    const float* FS = (const float*)(ws + WS_FS); const float* FP = (const float*)(ws + WS_FP); bf16* MIXED = (bf16*)(ws + WS_MIXED);
    const int rot = (blockIdx.x >> 6) & 3;
#pragma unroll 1
    for (int pass = 0; pass < 4; ++pass) {
    const int job = (pass + rot) & 3;
    if (job == 0) {
    for (int p = blockIdx.x; p < 256; p += G) {
        const int bh = p >> 2, s = p & 3, b = bh >> 3, h = bh & 7; const size_t tb = (size_t)b * SEQ;
        Attn2Args a; a.cs = (const float*)(ws + WS_CS); a.qstride = 512; a.Ka = KNEW + tb * 512 + h * 64; a.kastride = 512; a.Kb = nullptr; a.kbstride = 0;
        a.V = VNEW + tb * 512 + h * 64; a.vstride = 512; a.Fk = FP + (size_t)bh * SEQ; a.ostride = 1024;
        for (int i = 0; i < 2; ++i) { const int t0 = 256 * (i ? 7 - s : s); a.Q[i] = QFOX + (tb + t0) * 512 + h * 64; a.O[i] = MIXED + (tb + t0) * 1024 + h * 64; a.qpos0[i] = t0; a.nkv[i] = t0 + 256; }
        attn_unit2<64, true, 2>(a, lds);
    }
    } else if (job == 1) {
    for (int p = blockIdx.x; p < 256; p += G) {
        const int bh = p >> 2, s = 3 - (p & 3), b = bh >> 3, h = bh & 7; const size_t tb = (size_t)b * SEQ;
        Attn2Args a; a.cs = (const float*)(ws + WS_CS); a.qstride = 768; a.Ka = KVNEW + tb * 1024 + h * 64; a.kastride = 1024; a.Kb = KRNEW + tb * 32; a.kbstride = 32;
        a.V = KVNEW + tb * 1024 + 512 + h * 64; a.vstride = 1024; a.Fk = nullptr; a.ostride = 1024;
        for (int i = 0; i < 2; ++i) { const int t0 = 256 * (i ? 7 - s : s); a.Q[0] = QMLA + (tb + t0) * 768 + h * 96; a.O[0] = MIXED + (tb + t0) * 1024 + 512 + h * 64; a.qpos0[0] = t0; a.nkv[0] = t0 + 256;
            a.Q[1] = a.Q[0]; a.O[1] = a.O[0]; a.qpos0[1] = t0; a.nkv[1] = t0 + 256;
            attn_unit2<96, false, 1>(a, lds); }
    }
    } else if (job == 2) {
    for (int p = blockIdx.x; p < 256; p += G) {
        const int b = p >> 3, h = p & 7; const size_t tok0 = (size_t)TP + (size_t)b * DSEQ, pb = (size_t)b * PAST;
        AttnArgs a; a.cs = (const float*)(ws + WS_CS); a.Q = QFOX + tok0 * 512 + h * 64; a.qstride = 512;
        a.Ka_past = A.in[2] + pb * 512 + h * 64; a.Ka_new = A.out + O_KS + (size_t)b * DSEQ * 512 + h * 64; a.kastride = 512; a.Kb_past = a.Kb_new = nullptr; a.kbstride = 0;
        a.V_past = A.in[3] + pb * 512 + h * 64; a.V_new = A.out + O_VS + (size_t)b * DSEQ * 512 + h * 64; a.vstride = 512;
        a.Fq = FS + (size_t)p * KVS + PAST; a.Fk = FS + (size_t)p * KVS; a.O = MIXED + tok0 * 1024 + h * 64; a.ostride = 1024; a.P = PAST; a.qpos0 = PAST; a.nkv = KVS;
        attn_unit<64, true, 2, 4, true>(a, lds);
    }
    } else {
    for (int p = blockIdx.x; p < 256; p += G) {
        const int b = (p & 7) * 4 + (p >> 6), h = (p >> 3) & 7; const size_t tok0 = (size_t)TP + (size_t)b * DSEQ, pb = (size_t)b * PAST;
        AbsArgs a; a.Qlat = (const bf16*)(ws + WS_QLAT) + (size_t)b * DSEQ * 2048 + h * 256; a.Qrope = QMLA + tok0 * 768 + h * 96 + 64;
        a.Lat_past = (const bf16*)(ws + WS_LATPAST) + pb * 256; a.Lat_new = (const bf16*)(ws + WS_LATNEW) + tok0 * 256;
        a.Kr_past = KRPAST + pb * 32; a.Kr_new = KRNEW + tok0 * 32; a.WuvT = (const bf16*)(ws + WS_WKV) + (size_t)(512 + h * 64) * 256;
        a.O = MIXED + tok0 * 1024 + 512 + h * 64; a.cs = (const float*)(ws + WS_CS);
        mla_abs_unit(a, lds);
    }
    }
    }
}

template <class Epi> __device__ __forceinline__ void run_gemm(LAS unsigned char* lds, const bf16* Am, const bf16* Bt, int M, int N, int K, const Epi& E, int cu_shift = 0) {
    pg8::Gemm g{Am, Bt, M, N, K}; pg8::StaticOrder S; S.init(M, N, K, (int)gridDim.x, (int)((blockIdx.x + cu_shift) % gridDim.x));
    pg8::gemm_phase<Epi, pg8::StaticOrder, true, true>(lds, g, S, E);
}

__global__ void __launch_bounds__(NTHREADS, 2) fwd_kernel(Args A, int ph_lo, int ph_hi) {
    extern __shared__ __attribute__((aligned(16))) unsigned char lds_raw[];
    LAS unsigned char* lds = (LAS unsigned char*)lds_raw;
    unsigned char* ws = A.ws;
    if (threadIdx.x < 64) ((LAS unsigned*)(lds + 131072))[threadIdx.x] = 0u;
    __syncthreads();
    XcdBarrier bar = xcd_barrier_post((unsigned*)(ws + WS_CTL), (volatile LAS unsigned*)(lds + 131072 + 32));
#ifndef PH_MASK
#define PH_MASK 0xffff
#endif
#define IN(k) (((PH_MASK >> (k)) & 1) && ph_lo <= (k) && (k) < ph_hi)
#define SEAM(k) do { if (IN(k) && IN((k) + 1)) xcd_barrier(bar); } while (0)
#ifndef REP0
#define REP0 1
#endif
#ifndef REP4
#define REP4 1
#endif
#ifndef REP8
#define REP8 1
#endif
#ifndef REP1
#define REP1 1
#endif
#ifndef REP7
#define REP7 1
#endif
#ifndef REP9
#define REP9 1
#endif
    if (IN(0)) { for (int rep = 0; rep < REP0; ++rep) { p0_prologue(A, lds); __syncthreads(); } }
    SEAM(0);
    if (IN(1)) {
        EpiZ E{(bf16*)(ws + WS_QFOX), (bf16*)(ws + WS_KNEW), (bf16*)(ws + WS_VNEW), (bf16*)(ws + WS_KRNEW), (float*)(ws + WS_ZBUF), A.out, (const float*)(ws + WS_CS), A.in[10]};
        run_gemm(lds, (const bf16*)(ws + WS_H), (const bf16*)(ws + WS_WIN), TOK, NZ, DM, E);
    }
    SEAM(1);
    if (IN(2)) { p2_postz(A, lds); __syncthreads(); }
    SEAM(2);
    if (IN(3)) {
        EpiBf E{(bf16*)(ws + WS_QMLA), 768, 0.10206207261596575f * LOG2E};
        run_gemm(lds, (const bf16*)(ws + WS_QCN), (const bf16*)(ws + WS_WQ), TOK, 768, 384, E);
        EpiBf E2{(bf16*)(ws + WS_KVNEW), 1024, 1.f};
        run_gemm(lds, (const bf16*)(ws + WS_LATNEW), (const bf16*)(ws + WS_WKV), TP, 1024, 256, E2);
        EpiBf E3{(bf16*)(ws + WS_QLAT), 2048, 0.10206207261596575f * LOG2E};
        run_gemm(lds, (const bf16*)(ws + WS_QCN) + (size_t)TP * 384, (const bf16*)(ws + WS_WQA), TS, 2048, 384, E3, 64);
    }
    SEAM(3);
    if (IN(4)) { for (int rep = 0; rep < REP4; ++rep) p4_attention(A, lds); }
    SEAM(4);
    if (IN(5)) {
        pg8::Gemm g{(const bf16*)(ws + WS_MIXED), (const bf16*)(ws + WS_WOUT), TOK, DM, DM}; SplitOrder<16> S{(int)gridDim.x, (int)blockIdx.x};
        EpiOut E{A.in[0], A.in[1], (float*)(ws + WS_X1), (bf16*)(ws + WS_H), A.in[17], (float*)(ws + WS_ROWSS), (float*)(ws + WS_SLAB)};
        pg8::gemm_phase<EpiOut, SplitOrder<16>, true, true>(lds, g, S, E);
    }
    if (IN(5) && IN(7)) xcd_barrier(bar);
    if (IN(5)) {
        int t2 = threadIdx.x; asm volatile("" : "+v"(t2)); const int lane = t2 & 63, gw = blockIdx.x * NWAVES + (t2 >> 6), NGW = gridDim.x * NWAVES;
        for (int r = gw; r < TS; r += NGW) {
            const f32x4* xr = (const f32x4*)(A.in[1] + (size_t)r * DM) + lane; f32x4 v[4];
#pragma unroll
            for (int j = 0; j < 4; ++j) v[j] = xr[64 * j];
#pragma unroll
            for (int k = 0; k < DN_SL; ++k) { const f32x4* sr = (const f32x4*)((const float*)(ws + WS_SLAB) + ((size_t)k * TS + r) * DM) + lane;
#pragma unroll
                for (int j = 0; j < 4; ++j) v[j] += sr[64 * j]; }
            float ss = 0.f; const size_t row = (size_t)TP + r;
#pragma unroll
            for (int j = 0; j < 4; ++j) { ss += (v[j].x * v[j].x + v[j].y * v[j].y) + (v[j].z * v[j].z + v[j].w * v[j].w); ((f32x4*)((float*)(ws + WS_X1) + row * DM))[64 * j + lane] = v[j];
                const f32x4 gq = ((const f32x4*)A.in[17])[64 * j + lane]; const f32x4 o = v[j] * gq; ((u32x2*)((bf16*)(ws + WS_H) + row * DM))[64 * j + lane] = (u32x2){pk2(o.x, o.y), pk2(o.z, o.w)}; }
            ss = wave_sum(ss);
            if (lane < 16) ((float*)(ws + WS_ROWSS))[row * 16 + lane] = lane == 0 ? ss : 0.f;
        }
    }
    if (IN(5) && IN(7)) xcd_barrier(bar);
    if (IN(7)) { EpiGlu E{(bf16*)(ws + WS_ACT), (float*)(ws + WS_EDGE), A.in[19], A.in[20], (const float*)(ws + WS_ROWSS)}; run_gemm(lds, (const bf16*)(ws + WS_H), (const bf16*)(ws + WS_WUP), TOK, DFF2, DM, E); }
    SEAM(7);
    if (IN(8)) p8_fixup(A);
    SEAM(8);
    if (IN(9)) {
        pg8::Gemm g{(const bf16*)(ws + WS_ACT), (const bf16*)(ws + WS_WDOWN), TOK, DM, DFF}; DownOrder S{(int)gridDim.x, (int)blockIdx.x};
        EpiDown E{(const float*)(ws + WS_X1), (float*)(ws + WS_X2), (float*)(ws + WS_SLAB)};
        pg8::gemm_phase<EpiDown, DownOrder, true, true>(lds, g, S, E);
    }
    SEAM(9);
    if (IN(10)) { int t2 = threadIdx.x; asm volatile("" : "+v"(t2)); const int lane = t2 & 63, gw = blockIdx.x * NWAVES + (t2 >> 6), NGW = gridDim.x * NWAVES;
        for (int m = gw; m < TOK; m += NGW) {
            if (m < TP) rms_row<true>((const float*)(ws + WS_X2) + (size_t)m * DM, A.in[22], A.out + (size_t)m * DM, lane);
            else rms_row<true>((const float*)(ws + WS_X1) + (size_t)m * DM, A.in[22], A.out + (size_t)m * DM, lane, (const float*)(ws + WS_SLAB) + (size_t)(m - TP) * DM, DN_SL, (size_t)TS * DM); } }
#undef IN
#undef SEAM
}

#ifndef N_LAUNCHES
#define N_LAUNCHES 1
#endif
extern "C" void kernel_launch(void* const* d_in, const int* in_sizes, int n_in, void* d_out, int out_size, void* d_ws, size_t ws_size, hipStream_t stream) {
    static int grid = 0;
    if (grid == 0) {
        if (n_in != 23 || (size_t)out_size != O_END || ws_size < WS_END) { fprintf(stderr, "kernel_launch: unexpected shapes: n_in %d out %d ws %zu (need %zu)\n", n_in, out_size, ws_size, (size_t)WS_END); grid = -1; return; }
        int dev = 0, cus = 0, per_cu = 0;
        (void)hipGetDevice(&dev); (void)hipDeviceGetAttribute(&cus, hipDeviceAttributeMultiprocessorCount, dev);
        if (hipFuncSetAttribute((const void*)fwd_kernel, hipFuncAttributeMaxDynamicSharedMemorySize, LDS_BYTES) != hipSuccess) { fprintf(stderr, "hipFuncSetAttribute failed\n"); grid = -1; return; }
        if (hipOccupancyMaxActiveBlocksPerMultiprocessor(&per_cu, (const void*)fwd_kernel, NTHREADS, LDS_BYTES) != hipSuccess || per_cu < 1) { fprintf(stderr, "occupancy query: %d\n", per_cu); per_cu = 1; }
        (void)hipGetLastError();
        grid = cus * 1;
    }
    if (grid < 0) return;
    if (hipMemsetAsync((char*)d_ws + WS_CTL, 0, CTL_BYTES, stream) != hipSuccess) { fprintf(stderr, "memset failed\n"); return; }
    Args a{};
    for (int i = 0; i < 23; ++i) a.in[i] = (const float*)d_in[i];
    a.out = (float*)d_out; a.ws = (unsigned char*)d_ws;
    if (N_LAUNCHES == 1) {
        hipLaunchKernelGGL(fwd_kernel, dim3(grid), dim3(NTHREADS), LDS_BYTES, stream, a, 0, 11);
    } else {
        for (int k = 0; k < 11; ++k) hipLaunchKernelGGL(fwd_kernel, dim3(grid), dim3(NTHREADS), LDS_BYTES, stream, a, k, k + 1);
    }
}
```

```cpp
#include <hip/hip_runtime.h>
#include <cstdio>
#include <cstdint>
namespace pg8 {
#define PG8_LAS __attribute__((address_space(3)))
typedef unsigned short bf16_t;
typedef short bf16x8 __attribute__((ext_vector_type(8)));
typedef float f32x4 __attribute__((ext_vector_type(4)));
typedef unsigned u32x4 __attribute__((ext_vector_type(4)));
constexpr int BM = 256, BK = 64, HALF = 128, HTB = HALF * BK * 2  , STAGE_BYTES = 8 * HTB, NXCD = 8, WGM = 8;

__host__ __device__ __forceinline__ int lds_byte(int r, int c) { const int st = (r >> 4) * 2 + (c >> 5), rr = r & 15, cc = c & 31, ob = rr * 64 + cc * 2; return st * 1024 + (ob ^ (((ob >> 9) & 1) << 5)); }
__host__ __device__ __forceinline__ void stage_rc(int b, int& R, int& C) { const int st = b / 1024, sb = b % 1024, swz = sb ^ (((sb >> 9) & 1) << 5); R = (st >> 1) * 16 + swz / 64; C = (st & 1) * 32 + (swz % 64) / 2; }
__host__ __device__ __forceinline__ int perm32(int rho) { const int n = rho >> 4, i = rho & 15; return 8 * (i >> 2) + 4 * n + (i & 3); }

struct Unit { int pm, pn, k0, nkt, sl; };
struct Gemm { const bf16_t* A; const bf16_t* Bt; int M, N, K; };

struct StaticOrder {
    int nM, nN, nwg, G, c, nkt;
    __host__ __device__ void init(int M, int N, int K, int G_, int c_) { nM = M / BM; nN = N / BM; nwg = nM * nN; G = G_; c = c_; nkt = K / BK; }
    __host__ __device__ bool next(int i, Unit& u) const {
        const long L = (long)i * G + c; if (L >= nwg) return false;
        int wgid = (int)L; { const int q = nwg / NXCD, r = nwg % NXCD, xcd = wgid % NXCD, off = wgid / NXCD; wgid = (xcd < r ? xcd * (q + 1) : r * (q + 1) + (xcd - r) * q) + off; }
        const int nig = WGM * nN, gid = wgid / nig, fm = gid * WGM, gsz = (nM - fm) < WGM ? (nM - fm) : WGM;
        u.pm = fm + ((wgid % nig) % gsz); u.pn = (wgid % nig) / gsz; u.k0 = 0; u.nkt = nkt; u.sl = -1; return true;
    }
    __device__ __forceinline__ void a_ready(const Unit&) const {}
    __device__ __forceinline__ void done(const Unit&) const {}
};

template <class Epi, class Sched, bool ALIGN_EPI = false, bool SP2 = false>
__device__ __forceinline__ void gemm_phase(PG8_LAS unsigned char* lds, const Gemm g, const Sched& S, const Epi& E) {
    const int tid = threadIdx.x, wid = __builtin_amdgcn_readfirstlane(tid >> 6), lane = tid & 63, wr = wid >> 2, wc = wid & 3, fr = lane & 15, fq = lane >> 4;
    const int K = g.K;
    unsigned voffA[2], voffB[2];
#pragma unroll
    for (int i = 0; i < 2; ++i) { int R, C; stage_rc(tid * 16 + i * 8192, R, C); const int Rb = Epi::PERM ? ((R & ~31) + perm32(R & 31)) : R;
        voffA[i] = (unsigned)(R * K + C) * 2u; voffB[i] = (unsigned)(Rb * K + C) * 2u; }
    const size_t kstep = (size_t)(BK * 2);
    const size_t hstep = (size_t)HALF * K * 2;
    const size_t tstep = 2 * hstep;
    const unsigned ldsw = (unsigned)wid * 1024u;
    const int aoff = lds_byte(wr * 64 + fr, fq * 8), boff = lds_byte(wc * 32 + fr, fq * 8);
#define PG8_SA(b, h) (((b) * 2 + (h)) * HTB)
#define PG8_SB(b, h) ((4 + (b) * 2 + (h)) * HTB)
#define PG8_STAGE(bufoff, gbase, voff) do { _Pragma("unroll") for (int _i = 0; _i < 2; ++_i) \
        __builtin_amdgcn_global_load_lds((const unsigned*)((const char*)(gbase) + (voff)[_i]), (PG8_LAS unsigned*)(lds + (bufoff) + ldsw + _i * 8192), 16, 0, 0); } while (0)
#define PG8_LDA(dst, b, h) do { _Pragma("unroll") for (int m = 0; m < 4; ++m) _Pragma("unroll") for (int k = 0; k < 2; ++k) dst[m][k] = *(const PG8_LAS bf16x8*)(lds + PG8_SA(b, h) + aoff + m * 2048 + k * 1024); } while (0)
#define PG8_LDB(dst, b, h) do { _Pragma("unroll") for (int n = 0; n < 2; ++n) _Pragma("unroll") for (int k = 0; k < 2; ++k) dst[n][k] = *(const PG8_LAS bf16x8*)(lds + PG8_SB(b, h) + boff + n * 2048 + k * 1024); } while (0)
#define PG8_MMA(ai, bj, At, Bt) do { __builtin_amdgcn_s_setprio(1); _Pragma("unroll") for (int m = 0; m < 4; ++m) _Pragma("unroll") for (int n = 0; n < 2; ++n) _Pragma("unroll") for (int k = 0; k < 2; ++k) \
        acc[ai][bj][m][n] = __builtin_amdgcn_mfma_f32_16x16x32_bf16(Bt[n][k], At[m][k], acc[ai][bj][m][n], 0, 0, 0); __builtin_amdgcn_s_setprio(0); } while (0)
#define PG8_WAIT_V(n) asm volatile("s_waitcnt vmcnt(" #n ")" ::: "memory")
#define PG8_WAIT_L(n) asm volatile("s_waitcnt lgkmcnt(" #n ")" ::: "memory")
#define PG8_BAR __builtin_amdgcn_s_barrier()
#define PG8_SCHED __builtin_amdgcn_sched_barrier(0)
    Unit cur{}, nxt{}; int ui = 0;
    if (!S.next(0, cur)) return;
    f32x4 acc[2][2][4][2];
#pragma unroll
    for (int a = 0; a < 2; ++a)
#pragma unroll
        for (int b = 0; b < 2; ++b)
#pragma unroll
            for (int m = 0; m < 4; ++m)
#pragma unroll
                for (int n = 0; n < 2; ++n) acc[a][b][m][n] = (f32x4){0.f, 0.f, 0.f, 0.f};
    bf16x8 At[4][2], B0[2][2], B1[2][2];
    const char* cA = (const char*)g.A + (size_t)cur.pm * tstep + (size_t)cur.k0 * kstep; const char* cB = (const char*)g.Bt + (size_t)cur.pn * tstep + (size_t)cur.k0 * kstep;
    S.a_ready(cur);
    if constexpr (SP2) {
        PG8_STAGE(PG8_SB(0, 0), cB, voffB); PG8_STAGE(PG8_SB(0, 1), cB + hstep, voffB); PG8_STAGE(PG8_SA(0, 0), cA, voffA); PG8_STAGE(PG8_SA(0, 1), cA + hstep, voffA);
        if (wr == 1) PG8_BAR;
        PG8_WAIT_V(2); PG8_BAR;
        PG8_STAGE(PG8_SB(1, 0), cB + kstep, voffB); PG8_STAGE(PG8_SA(1, 0), cA + kstep, voffA); PG8_STAGE(PG8_SB(1, 1), cB + hstep + kstep, voffB);
        PG8_WAIT_V(6); PG8_BAR;
    } else {
        PG8_STAGE(PG8_SB(0, 0), cB, voffB); PG8_STAGE(PG8_SA(0, 0), cA, voffA); PG8_STAGE(PG8_SB(0, 1), cB + hstep, voffB); PG8_STAGE(PG8_SA(0, 1), cA + hstep, voffA);
        if (wr == 1) PG8_BAR;
        PG8_WAIT_V(4); PG8_BAR;
        PG8_STAGE(PG8_SB(1, 0), cB + kstep, voffB); PG8_STAGE(PG8_SA(1, 0), cA + kstep, voffA); PG8_STAGE(PG8_SB(1, 1), cB + hstep + kstep, voffB);
        PG8_WAIT_V(6); PG8_BAR;
    }
    for (;;) {
        const bool has_next = S.next(ui + 1, nxt);
        const char* nA = has_next ? (const char*)g.A + (size_t)nxt.pm * tstep + (size_t)nxt.k0 * kstep : cA; const char* nB = has_next ? (const char*)g.Bt + (size_t)nxt.pn * tstep + (size_t)nxt.k0 * kstep : cB;
        const int nt = cur.nkt;
        for (int t = 0; t < nt; t += 2) {
            const bool last = (t == nt - 2);
            const char* a1 = cA + (size_t)(t + 1) * kstep;
            const char* a2 = last ? nA : cA + (size_t)(t + 2) * kstep; const char* b2 = last ? nB : cB + (size_t)(t + 2) * kstep;
            const char* a3 = a2 + kstep; const char* b3 = b2 + kstep;
            if (last && has_next) S.a_ready(nxt);
            if constexpr (SP2) {
            PG8_LDB(B0, 0, 0); PG8_LDB(B1, 0, 1); PG8_SCHED; PG8_LDA(At, 0, 0); PG8_STAGE(PG8_SA(1, 1), a1 + hstep, voffA);
            PG8_WAIT_V(8); PG8_WAIT_L(0); PG8_BAR; PG8_MMA(0, 0, At, B0); PG8_MMA(0, 1, At, B1); PG8_BAR; PG8_SCHED;
            PG8_LDA(At, 0, 1); PG8_STAGE(PG8_SB(0, 0), b2, voffB); PG8_STAGE(PG8_SB(0, 1), b2 + hstep, voffB); PG8_STAGE(PG8_SA(0, 0), a2, voffA);
            PG8_WAIT_V(8); PG8_WAIT_L(0); PG8_BAR; PG8_MMA(1, 0, At, B0); PG8_MMA(1, 1, At, B1); PG8_BAR; PG8_SCHED;
            PG8_LDB(B0, 1, 0); PG8_LDB(B1, 1, 1); PG8_SCHED; PG8_LDA(At, 1, 0); PG8_STAGE(PG8_SA(0, 1), a2 + hstep, voffA);
            PG8_WAIT_V(8); PG8_WAIT_L(0); PG8_BAR; PG8_MMA(0, 0, At, B0); PG8_MMA(0, 1, At, B1); PG8_BAR; PG8_SCHED;
            PG8_LDA(At, 1, 1); PG8_STAGE(PG8_SB(1, 0), b3, voffB); PG8_STAGE(PG8_SB(1, 1), b3 + hstep, voffB); PG8_STAGE(PG8_SA(1, 0), a3, voffA);
            PG8_WAIT_V(8); PG8_WAIT_L(0); PG8_BAR; PG8_MMA(1, 0, At, B0); PG8_MMA(1, 1, At, B1); PG8_BAR; PG8_SCHED;
            } else {
            PG8_LDB(B0, 0, 0); PG8_SCHED; PG8_LDA(At, 0, 0); PG8_STAGE(PG8_SA(1, 1), a1 + hstep, voffA);
            PG8_WAIT_L(8); PG8_BAR; PG8_WAIT_L(0); PG8_MMA(0, 0, At, B0); PG8_BAR; PG8_SCHED;
            PG8_LDB(B1, 0, 1); PG8_STAGE(PG8_SB(0, 0), b2, voffB);
            PG8_BAR; PG8_WAIT_L(0); PG8_MMA(0, 1, At, B1); PG8_BAR;
            PG8_LDA(At, 0, 1); PG8_STAGE(PG8_SA(0, 0), a2, voffA);
            PG8_BAR; PG8_WAIT_L(0); PG8_MMA(1, 0, At, B0); PG8_BAR; PG8_SCHED;
            PG8_STAGE(PG8_SB(0, 1), b2 + hstep, voffB);
            PG8_WAIT_V(6); PG8_BAR; PG8_MMA(1, 1, At, B1); PG8_BAR;
            PG8_LDB(B0, 1, 0); PG8_SCHED; PG8_LDA(At, 1, 0); PG8_STAGE(PG8_SA(0, 1), a2 + hstep, voffA);
            PG8_WAIT_L(8); PG8_BAR; PG8_WAIT_L(0); PG8_MMA(0, 0, At, B0); PG8_BAR; PG8_SCHED;
            PG8_LDB(B1, 1, 1); PG8_STAGE(PG8_SB(1, 0), b3, voffB);
            PG8_BAR; PG8_WAIT_L(0); PG8_MMA(0, 1, At, B1); PG8_BAR;
            PG8_LDA(At, 1, 1); PG8_STAGE(PG8_SA(1, 0), a3, voffA);
            PG8_BAR; PG8_WAIT_L(0); PG8_MMA(1, 0, At, B0); PG8_BAR; PG8_SCHED;
            PG8_STAGE(PG8_SB(1, 1), b3 + hstep, voffB);
            PG8_WAIT_V(6); PG8_BAR; PG8_MMA(1, 1, At, B1); PG8_BAR;
            }
        }
        if constexpr (ALIGN_EPI) { if (wr == 0) PG8_BAR; }
        if constexpr (!Epi::AFTER_DRAIN) { E(acc, cur, wr, wc, fr, fq); S.done(cur); }
        if (!has_next) break;
#pragma unroll
        for (int a = 0; a < 2; ++a)
#pragma unroll
            for (int b = 0; b < 2; ++b)
#pragma unroll
                for (int m = 0; m < 4; ++m)
#pragma unroll
                    for (int n = 0; n < 2; ++n) acc[a][b][m][n] = (f32x4){0.f, 0.f, 0.f, 0.f};
        cur = nxt; cA = nA; cB = nB; ++ui;
        if constexpr (ALIGN_EPI) { if (wr == 1) PG8_BAR; }
    }
    PG8_WAIT_V(0);
    if constexpr (!ALIGN_EPI) { if (wr == 0) PG8_BAR; }
    PG8_BAR;
    if constexpr (Epi::AFTER_DRAIN) { E.fused(acc, cur, wr, wc, fr, fq, lds, wid, lane); S.done(cur); }
#undef PG8_SA
#undef PG8_SB
#undef PG8_STAGE
#undef PG8_LDA
#undef PG8_LDB
#undef PG8_MMA
#undef PG8_WAIT_V
#undef PG8_WAIT_L
#undef PG8_BAR
#undef PG8_SCHED
}
}

#define LAS __attribute__((address_space(3)))
typedef unsigned short bf16;
typedef short bf16x8 __attribute__((ext_vector_type(8)));
typedef short s16x4 __attribute__((ext_vector_type(4)));
typedef float f32x4 __attribute__((ext_vector_type(4)));
typedef float f32x2 __attribute__((ext_vector_type(2)));
typedef float f32x16 __attribute__((ext_vector_type(16)));
typedef unsigned u32x4 __attribute__((ext_vector_type(4)));
typedef unsigned u32x2 __attribute__((ext_vector_type(2)));

constexpr int DM = 1024, SEQ = 2048, NBP = 8, DSEQ = 64, NBS = 32, PAST = 4096;
constexpr int TP = NBP * SEQ, TS = NBS * DSEQ, TOK = TP + TS;
constexpr int NPAST = NBS * PAST;
constexpr int KVS = PAST + DSEQ;
constexpr int DIN = 2216, NZ = 2304, ZW = 640;
constexpr int DFF = 2816, DFF2 = 5632;
constexpr float LOG2E = 1.4426950408889634f;
constexpr float EPS = 1e-6f;
constexpr int NTHREADS = 512, NWAVES = 8;
constexpr int LDS_BYTES = 147456;

constexpr size_t O_YP = 0, O_YS = O_YP + (size_t)TP * DM, O_KP = O_YS + (size_t)TS * DM, O_VP = O_KP + (size_t)TP * 512, O_LFP = O_VP + (size_t)TP * 512,
                 O_LATP = O_LFP + (size_t)TP * 8, O_KRP = O_LATP + (size_t)TP * 256, O_CVP = O_KRP + (size_t)TP * 32, O_KS = O_CVP + (size_t)NBP * 2 * DFF2,
                 O_VS = O_KS + (size_t)TS * 512, O_LFS = O_VS + (size_t)TS * 512, O_LATS = O_LFS + (size_t)TS * 8, O_KRS = O_LATS + (size_t)TS * 256,
                 O_CVS = O_KRS + (size_t)TS * 32, O_END = O_CVS + (size_t)NBS * 2 * DFF2;

constexpr size_t MiB = 1u << 20;
constexpr size_t WS_CTL = 0, CTL_BYTES = 16384;
constexpr size_t WS_WIN = 1 * MiB, WS_WQ = 6 * MiB, WS_WKV = 7 * MiB, WS_WOUT = 8 * MiB, WS_WUP = 10 * MiB, WS_WDOWN = 21 * MiB, WS_CS = 27 * MiB,
                 WS_FS = 28 * MiB, WS_FP = 33 * MiB, WS_H = 34 * MiB, WS_QFOX = 70 * MiB, WS_KNEW = 88 * MiB, WS_VNEW = 106 * MiB, WS_ZBUF = 124 * MiB,
                 WS_QCN = 169 * MiB, WS_LATNEW = 183 * MiB, WS_KRNEW = 192 * MiB, WS_QMLA = 194 * MiB, WS_KVNEW = 221 * MiB, WS_MIXED = 257 * MiB,
                 WS_X1 = 293 * MiB, WS_X2 = 124 * MiB  , WS_LATPAST = 365 * MiB, WS_KRPAST = 429 * MiB, WS_KPAST = 437 * MiB,
                 WS_VPAST = 565 * MiB, WS_SLAB = 565 * MiB  , WS_KVPAST = 693 * MiB, WS_EDGE = 693 * MiB  , WS_ACT = 437 * MiB  , WS_WQA = 949 * MiB, WS_QLAT = 951 * MiB, WS_ROWSS = 959 * MiB  , WS_END = 961 * MiB;

struct Args {
    const float* in[23];
    float* out;
    unsigned char* ws;
};

__device__ __forceinline__ unsigned pk2(float lo, float hi) { typedef __bf16 bf2 __attribute__((ext_vector_type(2))); f32x2 v = {lo, hi}; bf2 b = __builtin_convertvector(v, bf2); return __builtin_bit_cast(unsigned, b); }
__device__ __forceinline__ float bflo(unsigned w) { return __builtin_bit_cast(float, w << 16); }
__device__ __forceinline__ float bfhi(unsigned w) { return __builtin_bit_cast(float, w & 0xffff0000u); }
__device__ __forceinline__ float wave_sum(float v) {
#pragma unroll
    for (int o = 1; o < 64; o <<= 1) v += __shfl_xor(v, o);
    return v;
}
__device__ __forceinline__ void st_bf4(bf16* p, f32x4 v) { *(u32x2*)p = (u32x2){pk2(v.x, v.y), pk2(v.z, v.w)}; }
__device__ __forceinline__ void lds_wait() { asm volatile("s_waitcnt lgkmcnt(0)" ::: "memory"); }
__device__ __forceinline__ float fast_exp2(float x) { return __builtin_amdgcn_exp2f(x); }

#define XB_TMO      128
#define XB_XCNT(j)  (256  + 64 * (j))
#define XB_XSUB(j)  (1280 + 64 * (j))
#define XB_XGEN(j)  (2304 + 64 * (j))
#define XB_TOP      3328
#define XB_TOPGEN   3392
#define XCD_BAR_WORDS 3456
#define XB_SPIN_CAP (1u << 18)

__device__ __forceinline__ unsigned xb_ld(unsigned* p)              { return __hip_atomic_load(p, __ATOMIC_RELAXED, __HIP_MEMORY_SCOPE_AGENT); }
__device__ __forceinline__ unsigned xb_add(unsigned* p, unsigned v) { return __hip_atomic_fetch_add(p, v, __ATOMIC_RELAXED, __HIP_MEMORY_SCOPE_AGENT); }
__device__ __forceinline__ unsigned xb_xcc_id() { return (unsigned)__builtin_amdgcn_s_getreg((3 << 11) | 20) & 0xFu; }
#define XB_SPIN(cond, bar) do { unsigned _sp = 0; while (cond) { __builtin_amdgcn_s_sleep(1); \
    if ((++_sp & 255u) == 0u) { if (xb_ld(&(bar)[XB_TMO])) break; if (_sp > XB_SPIN_CAP) { atomicAdd(&(bar)[XB_TMO], 1u); break; } } } } while (0)

struct XcdBarrier {
    unsigned* bar; unsigned x;
    volatile LAS unsigned* st;
};

__device__ __forceinline__ XcdBarrier xcd_barrier_post(unsigned* bar, volatile LAS unsigned* st) {
    XcdBarrier b; b.bar = bar; b.x = xb_xcc_id(); b.st = st;
    if (threadIdx.x == 0) (void)xb_add(&bar[XB_XCNT(b.x)], 1u);
    return b;
}
__device__ __forceinline__ void xcd_barrier_complete(unsigned* bar, unsigned x, unsigned& nloc, unsigned& nx) {
    const unsigned G = gridDim.x * gridDim.y * gridDim.z;
    unsigned sum, cnt, mine, sp = 0u;
    for (;;) {
        sum = 0u; cnt = 0u; mine = 0u;
#pragma unroll
        for (unsigned j = 0; j < 16; ++j) { const unsigned c = xb_ld(&bar[XB_XCNT(j)]); sum += c; cnt += (c > 0u) ? 1u : 0u; mine = (j == x) ? c : mine; }
        if (sum == G) break;
        __builtin_amdgcn_s_sleep(1);
        if ((++sp & 255u) == 0u) { if (xb_ld(&bar[XB_TMO])) break; if (sp > XB_SPIN_CAP) { atomicAdd(&bar[XB_TMO], 1u); break; } }
    }
    nloc = mine > 0u ? mine : 1u; nx = cnt > 0u ? cnt : 1u;
}

__device__ __forceinline__ void xcd_barrier(const XcdBarrier& b) {
    asm volatile("s_waitcnt vmcnt(0)" ::: "memory");
    __syncthreads();
    if (threadIdx.x == 0) {
        unsigned* bar = b.bar;
        __builtin_amdgcn_s_waitcnt(0);
        unsigned nloc = b.st[0], nx = b.st[1];
        if (nloc == 0u) { xcd_barrier_complete(bar, b.x, nloc, nx); b.st[0] = nloc; b.st[1] = nx; }
        const unsigned old = xb_add(&bar[XB_XSUB(b.x)], 1u);
        const unsigned gen = old / nloc;
        if (old + 1u == (gen + 1u) * nloc) {
            __builtin_amdgcn_fence(__ATOMIC_RELEASE, "agent");
            asm volatile("s_waitcnt vmcnt(0)" ::: "memory");
            const unsigned og = xb_add(&bar[XB_TOP], 1u);
            const unsigned tg = og / nx;
            if (og + 1u == (tg + 1u) * nx) xb_add(&bar[XB_TOPGEN], 1u);
            else XB_SPIN(xb_ld(&bar[XB_TOPGEN]) == tg, bar);
            __builtin_amdgcn_fence(__ATOMIC_ACQUIRE, "agent");
            xb_add(&bar[XB_XGEN(b.x)], 1u);
            asm volatile("s_waitcnt vmcnt(0)" ::: "memory");
        } else {
            XB_SPIN(xb_ld(&bar[XB_XGEN(b.x)]) == gen, bar);
            __builtin_amdgcn_fence(__ATOMIC_ACQUIRE, "agent");
            asm volatile("s_waitcnt vmcnt(0)" ::: "memory");
        }
    }
    __syncthreads();
}

template <int MODE> __device__ __forceinline__ int srccol(int n) {
    if (MODE == 0) return n;
    if (MODE == 2) return ((n & 16) ? DFF : 0) + 16 * (n >> 5) + (n & 15);
    if (n < 1536) return n;
    if (n < 1920) return 1544 + (n - 1536);
    if (n < 2176) return 1928 + (n - 1920);
    if (n < 2208) return 2184 + (n - 2176);
    if (n < 2216) return 1536 + (n - 2208);
    return -1;
}
template <int MODE>
__device__ __forceinline__ void tr_item(const float* W, int K, int Nsrc, int Ndst, bf16* WT, int row_off, LAS float* scr, int item, int lane) {
    const int nblk = Ndst / 32, kb = item / nblk, nb = item % nblk, k0 = 64 * kb, n0 = 32 * nb;
    const int sc = srccol<MODE>(n0 + (lane & 31));
#pragma unroll 8
    for (int i = 0; i < 32; ++i) { const int kk = 2 * i + (lane >> 5); scr[kk * 33 + (lane & 31)] = sc >= 0 ? W[(size_t)(k0 + kk) * Nsrc + sc] : 0.f; }
    lds_wait();
    const int c = lane & 7;
#pragma unroll
    for (int j = 0; j < 4; ++j) { const int n = (lane >> 3) + 8 * j; const LAS float* s = scr + (8 * c) * 33 + n;
        u32x4 o; o.x = pk2(s[0 * 33], s[1 * 33]); o.y = pk2(s[2 * 33], s[3 * 33]); o.z = pk2(s[4 * 33], s[5 * 33]); o.w = pk2(s[6 * 33], s[7 * 33]);
        *(u32x4*)(WT + (size_t)(row_off + n0 + n) * K + k0 + 8 * c) = o; }
    lds_wait();
}
template <bool OUTF>
__device__ __forceinline__ void rms_row(const float* xrow, const float* g, void* orow, int lane, const float* slab = nullptr, int nslab = 0, size_t slab_stride = 0) {
    const f32x4* xr = (const f32x4*)xrow + lane; const f32x4* gr = (const f32x4*)g + lane;
    f32x4 v[4]; float s = 0.f;
#pragma unroll
    for (int j = 0; j < 4; ++j) v[j] = xr[64 * j];
    for (int k = 0; k < nslab; ++k) { const f32x4* sr = (const f32x4*)(slab + (size_t)k * slab_stride) + lane;
#pragma unroll
        for (int j = 0; j < 4; ++j) v[j] += sr[64 * j]; }
#pragma unroll
    for (int j = 0; j < 4; ++j) { s += (v[j].x * v[j].x + v[j].y * v[j].y) + (v[j].z * v[j].z + v[j].w * v[j].w); }
    const float rstd = rsqrtf(wave_sum(s) * (1.f / DM) + EPS);
#pragma unroll
    for (int j = 0; j < 4; ++j) { const f32x4 gv = gr[64 * j]; const f32x4 o = v[j] * rstd * gv;
        if (OUTF) ((f32x4*)orow)[64 * j + lane] = o;
        else ((u32x2*)orow)[64 * j + lane] = (u32x2){pk2(o.x, o.y), pk2(o.z, o.w)}; }
}
__device__ __forceinline__ void cvt_stream(const float* src, bf16* dst, size_t n4, size_t gtid, size_t gthreads) {
    size_t i = gtid;
    for (; i + 7 * gthreads < n4; i += 8 * gthreads) {
        f32x4 v[8];
#pragma unroll
        for (int k = 0; k < 8; ++k) v[k] = __builtin_nontemporal_load((const f32x4*)src + i + k * gthreads);
#pragma unroll
        for (int k = 0; k < 8; ++k) ((u32x2*)dst)[i + k * gthreads] = (u32x2){pk2(v[k].x, v[k].y), pk2(v[k].z, v[k].w)};
    }
    for (; i < n4; i += gthreads) { const f32x4 v = ((const f32x4*)src)[i]; ((u32x2*)dst)[i] = (u32x2){pk2(v.x, v.y), pk2(v.z, v.w)}; }
}
__device__ __forceinline__ float wave_incl_scan(float v, int lane) {
#pragma unroll
    for (int o = 1; o < 64; o <<= 1) { const float t = __shfl_up(v, o); if (lane >= o) v += t; }
    return v;
}

template <int NCH>
__device__ __forceinline__ void scan_seq(const float* src, float* dst, float base, int lane, LAS float* scr) {
    float v[NCH];
#pragma unroll
    for (int c = 0; c < NCH; ++c) v[c] = src[(size_t)(64 * c + lane) * 8];
#pragma unroll
    for (int c = 0; c < NCH; ++c) { v[c] = wave_incl_scan(v[c], lane); if (lane == 63) scr[c] = v[c]; }
    lds_wait();
    const float st = wave_incl_scan(lane < NCH ? scr[lane] : 0.f, lane);
    lds_wait();
#pragma unroll
    for (int c = 0; c < NCH; ++c) { const float carry = c ? __builtin_bit_cast(float, __builtin_amdgcn_readlane(__builtin_bit_cast(int, st), c ? c - 1 : 0)) : 0.f; dst[64 * c + lane] = (v[c] + carry + base) * LOG2E; }
}
__device__ __forceinline__ void p0_prologue(const Args& A, LAS unsigned char* lds) {
    const int tid = threadIdx.x, lane = tid & 63, wave = tid >> 6;
    const int G = gridDim.x, gw = blockIdx.x * NWAVES + wave, NGW = G * NWAVES;
    unsigned char* ws = A.ws;
    LAS float* scr = (LAS float*)(lds + wave * 16384);
    constexpr int I_IN = (DM / 64) * (NZ / 32), I_Q = (384 / 64) * (768 / 32), I_UK = (256 / 64) * (512 / 32), I_OUT = (DM / 64) * (DM / 32),
                  I_UP = (DM / 64) * (DFF2 / 32), I_DN = (DFF / 64) * (DM / 32);
    constexpr int NITEMS = I_IN + I_Q + 2 * I_UK + I_OUT + I_UP + I_DN;
    for (int it = gw; it < NITEMS; it += NGW) {
        int r = it;
        if (r < I_IN) { tr_item<1>(A.in[9], DM, DIN, NZ, (bf16*)(ws + WS_WIN), 0, scr, r, lane); continue; } r -= I_IN;
        if (r < I_Q) { tr_item<0>(A.in[12], 384, 768, 768, (bf16*)(ws + WS_WQ), 0, scr, r, lane); continue; } r -= I_Q;
        if (r < I_UK) { tr_item<0>(A.in[14], 256, 512, 512, (bf16*)(ws + WS_WKV), 0, scr, r, lane); continue; } r -= I_UK;
        if (r < I_UK) { tr_item<0>(A.in[15], 256, 512, 512, (bf16*)(ws + WS_WKV), 512, scr, r, lane); continue; } r -= I_UK;
        if (r < I_OUT) { tr_item<0>(A.in[16], DM, DM, DM, (bf16*)(ws + WS_WOUT), 0, scr, r, lane); continue; } r -= I_OUT;
        if (r < I_UP) { tr_item<2>(A.in[18], DM, DFF2, DFF2, (bf16*)(ws + WS_WUP), 0, scr, r, lane); continue; } r -= I_UP;
        tr_item<0>(A.in[21], DFF, DM, DM, (bf16*)(ws + WS_WDOWN), 0, scr, r, lane);
    }
    for (int it = gw; it < 8 * 12 * 8; it += NGW) {
        const int h = it / 96, kt = (it % 96) / 8, ct = it % 8; const int r32 = lane & 31, hi2 = lane >> 5;
        const float* wq = A.in[12] + (size_t)(kt * 32 + r32) * 768 + h * 96 + 8 * hi2; const float* uk = A.in[14] + (size_t)(ct * 32 + r32) * 512 + h * 64 + 8 * hi2;
        f32x16 acc = {};
#pragma unroll
        for (int st = 0; st < 4; ++st) {
            const f32x4 a0 = *(const f32x4*)(wq + 16 * st), a1 = *(const f32x4*)(wq + 16 * st + 4), b0 = *(const f32x4*)(uk + 16 * st), b1 = *(const f32x4*)(uk + 16 * st + 4);
            const u32x4 aw = {pk2(a0.x, a0.y), pk2(a0.z, a0.w), pk2(a1.x, a1.y), pk2(a1.z, a1.w)}, bw = {pk2(b0.x, b0.y), pk2(b0.z, b0.w), pk2(b1.x, b1.y), pk2(b1.z, b1.w)};
            acc = __builtin_amdgcn_mfma_f32_32x32x16_bf16(__builtin_bit_cast(bf16x8, aw), __builtin_bit_cast(bf16x8, bw), acc, 0, 0, 0);
        }
        bf16* o = (bf16*)(ws + WS_WQA) + (size_t)(h * 256 + ct * 32 + r32) * 384 + kt * 32 + 4 * hi2;
#pragma unroll
        for (int q = 0; q < 4; ++q) st_bf4(o + 8 * q, (f32x4){acc[4 * q], acc[4 * q + 1], acc[4 * q + 2], acc[4 * q + 3]});
    }
    for (int m = gw; m < TOK; m += NGW) {
        const float* xr = m < TP ? A.in[0] + (size_t)m * DM : A.in[1] + (size_t)(m - TP) * DM;
        rms_row<false>(xr, A.in[8], (bf16*)(ws + WS_H) + (size_t)m * DM, lane);
    }
    {
        const int gt = blockIdx.x * NTHREADS + tid, GT = G * NTHREADS;
        for (int i = gt; i < 2112 * 16; i += GT) {
            const int pidx = i >> 4, k = i & 15; const int pos = pidx < 2048 ? pidx : PAST + (pidx - 2048);
            const float inv = exp2f(-(float)k * (13.287712379549449f / 16.f));
            const float ang = (float)pos * inv;
            const float kq = floorf(ang * 0.15915494309189535f);
            float r = fmaf(-kq, 6.2831854820251465f, ang); r = fmaf(-kq, -1.7484555e-7f, r);
            const float rev = r * 0.15915494309189535f;
            ((f32x2*)(ws + WS_CS))[i] = (f32x2){__builtin_amdgcn_cosf(rev), __builtin_amdgcn_sinf(rev)};
        }
    }
    for (int sq = (wave == 0 ? (int)blockIdx.x : NBS * 8); sq < NBS * 8; sq += G) {
        const int b = sq >> 3, h = sq & 7; const float* lf = A.in[4] + (size_t)b * PAST * 8 + h; float* Fo = (float*)(ws + WS_FS) + (size_t)sq * KVS;
        scan_seq<PAST / 64>(lf, Fo, 0.f, lane, scr);
    }
    {
        const size_t gt = (size_t)blockIdx.x * NTHREADS + tid, GT = (size_t)G * NTHREADS;
        cvt_stream(A.in[5], (bf16*)(ws + WS_LATPAST), (size_t)NPAST * 256 / 4, gt, GT);
        cvt_stream(A.in[6], (bf16*)(ws + WS_KRPAST), (size_t)NPAST * 32 / 4, gt, GT);
    }
}

__device__ __forceinline__ void rope4(f32x4& x1, f32x4& x2, const float* cs  ) {
    const f32x4 a = ((const f32x4*)cs)[0], b = ((const f32x4*)cs)[1];
    const f32x4 c = {a.x, a.z, b.x, b.z}, s = {a.y, a.w, b.y, b.w};
    const f32x4 o1 = x1 * c - x2 * s, o2 = x1 * s + x2 * c; x1 = o1; x2 = o2;
}
__device__ __forceinline__ float log_sigmoid(float x) { return fminf(x, 0.f) - log1pf(__expf(-fabsf(x))); }

struct EpiZ {
    static constexpr bool PERM = false, AFTER_DRAIN = false;
    bf16 *qfox, *knew, *vnew, *krnew; float* zbuf; float* out; const float* cs; const float* bfg;
    __device__ __forceinline__ void operator()(const f32x4 (&acc)[2][2][4][2], const pg8::Unit& u, int wr, int wc, int fr, int fq) const {
        const bool smp = u.pm >= TP / 256;
        const int row0 = u.pm * 256 + wr * 64 + fr;
#pragma unroll
        for (int bj = 0; bj < 2; ++bj) {
            const int cg = u.pn * 256 + bj * 128 + wc * 32;
            const int c0 = cg + 4 * fq;
#pragma unroll
            for (int ai = 0; ai < 2; ++ai)
#pragma unroll
                for (int m = 0; m < 4; ++m) {
                    const int row = row0 + ai * 128 + m * 16; const size_t lr = smp ? (size_t)(row - TP) : (size_t)row;
                    f32x4 v0 = acc[ai][bj][m][0], v1 = acc[ai][bj][m][1];
                    if (cg < 512) { const float sc = 0.125f * LOG2E; st_bf4(qfox + (size_t)row * 512 + c0, v0 * sc); st_bf4(qfox + (size_t)row * 512 + c0 + 16, v1 * sc); }
                    else if (cg < 1024) { const int c = c0 - 512; float* o = out + (smp ? O_KS : O_KP) + lr * 512 + c; *(f32x4*)o = v0; *(f32x4*)(o + 16) = v1;
                        st_bf4(knew + (size_t)row * 512 + c, v0); st_bf4(knew + (size_t)row * 512 + c + 16, v1); }
                    else if (cg < 1536) { const int c = c0 - 1024; float* o = out + (smp ? O_VS : O_VP) + lr * 512 + c; *(f32x4*)o = v0; *(f32x4*)(o + 16) = v1;
                        st_bf4(vnew + (size_t)row * 512 + c, v0); st_bf4(vnew + (size_t)row * 512 + c + 16, v1); }
                    else if (cg < 2176) { float* z = zbuf + (size_t)row * ZW + (c0 - 1536); *(f32x4*)z = v0; *(f32x4*)(z + 16) = v1; }
                    else if (cg == 2176) {
                        const int pidx = smp ? 2048 + ((row - TP) & 63) : (row & 2047);
                        rope4(v0, v1, cs + ((size_t)pidx * 16 + 4 * fq) * 2);
                        float* o = out + (smp ? O_KRS : O_KRP) + lr * 32 + 4 * fq; *(f32x4*)o = v0; *(f32x4*)(o + 16) = v1;
                        st_bf4(krnew + (size_t)row * 32 + 4 * fq, v0); st_bf4(krnew + (size_t)row * 32 + 4 * fq + 16, v1);
                    } else if (cg == 2208) {
                        if (fq < 2) { const f32x4 b = *(const f32x4*)(bfg + 4 * fq);
                            f32x4 lf; lf.x = log_sigmoid(v0.x + b.x); lf.y = log_sigmoid(v0.y + b.y); lf.z = log_sigmoid(v0.z + b.z); lf.w = log_sigmoid(v0.w + b.w);
                            *(f32x4*)(out + (smp ? O_LFS : O_LFP) + lr * 8 + 4 * fq) = lf; }
                    }
                }
        }
    }
};
struct EpiBf {
    static constexpr bool PERM = true, AFTER_DRAIN = false;
    bf16* O; int ldc; float sc;
    __device__ __forceinline__ void operator()(const f32x4 (&acc)[2][2][4][2], const pg8::Unit& u, int wr, int wc, int fr, int fq) const {
        const int row0 = u.pm * 256 + wr * 64 + fr;
#pragma unroll
        for (int ai = 0; ai < 2; ++ai)
#pragma unroll
            for (int m = 0; m < 4; ++m) { bf16* rp = O + (size_t)(row0 + ai * 128 + m * 16) * ldc + u.pn * 256 + wc * 32 + 8 * fq;
#pragma unroll
                for (int bj = 0; bj < 2; ++bj) { const f32x4 v0 = acc[ai][bj][m][0] * sc, v1 = acc[ai][bj][m][1] * sc;
                    *(u32x4*)(rp + bj * 128) = (u32x4){pk2(v0.x, v0.y), pk2(v0.z, v0.w), pk2(v1.x, v1.y), pk2(v1.z, v1.w)}; } }
    }
};
constexpr int DN_SL = 8;
template <int NKT  >
struct SplitOrder {
    int G, c;
    __device__ __forceinline__ bool next(int i, pg8::Unit& u) const {
        const int L = i * G + c; if (L >= 256 + 32 * DN_SL) return false;
        const bool full = L < 256; const int r = full ? L : L - 256, x = r & 7, y = r >> 3;
        pg8::Unit t; t.pm = full ? 8 * x + (y & 7) : 64 + x; t.pn = full ? (y >> 3) : (y & 3); const int sl = y >> 2;
        if (NKT == 44) { t.k0 = full ? 0 : (sl < 6 ? 6 * sl : 36 + 4 * (sl - 6)); t.nkt = full ? 44 : (sl < 6 ? 6 : 4); }
        else { t.k0 = full ? 0 : 2 * sl; t.nkt = full ? 16 : 2; }
        t.sl = full ? -1 : sl;
        u = t; return true;
    }
    __device__ __forceinline__ void a_ready(const pg8::Unit&) const {}
    __device__ __forceinline__ void done(const pg8::Unit&) const {}
};
typedef SplitOrder<44> DownOrder;
struct EpiDown {
    static constexpr bool PERM = false, AFTER_DRAIN = false;
    const float* x1; float* x2; float* slab;
    __device__ __forceinline__ void operator()(const f32x4 (&acc)[2][2][4][2], const pg8::Unit& u, int wr, int wc, int fr, int fq) const {
        const int row0 = u.pm * 256 + wr * 64 + fr; const bool part = u.sl >= 0;
#pragma unroll
        for (int ai = 0; ai < 2; ++ai)
#pragma unroll
            for (int m = 0; m < 4; ++m) { const int row = row0 + ai * 128 + m * 16; const int cb = u.pn * 256 + wc * 32 + 4 * fq;
                if (part) { float* op = slab + ((size_t)u.sl * TS + (row - TP)) * DM + cb;
#pragma unroll
                    for (int bj = 0; bj < 2; ++bj)
#pragma unroll
                        for (int n = 0; n < 2; ++n) *(f32x4*)(op + bj * 128 + n * 16) = acc[ai][bj][m][n]; }
                else { const float* bp = x1 + (size_t)row * DM + cb; float* op = x2 + (size_t)row * DM + cb;
#pragma unroll
                    for (int bj = 0; bj < 2; ++bj)
#pragma unroll
                        for (int n = 0; n < 2; ++n) *(f32x4*)(op + bj * 128 + n * 16) = *(const f32x4*)(bp + bj * 128 + n * 16) + acc[ai][bj][m][n]; } }
    }
};
struct EpiOut {
    static constexpr bool PERM = false, AFTER_DRAIN = false;
    const float* b0; const float* b1; float* O; bf16* H; const float* g; float* rowss; float* slab;
    __device__ __forceinline__ void operator()(const f32x4 (&acc)[2][2][4][2], const pg8::Unit& u, int wr, int wc, int fr, int fq) const {
        const int row0 = u.pm * 256 + wr * 64 + fr; const bool smp = u.pm >= TP / 256; const int cb = u.pn * 256 + wc * 32 + 4 * fq;
        if (u.sl >= 0) {
#pragma unroll
            for (int ai = 0; ai < 2; ++ai)
#pragma unroll
                for (int m = 0; m < 4; ++m) { float* sp = slab + ((size_t)u.sl * TS + (row0 + ai * 128 + m * 16 - TP)) * DM + cb;
#pragma unroll
                    for (int bj = 0; bj < 2; ++bj)
#pragma unroll
                        for (int n = 0; n < 2; ++n) *(f32x4*)(sp + bj * 128 + n * 16) = acc[ai][bj][m][n]; }
            return;
        }
        f32x4 gv[2][2];
#pragma unroll
        for (int bj = 0; bj < 2; ++bj)
#pragma unroll
            for (int n = 0; n < 2; ++n) gv[bj][n] = *(const f32x4*)(g + cb + bj * 128 + n * 16);
#pragma unroll
        for (int ai = 0; ai < 2; ++ai)
#pragma unroll
            for (int m = 0; m < 4; ++m) { const int row = row0 + ai * 128 + m * 16;
                const float* bp = (smp ? b1 + (size_t)(row - TP) * DM : b0 + (size_t)row * DM) + cb; float* op = O + (size_t)row * DM + cb; bf16* hp = H + (size_t)row * DM + cb;
                float ss = 0.f;
#pragma unroll
                for (int bj = 0; bj < 2; ++bj)
#pragma unroll
                    for (int n = 0; n < 2; ++n) { const f32x4 x = *(const f32x4*)(bp + bj * 128 + n * 16) + acc[ai][bj][m][n]; *(f32x4*)(op + bj * 128 + n * 16) = x;
                        ss += (x.x * x.x + x.y * x.y) + (x.z * x.z + x.w * x.w); st_bf4(hp + bj * 128 + n * 16, x * gv[bj][n]); }
                ss += __shfl_xor(ss, 16); ss += __shfl_xor(ss, 32);
                if (fq == 0) rowss[(size_t)row * 16 + u.pn * 4 + wc] = ss;
            }
    }
};
struct EpiRes {
    static constexpr bool PERM = false, AFTER_DRAIN = false;
    const float* b0; const float* b1; float* O;
    __device__ __forceinline__ void operator()(const f32x4 (&acc)[2][2][4][2], const pg8::Unit& u, int wr, int wc, int fr, int fq) const {
        const int row0 = u.pm * 256 + wr * 64 + fr; const bool smp = u.pm >= TP / 256;
#pragma unroll
        for (int ai = 0; ai < 2; ++ai)
#pragma unroll
            for (int m = 0; m < 4; ++m) { const int row = row0 + ai * 128 + m * 16; const int cb = u.pn * 256 + wc * 32 + 4 * fq;
                const float* bp = (smp ? b1 + (size_t)(row - TP) * DM : b0 + (size_t)row * DM) + cb; float* op = O + (size_t)row * DM + cb;
#pragma unroll
                for (int bj = 0; bj < 2; ++bj)
#pragma unroll
                    for (int n = 0; n < 2; ++n) *(f32x4*)(op + bj * 128 + n * 16) = *(const f32x4*)(bp + bj * 128 + n * 16) + acc[ai][bj][m][n]; }
    }
};


__device__ __forceinline__ float silu(float g) { return g * __builtin_amdgcn_rcpf(1.f + fast_exp2(-g * LOG2E)); }
template <int CTRL> __device__ __forceinline__ float dpp_mov(float old, float src) {
    return __builtin_bit_cast(float, __builtin_amdgcn_update_dpp(__builtin_bit_cast(int, old), __builtin_bit_cast(int, src), CTRL, 0xf, 0xf, false)); }
__device__ __forceinline__ f32x4 rows_m1(f32x4 cur, f32x4 prev) { f32x4 o;
#pragma unroll
    for (int e = 0; e < 4; ++e) o[e] = dpp_mov<0x111>(dpp_mov<0x121>(0.f, prev[e]), cur[e]);
    return o; }
__device__ __forceinline__ f32x4 rows_m2(f32x4 cur, f32x4 prev) { f32x4 o;
#pragma unroll
    for (int e = 0; e < 4; ++e) o[e] = dpp_mov<0x112>(dpp_mov<0x122>(0.f, prev[e]), cur[e]);
    return o; }
struct EpiGlu {
    static constexpr bool PERM = false, AFTER_DRAIN = false;
    bf16* act; float* edge; const float* cw; const float* cb; const float* rowss;
    __device__ __forceinline__ void operator()(const f32x4 (&acc)[2][2][4][2], const pg8::Unit& u, int wr, int wc, int fr, int fq) const {
        float rstd[2][4];
#pragma unroll
        for (int ai = 0; ai < 2; ++ai)
#pragma unroll
            for (int m = 0; m < 4; ++m) { const f32x4* rp = (const f32x4*)(rowss + (size_t)(u.pm * 256 + ai * 128 + wr * 64 + m * 16 + fr) * 16);
                const f32x4 a = rp[0], b = rp[1], c = rp[2], d = rp[3]; const f32x4 t = (a + b) + (c + d);
                rstd[ai][m] = rsqrtf(((t.x + t.y) + (t.z + t.w)) * (1.f / DM) + EPS); asm volatile("" : "+v"(rstd[ai][m]) :: "memory"); }
#pragma unroll
        for (int bj = 0; bj < 2; ++bj) {
            const int j = 16 * ((u.pn * 256 + bj * 128 + wc * 32) >> 5) + 4 * fq;
            const f32x4 w0g = *(const f32x4*)(cw + j), w1g = *(const f32x4*)(cw + DFF2 + j), w2g = *(const f32x4*)(cw + 2 * DFF2 + j), bg = *(const f32x4*)(cb + j);
            const f32x4 w0v = *(const f32x4*)(cw + DFF + j), w1v = *(const f32x4*)(cw + DFF2 + DFF + j), w2v = *(const f32x4*)(cw + 2 * DFF2 + DFF + j), bv = *(const f32x4*)(cb + DFF + j);
#pragma unroll
            for (int ai = 0; ai < 2; ++ai) {
                const int blk = u.pm * 4 + ai * 2 + wr; const int row0 = blk * 64 + fr;
#pragma unroll
                for (int m = 0; m < 4; ++m) {
                    const f32x4 gc = acc[ai][bj][m][0] * rstd[ai][m], vc = acc[ai][bj][m][1] * rstd[ai][m];
                    const f32x4 gp = acc[ai][bj][m ? m - 1 : 0][0] * rstd[ai][m ? m - 1 : 0], vp = acc[ai][bj][m ? m - 1 : 0][1] * rstd[ai][m ? m - 1 : 0];
                    const f32x4 g1 = rows_m1(gc, gp), g2 = rows_m2(gc, gp), v1 = rows_m1(vc, vp), v2 = rows_m2(vc, vp);
                    const f32x4 g = bg + w0g * g2 + w1g * g1 + w2g * gc, v = bv + w0v * v2 + w1v * v1 + w2v * vc;
                    f32x4 a; a.x = silu(g.x) * v.x; a.y = silu(g.y) * v.y; a.z = silu(g.z) * v.z; a.w = silu(g.w) * v.w;
                    if (m > 0 || fr >= 2) st_bf4(act + (size_t)(row0 + 16 * m) * DFF + j, a);
                    if (m == 0 && fr < 2) { float* e = edge + ((size_t)blk * 4 + fr) * DFF2; *(f32x4*)(e + j) = gc; *(f32x4*)(e + DFF + j) = vc; }
                    if (m == 3 && fr >= 14) { float* e = edge + ((size_t)blk * 4 + 2 + (fr - 14)) * DFF2; *(f32x4*)(e + j) = gc; *(f32x4*)(e + DFF + j) = vc; }
                }
            }
        }
    }
};

__device__ __forceinline__ void p2_postz(const Args& A, LAS unsigned char* lds) {
    const int tid = threadIdx.x, lane = tid & 63, wave = tid >> 6; const int gw = blockIdx.x * NWAVES + wave, NGW = gridDim.x * NWAVES;
    unsigned char* ws = A.ws; const float* zb = (const float*)(ws + WS_ZBUF);
    f32x2 gq[3]; { for (int j = 0; j < 3; ++j) gq[j] = ((const f32x2*)A.in[11])[lane + 64 * j]; }
    const f32x4 gk = ((const f32x4*)A.in[13])[lane];
    for (int m0 = gw; m0 < TOK; m0 += 3 * NGW) {
        f32x2 v[3][3]; f32x4 c[3]; float sq[3], sk[3]; bool ok[3];
#pragma unroll
        for (int u = 0; u < 3; ++u) { const int m = m0 + u * NGW; ok[u] = m < TOK; const float* z = zb + (size_t)(ok[u] ? m : m0) * ZW;
#pragma unroll
            for (int j = 0; j < 3; ++j) v[u][j] = ((const f32x2*)z)[lane + 64 * j];
            c[u] = ((const f32x4*)(z + 384))[lane]; }
#pragma unroll
        for (int u = 0; u < 3; ++u) { sq[u] = 0.f;
#pragma unroll
            for (int j = 0; j < 3; ++j) sq[u] += v[u][j].x * v[u][j].x + v[u][j].y * v[u][j].y;
            sk[u] = (c[u].x * c[u].x + c[u].y * c[u].y) + (c[u].z * c[u].z + c[u].w * c[u].w); }
#pragma unroll
        for (int o = 1; o < 64; o <<= 1) {
#pragma unroll
            for (int u = 0; u < 3; ++u) { sq[u] += __shfl_xor(sq[u], o); sk[u] += __shfl_xor(sk[u], o); } }
#pragma unroll
        for (int u = 0; u < 3; ++u) if (ok[u]) { const int m = m0 + u * NGW;
            const float rq = rsqrtf(sq[u] * (1.f / 384.f) + EPS), rk = rsqrtf(sk[u] * (1.f / 256.f) + EPS);
            unsigned* o = (unsigned*)((bf16*)(ws + WS_QCN) + (size_t)m * 384);
#pragma unroll
            for (int j = 0; j < 3; ++j) o[lane + 64 * j] = pk2(v[u][j].x * rq * gq[j].x, v[u][j].y * rq * gq[j].y);
            const f32x4 ov = c[u] * rk * gk;
            float* op = A.out + (m < TP ? O_LATP + (size_t)m * 256 : O_LATS + (size_t)(m - TP) * 256); ((f32x4*)op)[lane] = ov;
            st_bf4((bf16*)(ws + WS_LATNEW) + (size_t)m * 256 + 4 * lane, ov); }
    }
    for (int sq = ((gw & 3) == 0 ? (gw >> 2) : 64 + 256); sq < 64 + 256; sq += (NGW >> 2)) {
        if (sq < 64) { const int b = sq >> 3, h = sq & 7; const float* lf = A.out + O_LFP + (size_t)b * SEQ * 8 + h; float* Fo = (float*)(ws + WS_FP) + (size_t)sq * SEQ; scan_seq<SEQ / 64>(lf, Fo, 0.f, lane, (LAS float*)(lds + wave * 16384)); }
        else { const int s2 = sq - 64, b = s2 >> 3, h = s2 & 7; const float* lf = A.out + O_LFS + (size_t)b * DSEQ * 8 + h; float* Fo = (float*)(ws + WS_FS) + (size_t)s2 * KVS;
            const float base = Fo[PAST - 1]; const float v = wave_incl_scan(lf[(size_t)lane * 8], lane); Fo[PAST + lane] = base + v * LOG2E; }
    }
}

__device__ __forceinline__ f32x4 ld_bf4(const bf16* p) { const u32x2 w = *(const u32x2*)p; return (f32x4){bflo(w.x), bfhi(w.x), bflo(w.y), bfhi(w.y)}; }
__device__ __forceinline__ void p8_fixup(const Args& A) {
    int tid = threadIdx.x; asm volatile("" : "+v"(tid)); const int lane = tid & 63, wave = tid >> 6; const int gw = blockIdx.x * NWAVES + wave, NGW = gridDim.x * NWAVES;
    unsigned char* ws = A.ws; const float* __restrict__ EDGE = (const float*)(ws + WS_EDGE); bf16* __restrict__ ACT = (bf16*)(ws + WS_ACT);
    const float* __restrict__ cw = A.in[19]; const float* __restrict__ cb = A.in[20];
    constexpr int NBLK = TOK / 64, NSTRIP = DFF / 256, NIT = NBLK * NSTRIP;
    for (int it0 = gw; it0 < NIT; it0 += 2 * NGW) {
        f32x4 wg[2][4], wv[2][4], pg[2][2], pv[2][2], cg[2][2], cv[2][2], sg[2][2], sv[2][2]; bool ok[2], last[2], smp[2]; int j0[2], tok0[2], bb[2];
#pragma unroll
        for (int u = 0; u < 2; ++u) {
            const int it = it0 + u * NGW; ok[u] = it < NIT; const int itc = ok[u] ? it : it0;
            const int blk = itc / NSTRIP, strip = itc % NSTRIP; j0[u] = strip * 256 + lane * 4; tok0[u] = blk * 64;
            smp[u] = tok0[u] >= TP; const int T = smp[u] ? DSEQ : SEQ; const int lt = smp[u] ? tok0[u] - TP : tok0[u]; bb[u] = lt / T; const int t0 = lt % T; last[u] = (t0 + 64 == T);
#pragma unroll
            for (int k = 0; k < 3; ++k) { wg[u][k] = *(const f32x4*)(cw + k * DFF2 + j0[u]); wv[u][k] = *(const f32x4*)(cw + k * DFF2 + DFF + j0[u]); }
            wg[u][3] = *(const f32x4*)(cb + j0[u]); wv[u][3] = *(const f32x4*)(cb + DFF + j0[u]);
            const float* pe = (t0 == 0) ? (smp[u] ? A.in[7] + (size_t)bb[u] * 2 * DFF2 : EDGE  ) : EDGE + ((size_t)(blk - 1) * 4 + 2) * DFF2;
            const bool zero = (t0 == 0) && !smp[u];
#pragma unroll
            for (int i = 0; i < 2; ++i) { pg[u][i] = *(const f32x4*)(pe + i * DFF2 + j0[u]); pv[u][i] = *(const f32x4*)(pe + i * DFF2 + DFF + j0[u]);
                if (zero) { pg[u][i] = (f32x4){0.f, 0.f, 0.f, 0.f}; pv[u][i] = (f32x4){0.f, 0.f, 0.f, 0.f}; }
                const float* e = EDGE + ((size_t)blk * 4 + i) * DFF2; cg[u][i] = *(const f32x4*)(e + j0[u]); cv[u][i] = *(const f32x4*)(e + DFF + j0[u]);
                const float* e2 = EDGE + ((size_t)blk * 4 + 2 + i) * DFF2; sg[u][i] = *(const f32x4*)(e2 + j0[u]); sv[u][i] = *(const f32x4*)(e2 + DFF + j0[u]); }
        }
#pragma unroll
        for (int u = 0; u < 2; ++u) if (ok[u]) {
            f32x4 g2 = pg[u][0], g1 = pg[u][1], v2 = pv[u][0], v1 = pv[u][1];
#pragma unroll
            for (int i = 0; i < 2; ++i) {
                const f32x4 gc = cg[u][i], vc = cv[u][i];
                const f32x4 g = wg[u][3] + wg[u][0] * g2 + wg[u][1] * g1 + wg[u][2] * gc, v = wv[u][3] + wv[u][0] * v2 + wv[u][1] * v1 + wv[u][2] * vc;
                f32x4 a; a.x = silu(g.x) * v.x; a.y = silu(g.y) * v.y; a.z = silu(g.z) * v.z; a.w = silu(g.w) * v.w;
                st_bf4(ACT + (size_t)(tok0[u] + i) * DFF + j0[u], a);
                g2 = g1; g1 = gc; v2 = v1; v1 = vc;
            }
            if (last[u]) {
#pragma unroll
                for (int i = 0; i < 2; ++i) { float* o = A.out + (smp[u] ? O_CVS : O_CVP) + ((size_t)bb[u] * 2 + i) * DFF2; *(f32x4*)(o + j0[u]) = sg[u][i]; *(f32x4*)(o + DFF + j0[u]) = sv[u][i]; }
            }
        }
    }
}

struct AttnArgs {
    const bf16* Q; int qstride;
    const void *Ka_past, *Ka_new; int kastride;
    const bf16 *Kb_past, *Kb_new; int kbstride;
    const void *V_past, *V_new; int vstride;
    const float *Fq, *Fk;
    bf16* O; int ostride;
    int P, qpos0, nkv;
    const float* cs;
};
__device__ __forceinline__ int crow(int r, int hi) { return (r & 3) + 8 * (r >> 2) + 4 * hi; }
__device__ __forceinline__ s16x4 tr_read(const LAS unsigned char* p) { typedef short v4i16 __attribute__((ext_vector_type(4))); return __builtin_bit_cast(s16x4, __builtin_amdgcn_ds_read_tr16_b64_v4i16((LAS v4i16*)p)); }

template <int DQK, bool FOX, int QS, int KS, bool F32>
__device__ __forceinline__ void attn_unit(const AttnArgs& a, LAS unsigned char* lds_base) {
    LAS unsigned char* const lds = lds_base;
    static_assert(QS * KS == NWAVES, "8 waves");
    constexpr int KRB = (DQK + 8) * 2, VRB = 144, NKK = DQK / 16;
    constexpr int OFF_V = 64 * KS * KRB, OFF_F = OFF_V + 64 * KS * VRB, OFF_Q = OFF_F + 64 * KS * 4, OFF_END = OFF_Q + QS * NKK * 1024;
    constexpr bool QLDS = KS > 1;
    static_assert(OFF_END <= 131072, "attention LDS");
    int tid = threadIdx.x; asm volatile("" : "+v"(tid));
    const int lane = tid & 63, q32 = lane & 31, hi = lane >> 5; const int wid = __builtin_amdgcn_readfirstlane(tid >> 6);
    const int qs = wid % QS, ks = wid / QS;
    const int NT = (a.nkv + 64 * KS - 1) / (64 * KS);
    const int qmin = a.qpos0 + qs * 32, qpos = qmin + q32;
    bf16x8 qf[NKK];
    { const bf16* qp = a.Q + (size_t)(qs * 32 + q32) * a.qstride + hi * 8;
#pragma unroll
      for (int kk = 0; kk < NKK; ++kk) qf[kk] = *(const bf16x8*)(qp + kk * 16); }
    if (DQK == 96) {
        const int pidx = qpos < SEQ ? qpos : SEQ + (qpos - PAST);
        const f32x4* cp = (const f32x4*)(a.cs + ((size_t)pidx * 16 + 8 * hi) * 2);
        const u32x4 w1 = __builtin_bit_cast(u32x4, qf[NKK - 2]), w2 = __builtin_bit_cast(u32x4, qf[NKK - 1]); u32x4 r1, r2;
#pragma unroll
        for (int j = 0; j < 4; ++j) { const f32x4 c = cp[j];
            const float a0 = bflo(w1[j]), a1 = bfhi(w1[j]), b0 = bflo(w2[j]), b1 = bfhi(w2[j]);
            r1[j] = pk2(a0 * c.x - b0 * c.y, a1 * c.z - b1 * c.w); r2[j] = pk2(a0 * c.y + b0 * c.x, a1 * c.w + b1 * c.z); }
        qf[NKK - 2] = __builtin_bit_cast(bf16x8, r1); qf[NKK - 1] = __builtin_bit_cast(bf16x8, r2);
    }
    LAS unsigned char* qlds = lds + OFF_Q + qs * (NKK * 1024) + lane * 16;
    if (QLDS) {
#pragma unroll
        for (int kk = 0; kk < NKK; ++kk) *(LAS bf16x8*)(qlds + kk * 1024) = qf[kk];
    }
    const float fqv = FOX ? a.Fq[qs * 32 + q32] : 0.f;
    float mrun = -1e30f, lsum = 0.f; f32x16 o0 = {}, o1 = {};
    u32x4 rka[KS], rv[F32 ? 1 : KS]; u32x4 rkb[(DQK == 96) ? (KS + 1) / 2 : 1]; float rf = 0.f;
    f32x4 fka[F32 ? KS : 1][2], fva[F32 ? KS : 1][2];
    const int lrow = tid >> 3, lch = tid & 7;
    const int brow = (tid & 255) >> 2, bch = tid & 3;
    auto load_k = [&](int T) {
        const int jT = T * KS * 64; const bool past = jT < a.P; const size_t r0 = (size_t)(past ? jT : jT - a.P);
        if (F32) { const float* kp = (const float*)(past ? a.Ka_past : a.Ka_new) + (r0 + lrow) * a.kastride + lch * 8;
#pragma unroll
            for (int s = 0; s < KS; ++s) if (jT + s * 64 < a.nkv) { const f32x4* p4 = (const f32x4*)(kp + (size_t)s * 64 * a.kastride); fka[F32 ? s : 0][0] = p4[0]; fka[F32 ? s : 0][1] = p4[1]; } }
        else { const bf16* kp = (const bf16*)(past ? a.Ka_past : a.Ka_new) + (r0 + lrow) * a.kastride + lch * 8;
#pragma unroll
            for (int s = 0; s < KS; ++s) if (jT + s * 64 < a.nkv) rka[s] = *(const u32x4*)(kp + (size_t)s * 64 * a.kastride); }
        if (DQK == 96) { const bf16* bp = (past ? a.Kb_past : a.Kb_new) + (r0 + (tid >> 8) * 64 + brow) * a.kbstride + bch * 8;
#pragma unroll
            for (int i = 0; i < (KS + 1) / 2; ++i) { const int s = 2 * i + (tid >> 8); if (s < KS && jT + s * 64 < a.nkv) rkb[i] = *(const u32x4*)(bp + (size_t)i * 128 * a.kbstride); }
        }
        if (FOX) { const int j = jT + tid; if (tid < 64 * KS && j < a.nkv) rf = a.Fk[j]; }
    };
    auto cvt_k = [&]() {
        if (F32) {
#pragma unroll
            for (int s = 0; s < KS; ++s) { const f32x4 k0 = fka[F32 ? s : 0][0], k1 = fka[F32 ? s : 0][1]; rka[s] = (u32x4){pk2(k0.x, k0.y), pk2(k0.z, k0.w), pk2(k1.x, k1.y), pk2(k1.z, k1.w)}; }
        }
    };
    auto load_v = [&](int T) {
        const int jT = T * KS * 64; const bool past = jT < a.P; const size_t r0 = (size_t)(past ? jT : jT - a.P);
        if (F32) { const float* vp = (const float*)(past ? a.V_past : a.V_new) + (r0 + lrow) * a.vstride + lch * 8;
#pragma unroll
            for (int s = 0; s < KS; ++s) if (jT + s * 64 < a.nkv) { const f32x4* p4 = (const f32x4*)(vp + (size_t)s * 64 * a.vstride); fva[F32 ? s : 0][0] = p4[0]; fva[F32 ? s : 0][1] = p4[1]; } }
        else { const bf16* vp = (const bf16*)(past ? a.V_past : a.V_new) + (r0 + lrow) * a.vstride + lch * 8;
#pragma unroll
            for (int s = 0; s < KS; ++s) if (jT + s * 64 < a.nkv) rv[F32 ? 0 : s] = *(const u32x4*)(vp + (size_t)s * 64 * a.vstride); }
    };
    constexpr bool DB = (KS == 1);
    static_assert(!DB || OFF_Q <= 32768, "double buffer stride");
    auto store_tile = [&](int T) {
        LAS unsigned char* const lds = lds_base + (DB ? (T & 1) * 32768 : 0);
#pragma unroll
        for (int s = 0; s < KS; ++s) { const int j0 = (T * KS + s) * 64;
            if (j0 < a.nkv) {
                *(LAS u32x4*)(lds + (s * 64 + lrow) * KRB + lch * 16) = rka[s];
                if (F32) { const f32x4 v0 = fva[F32 ? s : 0][0], v1 = fva[F32 ? s : 0][1];
                    *(LAS u32x4*)(lds + OFF_V + (s * 64 + lrow) * VRB + lch * 16) = (u32x4){pk2(v0.x, v0.y), pk2(v0.z, v0.w), pk2(v1.x, v1.y), pk2(v1.z, v1.w)}; }
                else *(LAS u32x4*)(lds + OFF_V + (s * 64 + lrow) * VRB + lch * 16) = rv[F32 ? 0 : s]; } }
        if (DQK == 96) {
#pragma unroll
            for (int i = 0; i < (KS + 1) / 2; ++i) { const int s = 2 * i + (tid >> 8); const int j0 = (T * KS + s) * 64;
                if (s < KS && j0 < a.nkv) *(LAS u32x4*)(lds + (s * 64 + brow) * KRB + 128 + bch * 16) = rkb[i]; }
        }
        if (FOX) { if (tid < 64 * KS) *(LAS float*)(lds + OFF_F + tid * 4) = rf; }
    };
    load_k(0); cvt_k(); load_v(0);
    const LAS unsigned char* kbase0 = lds + (ks * 64 + q32) * KRB + hi * 16;
    const LAS unsigned char* vbase0 = lds + OFF_V + (ks * 64 + 4 * hi + ((lane & 15) >> 2)) * VRB + (16 * ((lane >> 4) & 1) + 4 * (lane & 3)) * 2;
    const LAS unsigned char* fbase0 = lds + OFF_F + (ks * 64 + 4 * hi) * 4;
    if (DB) { store_tile(0); __syncthreads(); }
    for (int T = 0; T < NT; ++T) {
        if (!DB) { __syncthreads(); store_tile(T); __syncthreads(); }
        const int bo = DB ? (T & 1) * 32768 : 0;
        const LAS unsigned char* kbase = kbase0 + bo; const LAS unsigned char* vbase = vbase0 + bo; const LAS unsigned char* fbase = fbase0 + bo;
        if (T + 1 < NT) load_k(T + 1);
        __builtin_amdgcn_sched_barrier(0);
        const int tt = T * KS + ks; const int j0 = tt * 64;
        const bool valid = (j0 < a.nkv) && (FOX ? (j0 <= qmin + 31) : (tt <= (qmin >> 6)));
        bf16x8 pb[4];
        if (valid) {
            f32x16 p0 = {}, p1 = {};
#pragma unroll
            for (int kk = 0; kk < NKK; ++kk) {
                const bf16x8 k0 = *(const LAS bf16x8*)(kbase + kk * 32), k1 = *(const LAS bf16x8*)(kbase + 32 * KRB + kk * 32);
                const bf16x8 qv = QLDS ? *(const LAS bf16x8*)(qlds + kk * 1024) : qf[kk];
                p0 = __builtin_amdgcn_mfma_f32_32x32x16_bf16(k0, qv, p0, 0, 0, 0);
                p1 = __builtin_amdgcn_mfma_f32_32x32x16_bf16(k1, qv, p1, 0, 0, 0);
            }
            if (FOX) {
#pragma unroll
                for (int g = 0; g < 4; ++g) { const f32x4 f0 = *(const LAS f32x4*)(fbase + g * 32), f1 = *(const LAS f32x4*)(fbase + 128 + g * 32);
#pragma unroll
                    for (int e = 0; e < 4; ++e) { p0[4 * g + e] += fqv - f0[e]; p1[4 * g + e] += fqv - f1[e]; } }
                if (j0 + 63 > qmin) {
#pragma unroll
                    for (int r = 0; r < 16; ++r) { const int kv = j0 + crow(r, hi); if (kv > qpos) p0[r] = -1e30f; if (kv + 32 > qpos) p1[r] = -1e30f; }
                }
            }
            float mt = fmaxf(p0[0], p1[0]);
#pragma unroll
            for (int r = 1; r < 16; ++r) mt = fmaxf(mt, fmaxf(p0[r], p1[r]));
            mt = fmaxf(mt, __shfl_xor(mt, 32));
            const float mnew = fmaxf(mrun, mt), alpha = fast_exp2(mrun - mnew); mrun = mnew;
            float ps = 0.f;
#pragma unroll
            for (int r = 0; r < 16; ++r) { p0[r] = fast_exp2(p0[r] - mnew); p1[r] = fast_exp2(p1[r] - mnew); ps += p0[r] + p1[r]; }
            lsum = lsum * alpha + ps;
            if (__builtin_amdgcn_ballot_w64(alpha != 1.f)) { o0 = o0 * alpha; o1 = o1 * alpha; }
#pragma unroll
            for (int s = 0; s < 2; ++s) {
                u32x4 w0 = {pk2(p0[8 * s], p0[8 * s + 1]), pk2(p0[8 * s + 2], p0[8 * s + 3]), pk2(p0[8 * s + 4], p0[8 * s + 5]), pk2(p0[8 * s + 6], p0[8 * s + 7])};
                u32x4 w1 = {pk2(p1[8 * s], p1[8 * s + 1]), pk2(p1[8 * s + 2], p1[8 * s + 3]), pk2(p1[8 * s + 4], p1[8 * s + 5]), pk2(p1[8 * s + 6], p1[8 * s + 7])};
                pb[s] = __builtin_bit_cast(bf16x8, w0); pb[2 + s] = __builtin_bit_cast(bf16x8, w1);
            }
        }
        __builtin_amdgcn_sched_barrier(0);
        if (T + 1 < NT) { cvt_k(); load_v(T + 1); }
        __builtin_amdgcn_sched_barrier(0);
        if (valid) {
#pragma unroll
            for (int kst = 0; kst < 4; ++kst) {
                const LAS unsigned char* vp = vbase + 16 * kst * VRB;
                const s16x4 a0l = tr_read(vp), a0h = tr_read(vp + 8 * VRB), a1l = tr_read(vp + 64), a1h = tr_read(vp + 64 + 8 * VRB);
                const bf16x8 A0 = {a0l[0], a0l[1], a0l[2], a0l[3], a0h[0], a0h[1], a0h[2], a0h[3]}, A1 = {a1l[0], a1l[1], a1l[2], a1l[3], a1h[0], a1h[1], a1h[2], a1h[3]};
                o0 = __builtin_amdgcn_mfma_f32_32x32x16_bf16(A0, pb[kst], o0, 0, 0, 0);
                o1 = __builtin_amdgcn_mfma_f32_32x32x16_bf16(A1, pb[kst], o1, 0, 0, 0);
            }
        }
        if (DB) { if (T + 1 < NT) store_tile(T + 1); __syncthreads(); }
    }
    lsum += __shfl_xor(lsum, 32);
    if (KS == 1) {
        const float inv = 1.f / lsum; bf16* op = a.O + (size_t)(qs * 32 + q32) * a.ostride + 4 * hi;
#pragma unroll
        for (int g = 0; g < 4; ++g) { st_bf4(op + 8 * g, (f32x4){o0[4 * g] * inv, o0[4 * g + 1] * inv, o0[4 * g + 2] * inv, o0[4 * g + 3] * inv});
            st_bf4(op + 32 + 8 * g, (f32x4){o1[4 * g] * inv, o1[4 * g + 1] * inv, o1[4 * g + 2] * inv, o1[4 * g + 3] * inv}); }
    } else {
        __syncthreads();
        LAS float* osc = (LAS float*)lds + wid * 2048;
        LAS float* msc = (LAS float*)(lds + 65536) + wid * 32; LAS float* lsc = (LAS float*)(lds + 65536 + 1024) + wid * 32;
#pragma unroll
        for (int r = 0; r < 16; ++r) { osc[r * 64 + lane] = o0[r]; osc[(16 + r) * 64 + lane] = o1[r]; }
        if (hi == 0) { msc[q32] = mrun; lsc[q32] = lsum; }
        __syncthreads();
        if (ks == 0) {
            float mk[KS], M = -1e30f;
#pragma unroll
            for (int k = 0; k < KS; ++k) { mk[k] = ((LAS float*)(lds + 65536))[(k * QS + qs) * 32 + q32]; M = fmaxf(M, mk[k]); }
            float L = 0.f; f32x16 t0 = {}, t1 = {};
#pragma unroll 1
            for (int k = 0; k < KS; ++k) { const float w = fast_exp2(((LAS float*)(lds + 65536))[(k * QS + qs) * 32 + q32] - M); L += w * ((LAS float*)(lds + 65536 + 1024))[(k * QS + qs) * 32 + q32];
                const LAS float* os = (LAS float*)lds + (k * QS + qs) * 2048;
#pragma unroll
                for (int r = 0; r < 16; ++r) { t0[r] += w * os[r * 64 + lane]; t1[r] += w * os[(16 + r) * 64 + lane]; } }
            const float inv = 1.f / L; bf16* op = a.O + (size_t)(qs * 32 + q32) * a.ostride + 4 * hi;
#pragma unroll
            for (int g = 0; g < 4; ++g) { st_bf4(op + 8 * g, (f32x4){t0[4 * g] * inv, t0[4 * g + 1] * inv, t0[4 * g + 2] * inv, t0[4 * g + 3] * inv});
                st_bf4(op + 32 + 8 * g, (f32x4){t1[4 * g] * inv, t1[4 * g + 1] * inv, t1[4 * g + 2] * inv, t1[4 * g + 3] * inv}); }
        }
    }
    __syncthreads();
}


struct Attn2Args {
    const bf16* Q[2]; int qstride;
    const bf16* Ka; int kastride; const bf16* Kb; int kbstride; const bf16* V; int vstride;
    const float* Fk; bf16* O[2]; int ostride; int qpos0[2]; int nkv[2]; const float* cs;
};
template <int DQK, bool FOX, int NG>
__device__ __forceinline__ void attn_unit2(const Attn2Args& a, LAS unsigned char* lds) {
    constexpr int KRB = (DQK + 8) * 2, VRB = 144, NKK = DQK / 16, OFF_V = 64 * KRB, OFF_F = OFF_V + 64 * VRB, BUF = 32768;
    static_assert(OFF_F + 256 <= BUF, "tile buffer");
    int tid = threadIdx.x; asm volatile("" : "+v"(tid));
    const int lane = tid & 63, q32 = lane & 31, hi = lane >> 5; const int wid = __builtin_amdgcn_readfirstlane(tid >> 6);
    int qmin[NG], qpos[NG]; bf16x8 qf[NG][NKK]; float mrun[NG], lsum[NG]; f32x16 o0[NG], o1[NG];
#pragma unroll
    for (int g = 0; g < NG; ++g) {
        qmin[g] = a.qpos0[g] + wid * 32; qpos[g] = qmin[g] + q32; mrun[g] = -1e30f; lsum[g] = 0.f; o0[g] = f32x16{}; o1[g] = f32x16{};
        const bf16* qp = a.Q[g] + (size_t)(wid * 32 + q32) * a.qstride + hi * 8;
#pragma unroll
        for (int kk = 0; kk < NKK; ++kk) qf[g][kk] = *(const bf16x8*)(qp + kk * 16);
        if (DQK == 96) {
            const f32x4* cp = (const f32x4*)(a.cs + ((size_t)qpos[g] * 16 + 8 * hi) * 2);
            const u32x4 w1 = __builtin_bit_cast(u32x4, qf[g][NKK - 2]), w2 = __builtin_bit_cast(u32x4, qf[g][NKK - 1]); u32x4 r1, r2;
#pragma unroll
            for (int j = 0; j < 4; ++j) { const f32x4 c = cp[j]; const float a0 = bflo(w1[j]), a1 = bfhi(w1[j]), b0 = bflo(w2[j]), b1 = bfhi(w2[j]);
                r1[j] = pk2(a0 * c.x - b0 * c.y, a1 * c.z - b1 * c.w); r2[j] = pk2(a0 * c.y + b0 * c.x, a1 * c.w + b1 * c.z); }
            qf[g][NKK - 2] = __builtin_bit_cast(bf16x8, r1); qf[g][NKK - 1] = __builtin_bit_cast(bf16x8, r2);
        }
    }
    const int NT = a.nkv[NG - 1] / 64;
    struct Stage { u32x4 ka, v, kb; float f; }; Stage st0, st1;
    const int lrow = tid >> 3, lch = tid & 7, brow = (tid & 255) >> 2, bch = tid & 3;
    auto load_t = [&](int T, Stage& st) {
        st.ka = *(const u32x4*)(a.Ka + (size_t)(T * 64 + lrow) * a.kastride + lch * 8);
        st.v = *(const u32x4*)(a.V + (size_t)(T * 64 + lrow) * a.vstride + lch * 8);
        if (DQK == 96) { if (tid < 256) st.kb = *(const u32x4*)(a.Kb + (size_t)(T * 64 + brow) * a.kbstride + bch * 8); }
        if (FOX) { if (tid < 64) st.f = a.Fk[T * 64 + tid]; }
    };
    auto store_tile = [&](int T, const Stage& st) {
        LAS unsigned char* b = lds + (T & 1) * BUF;
        *(LAS u32x4*)(b + lrow * KRB + lch * 16) = st.ka; *(LAS u32x4*)(b + OFF_V + lrow * VRB + lch * 16) = st.v;
        if (DQK == 96) { if (tid < 256) *(LAS u32x4*)(b + brow * KRB + 128 + bch * 16) = st.kb; }
        if (FOX) { if (tid < 64) *(LAS float*)(b + OFF_F + tid * 4) = st.f; }
    };
    load_t(0, st0); if (NT > 1) load_t(1, st1);
    const LAS unsigned char* kbase0 = lds + q32 * KRB + hi * 16;
    const LAS unsigned char* vbase0 = lds + OFF_V + (4 * hi + ((lane & 15) >> 2)) * VRB + (16 * ((lane >> 4) & 1) + 4 * (lane & 3)) * 2;
    const LAS unsigned char* fbase0 = lds + OFF_F + (4 * hi) * 4;
    store_tile(0, st0); __syncthreads();
    auto step = [&](int T, Stage& stL  , const Stage& stS  ) {
        const int bo = (T & 1) * BUF; const LAS unsigned char* kbase = kbase0 + bo; const LAS unsigned char* vbase = vbase0 + bo; const LAS unsigned char* fbase = fbase0 + bo;
        if (T + 2 < NT) load_t(T + 2, stL);
        __builtin_amdgcn_sched_barrier(0);
        const int j0 = T * 64; bool valid[NG]; bool any = false;
#pragma unroll
        for (int g = 0; g < NG; ++g) { valid[g] = (j0 < a.nkv[g]) && (FOX ? (j0 <= qmin[g] + 31) : (T <= (qmin[g] >> 6))); any = any || valid[g]; }
        bf16x8 pb[NG][4];
        if (any) {
            f32x16 p0[NG], p1[NG];
            if (FOX) {
                f32x16 b0, b1;
#pragma unroll
                for (int q = 0; q < 4; ++q) { const f32x4 f0 = *(const LAS f32x4*)(fbase + q * 32), f1 = *(const LAS f32x4*)(fbase + 128 + q * 32);
#pragma unroll
                    for (int e = 0; e < 4; ++e) { b0[4 * q + e] = -f0[e]; b1[4 * q + e] = -f1[e]; } }
#pragma unroll
                for (int g = 0; g < NG; ++g) { p0[g] = b0; p1[g] = b1; }
            } else {
#pragma unroll
                for (int g = 0; g < NG; ++g) { p0[g] = f32x16{}; p1[g] = f32x16{}; } }
#pragma unroll
            for (int kk = 0; kk < NKK; ++kk) {
                const bf16x8 k0 = *(const LAS bf16x8*)(kbase + kk * 32), k1 = *(const LAS bf16x8*)(kbase + 32 * KRB + kk * 32);
#pragma unroll
                for (int g = 0; g < NG; ++g) if (valid[g]) {
                    p0[g] = __builtin_amdgcn_mfma_f32_32x32x16_bf16(k0, qf[g][kk], p0[g], 0, 0, 0);
                    p1[g] = __builtin_amdgcn_mfma_f32_32x32x16_bf16(k1, qf[g][kk], p1[g], 0, 0, 0); }
            }
#pragma unroll
            for (int g = 0; g < NG; ++g) if (valid[g]) {
                if (FOX && j0 + 63 > qmin[g]) {
#pragma unroll
                    for (int r = 0; r < 16; ++r) { const int kv = j0 + crow(r, hi); if (kv > qpos[g]) p0[g][r] = -1e30f; if (kv + 32 > qpos[g]) p1[g][r] = -1e30f; }
                }
                float mt = fmaxf(p0[g][0], p1[g][0]);
#pragma unroll
                for (int r = 1; r < 16; ++r) mt = fmaxf(mt, fmaxf(p0[g][r], p1[g][r]));
                mt = fmaxf(mt, __shfl_xor(mt, 32));
                const float mnew = fmaxf(mrun[g], mt), alpha = fast_exp2(mrun[g] - mnew); mrun[g] = mnew;
                float ps = 0.f;
#pragma unroll
                for (int r = 0; r < 16; ++r) { p0[g][r] = fast_exp2(p0[g][r] - mnew); p1[g][r] = fast_exp2(p1[g][r] - mnew); ps += p0[g][r] + p1[g][r]; }
                lsum[g] = lsum[g] * alpha + ps; if (__builtin_amdgcn_ballot_w64(alpha != 1.f)) { o0[g] = o0[g] * alpha; o1[g] = o1[g] * alpha; }
#pragma unroll
                for (int s = 0; s < 2; ++s) {
                    u32x4 w0 = {pk2(p0[g][8 * s], p0[g][8 * s + 1]), pk2(p0[g][8 * s + 2], p0[g][8 * s + 3]), pk2(p0[g][8 * s + 4], p0[g][8 * s + 5]), pk2(p0[g][8 * s + 6], p0[g][8 * s + 7])};
                    u32x4 w1 = {pk2(p1[g][8 * s], p1[g][8 * s + 1]), pk2(p1[g][8 * s + 2], p1[g][8 * s + 3]), pk2(p1[g][8 * s + 4], p1[g][8 * s + 5]), pk2(p1[g][8 * s + 6], p1[g][8 * s + 7])};
                    pb[g][s] = __builtin_bit_cast(bf16x8, w0); pb[g][2 + s] = __builtin_bit_cast(bf16x8, w1);
                }
            }
        }
        if (any) {
#pragma unroll
            for (int kst = 0; kst < 4; ++kst) {
                const LAS unsigned char* vp = vbase + 16 * kst * VRB;
                const s16x4 a0l = tr_read(vp), a0h = tr_read(vp + 8 * VRB), a1l = tr_read(vp + 64), a1h = tr_read(vp + 64 + 8 * VRB);
                const bf16x8 A0 = {a0l[0], a0l[1], a0l[2], a0l[3], a0h[0], a0h[1], a0h[2], a0h[3]}, A1 = {a1l[0], a1l[1], a1l[2], a1l[3], a1h[0], a1h[1], a1h[2], a1h[3]};
#pragma unroll
                for (int g = 0; g < NG; ++g) if (valid[g]) {
                    o0[g] = __builtin_amdgcn_mfma_f32_32x32x16_bf16(A0, pb[g][kst], o0[g], 0, 0, 0);
                    o1[g] = __builtin_amdgcn_mfma_f32_32x32x16_bf16(A1, pb[g][kst], o1[g], 0, 0, 0); }
            }
        }
        if (T + 1 < NT) store_tile(T + 1, stS);
        __syncthreads();
    };
    for (int T = 0; T < NT; T += 2) { step(T, st0, st1); if (T + 1 < NT) step(T + 1, st1, st0); }
#pragma unroll
    for (int g = 0; g < NG; ++g) {
        const float l = lsum[g] + __shfl_xor(lsum[g], 32); const float inv = 1.f / l; bf16* op = a.O[g] + (size_t)(wid * 32 + q32) * a.ostride + 4 * hi;
#pragma unroll
        for (int q = 0; q < 4; ++q) { st_bf4(op + 8 * q, (f32x4){o0[g][4 * q] * inv, o0[g][4 * q + 1] * inv, o0[g][4 * q + 2] * inv, o0[g][4 * q + 3] * inv});
            st_bf4(op + 32 + 8 * q, (f32x4){o1[g][4 * q] * inv, o1[g][4 * q + 1] * inv, o1[g][4 * q + 2] * inv, o1[g][4 * q + 3] * inv}); }
    }
    __syncthreads();
}

struct AbsArgs { const bf16* Qlat; const bf16* Qrope; const bf16 *Lat_past, *Lat_new, *Kr_past, *Kr_new; const bf16* WuvT; bf16* O; const float* cs; };
__device__ __forceinline__ void mla_abs_unit(const AbsArgs& a, LAS unsigned char* lds) {
    constexpr int RB = 592, OFF_Q = 128 * RB, NKK = 18, NT = (KVS + 127) / 128;
    int tid = threadIdx.x; asm volatile("" : "+v"(tid));
    const int lane = tid & 63, q32 = lane & 31, hi = lane >> 5; const int wid = __builtin_amdgcn_readfirstlane(tid >> 6);
    const int qs = wid & 1, ks = wid >> 1;
    LAS unsigned char* qlds = lds + OFF_Q + qs * (NKK * 1024) + lane * 16;
    { const bf16* qp = a.Qlat + (size_t)(qs * 32 + q32) * 2048 + hi * 8;
#pragma unroll
      for (int kk = 0; kk < 16; ++kk) *(LAS bf16x8*)(qlds + kk * 1024) = *(const bf16x8*)(qp + kk * 16);
      const bf16* rp = a.Qrope + (size_t)(qs * 32 + q32) * 768 + hi * 8;
      const u32x4 w1 = *(const u32x4*)rp, w2 = *(const u32x4*)(rp + 16); u32x4 r1, r2;
      const f32x4* cp = (const f32x4*)(a.cs + ((size_t)(SEQ + qs * 32 + q32) * 16 + 8 * hi) * 2);
#pragma unroll
      for (int j = 0; j < 4; ++j) { const f32x4 c = cp[j]; const float a0 = bflo(w1[j]), a1 = bfhi(w1[j]), b0 = bflo(w2[j]), b1 = bfhi(w2[j]);
          r1[j] = pk2(a0 * c.x - b0 * c.y, a1 * c.z - b1 * c.w); r2[j] = pk2(a0 * c.y + b0 * c.x, a1 * c.w + b1 * c.z); }
      *(LAS u32x4*)(qlds + 16 * 1024) = r1; *(LAS u32x4*)(qlds + 17 * 1024) = r2; }
    float mrun = -1e30f, lsum = 0.f; f32x16 o[8] = {};
    u32x4 rl[8], rk;
    const int lrow = tid >> 5, lch = tid & 31, krow = tid >> 2, kch = tid & 3;
    auto load_t = [&](int T) {
        const int jT = T * 128; const bool past = jT < PAST; const size_t r0 = (size_t)(past ? jT : jT - PAST);
        const bf16* lp = (past ? a.Lat_past : a.Lat_new) + (r0 + lrow) * 256 + lch * 8;
#pragma unroll
        for (int i = 0; i < 8; ++i) if (jT + 16 * i < KVS) rl[i] = *(const u32x4*)(lp + (size_t)i * 16 * 256);
        if (jT + krow < KVS) rk = *(const u32x4*)((past ? a.Kr_past : a.Kr_new) + (r0 + krow) * 32 + kch * 8);
    };
    auto store_t = [&](int T) {
        const int jT = T * 128;
#pragma unroll
        for (int i = 0; i < 8; ++i) if (jT + 16 * i < KVS) *(LAS u32x4*)(lds + (lrow + 16 * i) * RB + lch * 16) = rl[i];
        if (jT + krow < KVS) *(LAS u32x4*)(lds + krow * RB + 512 + kch * 16) = rk;
    };
    load_t(0);
    const LAS unsigned char* kbase = lds + (ks * 32 + q32) * RB + hi * 16;
    const LAS unsigned char* vbase = lds + (ks * 32 + 4 * hi + ((lane & 15) >> 2)) * RB + (16 * ((lane >> 4) & 1) + 4 * (lane & 3)) * 2;
    for (int T = 0; T < NT; ++T) {
        __syncthreads();
        store_t(T);
        __syncthreads();
        if (T + 1 < NT) load_t(T + 1);
        __builtin_amdgcn_sched_barrier(0);
        if (T * 128 + ks * 32 < KVS) {
            f32x16 p0 = {}, pq = {};
#pragma unroll
            for (int kk = 0; kk < NKK; kk += 2) {
                const bf16x8 k0 = *(const LAS bf16x8*)(kbase + kk * 32); const bf16x8 qv = *(const LAS bf16x8*)(qlds + kk * 1024);
                const bf16x8 k1 = *(const LAS bf16x8*)(kbase + (kk + 1) * 32); const bf16x8 qw = *(const LAS bf16x8*)(qlds + (kk + 1) * 1024);
                p0 = __builtin_amdgcn_mfma_f32_32x32x16_bf16(k0, qv, p0, 0, 0, 0);
                pq = __builtin_amdgcn_mfma_f32_32x32x16_bf16(k1, qw, pq, 0, 0, 0);
            }
            p0 = p0 + pq;
            float mt = p0[0];
#pragma unroll
            for (int r = 1; r < 16; ++r) mt = fmaxf(mt, p0[r]);
            mt = fmaxf(mt, __shfl_xor(mt, 32));
            const float mnew = fmaxf(mrun, mt), alpha = fast_exp2(mrun - mnew); mrun = mnew;
            float ps = 0.f;
#pragma unroll
            for (int r = 0; r < 16; ++r) { p0[r] = fast_exp2(p0[r] - mnew); ps += p0[r]; }
            lsum = lsum * alpha + ps;
            if (__builtin_amdgcn_ballot_w64(alpha != 1.f)) {
#pragma unroll
                for (int dt = 0; dt < 8; ++dt) o[dt] = o[dt] * alpha; }
            bf16x8 pb[2];
#pragma unroll
            for (int s = 0; s < 2; ++s) {
                u32x4 w0 = {pk2(p0[8 * s], p0[8 * s + 1]), pk2(p0[8 * s + 2], p0[8 * s + 3]), pk2(p0[8 * s + 4], p0[8 * s + 5]), pk2(p0[8 * s + 6], p0[8 * s + 7])};
                pb[s] = __builtin_bit_cast(bf16x8, w0);
            }
#pragma unroll
            for (int kst = 0; kst < 2; ++kst) {
                const LAS unsigned char* vp = vbase + 16 * kst * RB;
#pragma unroll
                for (int dt = 0; dt < 8; ++dt) { const s16x4 al = tr_read(vp + dt * 64), ah = tr_read(vp + dt * 64 + 8 * RB);
                    const bf16x8 Af = {al[0], al[1], al[2], al[3], ah[0], ah[1], ah[2], ah[3]};
                    o[dt] = __builtin_amdgcn_mfma_f32_32x32x16_bf16(Af, pb[kst], o[dt], 0, 0, 0); }
            }
        }
    }
    lsum += __shfl_xor(lsum, 32);
    LAS float* msc = (LAS float*)(lds + 131072 + 4096);
    LAS float* lsc = msc + 256;
#pragma unroll 1
    for (int rnd = 0; rnd < 2; ++rnd) {
        const int half = rnd == 0 ? 2 : 1;
        __syncthreads();
        if (ks >= half && ks < 2 * half) { LAS float* osc = (LAS float*)lds + ((ks - half) * 2 + qs) * 8192;
#pragma unroll
            for (int dt = 0; dt < 8; ++dt)
#pragma unroll
                for (int r = 0; r < 16; ++r) osc[(dt * 16 + r) * 64 + lane] = o[dt][r];
            if (hi == 0) { msc[wid * 32 + q32] = mrun; lsc[wid * 32 + q32] = lsum; } }
        __syncthreads();
        if (ks < half) { const LAS float* osc = (const LAS float*)lds + (ks * 2 + qs) * 8192; const int pw = (ks + half) * 2 + qs;
            const float m2 = msc[pw * 32 + q32], l2 = lsc[pw * 32 + q32]; const float M = fmaxf(mrun, m2), w1 = fast_exp2(mrun - M), w2 = fast_exp2(m2 - M);
            lsum = w1 * lsum + w2 * l2; mrun = M;
#pragma unroll
            for (int dt = 0; dt < 8; ++dt)
#pragma unroll
                for (int r = 0; r < 16; ++r) o[dt][r] = w1 * o[dt][r] + w2 * osc[(dt * 16 + r) * 64 + lane]; }
    }
    if (ks == 0) {
        const float inv = 1.f / lsum; f32x16 t0 = {}, t1 = {};
        const bf16* wrow0 = a.WuvT + (size_t)q32 * 256 + 4 * hi; const bf16* wrow1 = wrow0 + 32 * 256;
#pragma unroll
        for (int sub = 0; sub < 8; ++sub)
#pragma unroll
            for (int s = 0; s < 2; ++s) {
                const u32x4 wv = {pk2(o[sub][8 * s] * inv, o[sub][8 * s + 1] * inv), pk2(o[sub][8 * s + 2] * inv, o[sub][8 * s + 3] * inv), pk2(o[sub][8 * s + 4] * inv, o[sub][8 * s + 5] * inv), pk2(o[sub][8 * s + 6] * inv, o[sub][8 * s + 7] * inv)};
                const bf16x8 Bf = __builtin_bit_cast(bf16x8, wv); const int c0 = 32 * sub + 16 * s;
                const s16x4 a0l = *(const s16x4*)(wrow0 + c0), a0h = *(const s16x4*)(wrow0 + c0 + 8), a1l = *(const s16x4*)(wrow1 + c0), a1h = *(const s16x4*)(wrow1 + c0 + 8);
                const bf16x8 A0 = {a0l[0], a0l[1], a0l[2], a0l[3], a0h[0], a0h[1], a0h[2], a0h[3]}, A1 = {a1l[0], a1l[1], a1l[2], a1l[3], a1h[0], a1h[1], a1h[2], a1h[3]};
                t0 = __builtin_amdgcn_mfma_f32_32x32x16_bf16(A0, Bf, t0, 0, 0, 0);
                t1 = __builtin_amdgcn_mfma_f32_32x32x16_bf16(A1, Bf, t1, 0, 0, 0);
            }
        bf16* op = a.O + (size_t)(qs * 32 + q32) * 1024 + 4 * hi;
#pragma unroll
        for (int g = 0; g < 4; ++g) { st_bf4(op + 8 * g, (f32x4){t0[4 * g], t0[4 * g + 1], t0[4 * g + 2], t0[4 * g + 3]}); st_bf4(op + 32 + 8 * g, (f32x4){t1[4 * g], t1[4 * g + 1], t1[4 * g + 2], t1[4 * g + 3]}); }
    }
    __syncthreads();
}

__device__ __forceinline__ void p4_attention(const Args& A, LAS unsigned char* lds) {
    unsigned char* ws = A.ws; const int G = gridDim.x;
    const bf16* QFOX = (const bf16*)(ws + WS_QFOX); const bf16* KNEW = (const bf16*)(ws + WS_KNEW); const bf16* VNEW = (const bf16*)(ws + WS_VNEW);
    const bf16* QMLA = (const bf16*)(ws + WS_QMLA); const bf16* KVNEW = (const bf16*)(ws + WS_KVNEW);
    const bf16* KRNEW = (const bf16*)(ws + WS_KRNEW); const bf16* KRPAST = (const bf16*)(ws + WS_KRPAST);
    const float* FS = (const float*)(ws + WS_FS); const float* FP = (const float*)(ws + WS_FP); bf16* MIXED = (bf16*)(ws + WS_MIXED);
    const int rot = (blockIdx.x >> 6) & 3;
#pragma unroll 1
    for (int pass = 0; pass < 4; ++pass) {
    const int job = (pass + rot) & 3;
    if (job == 0) {
    for (int p = blockIdx.x; p < 256; p += G) {
        const int bh = p >> 2, s = p & 3, b = bh >> 3, h = bh & 7; const size_t tb = (size_t)b * SEQ;
        Attn2Args a; a.cs = (const float*)(ws + WS_CS); a.qstride = 512; a.Ka = KNEW + tb * 512 + h * 64; a.kastride = 512; a.Kb = nullptr; a.kbstride = 0;
        a.V = VNEW + tb * 512 + h * 64; a.vstride = 512; a.Fk = FP + (size_t)bh * SEQ; a.ostride = 1024;
        for (int i = 0; i < 2; ++i) { const int t0 = 256 * (i ? 7 - s : s); a.Q[i] = QFOX + (tb + t0) * 512 + h * 64; a.O[i] = MIXED + (tb + t0) * 1024 + h * 64; a.qpos0[i] = t0; a.nkv[i] = t0 + 256; }
        attn_unit2<64, true, 2>(a, lds);
    }
    } else if (job == 1) {
    for (int p = blockIdx.x; p < 256; p += G) {
        const int bh = p >> 2, s = 3 - (p & 3), b = bh >> 3, h = bh & 7; const size_t tb = (size_t)b * SEQ;
        Attn2Args a; a.cs = (const float*)(ws + WS_CS); a.qstride = 768; a.Ka = KVNEW + tb * 1024 + h * 64; a.kastride = 1024; a.Kb = KRNEW + tb * 32; a.kbstride = 32;
        a.V = KVNEW + tb * 1024 + 512 + h * 64; a.vstride = 1024; a.Fk = nullptr; a.ostride = 1024;
        for (int i = 0; i < 2; ++i) { const int t0 = 256 * (i ? 7 - s : s); a.Q[0] = QMLA + (tb + t0) * 768 + h * 96; a.O[0] = MIXED + (tb + t0) * 1024 + 512 + h * 64; a.qpos0[0] = t0; a.nkv[0] = t0 + 256;
            a.Q[1] = a.Q[0]; a.O[1] = a.O[0]; a.qpos0[1] = t0; a.nkv[1] = t0 + 256;
            attn_unit2<96, false, 1>(a, lds); }
    }
    } else if (job == 2) {
    for (int p = blockIdx.x; p < 256; p += G) {
        const int b = p >> 3, h = p & 7; const size_t tok0 = (size_t)TP + (size_t)b * DSEQ, pb = (size_t)b * PAST;
        AttnArgs a; a.cs = (const float*)(ws + WS_CS); a.Q = QFOX + tok0 * 512 + h * 64; a.qstride = 512;
        a.Ka_past = A.in[2] + pb * 512 + h * 64; a.Ka_new = A.out + O_KS + (size_t)b * DSEQ * 512 + h * 64; a.kastride = 512; a.Kb_past = a.Kb_new = nullptr; a.kbstride = 0;
        a.V_past = A.in[3] + pb * 512 + h * 64; a.V_new = A.out + O_VS + (size_t)b * DSEQ * 512 + h * 64; a.vstride = 512;
        a.Fq = FS + (size_t)p * KVS + PAST; a.Fk = FS + (size_t)p * KVS; a.O = MIXED + tok0 * 1024 + h * 64; a.ostride = 1024; a.P = PAST; a.qpos0 = PAST; a.nkv = KVS;
        attn_unit<64, true, 2, 4, true>(a, lds);
    }
    } else {
    for (int p = blockIdx.x; p < 256; p += G) {
        const int b = (p & 7) * 4 + (p >> 6), h = (p >> 3) & 7; const size_t tok0 = (size_t)TP + (size_t)b * DSEQ, pb = (size_t)b * PAST;
        AbsArgs a; a.Qlat = (const bf16*)(ws + WS_QLAT) + (size_t)b * DSEQ * 2048 + h * 256; a.Qrope = QMLA + tok0 * 768 + h * 96 + 64;
        a.Lat_past = (const bf16*)(ws + WS_LATPAST) + pb * 256; a.Lat_new = (const bf16*)(ws + WS_LATNEW) + tok0 * 256;
        a.Kr_past = KRPAST + pb * 32; a.Kr_new = KRNEW + tok0 * 32; a.WuvT = (const bf16*)(ws + WS_WKV) + (size_t)(512 + h * 64) * 256;
        a.O = MIXED + tok0 * 1024 + 512 + h * 64; a.cs = (const float*)(ws + WS_CS);
        mla_abs_unit(a, lds);
    }
    }
    }
}

template <class Epi> __device__ __forceinline__ void run_gemm(LAS unsigned char* lds, const bf16* Am, const bf16* Bt, int M, int N, int K, const Epi& E, int cu_shift = 0) {
    pg8::Gemm g{Am, Bt, M, N, K}; pg8::StaticOrder S; S.init(M, N, K, (int)gridDim.x, (int)((blockIdx.x + cu_shift) % gridDim.x));
    pg8::gemm_phase<Epi, pg8::StaticOrder, true, true>(lds, g, S, E);
}

__global__ void __launch_bounds__(NTHREADS, 2) fwd_kernel(Args A, int ph_lo, int ph_hi) {
    extern __shared__ __attribute__((aligned(16))) unsigned char lds_raw[];
    LAS unsigned char* lds = (LAS unsigned char*)lds_raw;
    unsigned char* ws = A.ws;
    if (threadIdx.x < 64) ((LAS unsigned*)(lds + 131072))[threadIdx.x] = 0u;
    __syncthreads();
    XcdBarrier bar = xcd_barrier_post((unsigned*)(ws + WS_CTL), (volatile LAS unsigned*)(lds + 131072 + 32));
#ifndef PH_MASK
#define PH_MASK 0xffff
#endif
#define IN(k) (((PH_MASK >> (k)) & 1) && ph_lo <= (k) && (k) < ph_hi)
#define SEAM(k) do { if (IN(k) && IN((k) + 1)) xcd_barrier(bar); } while (0)
#ifndef REP0
#define REP0 1
#endif
#ifndef REP4
#define REP4 1
#endif
#ifndef REP8
#define REP8 1
#endif
#ifndef REP1
#define REP1 1
#endif
#ifndef REP7
#define REP7 1
#endif
#ifndef REP9
#define REP9 1
#endif
    if (IN(0)) { for (int rep = 0; rep < REP0; ++rep) { p0_prologue(A, lds); __syncthreads(); } }
    SEAM(0);
    if (IN(1)) {
        EpiZ E{(bf16*)(ws + WS_QFOX), (bf16*)(ws + WS_KNEW), (bf16*)(ws + WS_VNEW), (bf16*)(ws + WS_KRNEW), (float*)(ws + WS_ZBUF), A.out, (const float*)(ws + WS_CS), A.in[10]};
        run_gemm(lds, (const bf16*)(ws + WS_H), (const bf16*)(ws + WS_WIN), TOK, NZ, DM, E);
    }
    SEAM(1);
    if (IN(2)) { p2_postz(A, lds); __syncthreads(); }
    SEAM(2);
    if (IN(3)) {
        EpiBf E{(bf16*)(ws + WS_QMLA), 768, 0.10206207261596575f * LOG2E};
        run_gemm(lds, (const bf16*)(ws + WS_QCN), (const bf16*)(ws + WS_WQ), TOK, 768, 384, E);
        EpiBf E2{(bf16*)(ws + WS_KVNEW), 1024, 1.f};
        run_gemm(lds, (const bf16*)(ws + WS_LATNEW), (const bf16*)(ws + WS_WKV), TP, 1024, 256, E2);
        EpiBf E3{(bf16*)(ws + WS_QLAT), 2048, 0.10206207261596575f * LOG2E};
        run_gemm(lds, (const bf16*)(ws + WS_QCN) + (size_t)TP * 384, (const bf16*)(ws + WS_WQA), TS, 2048, 384, E3, 64);
    }
    SEAM(3);
    if (IN(4)) { for (int rep = 0; rep < REP4; ++rep) p4_attention(A, lds); }
    SEAM(4);
    if (IN(5)) {
        pg8::Gemm g{(const bf16*)(ws + WS_MIXED), (const bf16*)(ws + WS_WOUT), TOK, DM, DM}; SplitOrder<16> S{(int)gridDim.x, (int)blockIdx.x};
        EpiOut E{A.in[0], A.in[1], (float*)(ws + WS_X1), (bf16*)(ws + WS_H), A.in[17], (float*)(ws + WS_ROWSS), (float*)(ws + WS_SLAB)};
        pg8::gemm_phase<EpiOut, SplitOrder<16>, true, true>(lds, g, S, E);
    }
    if (IN(5) && IN(7)) xcd_barrier(bar);
    if (IN(5)) {
        int t2 = threadIdx.x; asm volatile("" : "+v"(t2)); const int lane = t2 & 63, gw = blockIdx.x * NWAVES + (t2 >> 6), NGW = gridDim.x * NWAVES;
        for (int r = gw; r < TS; r += NGW) {
            const f32x4* xr = (const f32x4*)(A.in[1] + (size_t)r * DM) + lane; f32x4 v[4];
#pragma unroll
            for (int j = 0; j < 4; ++j) v[j] = xr[64 * j];
#pragma unroll
            for (int k = 0; k < DN_SL; ++k) { const f32x4* sr = (const f32x4*)((const float*)(ws + WS_SLAB) + ((size_t)k * TS + r) * DM) + lane;
#pragma unroll
                for (int j = 0; j < 4; ++j) v[j] += sr[64 * j]; }
            float ss = 0.f; const size_t row = (size_t)TP + r;
#pragma unroll
            for (int j = 0; j < 4; ++j) { ss += (v[j].x * v[j].x + v[j].y * v[j].y) + (v[j].z * v[j].z + v[j].w * v[j].w); ((f32x4*)((float*)(ws + WS_X1) + row * DM))[64 * j + lane] = v[j];
                const f32x4 gq = ((const f32x4*)A.in[17])[64 * j + lane]; const f32x4 o = v[j] * gq; ((u32x2*)((bf16*)(ws + WS_H) + row * DM))[64 * j + lane] = (u32x2){pk2(o.x, o.y), pk2(o.z, o.w)}; }
            ss = wave_sum(ss);
            if (lane < 16) ((float*)(ws + WS_ROWSS))[row * 16 + lane] = lane == 0 ? ss : 0.f;
        }
    }
    if (IN(5) && IN(7)) xcd_barrier(bar);
    if (IN(7)) { EpiGlu E{(bf16*)(ws + WS_ACT), (float*)(ws + WS_EDGE), A.in[19], A.in[20], (const float*)(ws + WS_ROWSS)}; run_gemm(lds, (const bf16*)(ws + WS_H), (const bf16*)(ws + WS_WUP), TOK, DFF2, DM, E); }
    SEAM(7);
    if (IN(8)) p8_fixup(A);
    SEAM(8);
    if (IN(9)) {
        pg8::Gemm g{(const bf16*)(ws + WS_ACT), (const bf16*)(ws + WS_WDOWN), TOK, DM, DFF}; DownOrder S{(int)gridDim.x, (int)blockIdx.x};
        EpiDown E{(const float*)(ws + WS_X1), (float*)(ws + WS_X2), (float*)(ws + WS_SLAB)};
        pg8::gemm_phase<EpiDown, DownOrder, true, true>(lds, g, S, E);
    }
    SEAM(9);
    if (IN(10)) { int t2 = threadIdx.x; asm volatile("" : "+v"(t2)); const int lane = t2 & 63, gw = blockIdx.x * NWAVES + (t2 >> 6), NGW = gridDim.x * NWAVES;
        for (int m = gw; m < TOK; m += NGW) {
            if (m < TP) rms_row<true>((const float*)(ws + WS_X2) + (size_t)m * DM, A.in[22], A.out + (size_t)m * DM, lane);
            else rms_row<true>((const float*)(ws + WS_X1) + (size_t)m * DM, A.in[22], A.out + (size_t)m * DM, lane, (const float*)(ws + WS_SLAB) + (size_t)(m - TP) * DM, DN_SL, (size_t)TS * DM); } }
#undef IN
#undef SEAM
}

#ifndef N_LAUNCHES
#define N_LAUNCHES 1
#endif
extern "C" void kernel_launch(void* const* d_in, const int* in_sizes, int n_in, void* d_out, int out_size, void* d_ws, size_t ws_size, hipStream_t stream) {
    static int grid = 0;
    if (grid == 0) {
        if (n_in != 23 || (size_t)out_size != O_END || ws_size < WS_END) { fprintf(stderr, "kernel_launch: unexpected shapes: n_in %d out %d ws %zu (need %zu)\n", n_in, out_size, ws_size, (size_t)WS_END); grid = -1; return; }
        int dev = 0, cus = 0, per_cu = 0;
        (void)hipGetDevice(&dev); (void)hipDeviceGetAttribute(&cus, hipDeviceAttributeMultiprocessorCount, dev);
        if (hipFuncSetAttribute((const void*)fwd_kernel, hipFuncAttributeMaxDynamicSharedMemorySize, LDS_BYTES) != hipSuccess) { fprintf(stderr, "hipFuncSetAttribute failed\n"); grid = -1; return; }
        if (hipOccupancyMaxActiveBlocksPerMultiprocessor(&per_cu, (const void*)fwd_kernel, NTHREADS, LDS_BYTES) != hipSuccess || per_cu < 1) { fprintf(stderr, "occupancy query: %d\n", per_cu); per_cu = 1; }
        (void)hipGetLastError();
        grid = cus * 1;
    }
    if (grid < 0) return;
    if (hipMemsetAsync((char*)d_ws + WS_CTL, 0, CTL_BYTES, stream) != hipSuccess) { fprintf(stderr, "memset failed\n"); return; }
    Args a{};
    for (int i = 0; i < 23; ++i) a.in[i] = (const float*)d_in[i];
    a.out = (float*)d_out; a.ws = (unsigned char*)d_ws;
    if (N_LAUNCHES == 1) {
        hipLaunchKernelGGL(fwd_kernel, dim3(grid), dim3(NTHREADS), LDS_BYTES, stream, a, 0, 11);
    } else {
        for (int k = 0; k < 11; ++k) hipLaunchKernelGGL(fwd_kernel, dim3(grid), dim3(NTHREADS), LDS_BYTES, stream, a, k, k + 1);
    }
}
```

```cpp
#include <hip/hip_runtime.h>
#include <cstdio>
#include <cstdint>
namespace pg8 {
#define PG8_LAS __attribute__((address_space(3)))
typedef unsigned short bf16_t;
typedef short bf16x8 __attribute__((ext_vector_type(8)));
typedef float f32x4 __attribute__((ext_vector_type(4)));
typedef unsigned u32x4 __attribute__((ext_vector_type(4)));
constexpr int BM = 256, BK = 64, HALF = 128, HTB = HALF * BK * 2  , STAGE_BYTES = 8 * HTB, NXCD = 8, WGM = 8;

__host__ __device__ __forceinline__ int lds_byte(int r, int c) { const int st = (r >> 4) * 2 + (c >> 5), rr = r & 15, cc = c & 31, ob = rr * 64 + cc * 2; return st * 1024 + (ob ^ (((ob >> 9) & 1) << 5)); }
__host__ __device__ __forceinline__ void stage_rc(int b, int& R, int& C) { const int st = b / 1024, sb = b % 1024, swz = sb ^ (((sb >> 9) & 1) << 5); R = (st >> 1) * 16 + swz / 64; C = (st & 1) * 32 + (swz % 64) / 2; }
__host__ __device__ __forceinline__ int perm32(int rho) { const int n = rho >> 4, i = rho & 15; return 8 * (i >> 2) + 4 * n + (i & 3); }

struct Unit { int pm, pn, k0, nkt, sl; };
struct Gemm { const bf16_t* A; const bf16_t* Bt; int M, N, K; };

struct StaticOrder {
    int nM, nN, nwg, G, c, nkt;
    __host__ __device__ void init(int M, int N, int K, int G_, int c_) { nM = M / BM; nN = N / BM; nwg = nM * nN; G = G_; c = c_; nkt = K / BK; }
    __host__ __device__ bool next(int i, Unit& u) const {
        const long L = (long)i * G + c; if (L >= nwg) return false;
        int wgid = (int)L; { const int q = nwg / NXCD, r = nwg % NXCD, xcd = wgid % NXCD, off = wgid / NXCD; wgid = (xcd < r ? xcd * (q + 1) : r * (q + 1) + (xcd - r) * q) + off; }
        const int nig = WGM * nN, gid = wgid / nig, fm = gid * WGM, gsz = (nM - fm) < WGM ? (nM - fm) : WGM;
        u.pm = fm + ((wgid % nig) % gsz); u.pn = (wgid % nig) / gsz; u.k0 = 0; u.nkt = nkt; u.sl = -1; return true;
    }
    __device__ __forceinline__ void a_ready(const Unit&) const {}
    __device__ __forceinline__ void done(const Unit&) const {}
};

template <class Epi, class Sched, bool ALIGN_EPI = false, bool SP2 = false>
__device__ __forceinline__ void gemm_phase(PG8_LAS unsigned char* lds, const Gemm g, const Sched& S, const Epi& E) {
    const int tid = threadIdx.x, wid = __builtin_amdgcn_readfirstlane(tid >> 6), lane = tid & 63, wr = wid >> 2, wc = wid & 3, fr = lane & 15, fq = lane >> 4;
    const int K = g.K;
    unsigned voffA[2], voffB[2];
#pragma unroll
    for (int i = 0; i < 2; ++i) { int R, C; stage_rc(tid * 16 + i * 8192, R, C); const int Rb = Epi::PERM ? ((R & ~31) + perm32(R & 31)) : R;
        voffA[i] = (unsigned)(R * K + C) * 2u; voffB[i] = (unsigned)(Rb * K + C) * 2u; }
    const size_t kstep = (size_t)(BK * 2);
    const size_t hstep = (size_t)HALF * K * 2;
    const size_t tstep = 2 * hstep;
    const unsigned ldsw = (unsigned)wid * 1024u;
    const int aoff = lds_byte(wr * 64 + fr, fq * 8), boff = lds_byte(wc * 32 + fr, fq * 8);
#define PG8_SA(b, h) (((b) * 2 + (h)) * HTB)
#define PG8_SB(b, h) ((4 + (b) * 2 + (h)) * HTB)
#define PG8_STAGE(bufoff, gbase, voff) do { _Pragma("unroll") for (int _i = 0; _i < 2; ++_i) \
        __builtin_amdgcn_global_load_lds((const unsigned*)((const char*)(gbase) + (voff)[_i]), (PG8_LAS unsigned*)(lds + (bufoff) + ldsw + _i * 8192), 16, 0, 0); } while (0)
#define PG8_LDA(dst, b, h) do { _Pragma("unroll") for (int m = 0; m < 4; ++m) _Pragma("unroll") for (int k = 0; k < 2; ++k) dst[m][k] = *(const PG8_LAS bf16x8*)(lds + PG8_SA(b, h) + aoff + m * 2048 + k * 1024); } while (0)
#define PG8_LDB(dst, b, h) do { _Pragma("unroll") for (int n = 0; n < 2; ++n) _Pragma("unroll") for (int k = 0; k < 2; ++k) dst[n][k] = *(const PG8_LAS bf16x8*)(lds + PG8_SB(b, h) + boff + n * 2048 + k * 1024); } while (0)
#define PG8_MMA(ai, bj, At, Bt) do { __builtin_amdgcn_s_setprio(1); _Pragma("unroll") for (int m = 0; m < 4; ++m) _Pragma("unroll") for (int n = 0; n < 2; ++n) _Pragma("unroll") for (int k = 0; k < 2; ++k) \
        acc[ai][bj][m][n] = __builtin_amdgcn_mfma_f32_16x16x32_bf16(Bt[n][k], At[m][k], acc[ai][bj][m][n], 0, 0, 0); __builtin_amdgcn_s_setprio(0); } while (0)
#define PG8_WAIT_V(n) asm volatile("s_waitcnt vmcnt(" #n ")" ::: "memory")
#define PG8_WAIT_L(n) asm volatile("s_waitcnt lgkmcnt(" #n ")" ::: "memory")
#define PG8_BAR __builtin_amdgcn_s_barrier()
#define PG8_SCHED __builtin_amdgcn_sched_barrier(0)
    Unit cur{}, nxt{}; int ui = 0;
    if (!S.next(0, cur)) return;
    f32x4 acc[2][2][4][2];
#pragma unroll
    for (int a = 0; a < 2; ++a)
#pragma unroll
        for (int b = 0; b < 2; ++b)
#pragma unroll
            for (int m = 0; m < 4; ++m)
#pragma unroll
                for (int n = 0; n < 2; ++n) acc[a][b][m][n] = (f32x4){0.f, 0.f, 0.f, 0.f};
    bf16x8 At[4][2], B0[2][2], B1[2][2];
    const char* cA = (const char*)g.A + (size_t)cur.pm * tstep + (size_t)cur.k0 * kstep; const char* cB = (const char*)g.Bt + (size_t)cur.pn * tstep + (size_t)cur.k0 * kstep;
    S.a_ready(cur);
    if constexpr (SP2) {
        PG8_STAGE(PG8_SB(0, 0), cB, voffB); PG8_STAGE(PG8_SB(0, 1), cB + hstep, voffB); PG8_STAGE(PG8_SA(0, 0), cA, voffA); PG8_STAGE(PG8_SA(0, 1), cA + hstep, voffA);
        if (wr == 1) PG8_BAR;
        PG8_WAIT_V(2); PG8_BAR;
        PG8_STAGE(PG8_SB(1, 0), cB + kstep, voffB); PG8_STAGE(PG8_SA(1, 0), cA + kstep, voffA); PG8_STAGE(PG8_SB(1, 1), cB + hstep + kstep, voffB);
        PG8_WAIT_V(6); PG8_BAR;
    } else {
        PG8_STAGE(PG8_SB(0, 0), cB, voffB); PG8_STAGE(PG8_SA(0, 0), cA, voffA); PG8_STAGE(PG8_SB(0, 1), cB + hstep, voffB); PG8_STAGE(PG8_SA(0, 1), cA + hstep, voffA);
        if (wr == 1) PG8_BAR;
        PG8_WAIT_V(4); PG8_BAR;
        PG8_STAGE(PG8_SB(1, 0), cB + kstep, voffB); PG8_STAGE(PG8_SA(1, 0), cA + kstep, voffA); PG8_STAGE(PG8_SB(1, 1), cB + hstep + kstep, voffB);
        PG8_WAIT_V(6); PG8_BAR;
    }
    for (;;) {
        const bool has_next = S.next(ui + 1, nxt);
        const char* nA = has_next ? (const char*)g.A + (size_t)nxt.pm * tstep + (size_t)nxt.k0 * kstep : cA; const char* nB = has_next ? (const char*)g.Bt + (size_t)nxt.pn * tstep + (size_t)nxt.k0 * kstep : cB;
        const int nt = cur.nkt;
        for (int t = 0; t < nt; t += 2) {
            const bool last = (t == nt - 2);
            const char* a1 = cA + (size_t)(t + 1) * kstep;
            const char* a2 = last ? nA : cA + (size_t)(t + 2) * kstep; const char* b2 = last ? nB : cB + (size_t)(t + 2) * kstep;
            const char* a3 = a2 + kstep; const char* b3 = b2 + kstep;
            if (last && has_next) S.a_ready(nxt);
            if constexpr (SP2) {
            PG8_LDB(B0, 0, 0); PG8_LDB(B1, 0, 1); PG8_SCHED; PG8_LDA(At, 0, 0); PG8_STAGE(PG8_SA(1, 1), a1 + hstep, voffA);
            PG8_WAIT_V(8); PG8_WAIT_L(0); PG8_BAR; PG8_MMA(0, 0, At, B0); PG8_MMA(0, 1, At, B1); PG8_BAR; PG8_SCHED;
            PG8_LDA(At, 0, 1); PG8_STAGE(PG8_SB(0, 0), b2, voffB); PG8_STAGE(PG8_SB(0, 1), b2 + hstep, voffB); PG8_STAGE(PG8_SA(0, 0), a2, voffA);
            PG8_WAIT_V(8); PG8_WAIT_L(0); PG8_BAR; PG8_MMA(1, 0, At, B0); PG8_MMA(1, 1, At, B1); PG8_BAR; PG8_SCHED;
            PG8_LDB(B0, 1, 0); PG8_LDB(B1, 1, 1); PG8_SCHED; PG8_LDA(At, 1, 0); PG8_STAGE(PG8_SA(0, 1), a2 + hstep, voffA);
            PG8_WAIT_V(8); PG8_WAIT_L(0); PG8_BAR; PG8_MMA(0, 0, At, B0); PG8_MMA(0, 1, At, B1); PG8_BAR; PG8_SCHED;
            PG8_LDA(At, 1, 1); PG8_STAGE(PG8_SB(1, 0), b3, voffB); PG8_STAGE(PG8_SB(1, 1), b3 + hstep, voffB); PG8_STAGE(PG8_SA(1, 0), a3, voffA);
            PG8_WAIT_V(8); PG8_WAIT_L(0); PG8_BAR; PG8_MMA(1, 0, At, B0); PG8_MMA(1, 1, At, B1); PG8_BAR; PG8_SCHED;
            } else {
            PG8_LDB(B0, 0, 0); PG8_SCHED; PG8_LDA(At, 0, 0); PG8_STAGE(PG8_SA(1, 1), a1 + hstep, voffA);
            PG8_WAIT_L(8); PG8_BAR; PG8_WAIT_L(0); PG8_MMA(0, 0, At, B0); PG8_BAR; PG8_SCHED;
            PG8_LDB(B1, 0, 1); PG8_STAGE(PG8_SB(0, 0), b2, voffB);
            PG8_BAR; PG8_WAIT_L(0); PG8_MMA(0, 1, At, B1); PG8_BAR;
            PG8_LDA(At, 0, 1); PG8_STAGE(PG8_SA(0, 0), a2, voffA);
            PG8_BAR; PG8_WAIT_L(0); PG8_MMA(1, 0, At, B0); PG8_BAR; PG8_SCHED;
            PG8_STAGE(PG8_SB(0, 1), b2 + hstep, voffB);
            PG8_WAIT_V(6); PG8_BAR; PG8_MMA(1, 1, At, B1); PG8_BAR;
            PG8_LDB(B0, 1, 0); PG8_SCHED; PG8_LDA(At, 1, 0); PG8_STAGE(PG8_SA(0, 1), a2 + hstep, voffA);
            PG8_WAIT_L(8); PG8_BAR; PG8_WAIT_L(0); PG8_MMA(0, 0, At, B0); PG8_BAR; PG8_SCHED;
            PG8_LDB(B1, 1, 1); PG8_STAGE(PG8_SB(1, 0), b3, voffB);
            PG8_BAR; PG8_WAIT_L(0); PG8_MMA(0, 1, At, B1); PG8_BAR;
            PG8_LDA(At, 1, 1); PG8_STAGE(PG8_SA(1, 0), a3, voffA);
            PG8_BAR; PG8_WAIT_L(0); PG8_MMA(1, 0, At, B0); PG8_BAR; PG8_SCHED;
            PG8_STAGE(PG8_SB(1, 1), b3 + hstep, voffB);
            PG8_WAIT_V(6); PG8_BAR; PG8_MMA(1, 1, At, B1); PG8_BAR;
            }
        }
        if constexpr (ALIGN_EPI) { if (wr == 0) PG8_BAR; }
        if constexpr (!Epi::AFTER_DRAIN) { E(acc, cur, wr, wc, fr, fq); S.done(cur); }
        if (!has_next) break;
#pragma unroll
        for (int a = 0; a < 2; ++a)
#pragma unroll
            for (int b = 0; b < 2; ++b)
#pragma unroll
                for (int m = 0; m < 4; ++m)
#pragma unroll
                    for (int n = 0; n < 2; ++n) acc[a][b][m][n] = (f32x4){0.f, 0.f, 0.f, 0.f};
        cur = nxt; cA = nA; cB = nB; ++ui;
        if constexpr (ALIGN_EPI) { if (wr == 1) PG8_BAR; }
    }
    PG8_WAIT_V(0);
    if constexpr (!ALIGN_EPI) { if (wr == 0) PG8_BAR; }
    PG8_BAR;
    if constexpr (Epi::AFTER_DRAIN) { E.fused(acc, cur, wr, wc, fr, fq, lds, wid, lane); S.done(cur); }
#undef PG8_SA
#undef PG8_SB
#undef PG8_STAGE
#undef PG8_LDA
#undef PG8_LDB
#undef PG8_MMA
#undef PG8_WAIT_V
#undef PG8_WAIT_L
#undef PG8_BAR
#undef PG8_SCHED
}
}

#define LAS __attribute__((address_space(3)))
typedef unsigned short bf16;
typedef short bf16x8 __attribute__((ext_vector_type(8)));
typedef short s16x4 __attribute__((ext_vector_type(4)));
typedef float f32x4 __attribute__((ext_vector_type(4)));
typedef float f32x2 __attribute__((ext_vector_type(2)));
typedef float f32x16 __attribute__((ext_vector_type(16)));
typedef unsigned u32x4 __attribute__((ext_vector_type(4)));
typedef unsigned u32x2 __attribute__((ext_vector_type(2)));

constexpr int DM = 1024, SEQ = 2048, NBP = 8, DSEQ = 64, NBS = 32, PAST = 4096;
constexpr int TP = NBP * SEQ, TS = NBS * DSEQ, TOK = TP + TS;
constexpr int NPAST = NBS * PAST;
constexpr int KVS = PAST + DSEQ;
constexpr int DIN = 2216, NZ = 2304, ZW = 640;
constexpr int DFF = 2816, DFF2 = 5632;
constexpr float LOG2E = 1.4426950408889634f;
constexpr float EPS = 1e-6f;
constexpr int NTHREADS = 512, NWAVES = 8;
constexpr int LDS_BYTES = 147456;

constexpr size_t O_YP = 0, O_YS = O_YP + (size_t)TP * DM, O_KP = O_YS + (size_t)TS * DM, O_VP = O_KP + (size_t)TP * 512, O_LFP = O_VP + (size_t)TP * 512,
                 O_LATP = O_LFP + (size_t)TP * 8, O_KRP = O_LATP + (size_t)TP * 256, O_CVP = O_KRP + (size_t)TP * 32, O_KS = O_CVP + (size_t)NBP * 2 * DFF2,
                 O_VS = O_KS + (size_t)TS * 512, O_LFS = O_VS + (size_t)TS * 512, O_LATS = O_LFS + (size_t)TS * 8, O_KRS = O_LATS + (size_t)TS * 256,
                 O_CVS = O_KRS + (size_t)TS * 32, O_END = O_CVS + (size_t)NBS * 2 * DFF2;

constexpr size_t MiB = 1u << 20;
constexpr size_t WS_CTL = 0, CTL_BYTES = 16384;
constexpr size_t WS_WIN = 1 * MiB, WS_WQ = 6 * MiB, WS_WKV = 7 * MiB, WS_WOUT = 8 * MiB, WS_WUP = 10 * MiB, WS_WDOWN = 21 * MiB, WS_CS = 27 * MiB,
                 WS_FS = 28 * MiB, WS_FP = 33 * MiB, WS_H = 34 * MiB, WS_QFOX = 70 * MiB, WS_KNEW = 88 * MiB, WS_VNEW = 106 * MiB, WS_ZBUF = 124 * MiB,
                 WS_QCN = 169 * MiB, WS_LATNEW = 183 * MiB, WS_KRNEW = 192 * MiB, WS_QMLA = 194 * MiB, WS_KVNEW = 221 * MiB, WS_MIXED = 257 * MiB,
                 WS_X1 = 293 * MiB, WS_X2 = 124 * MiB  , WS_LATPAST = 365 * MiB, WS_KRPAST = 429 * MiB, WS_KPAST = 437 * MiB,
                 WS_VPAST = 565 * MiB, WS_SLAB = 565 * MiB  , WS_KVPAST = 693 * MiB, WS_EDGE = 693 * MiB  , WS_ACT = 437 * MiB  , WS_WQA = 949 * MiB, WS_QLAT = 951 * MiB, WS_ROWSS = 959 * MiB  , WS_RSTD = 960 * MiB + 512 * 1024  , WS_END = 961 * MiB;

struct Args {
    const float* in[23];
    float* out;
    unsigned char* ws;
};

__device__ __forceinline__ unsigned pk2(float lo, float hi) { typedef __bf16 bf2 __attribute__((ext_vector_type(2))); f32x2 v = {lo, hi}; bf2 b = __builtin_convertvector(v, bf2); return __builtin_bit_cast(unsigned, b); }
__device__ __forceinline__ float bflo(unsigned w) { return __builtin_bit_cast(float, w << 16); }
__device__ __forceinline__ float bfhi(unsigned w) { return __builtin_bit_cast(float, w & 0xffff0000u); }
__device__ __forceinline__ float wave_sum(float v) {
#pragma unroll
    for (int o = 1; o < 64; o <<= 1) v += __shfl_xor(v, o);
    return v;
}
__device__ __forceinline__ void st_bf4(bf16* p, f32x4 v) { *(u32x2*)p = (u32x2){pk2(v.x, v.y), pk2(v.z, v.w)}; }
__device__ __forceinline__ void lds_wait() { asm volatile("s_waitcnt lgkmcnt(0)" ::: "memory"); }
__device__ __forceinline__ float fast_exp2(float x) { return __builtin_amdgcn_exp2f(x); }

#define XB_TMO      128
#define XB_XCNT(j)  (256  + 64 * (j))
#define XB_XSUB(j)  (1280 + 64 * (j))
#define XB_XGEN(j)  (2304 + 64 * (j))
#define XB_TOP      3328
#define XB_TOPGEN   3392
#define XCD_BAR_WORDS 3456
#define XB_SPIN_CAP (1u << 18)

__device__ __forceinline__ unsigned xb_ld(unsigned* p)              { return __hip_atomic_load(p, __ATOMIC_RELAXED, __HIP_MEMORY_SCOPE_AGENT); }
__device__ __forceinline__ unsigned xb_add(unsigned* p, unsigned v) { return __hip_atomic_fetch_add(p, v, __ATOMIC_RELAXED, __HIP_MEMORY_SCOPE_AGENT); }
__device__ __forceinline__ unsigned xb_xcc_id() { return (unsigned)__builtin_amdgcn_s_getreg((3 << 11) | 20) & 0xFu; }
#define XB_SPIN(cond, bar) do { unsigned _sp = 0; while (cond) { __builtin_amdgcn_s_sleep(1); \
    if ((++_sp & 255u) == 0u) { if (xb_ld(&(bar)[XB_TMO])) break; if (_sp > XB_SPIN_CAP) { atomicAdd(&(bar)[XB_TMO], 1u); break; } } } } while (0)

struct XcdBarrier {
    unsigned* bar; unsigned x;
    volatile LAS unsigned* st;
};

__device__ __forceinline__ XcdBarrier xcd_barrier_post(unsigned* bar, volatile LAS unsigned* st) {
    XcdBarrier b; b.bar = bar; b.x = xb_xcc_id(); b.st = st;
    if (threadIdx.x == 0) (void)xb_add(&bar[XB_XCNT(b.x)], 1u);
    return b;
}
__device__ __forceinline__ void xcd_barrier_complete(unsigned* bar, unsigned x, unsigned& nloc, unsigned& nx) {
    const unsigned G = gridDim.x * gridDim.y * gridDim.z;
    unsigned sum, cnt, mine, sp = 0u;
    for (;;) {
        sum = 0u; cnt = 0u; mine = 0u;
#pragma unroll
        for (unsigned j = 0; j < 16; ++j) { const unsigned c = xb_ld(&bar[XB_XCNT(j)]); sum += c; cnt += (c > 0u) ? 1u : 0u; mine = (j == x) ? c : mine; }
        if (sum == G) break;
        __builtin_amdgcn_s_sleep(1);
        if ((++sp & 255u) == 0u) { if (xb_ld(&bar[XB_TMO])) break; if (sp > XB_SPIN_CAP) { atomicAdd(&bar[XB_TMO], 1u); break; } }
    }
    nloc = mine > 0u ? mine : 1u; nx = cnt > 0u ? cnt : 1u;
}

__device__ __forceinline__ void xcd_barrier(const XcdBarrier& b) {
    asm volatile("s_waitcnt vmcnt(0)" ::: "memory");
    __syncthreads();
    if (threadIdx.x == 0) {
        unsigned* bar = b.bar;
        __builtin_amdgcn_s_waitcnt(0);
        unsigned nloc = b.st[0], nx = b.st[1];
        if (nloc == 0u) { xcd_barrier_complete(bar, b.x, nloc, nx); b.st[0] = nloc; b.st[1] = nx; }
        const unsigned old = xb_add(&bar[XB_XSUB(b.x)], 1u);
        const unsigned gen = old / nloc;
        if (old + 1u == (gen + 1u) * nloc) {
            __builtin_amdgcn_fence(__ATOMIC_RELEASE, "agent");
            asm volatile("s_waitcnt vmcnt(0)" ::: "memory");
            const unsigned og = xb_add(&bar[XB_TOP], 1u);
            const unsigned tg = og / nx;
            if (og + 1u == (tg + 1u) * nx) xb_add(&bar[XB_TOPGEN], 1u);
            else XB_SPIN(xb_ld(&bar[XB_TOPGEN]) == tg, bar);
            __builtin_amdgcn_fence(__ATOMIC_ACQUIRE, "agent");
            xb_add(&bar[XB_XGEN(b.x)], 1u);
            asm volatile("s_waitcnt vmcnt(0)" ::: "memory");
        } else {
            XB_SPIN(xb_ld(&bar[XB_XGEN(b.x)]) == gen, bar);
            __builtin_amdgcn_fence(__ATOMIC_ACQUIRE, "agent");
            asm volatile("s_waitcnt vmcnt(0)" ::: "memory");
        }
    }
    __syncthreads();
}

template <int MODE> __device__ __forceinline__ int srccol(int n) {
    if (MODE == 0) return n;
    if (MODE == 2) return ((n & 16) ? DFF : 0) + 16 * (n >> 5) + (n & 15);
    if (n < 1536) return n;
    if (n < 1920) return 1544 + (n - 1536);
    if (n < 2176) return 1928 + (n - 1920);
    if (n < 2208) return 2184 + (n - 2176);
    if (n < 2216) return 1536 + (n - 2208);
    return -1;
}
template <int MODE>
__device__ __forceinline__ void tr_item(const float* W, int K, int Nsrc, int Ndst, bf16* WT, int row_off, LAS float* scr, int item, int lane) {
    const int nblk = Ndst / 32, kb = item / nblk, nb = item % nblk, k0 = 64 * kb, n0 = 32 * nb;
    const int sc = srccol<MODE>(n0 + (lane & 31));
#pragma unroll 8
    for (int i = 0; i < 32; ++i) { const int kk = 2 * i + (lane >> 5); scr[kk * 33 + (lane & 31)] = sc >= 0 ? W[(size_t)(k0 + kk) * Nsrc + sc] : 0.f; }
    lds_wait();
    const int c = lane & 7;
#pragma unroll
    for (int j = 0; j < 4; ++j) { const int n = (lane >> 3) + 8 * j; const LAS float* s = scr + (8 * c) * 33 + n;
        u32x4 o; o.x = pk2(s[0 * 33], s[1 * 33]); o.y = pk2(s[2 * 33], s[3 * 33]); o.z = pk2(s[4 * 33], s[5 * 33]); o.w = pk2(s[6 * 33], s[7 * 33]);
        *(u32x4*)(WT + (size_t)(row_off + n0 + n) * K + k0 + 8 * c) = o; }
    lds_wait();
}
template <bool OUTF>
__device__ __forceinline__ void rms_row(const float* xrow, const float* g, void* orow, int lane, const float* slab = nullptr, int nslab = 0, size_t slab_stride = 0) {
    const f32x4* xr = (const f32x4*)xrow + lane; const f32x4* gr = (const f32x4*)g + lane;
    f32x4 v[4]; float s = 0.f;
#pragma unroll
    for (int j = 0; j < 4; ++j) v[j] = xr[64 * j];
    for (int k = 0; k < nslab; ++k) { const f32x4* sr = (const f32x4*)(slab + (size_t)k * slab_stride) + lane;
#pragma unroll
        for (int j = 0; j < 4; ++j) v[j] += sr[64 * j]; }
#pragma unroll
    for (int j = 0; j < 4; ++j) { s += (v[j].x * v[j].x + v[j].y * v[j].y) + (v[j].z * v[j].z + v[j].w * v[j].w); }
    const float rstd = rsqrtf(wave_sum(s) * (1.f / DM) + EPS);
#pragma unroll
    for (int j = 0; j < 4; ++j) { const f32x4 gv = gr[64 * j]; const f32x4 o = v[j] * rstd * gv;
        if (OUTF) ((f32x4*)orow)[64 * j + lane] = o;
        else ((u32x2*)orow)[64 * j + lane] = (u32x2){pk2(o.x, o.y), pk2(o.z, o.w)}; }
}
__device__ __forceinline__ void cvt_stream(const float* src, bf16* dst, size_t n4, size_t gtid, size_t gthreads) {
    size_t i = gtid;
    for (; i + 7 * gthreads < n4; i += 8 * gthreads) {
        f32x4 v[8];
#pragma unroll
        for (int k = 0; k < 8; ++k) v[k] = __builtin_nontemporal_load((const f32x4*)src + i + k * gthreads);
#pragma unroll
        for (int k = 0; k < 8; ++k) ((u32x2*)dst)[i + k * gthreads] = (u32x2){pk2(v[k].x, v[k].y), pk2(v[k].z, v[k].w)};
    }
    for (; i < n4; i += gthreads) { const f32x4 v = ((const f32x4*)src)[i]; ((u32x2*)dst)[i] = (u32x2){pk2(v.x, v.y), pk2(v.z, v.w)}; }
}
__device__ __forceinline__ float wave_incl_scan(float v, int lane) {
#pragma unroll
    for (int o = 1; o < 64; o <<= 1) { const float t = __shfl_up(v, o); if (lane >= o) v += t; }
    return v;
}

template <int NCH>
__device__ __forceinline__ void scan_seq(const float* src, float* dst, float base, int lane, LAS float* scr) {
    float v[NCH];
#pragma unroll
    for (int c = 0; c < NCH; ++c) v[c] = src[(size_t)(64 * c + lane) * 8];
#pragma unroll
    for (int c = 0; c < NCH; ++c) { v[c] = wave_incl_scan(v[c], lane); if (lane == 63) scr[c] = v[c]; }
    lds_wait();
    const float st = wave_incl_scan(lane < NCH ? scr[lane] : 0.f, lane);
    lds_wait();
#pragma unroll
    for (int c = 0; c < NCH; ++c) { const float carry = c ? __builtin_bit_cast(float, __builtin_amdgcn_readlane(__builtin_bit_cast(int, st), c ? c - 1 : 0)) : 0.f; dst[64 * c + lane] = (v[c] + carry + base) * LOG2E; }
}
__device__ __forceinline__ void p0_prologue(const Args& A, LAS unsigned char* lds) {
    const int tid = threadIdx.x, lane = tid & 63, wave = tid >> 6;
    const int G = gridDim.x, gw = blockIdx.x * NWAVES + wave, NGW = G * NWAVES;
    unsigned char* ws = A.ws;
    LAS float* scr = (LAS float*)(lds + wave * 16384);
    constexpr int I_IN = (DM / 64) * (NZ / 32), I_Q = (384 / 64) * (768 / 32), I_UK = (256 / 64) * (512 / 32), I_OUT = (DM / 64) * (DM / 32),
                  I_UP = (DM / 64) * (DFF2 / 32), I_DN = (DFF / 64) * (DM / 32);
    constexpr int NITEMS = I_IN + I_Q + 2 * I_UK + I_OUT + I_UP + I_DN;
    for (int it = gw; it < NITEMS; it += NGW) {
        int r = it;
        if (r < I_IN) { tr_item<1>(A.in[9], DM, DIN, NZ, (bf16*)(ws + WS_WIN), 0, scr, r, lane); continue; } r -= I_IN;
        if (r < I_Q) { tr_item<0>(A.in[12], 384, 768, 768, (bf16*)(ws + WS_WQ), 0, scr, r, lane); continue; } r -= I_Q;
        if (r < I_UK) { tr_item<0>(A.in[14], 256, 512, 512, (bf16*)(ws + WS_WKV), 0, scr, r, lane); continue; } r -= I_UK;
        if (r < I_UK) { tr_item<0>(A.in[15], 256, 512, 512, (bf16*)(ws + WS_WKV), 512, scr, r, lane); continue; } r -= I_UK;
        if (r < I_OUT) { tr_item<0>(A.in[16], DM, DM, DM, (bf16*)(ws + WS_WOUT), 0, scr, r, lane); continue; } r -= I_OUT;
        if (r < I_UP) { tr_item<2>(A.in[18], DM, DFF2, DFF2, (bf16*)(ws + WS_WUP), 0, scr, r, lane); continue; } r -= I_UP;
        tr_item<0>(A.in[21], DFF, DM, DM, (bf16*)(ws + WS_WDOWN), 0, scr, r, lane);
    }
    for (int it = gw; it < 8 * 12 * 8; it += NGW) {
        const int h = it / 96, kt = (it % 96) / 8, ct = it % 8; const int r32 = lane & 31, hi2 = lane >> 5;
        const float* wq = A.in[12] + (size_t)(kt * 32 + r32) * 768 + h * 96 + 8 * hi2; const float* uk = A.in[14] + (size_t)(ct * 32 + r32) * 512 + h * 64 + 8 * hi2;
        f32x16 acc = {};
#pragma unroll
        for (int st = 0; st < 4; ++st) {
            const f32x4 a0 = *(const f32x4*)(wq + 16 * st), a1 = *(const f32x4*)(wq + 16 * st + 4), b0 = *(const f32x4*)(uk + 16 * st), b1 = *(const f32x4*)(uk + 16 * st + 4);
            const u32x4 aw = {pk2(a0.x, a0.y), pk2(a0.z, a0.w), pk2(a1.x, a1.y), pk2(a1.z, a1.w)}, bw = {pk2(b0.x, b0.y), pk2(b0.z, b0.w), pk2(b1.x, b1.y), pk2(b1.z, b1.w)};
            acc = __builtin_amdgcn_mfma_f32_32x32x16_bf16(__builtin_bit_cast(bf16x8, aw), __builtin_bit_cast(bf16x8, bw), acc, 0, 0, 0);
        }
        bf16* o = (bf16*)(ws + WS_WQA) + (size_t)(h * 256 + ct * 32 + r32) * 384 + kt * 32 + 4 * hi2;
#pragma unroll
        for (int q = 0; q < 4; ++q) st_bf4(o + 8 * q, (f32x4){acc[4 * q], acc[4 * q + 1], acc[4 * q + 2], acc[4 * q + 3]});
    }
    for (int m = gw; m < TOK; m += NGW) {
        const float* xr = m < TP ? A.in[0] + (size_t)m * DM : A.in[1] + (size_t)(m - TP) * DM;
        rms_row<false>(xr, A.in[8], (bf16*)(ws + WS_H) + (size_t)m * DM, lane);
    }
    {
        const int gt = blockIdx.x * NTHREADS + tid, GT = G * NTHREADS;
        for (int i = gt; i < 2112 * 16; i += GT) {
            const int pidx = i >> 4, k = i & 15; const int pos = pidx < 2048 ? pidx : PAST + (pidx - 2048);
            const float inv = exp2f(-(float)k * (13.287712379549449f / 16.f));
            const float ang = (float)pos * inv;
            const float kq = floorf(ang * 0.15915494309189535f);
            float r = fmaf(-kq, 6.2831854820251465f, ang); r = fmaf(-kq, -1.7484555e-7f, r);
            const float rev = r * 0.15915494309189535f;
            ((f32x2*)(ws + WS_CS))[i] = (f32x2){__builtin_amdgcn_cosf(rev), __builtin_amdgcn_sinf(rev)};
        }
    }
    for (int sq = (wave == 0 ? (int)blockIdx.x : NBS * 8); sq < NBS * 8; sq += G) {
        const int b = sq >> 3, h = sq & 7; const float* lf = A.in[4] + (size_t)b * PAST * 8 + h; float* Fo = (float*)(ws + WS_FS) + (size_t)sq * KVS;
        scan_seq<PAST / 64>(lf, Fo, 0.f, lane, scr);
    }
    {
        const size_t gt = (size_t)blockIdx.x * NTHREADS + tid, GT = (size_t)G * NTHREADS;
        cvt_stream(A.in[5], (bf16*)(ws + WS_LATPAST), (size_t)NPAST * 256 / 4, gt, GT);
        cvt_stream(A.in[6], (bf16*)(ws + WS_KRPAST), (size_t)NPAST * 32 / 4, gt, GT);
    }
}

__device__ __forceinline__ void rope4(f32x4& x1, f32x4& x2, const float* cs  ) {
    const f32x4 a = ((const f32x4*)cs)[0], b = ((const f32x4*)cs)[1];
    const f32x4 c = {a.x, a.z, b.x, b.z}, s = {a.y, a.w, b.y, b.w};
    const f32x4 o1 = x1 * c - x2 * s, o2 = x1 * s + x2 * c; x1 = o1; x2 = o2;
}
__device__ __forceinline__ float log_sigmoid(float x) { return fminf(x, 0.f) - log1pf(__expf(-fabsf(x))); }

struct EpiZ {
    static constexpr bool PERM = false, AFTER_DRAIN = false;
    bf16 *qfox, *knew, *vnew, *krnew; float* zbuf; float* out; const float* cs; const float* bfg;
    __device__ __forceinline__ void operator()(const f32x4 (&acc)[2][2][4][2], const pg8::Unit& u, int wr, int wc, int fr, int fq) const {
        const bool smp = u.pm >= TP / 256;
        const int row0 = u.pm * 256 + wr * 64 + fr;
#pragma unroll
        for (int bj = 0; bj < 2; ++bj) {
            const int cg = u.pn * 256 + bj * 128 + wc * 32;
            const int c0 = cg + 4 * fq;
#pragma unroll
            for (int ai = 0; ai < 2; ++ai)
#pragma unroll
                for (int m = 0; m < 4; ++m) {
                    const int row = row0 + ai * 128 + m * 16; const size_t lr = smp ? (size_t)(row - TP) : (size_t)row;
                    f32x4 v0 = acc[ai][bj][m][0], v1 = acc[ai][bj][m][1];
                    if (cg < 512) { const float sc = 0.125f * LOG2E; st_bf4(qfox + (size_t)row * 512 + c0, v0 * sc); st_bf4(qfox + (size_t)row * 512 + c0 + 16, v1 * sc); }
                    else if (cg < 1024) { const int c = c0 - 512; float* o = out + (smp ? O_KS : O_KP) + lr * 512 + c; *(f32x4*)o = v0; *(f32x4*)(o + 16) = v1;
                        st_bf4(knew + (size_t)row * 512 + c, v0); st_bf4(knew + (size_t)row * 512 + c + 16, v1); }
                    else if (cg < 1536) { const int c = c0 - 1024; float* o = out + (smp ? O_VS : O_VP) + lr * 512 + c; *(f32x4*)o = v0; *(f32x4*)(o + 16) = v1;
                        st_bf4(vnew + (size_t)row * 512 + c, v0); st_bf4(vnew + (size_t)row * 512 + c + 16, v1); }
                    else if (cg < 2176) { float* z = zbuf + (size_t)row * ZW + (c0 - 1536); *(f32x4*)z = v0; *(f32x4*)(z + 16) = v1; }
                    else if (cg == 2176) {
                        const int pidx = smp ? 2048 + ((row - TP) & 63) : (row & 2047);
                        rope4(v0, v1, cs + ((size_t)pidx * 16 + 4 * fq) * 2);
                        float* o = out + (smp ? O_KRS : O_KRP) + lr * 32 + 4 * fq; *(f32x4*)o = v0; *(f32x4*)(o + 16) = v1;
                        st_bf4(krnew + (size_t)row * 32 + 4 * fq, v0); st_bf4(krnew + (size_t)row * 32 + 4 * fq + 16, v1);
                    } else if (cg == 2208) {
                        if (fq < 2) { const f32x4 b = *(const f32x4*)(bfg + 4 * fq);
                            f32x4 lf; lf.x = log_sigmoid(v0.x + b.x); lf.y = log_sigmoid(v0.y + b.y); lf.z = log_sigmoid(v0.z + b.z); lf.w = log_sigmoid(v0.w + b.w);
                            *(f32x4*)(out + (smp ? O_LFS : O_LFP) + lr * 8 + 4 * fq) = lf; }
                    }
                }
        }
    }
};
struct EpiBf {
    static constexpr bool PERM = true, AFTER_DRAIN = false;
    bf16* O; int ldc; float sc;
    __device__ __forceinline__ void operator()(const f32x4 (&acc)[2][2][4][2], const pg8::Unit& u, int wr, int wc, int fr, int fq) const {
        const int row0 = u.pm * 256 + wr * 64 + fr;
#pragma unroll
        for (int ai = 0; ai < 2; ++ai)
#pragma unroll
            for (int m = 0; m < 4; ++m) { bf16* rp = O + (size_t)(row0 + ai * 128 + m * 16) * ldc + u.pn * 256 + wc * 32 + 8 * fq;
#pragma unroll
                for (int bj = 0; bj < 2; ++bj) { const f32x4 v0 = acc[ai][bj][m][0] * sc, v1 = acc[ai][bj][m][1] * sc;
                    *(u32x4*)(rp + bj * 128) = (u32x4){pk2(v0.x, v0.y), pk2(v0.z, v0.w), pk2(v1.x, v1.y), pk2(v1.z, v1.w)}; } }
    }
};
constexpr int DN_SL = 8;
template <int NKT  >
struct SplitOrder {
    int G, c;
    __device__ __forceinline__ bool next(int i, pg8::Unit& u) const {
        const int L = i * G + c; if (L >= 256 + 32 * DN_SL) return false;
        const bool full = L < 256; const int r = full ? L : L - 256, x = r & 7, y = r >> 3;
        pg8::Unit t; t.pm = full ? 8 * x + (y & 7) : 64 + x; t.pn = full ? (y >> 3) : (y & 3); const int sl = y >> 2;
        if (NKT == 44) { t.k0 = full ? 0 : (sl < 6 ? 6 * sl : 36 + 4 * (sl - 6)); t.nkt = full ? 44 : (sl < 6 ? 6 : 4); }
        else { t.k0 = full ? 0 : 2 * sl; t.nkt = full ? 16 : 2; }
        t.sl = full ? -1 : sl;
        u = t; return true;
    }
    __device__ __forceinline__ void a_ready(const pg8::Unit&) const {}
    __device__ __forceinline__ void done(const pg8::Unit&) const {}
};
typedef SplitOrder<44> DownOrder;
struct EpiDown {
    static constexpr bool PERM = false, AFTER_DRAIN = false;
    const float* x1; float* x2; float* slab;
    __device__ __forceinline__ void operator()(const f32x4 (&acc)[2][2][4][2], const pg8::Unit& u, int wr, int wc, int fr, int fq) const {
        const int row0 = u.pm * 256 + wr * 64 + fr; const bool part = u.sl >= 0;
#pragma unroll
        for (int ai = 0; ai < 2; ++ai)
#pragma unroll
            for (int m = 0; m < 4; ++m) { const int row = row0 + ai * 128 + m * 16; const int cb = u.pn * 256 + wc * 32 + 4 * fq;
                if (part) { float* op = slab + ((size_t)u.sl * TS + (row - TP)) * DM + cb;
#pragma unroll
                    for (int bj = 0; bj < 2; ++bj)
#pragma unroll
                        for (int n = 0; n < 2; ++n) *(f32x4*)(op + bj * 128 + n * 16) = acc[ai][bj][m][n]; }
                else { const float* bp = x1 + (size_t)row * DM + cb; float* op = x2 + (size_t)row * DM + cb;
#pragma unroll
                    for (int bj = 0; bj < 2; ++bj)
#pragma unroll
                        for (int n = 0; n < 2; ++n) *(f32x4*)(op + bj * 128 + n * 16) = *(const f32x4*)(bp + bj * 128 + n * 16) + acc[ai][bj][m][n]; } }
    }
};
struct EpiOut {
    static constexpr bool PERM = false, AFTER_DRAIN = false;
    const float* b0; const float* b1; float* O; bf16* H; const float* g; float* rowss; float* slab;
    __device__ __forceinline__ void operator()(const f32x4 (&acc)[2][2][4][2], const pg8::Unit& u, int wr, int wc, int fr, int fq) const {
        const int row0 = u.pm * 256 + wr * 64 + fr; const bool smp = u.pm >= TP / 256; const int cb = u.pn * 256 + wc * 32 + 4 * fq;
        if (u.sl >= 0) {
#pragma unroll
            for (int ai = 0; ai < 2; ++ai)
#pragma unroll
                for (int m = 0; m < 4; ++m) { float* sp = slab + ((size_t)u.sl * TS + (row0 + ai * 128 + m * 16 - TP)) * DM + cb;
#pragma unroll
                    for (int bj = 0; bj < 2; ++bj)
#pragma unroll
                        for (int n = 0; n < 2; ++n) *(f32x4*)(sp + bj * 128 + n * 16) = acc[ai][bj][m][n]; }
            return;
        }
        f32x4 gv[2][2];
#pragma unroll
        for (int bj = 0; bj < 2; ++bj)
#pragma unroll
            for (int n = 0; n < 2; ++n) gv[bj][n] = *(const f32x4*)(g + cb + bj * 128 + n * 16);
#pragma unroll
        for (int ai = 0; ai < 2; ++ai)
#pragma unroll
            for (int m = 0; m < 4; ++m) { const int row = row0 + ai * 128 + m * 16;
                const float* bp = (smp ? b1 + (size_t)(row - TP) * DM : b0 + (size_t)row * DM) + cb; float* op = O + (size_t)row * DM + cb; bf16* hp = H + (size_t)row * DM + cb;
                float ss = 0.f;
#pragma unroll
                for (int bj = 0; bj < 2; ++bj)
#pragma unroll
                    for (int n = 0; n < 2; ++n) { const f32x4 x = *(const f32x4*)(bp + bj * 128 + n * 16) + acc[ai][bj][m][n]; *(f32x4*)(op + bj * 128 + n * 16) = x;
                        ss += (x.x * x.x + x.y * x.y) + (x.z * x.z + x.w * x.w); st_bf4(hp + bj * 128 + n * 16, x * gv[bj][n]); }
                ss += __shfl_xor(ss, 16); ss += __shfl_xor(ss, 32);
                if (fq == 0) rowss[(size_t)row * 16 + u.pn * 4 + wc] = ss;
            }
    }
};
struct EpiRes {
    static constexpr bool PERM = false, AFTER_DRAIN = false;
    const float* b0; const float* b1; float* O;
    __device__ __forceinline__ void operator()(const f32x4 (&acc)[2][2][4][2], const pg8::Unit& u, int wr, int wc, int fr, int fq) const {
        const int row0 = u.pm * 256 + wr * 64 + fr; const bool smp = u.pm >= TP / 256;
#pragma unroll
        for (int ai = 0; ai < 2; ++ai)
#pragma unroll
            for (int m = 0; m < 4; ++m) { const int row = row0 + ai * 128 + m * 16; const int cb = u.pn * 256 + wc * 32 + 4 * fq;
                const float* bp = (smp ? b1 + (size_t)(row - TP) * DM : b0 + (size_t)row * DM) + cb; float* op = O + (size_t)row * DM + cb;
#pragma unroll
                for (int bj = 0; bj < 2; ++bj)
#pragma unroll
                    for (int n = 0; n < 2; ++n) *(f32x4*)(op + bj * 128 + n * 16) = *(const f32x4*)(bp + bj * 128 + n * 16) + acc[ai][bj][m][n]; }
    }
};


__device__ __forceinline__ float silu(float g) { return g * __builtin_amdgcn_rcpf(1.f + fast_exp2(-g * LOG2E)); }
template <int CTRL> __device__ __forceinline__ float dpp_mov(float old, float src) {
    return __builtin_bit_cast(float, __builtin_amdgcn_update_dpp(__builtin_bit_cast(int, old), __builtin_bit_cast(int, src), CTRL, 0xf, 0xf, false)); }
__device__ __forceinline__ f32x4 rows_m1(f32x4 cur, f32x4 prev) { f32x4 o;
#pragma unroll
    for (int e = 0; e < 4; ++e) o[e] = dpp_mov<0x111>(dpp_mov<0x121>(0.f, prev[e]), cur[e]);
    return o; }
__device__ __forceinline__ f32x4 rows_m2(f32x4 cur, f32x4 prev) { f32x4 o;
#pragma unroll
    for (int e = 0; e < 4; ++e) o[e] = dpp_mov<0x112>(dpp_mov<0x122>(0.f, prev[e]), cur[e]);
    return o; }
struct EpiGlu {
    static constexpr bool PERM = false, AFTER_DRAIN = false;
    bf16* act; float* edge; const float* cw; const float* cb; const float* rowss;
    __device__ __forceinline__ void operator()(const f32x4 (&acc)[2][2][4][2], const pg8::Unit& u, int wr, int wc, int fr, int fq) const {
        float rstd[2][4];
#pragma unroll
        for (int ai = 0; ai < 2; ++ai)
#pragma unroll
            for (int m = 0; m < 4; ++m) rstd[ai][m] = rowss[u.pm * 256 + ai * 128 + wr * 64 + m * 16 + fr];
#pragma unroll
        for (int bj = 0; bj < 2; ++bj) {
            const int j = 16 * ((u.pn * 256 + bj * 128 + wc * 32) >> 5) + 4 * fq;
            const f32x4 w0g = *(const f32x4*)(cw + j), w1g = *(const f32x4*)(cw + DFF2 + j), w2g = *(const f32x4*)(cw + 2 * DFF2 + j), bg = *(const f32x4*)(cb + j);
            const f32x4 w0v = *(const f32x4*)(cw + DFF + j), w1v = *(const f32x4*)(cw + DFF2 + DFF + j), w2v = *(const f32x4*)(cw + 2 * DFF2 + DFF + j), bv = *(const f32x4*)(cb + DFF + j);
#pragma unroll
            for (int ai = 0; ai < 2; ++ai) {
                const int blk = u.pm * 4 + ai * 2 + wr; const int row0 = blk * 64 + fr;
#pragma unroll
                for (int m = 0; m < 4; ++m) {
                    const f32x4 gc = acc[ai][bj][m][0] * rstd[ai][m], vc = acc[ai][bj][m][1] * rstd[ai][m];
                    const f32x4 gp = acc[ai][bj][m ? m - 1 : 0][0] * rstd[ai][m ? m - 1 : 0], vp = acc[ai][bj][m ? m - 1 : 0][1] * rstd[ai][m ? m - 1 : 0];
                    const f32x4 g1 = rows_m1(gc, gp), g2 = rows_m2(gc, gp), v1 = rows_m1(vc, vp), v2 = rows_m2(vc, vp);
                    const f32x4 g = bg + w0g * g2 + w1g * g1 + w2g * gc, v = bv + w0v * v2 + w1v * v1 + w2v * vc;
                    f32x4 a; a.x = silu(g.x) * v.x; a.y = silu(g.y) * v.y; a.z = silu(g.z) * v.z; a.w = silu(g.w) * v.w;
                    if (m > 0 || fr >= 2) st_bf4(act + (size_t)(row0 + 16 * m) * DFF + j, a);
                    if (m == 0 && fr < 2) { float* e = edge + ((size_t)blk * 4 + fr) * DFF2; *(f32x4*)(e + j) = gc; *(f32x4*)(e + DFF + j) = vc; }
                    if (m == 3 && fr >= 14) { float* e = edge + ((size_t)blk * 4 + 2 + (fr - 14)) * DFF2; *(f32x4*)(e + j) = gc; *(f32x4*)(e + DFF + j) = vc; }
                }
            }
        }
    }
};

__device__ __forceinline__ void p2_postz(const Args& A, LAS unsigned char* lds) {
    const int tid = threadIdx.x, lane = tid & 63, wave = tid >> 6; const int gw = blockIdx.x * NWAVES + wave, NGW = gridDim.x * NWAVES;
    unsigned char* ws = A.ws; const float* zb = (const float*)(ws + WS_ZBUF);
    f32x2 gq[3]; { for (int j = 0; j < 3; ++j) gq[j] = ((const f32x2*)A.in[11])[lane + 64 * j]; }
    const f32x4 gk = ((const f32x4*)A.in[13])[lane];
    for (int m0 = gw; m0 < TOK; m0 += 3 * NGW) {
        f32x2 v[3][3]; f32x4 c[3]; float sq[3], sk[3]; bool ok[3];
#pragma unroll
        for (int u = 0; u < 3; ++u) { const int m = m0 + u * NGW; ok[u] = m < TOK; const float* z = zb + (size_t)(ok[u] ? m : m0) * ZW;
#pragma unroll
            for (int j = 0; j < 3; ++j) v[u][j] = ((const f32x2*)z)[lane + 64 * j];
            c[u] = ((const f32x4*)(z + 384))[lane]; }
#pragma unroll
        for (int u = 0; u < 3; ++u) { sq[u] = 0.f;
#pragma unroll
            for (int j = 0; j < 3; ++j) sq[u] += v[u][j].x * v[u][j].x + v[u][j].y * v[u][j].y;
            sk[u] = (c[u].x * c[u].x + c[u].y * c[u].y) + (c[u].z * c[u].z + c[u].w * c[u].w); }
#pragma unroll
        for (int o = 1; o < 64; o <<= 1) {
#pragma unroll
            for (int u = 0; u < 3; ++u) { sq[u] += __shfl_xor(sq[u], o); sk[u] += __shfl_xor(sk[u], o); } }
#pragma unroll
        for (int u = 0; u < 3; ++u) if (ok[u]) { const int m = m0 + u * NGW;
            const float rq = rsqrtf(sq[u] * (1.f / 384.f) + EPS), rk = rsqrtf(sk[u] * (1.f / 256.f) + EPS);
            unsigned* o = (unsigned*)((bf16*)(ws + WS_QCN) + (size_t)m * 384);
#pragma unroll
            for (int j = 0; j < 3; ++j) o[lane + 64 * j] = pk2(v[u][j].x * rq * gq[j].x, v[u][j].y * rq * gq[j].y);
            const f32x4 ov = c[u] * rk * gk;
            float* op = A.out + (m < TP ? O_LATP + (size_t)m * 256 : O_LATS + (size_t)(m - TP) * 256); ((f32x4*)op)[lane] = ov;
            st_bf4((bf16*)(ws + WS_LATNEW) + (size_t)m * 256 + 4 * lane, ov); }
    }
    for (int sq = ((gw & 3) == 0 ? (gw >> 2) : 64 + 256); sq < 64 + 256; sq += (NGW >> 2)) {
        if (sq < 64) { const int b = sq >> 3, h = sq & 7; const float* lf = A.out + O_LFP + (size_t)b * SEQ * 8 + h; float* Fo = (float*)(ws + WS_FP) + (size_t)sq * SEQ; scan_seq<SEQ / 64>(lf, Fo, 0.f, lane, (LAS float*)(lds + wave * 16384)); }
        else { const int s2 = sq - 64, b = s2 >> 3, h = s2 & 7; const float* lf = A.out + O_LFS + (size_t)b * DSEQ * 8 + h; float* Fo = (float*)(ws + WS_FS) + (size_t)s2 * KVS;
            const float base = Fo[PAST - 1]; const float v = wave_incl_scan(lf[(size_t)lane * 8], lane); Fo[PAST + lane] = base + v * LOG2E; }
    }
}

__device__ __forceinline__ f32x4 ld_bf4(const bf16* p) { const u32x2 w = *(const u32x2*)p; return (f32x4){bflo(w.x), bfhi(w.x), bflo(w.y), bfhi(w.y)}; }
__device__ __forceinline__ void p8_fixup(const Args& A) {
    int tid = threadIdx.x; asm volatile("" : "+v"(tid)); const int lane = tid & 63, wave = tid >> 6; const int gw = blockIdx.x * NWAVES + wave, NGW = gridDim.x * NWAVES;
    unsigned char* ws = A.ws; const float* __restrict__ EDGE = (const float*)(ws + WS_EDGE); bf16* __restrict__ ACT = (bf16*)(ws + WS_ACT);
    const float* __restrict__ cw = A.in[19]; const float* __restrict__ cb = A.in[20];
    constexpr int NBLK = TOK / 64, NSTRIP = DFF / 256, NIT = NBLK * NSTRIP;
    for (int it0 = gw; it0 < NIT; it0 += 2 * NGW) {
        f32x4 wg[2][4], wv[2][4], pg[2][2], pv[2][2], cg[2][2], cv[2][2], sg[2][2], sv[2][2]; bool ok[2], last[2], smp[2]; int j0[2], tok0[2], bb[2];
#pragma unroll
        for (int u = 0; u < 2; ++u) {
            const int it = it0 + u * NGW; ok[u] = it < NIT; const int itc = ok[u] ? it : it0;
            const int blk = itc / NSTRIP, strip = itc % NSTRIP; j0[u] = strip * 256 + lane * 4; tok0[u] = blk * 64;
            smp[u] = tok0[u] >= TP; const int T = smp[u] ? DSEQ : SEQ; const int lt = smp[u] ? tok0[u] - TP : tok0[u]; bb[u] = lt / T; const int t0 = lt % T; last[u] = (t0 + 64 == T);
#pragma unroll
            for (int k = 0; k < 3; ++k) { wg[u][k] = *(const f32x4*)(cw + k * DFF2 + j0[u]); wv[u][k] = *(const f32x4*)(cw + k * DFF2 + DFF + j0[u]); }
            wg[u][3] = *(const f32x4*)(cb + j0[u]); wv[u][3] = *(const f32x4*)(cb + DFF + j0[u]);
            const float* pe = (t0 == 0) ? (smp[u] ? A.in[7] + (size_t)bb[u] * 2 * DFF2 : EDGE  ) : EDGE + ((size_t)(blk - 1) * 4 + 2) * DFF2;
            const bool zero = (t0 == 0) && !smp[u];
#pragma unroll
            for (int i = 0; i < 2; ++i) { pg[u][i] = *(const f32x4*)(pe + i * DFF2 + j0[u]); pv[u][i] = *(const f32x4*)(pe + i * DFF2 + DFF + j0[u]);
                if (zero) { pg[u][i] = (f32x4){0.f, 0.f, 0.f, 0.f}; pv[u][i] = (f32x4){0.f, 0.f, 0.f, 0.f}; }
                const float* e = EDGE + ((size_t)blk * 4 + i) * DFF2; cg[u][i] = *(const f32x4*)(e + j0[u]); cv[u][i] = *(const f32x4*)(e + DFF + j0[u]);
                const float* e2 = EDGE + ((size_t)blk * 4 + 2 + i) * DFF2; sg[u][i] = *(const f32x4*)(e2 + j0[u]); sv[u][i] = *(const f32x4*)(e2 + DFF + j0[u]); }
        }
#pragma unroll
        for (int u = 0; u < 2; ++u) if (ok[u]) {
            f32x4 g2 = pg[u][0], g1 = pg[u][1], v2 = pv[u][0], v1 = pv[u][1];
#pragma unroll
            for (int i = 0; i < 2; ++i) {
                const f32x4 gc = cg[u][i], vc = cv[u][i];
                const f32x4 g = wg[u][3] + wg[u][0] * g2 + wg[u][1] * g1 + wg[u][2] * gc, v = wv[u][3] + wv[u][0] * v2 + wv[u][1] * v1 + wv[u][2] * vc;
                f32x4 a; a.x = silu(g.x) * v.x; a.y = silu(g.y) * v.y; a.z = silu(g.z) * v.z; a.w = silu(g.w) * v.w;
                st_bf4(ACT + (size_t)(tok0[u] + i) * DFF + j0[u], a);
                g2 = g1; g1 = gc; v2 = v1; v1 = vc;
            }
            if (last[u]) {
#pragma unroll
                for (int i = 0; i < 2; ++i) { float* o = A.out + (smp[u] ? O_CVS : O_CVP) + ((size_t)bb[u] * 2 + i) * DFF2; *(f32x4*)(o + j0[u]) = sg[u][i]; *(f32x4*)(o + DFF + j0[u]) = sv[u][i]; }
            }
        }
    }
}

struct AttnArgs {
    const bf16* Q; int qstride;
    const void *Ka_past, *Ka_new; int kastride;
    const bf16 *Kb_past, *Kb_new; int kbstride;
    const void *V_past, *V_new; int vstride;
    const float *Fq, *Fk;
    bf16* O; int ostride;
    int P, qpos0, nkv;
    const float* cs;
};
__device__ __forceinline__ int crow(int r, int hi) { return (r & 3) + 8 * (r >> 2) + 4 * hi; }
__device__ __forceinline__ s16x4 tr_read(const LAS unsigned char* p) { typedef short v4i16 __attribute__((ext_vector_type(4))); return __builtin_bit_cast(s16x4, __builtin_amdgcn_ds_read_tr16_b64_v4i16((LAS v4i16*)p)); }

template <int DQK, bool FOX, int QS, int KS, bool F32>
__device__ __forceinline__ void attn_unit(const AttnArgs& a, LAS unsigned char* lds_base) {
    LAS unsigned char* const lds = lds_base;
    static_assert(QS * KS == NWAVES, "8 waves");
    constexpr int KRB = (DQK + 8) * 2, VRB = 144, NKK = DQK / 16;
    constexpr int OFF_V = 64 * KS * KRB, OFF_F = OFF_V + 64 * KS * VRB, OFF_Q = OFF_F + 64 * KS * 4, OFF_END = OFF_Q + QS * NKK * 1024;
    constexpr bool QLDS = KS > 1;
    static_assert(OFF_END <= 131072, "attention LDS");
    int tid = threadIdx.x; asm volatile("" : "+v"(tid));
    const int lane = tid & 63, q32 = lane & 31, hi = lane >> 5; const int wid = __builtin_amdgcn_readfirstlane(tid >> 6);
    const int qs = wid % QS, ks = wid / QS;
    const int NT = (a.nkv + 64 * KS - 1) / (64 * KS);
    const int qmin = a.qpos0 + qs * 32, qpos = qmin + q32;
    bf16x8 qf[NKK];
    { const bf16* qp = a.Q + (size_t)(qs * 32 + q32) * a.qstride + hi * 8;
#pragma unroll
      for (int kk = 0; kk < NKK; ++kk) qf[kk] = *(const bf16x8*)(qp + kk * 16); }
    if (DQK == 96) {
        const int pidx = qpos < SEQ ? qpos : SEQ + (qpos - PAST);
        const f32x4* cp = (const f32x4*)(a.cs + ((size_t)pidx * 16 + 8 * hi) * 2);
        const u32x4 w1 = __builtin_bit_cast(u32x4, qf[NKK - 2]), w2 = __builtin_bit_cast(u32x4, qf[NKK - 1]); u32x4 r1, r2;
#pragma unroll
        for (int j = 0; j < 4; ++j) { const f32x4 c = cp[j];
            const float a0 = bflo(w1[j]), a1 = bfhi(w1[j]), b0 = bflo(w2[j]), b1 = bfhi(w2[j]);
            r1[j] = pk2(a0 * c.x - b0 * c.y, a1 * c.z - b1 * c.w); r2[j] = pk2(a0 * c.y + b0 * c.x, a1 * c.w + b1 * c.z); }
        qf[NKK - 2] = __builtin_bit_cast(bf16x8, r1); qf[NKK - 1] = __builtin_bit_cast(bf16x8, r2);
    }
    LAS unsigned char* qlds = lds + OFF_Q + qs * (NKK * 1024) + lane * 16;
    if (QLDS) {
#pragma unroll
        for (int kk = 0; kk < NKK; ++kk) *(LAS bf16x8*)(qlds + kk * 1024) = qf[kk];
    }
    const float fqv = FOX ? a.Fq[qs * 32 + q32] : 0.f;
    float mrun = -1e30f, lsum = 0.f; f32x16 o0 = {}, o1 = {};
    u32x4 rka[KS], rv[F32 ? 1 : KS]; u32x4 rkb[(DQK == 96) ? (KS + 1) / 2 : 1]; float rf = 0.f;
    f32x4 fka[F32 ? KS : 1][2], fva[F32 ? KS : 1][2];
    const int lrow = tid >> 3, lch = tid & 7;
    const int brow = (tid & 255) >> 2, bch = tid & 3;
    auto load_k = [&](int T) {
        const int jT = T * KS * 64; const bool past = jT < a.P; const size_t r0 = (size_t)(past ? jT : jT - a.P);
        if (F32) { const float* kp = (const float*)(past ? a.Ka_past : a.Ka_new) + (r0 + lrow) * a.kastride + lch * 8;
#pragma unroll
            for (int s = 0; s < KS; ++s) if (jT + s * 64 < a.nkv) { const f32x4* p4 = (const f32x4*)(kp + (size_t)s * 64 * a.kastride); fka[F32 ? s : 0][0] = p4[0]; fka[F32 ? s : 0][1] = p4[1]; } }
        else { const bf16* kp = (const bf16*)(past ? a.Ka_past : a.Ka_new) + (r0 + lrow) * a.kastride + lch * 8;
#pragma unroll
            for (int s = 0; s < KS; ++s) if (jT + s * 64 < a.nkv) rka[s] = *(const u32x4*)(kp + (size_t)s * 64 * a.kastride); }
        if (DQK == 96) { const bf16* bp = (past ? a.Kb_past : a.Kb_new) + (r0 + (tid >> 8) * 64 + brow) * a.kbstride + bch * 8;
#pragma unroll
            for (int i = 0; i < (KS + 1) / 2; ++i) { const int s = 2 * i + (tid >> 8); if (s < KS && jT + s * 64 < a.nkv) rkb[i] = *(const u32x4*)(bp + (size_t)i * 128 * a.kbstride); }
        }
        if (FOX) { const int j = jT + tid; if (tid < 64 * KS && j < a.nkv) rf = a.Fk[j]; }
    };
    auto cvt_k = [&]() {
        if (F32) {
#pragma unroll
            for (int s = 0; s < KS; ++s) { const f32x4 k0 = fka[F32 ? s : 0][0], k1 = fka[F32 ? s : 0][1]; rka[s] = (u32x4){pk2(k0.x, k0.y), pk2(k0.z, k0.w), pk2(k1.x, k1.y), pk2(k1.z, k1.w)}; }
        }
    };
    auto load_v = [&](int T) {
        const int jT = T * KS * 64; const bool past = jT < a.P; const size_t r0 = (size_t)(past ? jT : jT - a.P);
        if (F32) { const float* vp = (const float*)(past ? a.V_past : a.V_new) + (r0 + lrow) * a.vstride + lch * 8;
#pragma unroll
            for (int s = 0; s < KS; ++s) if (jT + s * 64 < a.nkv) { const f32x4* p4 = (const f32x4*)(vp + (size_t)s * 64 * a.vstride); fva[F32 ? s : 0][0] = p4[0]; fva[F32 ? s : 0][1] = p4[1]; } }
        else { const bf16* vp = (const bf16*)(past ? a.V_past : a.V_new) + (r0 + lrow) * a.vstride + lch * 8;
#pragma unroll
            for (int s = 0; s < KS; ++s) if (jT + s * 64 < a.nkv) rv[F32 ? 0 : s] = *(const u32x4*)(vp + (size_t)s * 64 * a.vstride); }
    };
    constexpr bool DB = (KS == 1);
    static_assert(!DB || OFF_Q <= 32768, "double buffer stride");
    auto store_tile = [&](int T) {
        LAS unsigned char* const lds = lds_base + (DB ? (T & 1) * 32768 : 0);
#pragma unroll
        for (int s = 0; s < KS; ++s) { const int j0 = (T * KS + s) * 64;
            if (j0 < a.nkv) {
                *(LAS u32x4*)(lds + (s * 64 + lrow) * KRB + lch * 16) = rka[s];
                if (F32) { const f32x4 v0 = fva[F32 ? s : 0][0], v1 = fva[F32 ? s : 0][1];
                    *(LAS u32x4*)(lds + OFF_V + (s * 64 + lrow) * VRB + lch * 16) = (u32x4){pk2(v0.x, v0.y), pk2(v0.z, v0.w), pk2(v1.x, v1.y), pk2(v1.z, v1.w)}; }
                else *(LAS u32x4*)(lds + OFF_V + (s * 64 + lrow) * VRB + lch * 16) = rv[F32 ? 0 : s]; } }
        if (DQK == 96) {
#pragma unroll
            for (int i = 0; i < (KS + 1) / 2; ++i) { const int s = 2 * i + (tid >> 8); const int j0 = (T * KS + s) * 64;
                if (s < KS && j0 < a.nkv) *(LAS u32x4*)(lds + (s * 64 + brow) * KRB + 128 + bch * 16) = rkb[i]; }
        }
        if (FOX) { if (tid < 64 * KS) *(LAS float*)(lds + OFF_F + tid * 4) = rf; }
    };
    load_k(0); cvt_k(); load_v(0);
    const LAS unsigned char* kbase0 = lds + (ks * 64 + q32) * KRB + hi * 16;
    const LAS unsigned char* vbase0 = lds + OFF_V + (ks * 64 + 4 * hi + ((lane & 15) >> 2)) * VRB + (16 * ((lane >> 4) & 1) + 4 * (lane & 3)) * 2;
    const LAS unsigned char* fbase0 = lds + OFF_F + (ks * 64 + 4 * hi) * 4;
    if (DB) { store_tile(0); __syncthreads(); }
    for (int T = 0; T < NT; ++T) {
        if (!DB) { __syncthreads(); store_tile(T); __syncthreads(); }
        const int bo = DB ? (T & 1) * 32768 : 0;
        const LAS unsigned char* kbase = kbase0 + bo; const LAS unsigned char* vbase = vbase0 + bo; const LAS unsigned char* fbase = fbase0 + bo;
        if (T + 1 < NT) load_k(T + 1);
        __builtin_amdgcn_sched_barrier(0);
        const int tt = T * KS + ks; const int j0 = tt * 64;
        const bool valid = (j0 < a.nkv) && (FOX ? (j0 <= qmin + 31) : (tt <= (qmin >> 6)));
        bf16x8 pb[4];
        if (valid) {
            f32x16 p0 = {}, p1 = {};
#pragma unroll
            for (int kk = 0; kk < NKK; ++kk) {
                const bf16x8 k0 = *(const LAS bf16x8*)(kbase + kk * 32), k1 = *(const LAS bf16x8*)(kbase + 32 * KRB + kk * 32);
                const bf16x8 qv = QLDS ? *(const LAS bf16x8*)(qlds + kk * 1024) : qf[kk];
                p0 = __builtin_amdgcn_mfma_f32_32x32x16_bf16(k0, qv, p0, 0, 0, 0);
                p1 = __builtin_amdgcn_mfma_f32_32x32x16_bf16(k1, qv, p1, 0, 0, 0);
            }
            if (FOX) {
#pragma unroll
                for (int g = 0; g < 4; ++g) { const f32x4 f0 = *(const LAS f32x4*)(fbase + g * 32), f1 = *(const LAS f32x4*)(fbase + 128 + g * 32);
#pragma unroll
                    for (int e = 0; e < 4; ++e) { p0[4 * g + e] += fqv - f0[e]; p1[4 * g + e] += fqv - f1[e]; } }
                if (j0 + 63 > qmin) {
#pragma unroll
                    for (int r = 0; r < 16; ++r) { const int kv = j0 + crow(r, hi); if (kv > qpos) p0[r] = -1e30f; if (kv + 32 > qpos) p1[r] = -1e30f; }
                }
            }
            float mt = fmaxf(p0[0], p1[0]);
#pragma unroll
            for (int r = 1; r < 16; ++r) mt = fmaxf(mt, fmaxf(p0[r], p1[r]));
            mt = fmaxf(mt, __shfl_xor(mt, 32));
            const float mnew = fmaxf(mrun, mt), alpha = fast_exp2(mrun - mnew); mrun = mnew;
            float ps = 0.f;
#pragma unroll
            for (int r = 0; r < 16; ++r) { p0[r] = fast_exp2(p0[r] - mnew); p1[r] = fast_exp2(p1[r] - mnew); ps += p0[r] + p1[r]; }
            lsum = lsum * alpha + ps;
            if (__builtin_amdgcn_ballot_w64(alpha != 1.f)) { o0 = o0 * alpha; o1 = o1 * alpha; }
#pragma unroll
            for (int s = 0; s < 2; ++s) {
                u32x4 w0 = {pk2(p0[8 * s], p0[8 * s + 1]), pk2(p0[8 * s + 2], p0[8 * s + 3]), pk2(p0[8 * s + 4], p0[8 * s + 5]), pk2(p0[8 * s + 6], p0[8 * s + 7])};
                u32x4 w1 = {pk2(p1[8 * s], p1[8 * s + 1]), pk2(p1[8 * s + 2], p1[8 * s + 3]), pk2(p1[8 * s + 4], p1[8 * s + 5]), pk2(p1[8 * s + 6], p1[8 * s + 7])};
                pb[s] = __builtin_bit_cast(bf16x8, w0); pb[2 + s] = __builtin_bit_cast(bf16x8, w1);
            }
        }
        __builtin_amdgcn_sched_barrier(0);
        if (T + 1 < NT) { cvt_k(); load_v(T + 1); }
        __builtin_amdgcn_sched_barrier(0);
        if (valid) {
#pragma unroll
            for (int kst = 0; kst < 4; ++kst) {
                const LAS unsigned char* vp = vbase + 16 * kst * VRB;
                const s16x4 a0l = tr_read(vp), a0h = tr_read(vp + 8 * VRB), a1l = tr_read(vp + 64), a1h = tr_read(vp + 64 + 8 * VRB);
                const bf16x8 A0 = {a0l[0], a0l[1], a0l[2], a0l[3], a0h[0], a0h[1], a0h[2], a0h[3]}, A1 = {a1l[0], a1l[1], a1l[2], a1l[3], a1h[0], a1h[1], a1h[2], a1h[3]};
                o0 = __builtin_amdgcn_mfma_f32_32x32x16_bf16(A0, pb[kst], o0, 0, 0, 0);
                o1 = __builtin_amdgcn_mfma_f32_32x32x16_bf16(A1, pb[kst], o1, 0, 0, 0);
            }
        }
        if (DB) { if (T + 1 < NT) store_tile(T + 1); __syncthreads(); }
    }
    lsum += __shfl_xor(lsum, 32);
    if (KS == 1) {
        const float inv = 1.f / lsum; bf16* op = a.O + (size_t)(qs * 32 + q32) * a.ostride + 4 * hi;
#pragma unroll
        for (int g = 0; g < 4; ++g) { st_bf4(op + 8 * g, (f32x4){o0[4 * g] * inv, o0[4 * g + 1] * inv, o0[4 * g + 2] * inv, o0[4 * g + 3] * inv});
            st_bf4(op + 32 + 8 * g, (f32x4){o1[4 * g] * inv, o1[4 * g + 1] * inv, o1[4 * g + 2] * inv, o1[4 * g + 3] * inv}); }
    } else {
        __syncthreads();
        LAS float* osc = (LAS float*)lds + wid * 2048;
        LAS float* msc = (LAS float*)(lds + 65536) + wid * 32; LAS float* lsc = (LAS float*)(lds + 65536 + 1024) + wid * 32;
#pragma unroll
        for (int r = 0; r < 16; ++r) { osc[r * 64 + lane] = o0[r]; osc[(16 + r) * 64 + lane] = o1[r]; }
        if (hi == 0) { msc[q32] = mrun; lsc[q32] = lsum; }
        __syncthreads();
        if (ks == 0) {
            float mk[KS], M = -1e30f;
#pragma unroll
            for (int k = 0; k < KS; ++k) { mk[k] = ((LAS float*)(lds + 65536))[(k * QS + qs) * 32 + q32]; M = fmaxf(M, mk[k]); }
            float L = 0.f; f32x16 t0 = {}, t1 = {};
#pragma unroll 1
            for (int k = 0; k < KS; ++k) { const float w = fast_exp2(((LAS float*)(lds + 65536))[(k * QS + qs) * 32 + q32] - M); L += w * ((LAS float*)(lds + 65536 + 1024))[(k * QS + qs) * 32 + q32];
                const LAS float* os = (LAS float*)lds + (k * QS + qs) * 2048;
#pragma unroll
                for (int r = 0; r < 16; ++r) { t0[r] += w * os[r * 64 + lane]; t1[r] += w * os[(16 + r) * 64 + lane]; } }
            const float inv = 1.f / L; bf16* op = a.O + (size_t)(qs * 32 + q32) * a.ostride + 4 * hi;
#pragma unroll
            for (int g = 0; g < 4; ++g) { st_bf4(op + 8 * g, (f32x4){t0[4 * g] * inv, t0[4 * g + 1] * inv, t0[4 * g + 2] * inv, t0[4 * g + 3] * inv});
                st_bf4(op + 32 + 8 * g, (f32x4){t1[4 * g] * inv, t1[4 * g + 1] * inv, t1[4 * g + 2] * inv, t1[4 * g + 3] * inv}); }
        }
    }
    __syncthreads();
}


struct Attn2Args {
    const bf16* Q[2]; int qstride;
    const bf16* Ka; int kastride; const bf16* Kb; int kbstride; const bf16* V; int vstride;
    const float* Fk; bf16* O[2]; int ostride; int qpos0[2]; int nkv[2]; const float* cs;
};
template <int DQK, bool FOX, int NG>
__device__ __forceinline__ void attn_unit2(const Attn2Args& a, LAS unsigned char* lds) {
    constexpr int KRB = (DQK + 8) * 2, VRB = 144, NKK = DQK / 16, OFF_V = 64 * KRB, OFF_F = OFF_V + 64 * VRB, BUF = 32768;
    static_assert(OFF_F + 256 <= BUF, "tile buffer");
    int tid = threadIdx.x; asm volatile("" : "+v"(tid));
    const int lane = tid & 63, q32 = lane & 31, hi = lane >> 5; const int wid = __builtin_amdgcn_readfirstlane(tid >> 6);
    int qmin[NG], qpos[NG]; bf16x8 qf[NG][NKK]; float mrun[NG], lsum[NG]; f32x16 o0[NG], o1[NG];
#pragma unroll
    for (int g = 0; g < NG; ++g) {
        qmin[g] = a.qpos0[g] + wid * 32; qpos[g] = qmin[g] + q32; mrun[g] = -1e30f; lsum[g] = 0.f; o0[g] = f32x16{}; o1[g] = f32x16{};
        const bf16* qp = a.Q[g] + (size_t)(wid * 32 + q32) * a.qstride + hi * 8;
#pragma unroll
        for (int kk = 0; kk < NKK; ++kk) qf[g][kk] = *(const bf16x8*)(qp + kk * 16);
        if (DQK == 96) {
            const f32x4* cp = (const f32x4*)(a.cs + ((size_t)qpos[g] * 16 + 8 * hi) * 2);
            const u32x4 w1 = __builtin_bit_cast(u32x4, qf[g][NKK - 2]), w2 = __builtin_bit_cast(u32x4, qf[g][NKK - 1]); u32x4 r1, r2;
#pragma unroll
            for (int j = 0; j < 4; ++j) { const f32x4 c = cp[j]; const float a0 = bflo(w1[j]), a1 = bfhi(w1[j]), b0 = bflo(w2[j]), b1 = bfhi(w2[j]);
                r1[j] = pk2(a0 * c.x - b0 * c.y, a1 * c.z - b1 * c.w); r2[j] = pk2(a0 * c.y + b0 * c.x, a1 * c.w + b1 * c.z); }
            qf[g][NKK - 2] = __builtin_bit_cast(bf16x8, r1); qf[g][NKK - 1] = __builtin_bit_cast(bf16x8, r2);
        }
    }
    const int NT = a.nkv[NG - 1] / 64;
    struct Stage { u32x4 ka, v, kb; float f; }; Stage st0, st1;
    const int lrow = tid >> 3, lch = tid & 7, brow = (tid & 255) >> 2, bch = tid & 3;
    auto load_t = [&](int T, Stage& st) {
        st.ka = *(const u32x4*)(a.Ka + (size_t)(T * 64 + lrow) * a.kastride + lch * 8);
        st.v = *(const u32x4*)(a.V + (size_t)(T * 64 + lrow) * a.vstride + lch * 8);
        if (DQK == 96) { if (tid < 256) st.kb = *(const u32x4*)(a.Kb + (size_t)(T * 64 + brow) * a.kbstride + bch * 8); }
        if (FOX) { if (tid < 64) st.f = a.Fk[T * 64 + tid]; }
    };
    auto store_tile = [&](int T, const Stage& st) {
        LAS unsigned char* b = lds + (T & 1) * BUF;
        *(LAS u32x4*)(b + lrow * KRB + lch * 16) = st.ka; *(LAS u32x4*)(b + OFF_V + lrow * VRB + lch * 16) = st.v;
        if (DQK == 96) { if (tid < 256) *(LAS u32x4*)(b + brow * KRB + 128 + bch * 16) = st.kb; }
        if (FOX) { if (tid < 64) *(LAS float*)(b + OFF_F + tid * 4) = st.f; }
    };
    load_t(0, st0); if (NT > 1) load_t(1, st1);
    const LAS unsigned char* kbase0 = lds + q32 * KRB + hi * 16;
    const LAS unsigned char* vbase0 = lds + OFF_V + (4 * hi + ((lane & 15) >> 2)) * VRB + (16 * ((lane >> 4) & 1) + 4 * (lane & 3)) * 2;
    const LAS unsigned char* fbase0 = lds + OFF_F + (4 * hi) * 4;
    store_tile(0, st0); __syncthreads();
    auto step = [&](int T, Stage& stL  , const Stage& stS  ) {
        const int bo = (T & 1) * BUF; const LAS unsigned char* kbase = kbase0 + bo; const LAS unsigned char* vbase = vbase0 + bo; const LAS unsigned char* fbase = fbase0 + bo;
        if (T + 2 < NT) load_t(T + 2, stL);
        __builtin_amdgcn_sched_barrier(0);
        const int j0 = T * 64; bool valid[NG]; bool any = false;
#pragma unroll
        for (int g = 0; g < NG; ++g) { valid[g] = (j0 < a.nkv[g]) && (FOX ? (j0 <= qmin[g] + 31) : (T <= (qmin[g] >> 6))); any = any || valid[g]; }
        bf16x8 pb[NG][4];
        if (any) {
            f32x16 p0[NG], p1[NG];
            if (FOX) {
                f32x16 b0, b1;
#pragma unroll
                for (int q = 0; q < 4; ++q) { const f32x4 f0 = *(const LAS f32x4*)(fbase + q * 32), f1 = *(const LAS f32x4*)(fbase + 128 + q * 32);
#pragma unroll
                    for (int e = 0; e < 4; ++e) { b0[4 * q + e] = -f0[e]; b1[4 * q + e] = -f1[e]; } }
#pragma unroll
                for (int g = 0; g < NG; ++g) { p0[g] = b0; p1[g] = b1; }
            } else {
#pragma unroll
                for (int g = 0; g < NG; ++g) { p0[g] = f32x16{}; p1[g] = f32x16{}; } }
#pragma unroll
            for (int kk = 0; kk < NKK; ++kk) {
                const bf16x8 k0 = *(const LAS bf16x8*)(kbase + kk * 32), k1 = *(const LAS bf16x8*)(kbase + 32 * KRB + kk * 32);
#pragma unroll
                for (int g = 0; g < NG; ++g) if (valid[g]) {
                    p0[g] = __builtin_amdgcn_mfma_f32_32x32x16_bf16(k0, qf[g][kk], p0[g], 0, 0, 0);
                    p1[g] = __builtin_amdgcn_mfma_f32_32x32x16_bf16(k1, qf[g][kk], p1[g], 0, 0, 0); }
            }
#pragma unroll
            for (int g = 0; g < NG; ++g) if (valid[g]) {
                if (FOX && j0 + 63 > qmin[g]) {
#pragma unroll
                    for (int r = 0; r < 16; ++r) { const int kv = j0 + crow(r, hi); if (kv > qpos[g]) p0[g][r] = -1e30f; if (kv + 32 > qpos[g]) p1[g][r] = -1e30f; }
                }
                float mt = fmaxf(p0[g][0], p1[g][0]);
#pragma unroll
                for (int r = 1; r < 16; ++r) mt = fmaxf(mt, fmaxf(p0[g][r], p1[g][r]));
                mt = fmaxf(mt, __shfl_xor(mt, 32));
                const float mnew = fmaxf(mrun[g], mt), alpha = fast_exp2(mrun[g] - mnew); mrun[g] = mnew;
                float ps = 0.f;
#pragma unroll
                for (int r = 0; r < 16; ++r) { p0[g][r] = fast_exp2(p0[g][r] - mnew); p1[g][r] = fast_exp2(p1[g][r] - mnew); ps += p0[g][r] + p1[g][r]; }
                lsum[g] = lsum[g] * alpha + ps; if (__builtin_amdgcn_ballot_w64(alpha != 1.f)) { o0[g] = o0[g] * alpha; o1[g] = o1[g] * alpha; }
#pragma unroll
                for (int s = 0; s < 2; ++s) {
                    u32x4 w0 = {pk2(p0[g][8 * s], p0[g][8 * s + 1]), pk2(p0[g][8 * s + 2], p0[g][8 * s + 3]), pk2(p0[g][8 * s + 4], p0[g][8 * s + 5]), pk2(p0[g][8 * s + 6], p0[g][8 * s + 7])};
                    u32x4 w1 = {pk2(p1[g][8 * s], p1[g][8 * s + 1]), pk2(p1[g][8 * s + 2], p1[g][8 * s + 3]), pk2(p1[g][8 * s + 4], p1[g][8 * s + 5]), pk2(p1[g][8 * s + 6], p1[g][8 * s + 7])};
                    pb[g][s] = __builtin_bit_cast(bf16x8, w0); pb[g][2 + s] = __builtin_bit_cast(bf16x8, w1);
                }
            }
        }
        if (any) {
#pragma unroll
            for (int kst = 0; kst < 4; ++kst) {
                const LAS unsigned char* vp = vbase + 16 * kst * VRB;
                const s16x4 a0l = tr_read(vp), a0h = tr_read(vp + 8 * VRB), a1l = tr_read(vp + 64), a1h = tr_read(vp + 64 + 8 * VRB);
                const bf16x8 A0 = {a0l[0], a0l[1], a0l[2], a0l[3], a0h[0], a0h[1], a0h[2], a0h[3]}, A1 = {a1l[0], a1l[1], a1l[2], a1l[3], a1h[0], a1h[1], a1h[2], a1h[3]};
#pragma unroll
                for (int g = 0; g < NG; ++g) if (valid[g]) {
                    o0[g] = __builtin_amdgcn_mfma_f32_32x32x16_bf16(A0, pb[g][kst], o0[g], 0, 0, 0);
                    o1[g] = __builtin_amdgcn_mfma_f32_32x32x16_bf16(A1, pb[g][kst], o1[g], 0, 0, 0); }
            }
        }
        if (T + 1 < NT) store_tile(T + 1, stS);
        __syncthreads();
    };
    for (int T = 0; T < NT; T += 2) { step(T, st0, st1); if (T + 1 < NT) step(T + 1, st1, st0); }
#pragma unroll
    for (int g = 0; g < NG; ++g) {
        const float l = lsum[g] + __shfl_xor(lsum[g], 32); const float inv = 1.f / l; bf16* op = a.O[g] + (size_t)(wid * 32 + q32) * a.ostride + 4 * hi;
#pragma unroll
        for (int q = 0; q < 4; ++q) { st_bf4(op + 8 * q, (f32x4){o0[g][4 * q] * inv, o0[g][4 * q + 1] * inv, o0[g][4 * q + 2] * inv, o0[g][4 * q + 3] * inv});
            st_bf4(op + 32 + 8 * q, (f32x4){o1[g][4 * q] * inv, o1[g][4 * q + 1] * inv, o1[g][4 * q + 2] * inv, o1[g][4 * q + 3] * inv}); }
    }
    __syncthreads();
}

struct AbsArgs { const bf16* Qlat; const bf16* Qrope; const bf16 *Lat_past, *Lat_new, *Kr_past, *Kr_new; const bf16* WuvT; bf16* O; const float* cs; };
__device__ __forceinline__ void mla_abs_unit(const AbsArgs& a, LAS unsigned char* lds) {
    constexpr int RB = 592, OFF_Q = 128 * RB, NKK = 18, NT = (KVS + 127) / 128;
    int tid = threadIdx.x; asm volatile("" : "+v"(tid));
    const int lane = tid & 63, q32 = lane & 31, hi = lane >> 5; const int wid = __builtin_amdgcn_readfirstlane(tid >> 6);
    const int qs = wid & 1, ks = wid >> 1;
    LAS unsigned char* qlds = lds + OFF_Q + qs * (NKK * 1024) + lane * 16;
    { const bf16* qp = a.Qlat + (size_t)(qs * 32 + q32) * 2048 + hi * 8;
#pragma unroll
      for (int kk = 0; kk < 16; ++kk) *(LAS bf16x8*)(qlds + kk * 1024) = *(const bf16x8*)(qp + kk * 16);
      const bf16* rp = a.Qrope + (size_t)(qs * 32 + q32) * 768 + hi * 8;
      const u32x4 w1 = *(const u32x4*)rp, w2 = *(const u32x4*)(rp + 16); u32x4 r1, r2;
      const f32x4* cp = (const f32x4*)(a.cs + ((size_t)(SEQ + qs * 32 + q32) * 16 + 8 * hi) * 2);
#pragma unroll
      for (int j = 0; j < 4; ++j) { const f32x4 c = cp[j]; const float a0 = bflo(w1[j]), a1 = bfhi(w1[j]), b0 = bflo(w2[j]), b1 = bfhi(w2[j]);
          r1[j] = pk2(a0 * c.x - b0 * c.y, a1 * c.z - b1 * c.w); r2[j] = pk2(a0 * c.y + b0 * c.x, a1 * c.w + b1 * c.z); }
      *(LAS u32x4*)(qlds + 16 * 1024) = r1; *(LAS u32x4*)(qlds + 17 * 1024) = r2; }
    float mrun = -1e30f, lsum = 0.f; f32x16 o[8] = {};
    u32x4 rl[8], rk;
    const int lrow = tid >> 5, lch = tid & 31, krow = tid >> 2, kch = tid & 3;
    auto load_t = [&](int T) {
        const int jT = T * 128; const bool past = jT < PAST; const size_t r0 = (size_t)(past ? jT : jT - PAST);
        const bf16* lp = (past ? a.Lat_past : a.Lat_new) + (r0 + lrow) * 256 + lch * 8;
#pragma unroll
        for (int i = 0; i < 8; ++i) if (jT + 16 * i < KVS) rl[i] = *(const u32x4*)(lp + (size_t)i * 16 * 256);
        if (jT + krow < KVS) rk = *(const u32x4*)((past ? a.Kr_past : a.Kr_new) + (r0 + krow) * 32 + kch * 8);
    };
    auto store_t = [&](int T) {
        const int jT = T * 128;
#pragma unroll
        for (int i = 0; i < 8; ++i) if (jT + 16 * i < KVS) *(LAS u32x4*)(lds + (lrow + 16 * i) * RB + lch * 16) = rl[i];
        if (jT + krow < KVS) *(LAS u32x4*)(lds + krow * RB + 512 + kch * 16) = rk;
    };
    load_t(0);
    const LAS unsigned char* kbase = lds + (ks * 32 + q32) * RB + hi * 16;
    const LAS unsigned char* vbase = lds + (ks * 32 + 4 * hi + ((lane & 15) >> 2)) * RB + (16 * ((lane >> 4) & 1) + 4 * (lane & 3)) * 2;
    for (int T = 0; T < NT; ++T) {
        __syncthreads();
        store_t(T);
        __syncthreads();
        if (T + 1 < NT) load_t(T + 1);
        __builtin_amdgcn_sched_barrier(0);
        if (T * 128 + ks * 32 < KVS) {
            f32x16 p0 = {}, pq = {};
#pragma unroll
            for (int kk = 0; kk < NKK; kk += 2) {
                const bf16x8 k0 = *(const LAS bf16x8*)(kbase + kk * 32); const bf16x8 qv = *(const LAS bf16x8*)(qlds + kk * 1024);
                const bf16x8 k1 = *(const LAS bf16x8*)(kbase + (kk + 1) * 32); const bf16x8 qw = *(const LAS bf16x8*)(qlds + (kk + 1) * 1024);
                p0 = __builtin_amdgcn_mfma_f32_32x32x16_bf16(k0, qv, p0, 0, 0, 0);
                pq = __builtin_amdgcn_mfma_f32_32x32x16_bf16(k1, qw, pq, 0, 0, 0);
            }
            p0 = p0 + pq;
            float mt = p0[0];
#pragma unroll
            for (int r = 1; r < 16; ++r) mt = fmaxf(mt, p0[r]);
            mt = fmaxf(mt, __shfl_xor(mt, 32));
            const float mnew = fmaxf(mrun, mt), alpha = fast_exp2(mrun - mnew); mrun = mnew;
            float ps = 0.f;
#pragma unroll
            for (int r = 0; r < 16; ++r) { p0[r] = fast_exp2(p0[r] - mnew); ps += p0[r]; }
            lsum = lsum * alpha + ps;
            if (__builtin_amdgcn_ballot_w64(alpha != 1.f)) {
#pragma unroll
                for (int dt = 0; dt < 8; ++dt) o[dt] = o[dt] * alpha; }
            bf16x8 pb[2];
#pragma unroll
            for (int s = 0; s < 2; ++s) {
                u32x4 w0 = {pk2(p0[8 * s], p0[8 * s + 1]), pk2(p0[8 * s + 2], p0[8 * s + 3]), pk2(p0[8 * s + 4], p0[8 * s + 5]), pk2(p0[8 * s + 6], p0[8 * s + 7])};
                pb[s] = __builtin_bit_cast(bf16x8, w0);
            }
#pragma unroll
            for (int kst = 0; kst < 2; ++kst) {
                const LAS unsigned char* vp = vbase + 16 * kst * RB;
#pragma unroll
                for (int dt = 0; dt < 8; ++dt) { const s16x4 al = tr_read(vp + dt * 64), ah = tr_read(vp + dt * 64 + 8 * RB);
                    const bf16x8 Af = {al[0], al[1], al[2], al[3], ah[0], ah[1], ah[2], ah[3]};
                    o[dt] = __builtin_amdgcn_mfma_f32_32x32x16_bf16(Af, pb[kst], o[dt], 0, 0, 0); }
            }
        }
    }
    lsum += __shfl_xor(lsum, 32);
    LAS float* msc = (LAS float*)(lds + 131072 + 4096);
    LAS float* lsc = msc + 256;
#pragma unroll 1
    for (int rnd = 0; rnd < 2; ++rnd) {
        const int half = rnd == 0 ? 2 : 1;
        __syncthreads();
        if (ks >= half && ks < 2 * half) { LAS float* osc = (LAS float*)lds + ((ks - half) * 2 + qs) * 8192;
#pragma unroll
            for (int dt = 0; dt < 8; ++dt)
#pragma unroll
                for (int r = 0; r < 16; ++r) osc[(dt * 16 + r) * 64 + lane] = o[dt][r];
            if (hi == 0) { msc[wid * 32 + q32] = mrun; lsc[wid * 32 + q32] = lsum; } }
        __syncthreads();
        if (ks < half) { const LAS float* osc = (const LAS float*)lds + (ks * 2 + qs) * 8192; const int pw = (ks + half) * 2 + qs;
            const float m2 = msc[pw * 32 + q32], l2 = lsc[pw * 32 + q32]; const float M = fmaxf(mrun, m2), w1 = fast_exp2(mrun - M), w2 = fast_exp2(m2 - M);
            lsum = w1 * lsum + w2 * l2; mrun = M;
#pragma unroll
            for (int dt = 0; dt < 8; ++dt)
#pragma unroll
                for (int r = 0; r < 16; ++r) o[dt][r] = w1 * o[dt][r] + w2 * osc[(dt * 16 + r) * 64 + lane]; }
    }
    if (ks == 0) {
        const float inv = 1.f / lsum; f32x16 t0 = {}, t1 = {};
        const bf16* wrow0 = a.WuvT + (size_t)q32 * 256 + 4 * hi; const bf16* wrow1 = wrow0 + 32 * 256;
#pragma unroll
        for (int sub = 0; sub < 8; ++sub)
#pragma unroll
            for (int s = 0; s < 2; ++s) {
                const u32x4 wv = {pk2(o[sub][8 * s] * inv, o[sub][8 * s + 1] * inv), pk2(o[sub][8 * s + 2] * inv, o[sub][8 * s + 3] * inv), pk2(o[sub][8 * s + 4] * inv, o[sub][8 * s + 5] * inv), pk2(o[sub][8 * s + 6] * inv, o[sub][8 * s + 7] * inv)};
                const bf16x8 Bf = __builtin_bit_cast(bf16x8, wv); const int c0 = 32 * sub + 16 * s;
                const s16x4 a0l = *(const s16x4*)(wrow0 + c0), a0h = *(const s16x4*)(wrow0 + c0 + 8), a1l = *(const s16x4*)(wrow1 + c0), a1h = *(const s16x4*)(wrow1 + c0 + 8);
                const bf16x8 A0 = {a0l[0], a0l[1], a0l[2], a0l[3], a0h[0], a0h[1], a0h[2], a0h[3]}, A1 = {a1l[0], a1l[1], a1l[2], a1l[3], a1h[0], a1h[1], a1h[2], a1h[3]};
                t0 = __builtin_amdgcn_mfma_f32_32x32x16_bf16(A0, Bf, t0, 0, 0, 0);
                t1 = __builtin_amdgcn_mfma_f32_32x32x16_bf16(A1, Bf, t1, 0, 0, 0);
            }
        bf16* op = a.O + (size_t)(qs * 32 + q32) * 1024 + 4 * hi;
#pragma unroll
        for (int g = 0; g < 4; ++g) { st_bf4(op + 8 * g, (f32x4){t0[4 * g], t0[4 * g + 1], t0[4 * g + 2], t0[4 * g + 3]}); st_bf4(op + 32 + 8 * g, (f32x4){t1[4 * g], t1[4 * g + 1], t1[4 * g + 2], t1[4 * g + 3]}); }
    }
    __syncthreads();
}

__device__ __forceinline__ void p4_attention(const Args& A, LAS unsigned char* lds) {
    unsigned char* ws = A.ws; const int G = gridDim.x;
    const bf16* QFOX = (const bf16*)(ws + WS_QFOX); const bf16* KNEW = (const bf16*)(ws + WS_KNEW); const bf16* VNEW = (const bf16*)(ws + WS_VNEW);
    const bf16* QMLA = (const bf16*)(ws + WS_QMLA); const bf16* KVNEW = (const bf16*)(ws + WS_KVNEW);
    const bf16* KRNEW = (const bf16*)(ws + WS_KRNEW); const bf16* KRPAST = (const bf16*)(ws + WS_KRPAST);
    const float* FS = (const float*)(ws + WS_FS); const float* FP = (const float*)(ws + WS_FP); bf16* MIXED = (bf16*)(ws + WS_MIXED);
    const int rot = (blockIdx.x >> 6) & 3;
#pragma unroll 1
    for (int pass = 0; pass < 4; ++pass) {
    const int job = (pass + rot) & 3;
    if (job == 0) {
    for (int p = blockIdx.x; p < 256; p += G) {
        const int bh = p >> 2, s = p & 3, b = bh >> 3, h = bh & 7; const size_t tb = (size_t)b * SEQ;
        Attn2Args a; a.cs = (const float*)(ws + WS_CS); a.qstride = 512; a.Ka = KNEW + tb * 512 + h * 64; a.kastride = 512; a.Kb = nullptr; a.kbstride = 0;
        a.V = VNEW + tb * 512 + h * 64; a.vstride = 512; a.Fk = FP + (size_t)bh * SEQ; a.ostride = 1024;
        for (int i = 0; i < 2; ++i) { const int t0 = 256 * (i ? 7 - s : s); a.Q[i] = QFOX + (tb + t0) * 512 + h * 64; a.O[i] = MIXED + (tb + t0) * 1024 + h * 64; a.qpos0[i] = t0; a.nkv[i] = t0 + 256; }
        attn_unit2<64, true, 2>(a, lds);
    }
    } else if (job == 1) {
    for (int p = blockIdx.x; p < 256; p += G) {
        const int bh = p >> 2, s = 3 - (p & 3), b = bh >> 3, h = bh & 7; const size_t tb = (size_t)b * SEQ;
        Attn2Args a; a.cs = (const float*)(ws + WS_CS); a.qstride = 768; a.Ka = KVNEW + tb * 1024 + h * 64; a.kastride = 1024; a.Kb = KRNEW + tb * 32; a.kbstride = 32;
        a.V = KVNEW + tb * 1024 + 512 + h * 64; a.vstride = 1024; a.Fk = nullptr; a.ostride = 1024;
        for (int i = 0; i < 2; ++i) { const int t0 = 256 * (i ? 7 - s : s); a.Q[0] = QMLA + (tb + t0) * 768 + h * 96; a.O[0] = MIXED + (tb + t0) * 1024 + 512 + h * 64; a.qpos0[0] = t0; a.nkv[0] = t0 + 256;
            a.Q[1] = a.Q[0]; a.O[1] = a.O[0]; a.qpos0[1] = t0; a.nkv[1] = t0 + 256;
            attn_unit2<96, false, 1>(a, lds); }
    }
    } else if (job == 2) {
    for (int p = blockIdx.x; p < 256; p += G) {
        const int b = p >> 3, h = p & 7; const size_t tok0 = (size_t)TP + (size_t)b * DSEQ, pb = (size_t)b * PAST;
        AttnArgs a; a.cs = (const float*)(ws + WS_CS); a.Q = QFOX + tok0 * 512 + h * 64; a.qstride = 512;
        a.Ka_past = A.in[2] + pb * 512 + h * 64; a.Ka_new = A.out + O_KS + (size_t)b * DSEQ * 512 + h * 64; a.kastride = 512; a.Kb_past = a.Kb_new = nullptr; a.kbstride = 0;
        a.V_past = A.in[3] + pb * 512 + h * 64; a.V_new = A.out + O_VS + (size_t)b * DSEQ * 512 + h * 64; a.vstride = 512;
        a.Fq = FS + (size_t)p * KVS + PAST; a.Fk = FS + (size_t)p * KVS; a.O = MIXED + tok0 * 1024 + h * 64; a.ostride = 1024; a.P = PAST; a.qpos0 = PAST; a.nkv = KVS;
        attn_unit<64, true, 2, 4, true>(a, lds);
    }
    } else {
    for (int p = blockIdx.x; p < 256; p += G) {
        const int b = (p & 7) * 4 + (p >> 6), h = (p >> 3) & 7; const size_t tok0 = (size_t)TP + (size_t)b * DSEQ, pb = (size_t)b * PAST;
        AbsArgs a; a.Qlat = (const bf16*)(ws + WS_QLAT) + (size_t)b * DSEQ * 2048 + h * 256; a.Qrope = QMLA + tok0 * 768 + h * 96 + 64;
        a.Lat_past = (const bf16*)(ws + WS_LATPAST) + pb * 256; a.Lat_new = (const bf16*)(ws + WS_LATNEW) + tok0 * 256;
        a.Kr_past = KRPAST + pb * 32; a.Kr_new = KRNEW + tok0 * 32; a.WuvT = (const bf16*)(ws + WS_WKV) + (size_t)(512 + h * 64) * 256;
        a.O = MIXED + tok0 * 1024 + 512 + h * 64; a.cs = (const float*)(ws + WS_CS);
        mla_abs_unit(a, lds);
    }
    }
    }
}

template <class Epi> __device__ __forceinline__ void run_gemm(LAS unsigned char* lds, const bf16* Am, const bf16* Bt, int M, int N, int K, const Epi& E, int cu_shift = 0) {
    pg8::Gemm g{Am, Bt, M, N, K}; pg8::StaticOrder S; S.init(M, N, K, (int)gridDim.x, (int)((blockIdx.x + cu_shift) % gridDim.x));
    pg8::gemm_phase<Epi, pg8::StaticOrder, true, true>(lds, g, S, E);
}

__global__ void __launch_bounds__(NTHREADS, 2) fwd_kernel(Args A, int ph_lo, int ph_hi) {
    extern __shared__ __attribute__((aligned(16))) unsigned char lds_raw[];
    LAS unsigned char* lds = (LAS unsigned char*)lds_raw;
    unsigned char* ws = A.ws;
    if (threadIdx.x < 64) ((LAS unsigned*)(lds + 131072))[threadIdx.x] = 0u;
    __syncthreads();
    XcdBarrier bar = xcd_barrier_post((unsigned*)(ws + WS_CTL), (volatile LAS unsigned*)(lds + 131072 + 32));
#ifndef PH_MASK
#define PH_MASK 0xffff
#endif
#define IN(k) (((PH_MASK >> (k)) & 1) && ph_lo <= (k) && (k) < ph_hi)
#define SEAM(k) do { if (IN(k) && IN((k) + 1)) xcd_barrier(bar); } while (0)
#ifndef REP0
#define REP0 1
#endif
#ifndef REP4
#define REP4 1
#endif
#ifndef REP8
#define REP8 1
#endif
#ifndef REP1
#define REP1 1
#endif
#ifndef REP7
#define REP7 1
#endif
#ifndef REP9
#define REP9 1
#endif
    if (IN(0)) { for (int rep = 0; rep < REP0; ++rep) { p0_prologue(A, lds); __syncthreads(); } }
    SEAM(0);
    if (IN(1)) {
        EpiZ E{(bf16*)(ws + WS_QFOX), (bf16*)(ws + WS_KNEW), (bf16*)(ws + WS_VNEW), (bf16*)(ws + WS_KRNEW), (float*)(ws + WS_ZBUF), A.out, (const float*)(ws + WS_CS), A.in[10]};
        run_gemm(lds, (const bf16*)(ws + WS_H), (const bf16*)(ws + WS_WIN), TOK, NZ, DM, E);
    }
    SEAM(1);
    if (IN(2)) { p2_postz(A, lds); __syncthreads(); }
    SEAM(2);
    if (IN(3)) {
        EpiBf E{(bf16*)(ws + WS_QMLA), 768, 0.10206207261596575f * LOG2E};
        run_gemm(lds, (const bf16*)(ws + WS_QCN), (const bf16*)(ws + WS_WQ), TOK, 768, 384, E);
        EpiBf E2{(bf16*)(ws + WS_KVNEW), 1024, 1.f};
        run_gemm(lds, (const bf16*)(ws + WS_LATNEW), (const bf16*)(ws + WS_WKV), TP, 1024, 256, E2);
        EpiBf E3{(bf16*)(ws + WS_QLAT), 2048, 0.10206207261596575f * LOG2E};
        run_gemm(lds, (const bf16*)(ws + WS_QCN) + (size_t)TP * 384, (const bf16*)(ws + WS_WQA), TS, 2048, 384, E3, 64);
    }
    SEAM(3);
    if (IN(4)) { for (int rep = 0; rep < REP4; ++rep) p4_attention(A, lds); }
    SEAM(4);
    if (IN(5)) {
        pg8::Gemm g{(const bf16*)(ws + WS_MIXED), (const bf16*)(ws + WS_WOUT), TOK, DM, DM}; SplitOrder<16> S{(int)gridDim.x, (int)blockIdx.x};
        EpiOut E{A.in[0], A.in[1], (float*)(ws + WS_X1), (bf16*)(ws + WS_H), A.in[17], (float*)(ws + WS_ROWSS), (float*)(ws + WS_SLAB)};
        pg8::gemm_phase<EpiOut, SplitOrder<16>, true, true>(lds, g, S, E);
    }
    if (IN(5) && IN(7)) xcd_barrier(bar);
    if (IN(5)) {
        int t2 = threadIdx.x; asm volatile("" : "+v"(t2)); const int lane = t2 & 63, gw = blockIdx.x * NWAVES + (t2 >> 6), NGW = gridDim.x * NWAVES;
        for (int r = gw; r < TS; r += NGW) {
            const f32x4* xr = (const f32x4*)(A.in[1] + (size_t)r * DM) + lane; f32x4 v[4];
#pragma unroll
            for (int j = 0; j < 4; ++j) v[j] = xr[64 * j];
#pragma unroll
            for (int k = 0; k < DN_SL; ++k) { const f32x4* sr = (const f32x4*)((const float*)(ws + WS_SLAB) + ((size_t)k * TS + r) * DM) + lane;
#pragma unroll
                for (int j = 0; j < 4; ++j) v[j] += sr[64 * j]; }
            float ss = 0.f; const size_t row = (size_t)TP + r;
#pragma unroll
            for (int j = 0; j < 4; ++j) { ss += (v[j].x * v[j].x + v[j].y * v[j].y) + (v[j].z * v[j].z + v[j].w * v[j].w); ((f32x4*)((float*)(ws + WS_X1) + row * DM))[64 * j + lane] = v[j];
                const f32x4 gq = ((const f32x4*)A.in[17])[64 * j + lane]; const f32x4 o = v[j] * gq; ((u32x2*)((bf16*)(ws + WS_H) + row * DM))[64 * j + lane] = (u32x2){pk2(o.x, o.y), pk2(o.z, o.w)}; }
            ss = wave_sum(ss);
            if (lane == 0) ((float*)(ws + WS_RSTD))[row] = rsqrtf(ss * (1.f / DM) + EPS);
        }
        for (int r = blockIdx.x * NTHREADS + t2; r < TP; r += gridDim.x * NTHREADS) {
            const f32x4* rp = (const f32x4*)((const float*)(ws + WS_ROWSS) + (size_t)r * 16); const f32x4 t = (rp[0] + rp[1]) + (rp[2] + rp[3]);
            ((float*)(ws + WS_RSTD))[r] = rsqrtf(((t.x + t.y) + (t.z + t.w)) * (1.f / DM) + EPS);
        }
    }
    if (IN(5) && IN(7)) xcd_barrier(bar);
    if (IN(7)) { EpiGlu E{(bf16*)(ws + WS_ACT), (float*)(ws + WS_EDGE), A.in[19], A.in[20], (const float*)(ws + WS_RSTD)}; run_gemm(lds, (const bf16*)(ws + WS_H), (const bf16*)(ws + WS_WUP), TOK, DFF2, DM, E); }
    SEAM(7);
    if (IN(8)) p8_fixup(A);
    SEAM(8);
    if (IN(9)) {
        pg8::Gemm g{(const bf16*)(ws + WS_ACT), (const bf16*)(ws + WS_WDOWN), TOK, DM, DFF}; DownOrder S{(int)gridDim.x, (int)blockIdx.x};
        EpiDown E{(const float*)(ws + WS_X1), (float*)(ws + WS_X2), (float*)(ws + WS_SLAB)};
        pg8::gemm_phase<EpiDown, DownOrder, true, true>(lds, g, S, E);
    }
    SEAM(9);
    if (IN(10)) { int t2 = threadIdx.x; asm volatile("" : "+v"(t2)); const int lane = t2 & 63, gw = blockIdx.x * NWAVES + (t2 >> 6), NGW = gridDim.x * NWAVES;
        for (int m = gw; m < TOK; m += NGW) {
            if (m < TP) rms_row<true>((const float*)(ws + WS_X2) + (size_t)m * DM, A.in[22], A.out + (size_t)m * DM, lane);
            else rms_row<true>((const float*)(ws + WS_X1) + (size_t)m * DM, A.in[22], A.out + (size_t)m * DM, lane, (const float*)(ws + WS_SLAB) + (size_t)(m - TP) * DM, DN_SL, (size_t)TS * DM); } }
#undef IN
#undef SEAM
}

#ifndef N_LAUNCHES
#define N_LAUNCHES 1
#endif
extern "C" void kernel_launch(void* const* d_in, const int* in_sizes, int n_in, void* d_out, int out_size, void* d_ws, size_t ws_size, hipStream_t stream) {
    static int grid = 0;
    if (grid == 0) {
        if (n_in != 23 || (size_t)out_size != O_END || ws_size < WS_END) { fprintf(stderr, "kernel_launch: unexpected shapes: n_in %d out %d ws %zu (need %zu)\n", n_in, out_size, ws_size, (size_t)WS_END); grid = -1; return; }
        int dev = 0, cus = 0, per_cu = 0;
        (void)hipGetDevice(&dev); (void)hipDeviceGetAttribute(&cus, hipDeviceAttributeMultiprocessorCount, dev);
        if (hipFuncSetAttribute((const void*)fwd_kernel, hipFuncAttributeMaxDynamicSharedMemorySize, LDS_BYTES) != hipSuccess) { fprintf(stderr, "hipFuncSetAttribute failed\n"); grid = -1; return; }
        if (hipOccupancyMaxActiveBlocksPerMultiprocessor(&per_cu, (const void*)fwd_kernel, NTHREADS, LDS_BYTES) != hipSuccess || per_cu < 1) { fprintf(stderr, "occupancy query: %d\n", per_cu); per_cu = 1; }
        (void)hipGetLastError();
        grid = cus * 1;
    }
    if (grid < 0) return;
    if (hipMemsetAsync((char*)d_ws + WS_CTL, 0, CTL_BYTES, stream) != hipSuccess) { fprintf(stderr, "memset failed\n"); return; }
    Args a{};
    for (int i = 0; i < 23; ++i) a.in[i] = (const float*)d_in[i];
    a.out = (float*)d_out; a.ws = (unsigned char*)d_ws;
    if (N_LAUNCHES == 1) {
        hipLaunchKernelGGL(fwd_kernel, dim3(grid), dim3(NTHREADS), LDS_BYTES, stream, a, 0, 11);
    } else {
        for (int k = 0; k < 11; ++k) hipLaunchKernelGGL(fwd_kernel, dim3(grid), dim3(NTHREADS), LDS_BYTES, stream, a, k, k + 1);
    }
}
```

```cpp
#include <hip/hip_runtime.h>
#include <cstdio>
#include <cstdint>
namespace pg8 {
#define PG8_LAS __attribute__((address_space(3)))
typedef unsigned short bf16_t;
typedef short bf16x8 __attribute__((ext_vector_type(8)));
typedef float f32x4 __attribute__((ext_vector_type(4)));
typedef unsigned u32x4 __attribute__((ext_vector_type(4)));
constexpr int BM = 256, BK = 64, HALF = 128, HTB = HALF * BK * 2  , STAGE_BYTES = 8 * HTB, NXCD = 8, WGM = 8;

__host__ __device__ __forceinline__ int lds_byte(int r, int c) { const int st = (r >> 4) * 2 + (c >> 5), rr = r & 15, cc = c & 31, ob = rr * 64 + cc * 2; return st * 1024 + (ob ^ (((ob >> 9) & 1) << 5)); }
__host__ __device__ __forceinline__ void stage_rc(int b, int& R, int& C) { const int st = b / 1024, sb = b % 1024, swz = sb ^ (((sb >> 9) & 1) << 5); R = (st >> 1) * 16 + swz / 64; C = (st & 1) * 32 + (swz % 64) / 2; }
__host__ __device__ __forceinline__ int perm32(int rho) { const int n = rho >> 4, i = rho & 15; return 8 * (i >> 2) + 4 * n + (i & 3); }

struct Unit { int pm, pn, k0, nkt, sl; };
struct Gemm { const bf16_t* A; const bf16_t* Bt; int M, N, K; };

struct StaticOrder {
    int nM, nN, nwg, G, c, nkt;
    __host__ __device__ void init(int M, int N, int K, int G_, int c_) { nM = M / BM; nN = N / BM; nwg = nM * nN; G = G_; c = c_; nkt = K / BK; }
    __host__ __device__ bool next(int i, Unit& u) const {
        const long L = (long)i * G + c; if (L >= nwg) return false;
        int wgid = (int)L; { const int q = nwg / NXCD, r = nwg % NXCD, xcd = wgid % NXCD, off = wgid / NXCD; wgid = (xcd < r ? xcd * (q + 1) : r * (q + 1) + (xcd - r) * q) + off; }
        const int nig = WGM * nN, gid = wgid / nig, fm = gid * WGM, gsz = (nM - fm) < WGM ? (nM - fm) : WGM;
        u.pm = fm + ((wgid % nig) % gsz); u.pn = (wgid % nig) / gsz; u.k0 = 0; u.nkt = nkt; u.sl = -1; return true;
    }
    __device__ __forceinline__ void a_ready(const Unit&) const {}
    __device__ __forceinline__ void done(const Unit&) const {}
};

template <class Epi, class Sched, bool ALIGN_EPI = false, bool SP2 = false>
__device__ __forceinline__ void gemm_phase(PG8_LAS unsigned char* lds, const Gemm g, const Sched& S, const Epi& E) {
    const int tid = threadIdx.x, wid = __builtin_amdgcn_readfirstlane(tid >> 6), lane = tid & 63, wr = wid >> 2, wc = wid & 3, fr = lane & 15, fq = lane >> 4;
    const int K = g.K;
    unsigned voffA[2], voffB[2];
#pragma unroll
    for (int i = 0; i < 2; ++i) { int R, C; stage_rc(tid * 16 + i * 8192, R, C); const int Rb = Epi::PERM ? ((R & ~31) + perm32(R & 31)) : R;
        voffA[i] = (unsigned)(R * K + C) * 2u; voffB[i] = (unsigned)(Rb * K + C) * 2u; }
    const size_t kstep = (size_t)(BK * 2);
    const size_t hstep = (size_t)HALF * K * 2;
    const size_t tstep = 2 * hstep;
    const unsigned ldsw = (unsigned)wid * 1024u;
    const int aoff = lds_byte(wr * 64 + fr, fq * 8), boff = lds_byte(wc * 32 + fr, fq * 8);
#define PG8_SA(b, h) (((b) * 2 + (h)) * HTB)
#define PG8_SB(b, h) ((4 + (b) * 2 + (h)) * HTB)
#define PG8_STAGE(bufoff, gbase, voff) do { _Pragma("unroll") for (int _i = 0; _i < 2; ++_i) \
        __builtin_amdgcn_global_load_lds((const unsigned*)((const char*)(gbase) + (voff)[_i]), (PG8_LAS unsigned*)(lds + (bufoff) + ldsw + _i * 8192), 16, 0, 0); } while (0)
#define PG8_LDA(dst, b, h) do { _Pragma("unroll") for (int m = 0; m < 4; ++m) _Pragma("unroll") for (int k = 0; k < 2; ++k) dst[m][k] = *(const PG8_LAS bf16x8*)(lds + PG8_SA(b, h) + aoff + m * 2048 + k * 1024); } while (0)
#define PG8_LDB(dst, b, h) do { _Pragma("unroll") for (int n = 0; n < 2; ++n) _Pragma("unroll") for (int k = 0; k < 2; ++k) dst[n][k] = *(const PG8_LAS bf16x8*)(lds + PG8_SB(b, h) + boff + n * 2048 + k * 1024); } while (0)
#define PG8_MMA(ai, bj, At, Bt) do { __builtin_amdgcn_s_setprio(1); _Pragma("unroll") for (int m = 0; m < 4; ++m) _Pragma("unroll") for (int n = 0; n < 2; ++n) _Pragma("unroll") for (int k = 0; k < 2; ++k) \
        acc[ai][bj][m][n] = __builtin_amdgcn_mfma_f32_16x16x32_bf16(Bt[n][k], At[m][k], acc[ai][bj][m][n], 0, 0, 0); __builtin_amdgcn_s_setprio(0); } while (0)
#define PG8_WAIT_V(n) asm volatile("s_waitcnt vmcnt(" #n ")" ::: "memory")
#define PG8_WAIT_L(n) asm volatile("s_waitcnt lgkmcnt(" #n ")" ::: "memory")
#define PG8_BAR __builtin_amdgcn_s_barrier()
#define PG8_SCHED __builtin_amdgcn_sched_barrier(0)
    Unit cur{}, nxt{}; int ui = 0;
    if (!S.next(0, cur)) return;
    f32x4 acc[2][2][4][2];
#pragma unroll
    for (int a = 0; a < 2; ++a)
#pragma unroll
        for (int b = 0; b < 2; ++b)
#pragma unroll
            for (int m = 0; m < 4; ++m)
#pragma unroll
                for (int n = 0; n < 2; ++n) acc[a][b][m][n] = (f32x4){0.f, 0.f, 0.f, 0.f};
    bf16x8 At[4][2], B0[2][2], B1[2][2];
    const char* cA = (const char*)g.A + (size_t)cur.pm * tstep + (size_t)cur.k0 * kstep; const char* cB = (const char*)g.Bt + (size_t)cur.pn * tstep + (size_t)cur.k0 * kstep;
    S.a_ready(cur);
    if constexpr (SP2) {
        PG8_STAGE(PG8_SB(0, 0), cB, voffB); PG8_STAGE(PG8_SB(0, 1), cB + hstep, voffB); PG8_STAGE(PG8_SA(0, 0), cA, voffA); PG8_STAGE(PG8_SA(0, 1), cA + hstep, voffA);
        if (wr == 1) PG8_BAR;
        PG8_WAIT_V(2); PG8_BAR;
        PG8_STAGE(PG8_SB(1, 0), cB + kstep, voffB); PG8_STAGE(PG8_SA(1, 0), cA + kstep, voffA); PG8_STAGE(PG8_SB(1, 1), cB + hstep + kstep, voffB);
        PG8_WAIT_V(6); PG8_BAR;
    } else {
        PG8_STAGE(PG8_SB(0, 0), cB, voffB); PG8_STAGE(PG8_SA(0, 0), cA, voffA); PG8_STAGE(PG8_SB(0, 1), cB + hstep, voffB); PG8_STAGE(PG8_SA(0, 1), cA + hstep, voffA);
        if (wr == 1) PG8_BAR;
        PG8_WAIT_V(4); PG8_BAR;
        PG8_STAGE(PG8_SB(1, 0), cB + kstep, voffB); PG8_STAGE(PG8_SA(1, 0), cA + kstep, voffA); PG8_STAGE(PG8_SB(1, 1), cB + hstep + kstep, voffB);
        PG8_WAIT_V(6); PG8_BAR;
    }
    for (;;) {
        const bool has_next = S.next(ui + 1, nxt);
        const char* nA = has_next ? (const char*)g.A + (size_t)nxt.pm * tstep + (size_t)nxt.k0 * kstep : cA; const char* nB = has_next ? (const char*)g.Bt + (size_t)nxt.pn * tstep + (size_t)nxt.k0 * kstep : cB;
        const int nt = cur.nkt;
        for (int t = 0; t < nt; t += 2) {
            const bool last = (t == nt - 2);
            const char* a1 = cA + (size_t)(t + 1) * kstep;
            const char* a2 = last ? nA : cA + (size_t)(t + 2) * kstep; const char* b2 = last ? nB : cB + (size_t)(t + 2) * kstep;
            const char* a3 = a2 + kstep; const char* b3 = b2 + kstep;
            if (last && has_next) S.a_ready(nxt);
            if constexpr (SP2) {
            PG8_LDB(B0, 0, 0); PG8_LDB(B1, 0, 1); PG8_SCHED; PG8_LDA(At, 0, 0); PG8_STAGE(PG8_SA(1, 1), a1 + hstep, voffA);
            PG8_WAIT_V(8); PG8_WAIT_L(0); PG8_BAR; PG8_MMA(0, 0, At, B0); PG8_MMA(0, 1, At, B1); PG8_BAR; PG8_SCHED;
            PG8_LDA(At, 0, 1); PG8_STAGE(PG8_SB(0, 0), b2, voffB); PG8_STAGE(PG8_SB(0, 1), b2 + hstep, voffB); PG8_STAGE(PG8_SA(0, 0), a2, voffA);
            PG8_WAIT_V(8); PG8_WAIT_L(0); PG8_BAR; PG8_MMA(1, 0, At, B0); PG8_MMA(1, 1, At, B1); PG8_BAR; PG8_SCHED;
            PG8_LDB(B0, 1, 0); PG8_LDB(B1, 1, 1); PG8_SCHED; PG8_LDA(At, 1, 0); PG8_STAGE(PG8_SA(0, 1), a2 + hstep, voffA);
            PG8_WAIT_V(8); PG8_WAIT_L(0); PG8_BAR; PG8_MMA(0, 0, At, B0); PG8_MMA(0, 1, At, B1); PG8_BAR; PG8_SCHED;
            PG8_LDA(At, 1, 1); PG8_STAGE(PG8_SB(1, 0), b3, voffB); PG8_STAGE(PG8_SB(1, 1), b3 + hstep, voffB); PG8_STAGE(PG8_SA(1, 0), a3, voffA);
            PG8_WAIT_V(8); PG8_WAIT_L(0); PG8_BAR; PG8_MMA(1, 0, At, B0); PG8_MMA(1, 1, At, B1); PG8_BAR; PG8_SCHED;
            } else {
            PG8_LDB(B0, 0, 0); PG8_SCHED; PG8_LDA(At, 0, 0); PG8_STAGE(PG8_SA(1, 1), a1 + hstep, voffA);
            PG8_WAIT_L(8); PG8_BAR; PG8_WAIT_L(0); PG8_MMA(0, 0, At, B0); PG8_BAR; PG8_SCHED;
            PG8_LDB(B1, 0, 1); PG8_STAGE(PG8_SB(0, 0), b2, voffB);
            PG8_BAR; PG8_WAIT_L(0); PG8_MMA(0, 1, At, B1); PG8_BAR;
            PG8_LDA(At, 0, 1); PG8_STAGE(PG8_SA(0, 0), a2, voffA);
            PG8_BAR; PG8_WAIT_L(0); PG8_MMA(1, 0, At, B0); PG8_BAR; PG8_SCHED;
            PG8_STAGE(PG8_SB(0, 1), b2 + hstep, voffB);
            PG8_WAIT_V(6); PG8_BAR; PG8_MMA(1, 1, At, B1); PG8_BAR;
            PG8_LDB(B0, 1, 0); PG8_SCHED; PG8_LDA(At, 1, 0); PG8_STAGE(PG8_SA(0, 1), a2 + hstep, voffA);
            PG8_WAIT_L(8); PG8_BAR; PG8_WAIT_L(0); PG8_MMA(0, 0, At, B0); PG8_BAR; PG8_SCHED;
            PG8_LDB(B1, 1, 1); PG8_STAGE(PG8_SB(1, 0), b3, voffB);
            PG8_BAR; PG8_WAIT_L(0); PG8_MMA(0, 1, At, B1); PG8_BAR;
            PG8_LDA(At, 1, 1); PG8_STAGE(PG8_SA(1, 0), a3, voffA);
            PG8_BAR; PG8_WAIT_L(0); PG8_MMA(1, 0, At, B0); PG8_BAR; PG8_SCHED;
            PG8_STAGE(PG8_SB(1, 1), b3 + hstep, voffB);
            PG8_WAIT_V(6); PG8_BAR; PG8_MMA(1, 1, At, B1); PG8_BAR;
            }
        }
        if constexpr (ALIGN_EPI) { if (wr == 0) PG8_BAR; }
        if constexpr (!Epi::AFTER_DRAIN) { E(acc, cur, wr, wc, fr, fq); S.done(cur); }
        if (!has_next) break;
#pragma unroll
        for (int a = 0; a < 2; ++a)
#pragma unroll
            for (int b = 0; b < 2; ++b)
#pragma unroll
                for (int m = 0; m < 4; ++m)
#pragma unroll
                    for (int n = 0; n < 2; ++n) acc[a][b][m][n] = (f32x4){0.f, 0.f, 0.f, 0.f};
        cur = nxt; cA = nA; cB = nB; ++ui;
        if constexpr (ALIGN_EPI) { if (wr == 1) PG8_BAR; }
    }
    PG8_WAIT_V(0);
    if constexpr (!ALIGN_EPI) { if (wr == 0) PG8_BAR; }
    PG8_BAR;
    if constexpr (Epi::AFTER_DRAIN) { E.fused(acc, cur, wr, wc, fr, fq, lds, wid, lane); S.done(cur); }
#undef PG8_SA
#undef PG8_SB
#undef PG8_STAGE
#undef PG8_LDA
#undef PG8_LDB
#undef PG8_MMA
#undef PG8_WAIT_V
#undef PG8_WAIT_L
#undef PG8_BAR
#undef PG8_SCHED
}
}

#define LAS __attribute__((address_space(3)))
typedef unsigned short bf16;
typedef short bf16x8 __attribute__((ext_vector_type(8)));
typedef short s16x4 __attribute__((ext_vector_type(4)));
typedef float f32x4 __attribute__((ext_vector_type(4)));
typedef float f32x2 __attribute__((ext_vector_type(2)));
typedef float f32x16 __attribute__((ext_vector_type(16)));
typedef unsigned u32x4 __attribute__((ext_vector_type(4)));
typedef unsigned u32x2 __attribute__((ext_vector_type(2)));

constexpr int DM = 1024, SEQ = 2048, NBP = 8, DSEQ = 64, NBS = 32, PAST = 4096;
constexpr int TP = NBP * SEQ, TS = NBS * DSEQ, TOK = TP + TS;
constexpr int NPAST = NBS * PAST;
constexpr int KVS = PAST + DSEQ;
constexpr int DIN = 2216, NZ = 2304, ZW = 640;
constexpr int DFF = 2816, DFF2 = 5632;
constexpr float LOG2E = 1.4426950408889634f;
constexpr float EPS = 1e-6f;
constexpr int NTHREADS = 512, NWAVES = 8;
constexpr int LDS_BYTES = 147456;

constexpr size_t O_YP = 0, O_YS = O_YP + (size_t)TP * DM, O_KP = O_YS + (size_t)TS * DM, O_VP = O_KP + (size_t)TP * 512, O_LFP = O_VP + (size_t)TP * 512,
                 O_LATP = O_LFP + (size_t)TP * 8, O_KRP = O_LATP + (size_t)TP * 256, O_CVP = O_KRP + (size_t)TP * 32, O_KS = O_CVP + (size_t)NBP * 2 * DFF2,
                 O_VS = O_KS + (size_t)TS * 512, O_LFS = O_VS + (size_t)TS * 512, O_LATS = O_LFS + (size_t)TS * 8, O_KRS = O_LATS + (size_t)TS * 256,
                 O_CVS = O_KRS + (size_t)TS * 32, O_END = O_CVS + (size_t)NBS * 2 * DFF2;

constexpr size_t MiB = 1u << 20;
constexpr size_t WS_CTL = 0, CTL_BYTES = 16384;
constexpr size_t WS_WIN = 1 * MiB, WS_WQ = 6 * MiB, WS_WKV = 7 * MiB, WS_WOUT = 8 * MiB, WS_WUP = 10 * MiB, WS_WDOWN = 21 * MiB, WS_CS = 27 * MiB,
                 WS_FS = 28 * MiB, WS_FP = 33 * MiB, WS_H = 34 * MiB, WS_QFOX = 70 * MiB, WS_KNEW = 88 * MiB, WS_VNEW = 106 * MiB, WS_ZBUF = 124 * MiB,
                 WS_QCN = 169 * MiB, WS_LATNEW = 183 * MiB, WS_KRNEW = 192 * MiB, WS_QMLA = 194 * MiB, WS_KVNEW = 221 * MiB, WS_MIXED = 257 * MiB,
                 WS_X1 = 293 * MiB, WS_X2 = 124 * MiB  , WS_LATPAST = 365 * MiB, WS_KRPAST = 429 * MiB, WS_KPAST = 437 * MiB,
                 WS_VPAST = 565 * MiB, WS_SLAB = 565 * MiB  , WS_KVPAST = 693 * MiB, WS_EDGE = 693 * MiB  , WS_ACT = 437 * MiB  , WS_WQA = 949 * MiB, WS_QLAT = 951 * MiB, WS_ROWSS = 959 * MiB  , WS_RSTD = 960 * MiB + 512 * 1024  , WS_END = 961 * MiB;

struct Args {
    const float* in[23];
    float* out;
    unsigned char* ws;
};

__device__ __forceinline__ unsigned pk2(float lo, float hi) { typedef __bf16 bf2 __attribute__((ext_vector_type(2))); f32x2 v = {lo, hi}; bf2 b = __builtin_convertvector(v, bf2); return __builtin_bit_cast(unsigned, b); }
__device__ __forceinline__ float bflo(unsigned w) { return __builtin_bit_cast(float, w << 16); }
__device__ __forceinline__ float bfhi(unsigned w) { return __builtin_bit_cast(float, w & 0xffff0000u); }
__device__ __forceinline__ float wave_sum(float v) {
#pragma unroll
    for (int o = 1; o < 64; o <<= 1) v += __shfl_xor(v, o);
    return v;
}
__device__ __forceinline__ void st_bf4(bf16* p, f32x4 v) { *(u32x2*)p = (u32x2){pk2(v.x, v.y), pk2(v.z, v.w)}; }
__device__ __forceinline__ void lds_wait() { asm volatile("s_waitcnt lgkmcnt(0)" ::: "memory"); }
__device__ __forceinline__ float fast_exp2(float x) { return __builtin_amdgcn_exp2f(x); }

#define XB_TMO      128
#define XB_XCNT(j)  (256  + 64 * (j))
#define XB_XSUB(j)  (1280 + 64 * (j))
#define XB_XGEN(j)  (2304 + 64 * (j))
#define XB_TOP      3328
#define XB_TOPGEN   3392
#define XCD_BAR_WORDS 3456
#define XB_SPIN_CAP (1u << 18)

__device__ __forceinline__ unsigned xb_ld(unsigned* p)              { return __hip_atomic_load(p, __ATOMIC_RELAXED, __HIP_MEMORY_SCOPE_AGENT); }
__device__ __forceinline__ unsigned xb_add(unsigned* p, unsigned v) { return __hip_atomic_fetch_add(p, v, __ATOMIC_RELAXED, __HIP_MEMORY_SCOPE_AGENT); }
__device__ __forceinline__ unsigned xb_xcc_id() { return (unsigned)__builtin_amdgcn_s_getreg((3 << 11) | 20) & 0xFu; }
#define XB_SPIN(cond, bar) do { unsigned _sp = 0; while (cond) { __builtin_amdgcn_s_sleep(1); \
    if ((++_sp & 255u) == 0u) { if (xb_ld(&(bar)[XB_TMO])) break; if (_sp > XB_SPIN_CAP) { atomicAdd(&(bar)[XB_TMO], 1u); break; } } } } while (0)

struct XcdBarrier {
    unsigned* bar; unsigned x;
    volatile LAS unsigned* st;
};

__device__ __forceinline__ XcdBarrier xcd_barrier_post(unsigned* bar, volatile LAS unsigned* st) {
    XcdBarrier b; b.bar = bar; b.x = xb_xcc_id(); b.st = st;
    if (threadIdx.x == 0) (void)xb_add(&bar[XB_XCNT(b.x)], 1u);
    return b;
}
__device__ __forceinline__ void xcd_barrier_complete(unsigned* bar, unsigned x, unsigned& nloc, unsigned& nx) {
    const unsigned G = gridDim.x * gridDim.y * gridDim.z;
    unsigned sum, cnt, mine, sp = 0u;
    for (;;) {
        sum = 0u; cnt = 0u; mine = 0u;
#pragma unroll
        for (unsigned j = 0; j < 16; ++j) { const unsigned c = xb_ld(&bar[XB_XCNT(j)]); sum += c; cnt += (c > 0u) ? 1u : 0u; mine = (j == x) ? c : mine; }
        if (sum == G) break;
        __builtin_amdgcn_s_sleep(1);
        if ((++sp & 255u) == 0u) { if (xb_ld(&bar[XB_TMO])) break; if (sp > XB_SPIN_CAP) { atomicAdd(&bar[XB_TMO], 1u); break; } }
    }
    nloc = mine > 0u ? mine : 1u; nx = cnt > 0u ? cnt : 1u;
}

__device__ __forceinline__ void xcd_barrier(const XcdBarrier& b) {
    asm volatile("s_waitcnt vmcnt(0)" ::: "memory");
    __syncthreads();
    if (threadIdx.x == 0) {
        unsigned* bar = b.bar;
        __builtin_amdgcn_s_waitcnt(0);
        unsigned nloc = b.st[0], nx = b.st[1];
        if (nloc == 0u) { xcd_barrier_complete(bar, b.x, nloc, nx); b.st[0] = nloc; b.st[1] = nx; }
        const unsigned old = xb_add(&bar[XB_XSUB(b.x)], 1u);
        const unsigned gen = old / nloc;
        if (old + 1u == (gen + 1u) * nloc) {
            __builtin_amdgcn_fence(__ATOMIC_RELEASE, "agent");
            asm volatile("s_waitcnt vmcnt(0)" ::: "memory");
            const unsigned og = xb_add(&bar[XB_TOP], 1u);
            const unsigned tg = og / nx;
            if (og + 1u == (tg + 1u) * nx) xb_add(&bar[XB_TOPGEN], 1u);
            else XB_SPIN(xb_ld(&bar[XB_TOPGEN]) == tg, bar);
            __builtin_amdgcn_fence(__ATOMIC_ACQUIRE, "agent");
            xb_add(&bar[XB_XGEN(b.x)], 1u);
            asm volatile("s_waitcnt vmcnt(0)" ::: "memory");
        } else {
            XB_SPIN(xb_ld(&bar[XB_XGEN(b.x)]) == gen, bar);
            __builtin_amdgcn_fence(__ATOMIC_ACQUIRE, "agent");
            asm volatile("s_waitcnt vmcnt(0)" ::: "memory");
        }
    }
    __syncthreads();
}

template <int MODE> __device__ __forceinline__ int srccol(int n) {
    if (MODE == 0) return n;
    if (MODE == 2) return ((n & 16) ? DFF : 0) + 16 * (n >> 5) + (n & 15);
    if (n < 1536) return n;
    if (n < 1920) return 1544 + (n - 1536);
    if (n < 2176) return 1928 + (n - 1920);
    if (n < 2208) return 2184 + (n - 2176);
    if (n < 2216) return 1536 + (n - 2208);
    return -1;
}
template <int MODE>
__device__ __forceinline__ void tr_item(const float* W, int K, int Nsrc, int Ndst, bf16* WT, int row_off, LAS float* scr, int item, int lane) {
    const int nblk = Ndst / 32, kb = item / nblk, nb = item % nblk, k0 = 64 * kb, n0 = 32 * nb;
    const int sc = srccol<MODE>(n0 + (lane & 31));
    float wv[32];
#pragma unroll
    for (int i = 0; i < 32; ++i) { const int kk = 2 * i + (lane >> 5); wv[i] = W[(size_t)(k0 + kk) * Nsrc + (sc >= 0 ? sc : 0)]; }
#pragma unroll
    for (int i = 0; i < 32; ++i) { const int kk = 2 * i + (lane >> 5); scr[kk * 33 + (lane & 31)] = sc >= 0 ? wv[i] : 0.f; }
    lds_wait();
    const int c = lane & 7;
#pragma unroll
    for (int j = 0; j < 4; ++j) { const int n = (lane >> 3) + 8 * j; const LAS float* s = scr + (8 * c) * 33 + n;
        u32x4 o; o.x = pk2(s[0 * 33], s[1 * 33]); o.y = pk2(s[2 * 33], s[3 * 33]); o.z = pk2(s[4 * 33], s[5 * 33]); o.w = pk2(s[6 * 33], s[7 * 33]);
        *(u32x4*)(WT + (size_t)(row_off + n0 + n) * K + k0 + 8 * c) = o; }
    lds_wait();
}
template <bool OUTF>
__device__ __forceinline__ void rms_row(const float* xrow, const float* g, void* orow, int lane, const float* slab = nullptr, int nslab = 0, size_t slab_stride = 0) {
    const f32x4* xr = (const f32x4*)xrow + lane; const f32x4* gr = (const f32x4*)g + lane;
    f32x4 v[4]; float s = 0.f;
#pragma unroll
    for (int j = 0; j < 4; ++j) v[j] = xr[64 * j];
    for (int k = 0; k < nslab; ++k) { const f32x4* sr = (const f32x4*)(slab + (size_t)k * slab_stride) + lane;
#pragma unroll
        for (int j = 0; j < 4; ++j) v[j] += sr[64 * j]; }
#pragma unroll
    for (int j = 0; j < 4; ++j) { s += (v[j].x * v[j].x + v[j].y * v[j].y) + (v[j].z * v[j].z + v[j].w * v[j].w); }
    const float rstd = rsqrtf(wave_sum(s) * (1.f / DM) + EPS);
#pragma unroll
    for (int j = 0; j < 4; ++j) { const f32x4 gv = gr[64 * j]; const f32x4 o = v[j] * rstd * gv;
        if (OUTF) ((f32x4*)orow)[64 * j + lane] = o;
        else ((u32x2*)orow)[64 * j + lane] = (u32x2){pk2(o.x, o.y), pk2(o.z, o.w)}; }
}
__device__ __forceinline__ void rms_row3(const float* x0, const float* x1, const float* x2, const float* g, bf16* o0, bf16* o1, bf16* o2, int lane) {
    const f32x4* xp[3] = {(const f32x4*)x0 + lane, (const f32x4*)x1 + lane, (const f32x4*)x2 + lane}; bf16* op[3] = {o0, o1, o2};
    f32x4 v[3][4]; float ss[3];
#pragma unroll
    for (int u = 0; u < 3; ++u)
#pragma unroll
        for (int j = 0; j < 4; ++j) v[u][j] = xp[u][64 * j];
#pragma unroll
    for (int u = 0; u < 3; ++u) { ss[u] = 0.f;
#pragma unroll
        for (int j = 0; j < 4; ++j) ss[u] += (v[u][j].x * v[u][j].x + v[u][j].y * v[u][j].y) + (v[u][j].z * v[u][j].z + v[u][j].w * v[u][j].w); }
#pragma unroll
    for (int o = 1; o < 64; o <<= 1) {
#pragma unroll
        for (int u = 0; u < 3; ++u) ss[u] += __shfl_xor(ss[u], o); }
#pragma unroll
    for (int j = 0; j < 4; ++j) { const f32x4 gv = ((const f32x4*)g)[64 * j + lane];
#pragma unroll
        for (int u = 0; u < 3; ++u) { const f32x4 o = v[u][j] * rsqrtf(ss[u] * (1.f / DM) + EPS) * gv; ((u32x2*)op[u])[64 * j + lane] = (u32x2){pk2(o.x, o.y), pk2(o.z, o.w)}; } }
}
__device__ __forceinline__ void cvt_stream(const float* src, bf16* dst, size_t n4, size_t gtid, size_t gthreads) {
    size_t i = gtid;
    for (; i + 7 * gthreads < n4; i += 8 * gthreads) {
        f32x4 v[8];
#pragma unroll
        for (int k = 0; k < 8; ++k) v[k] = __builtin_nontemporal_load((const f32x4*)src + i + k * gthreads);
#pragma unroll
        for (int k = 0; k < 8; ++k) ((u32x2*)dst)[i + k * gthreads] = (u32x2){pk2(v[k].x, v[k].y), pk2(v[k].z, v[k].w)};
    }
    for (; i < n4; i += gthreads) { const f32x4 v = ((const f32x4*)src)[i]; ((u32x2*)dst)[i] = (u32x2){pk2(v.x, v.y), pk2(v.z, v.w)}; }
}
__device__ __forceinline__ float wave_incl_scan(float v, int lane) {
#pragma unroll
    for (int o = 1; o < 64; o <<= 1) { const float t = __shfl_up(v, o); if (lane >= o) v += t; }
    return v;
}

template <int NCH>
__device__ __forceinline__ void scan_seq(const float* src, float* dst, float base, int lane, LAS float* scr) {
    float v[NCH];
#pragma unroll
    for (int c = 0; c < NCH; ++c) v[c] = src[(size_t)(64 * c + lane) * 8];
#pragma unroll
    for (int c = 0; c < NCH; ++c) { v[c] = wave_incl_scan(v[c], lane); if (lane == 63) scr[c] = v[c]; }
    lds_wait();
    const float st = wave_incl_scan(lane < NCH ? scr[lane] : 0.f, lane);
    lds_wait();
#pragma unroll
    for (int c = 0; c < NCH; ++c) { const float carry = c ? __builtin_bit_cast(float, __builtin_amdgcn_readlane(__builtin_bit_cast(int, st), c ? c - 1 : 0)) : 0.f; dst[64 * c + lane] = (v[c] + carry + base) * LOG2E; }
}
__device__ __forceinline__ void p0_prologue(const Args& A, LAS unsigned char* lds) {
    const int tid = threadIdx.x, lane = tid & 63, wave = tid >> 6;
    const int G = gridDim.x, gw = blockIdx.x * NWAVES + wave, NGW = G * NWAVES;
    unsigned char* ws = A.ws;
    LAS float* scr = (LAS float*)(lds + wave * 16384);
    constexpr int I_IN = (DM / 64) * (NZ / 32), I_Q = (384 / 64) * (768 / 32), I_UK = (256 / 64) * (512 / 32), I_OUT = (DM / 64) * (DM / 32),
                  I_UP = (DM / 64) * (DFF2 / 32), I_DN = (DFF / 64) * (DM / 32);
    constexpr int NITEMS = I_IN + I_Q + 2 * I_UK + I_OUT + I_UP + I_DN;
    for (int it = gw; it < NITEMS; it += NGW) {
        int r = it;
        if (r < I_IN) { tr_item<1>(A.in[9], DM, DIN, NZ, (bf16*)(ws + WS_WIN), 0, scr, r, lane); continue; } r -= I_IN;
        if (r < I_Q) { tr_item<0>(A.in[12], 384, 768, 768, (bf16*)(ws + WS_WQ), 0, scr, r, lane); continue; } r -= I_Q;
        if (r < I_UK) { tr_item<0>(A.in[14], 256, 512, 512, (bf16*)(ws + WS_WKV), 0, scr, r, lane); continue; } r -= I_UK;
        if (r < I_UK) { tr_item<0>(A.in[15], 256, 512, 512, (bf16*)(ws + WS_WKV), 512, scr, r, lane); continue; } r -= I_UK;
        if (r < I_OUT) { tr_item<0>(A.in[16], DM, DM, DM, (bf16*)(ws + WS_WOUT), 0, scr, r, lane); continue; } r -= I_OUT;
        if (r < I_UP) { tr_item<2>(A.in[18], DM, DFF2, DFF2, (bf16*)(ws + WS_WUP), 0, scr, r, lane); continue; } r -= I_UP;
        tr_item<0>(A.in[21], DFF, DM, DM, (bf16*)(ws + WS_WDOWN), 0, scr, r, lane);
    }
    for (int it = gw; it < 8 * 12 * 8; it += NGW) {
        const int h = it / 96, kt = (it % 96) / 8, ct = it % 8; const int r32 = lane & 31, hi2 = lane >> 5;
        const float* wq = A.in[12] + (size_t)(kt * 32 + r32) * 768 + h * 96 + 8 * hi2; const float* uk = A.in[14] + (size_t)(ct * 32 + r32) * 512 + h * 64 + 8 * hi2;
        f32x16 acc = {};
#pragma unroll
        for (int st = 0; st < 4; ++st) {
            const f32x4 a0 = *(const f32x4*)(wq + 16 * st), a1 = *(const f32x4*)(wq + 16 * st + 4), b0 = *(const f32x4*)(uk + 16 * st), b1 = *(const f32x4*)(uk + 16 * st + 4);
            const u32x4 aw = {pk2(a0.x, a0.y), pk2(a0.z, a0.w), pk2(a1.x, a1.y), pk2(a1.z, a1.w)}, bw = {pk2(b0.x, b0.y), pk2(b0.z, b0.w), pk2(b1.x, b1.y), pk2(b1.z, b1.w)};
            acc = __builtin_amdgcn_mfma_f32_32x32x16_bf16(__builtin_bit_cast(bf16x8, aw), __builtin_bit_cast(bf16x8, bw), acc, 0, 0, 0);
        }
        bf16* o = (bf16*)(ws + WS_WQA) + (size_t)(h * 256 + ct * 32 + r32) * 384 + kt * 32 + 4 * hi2;
#pragma unroll
        for (int q = 0; q < 4; ++q) st_bf4(o + 8 * q, (f32x4){acc[4 * q], acc[4 * q + 1], acc[4 * q + 2], acc[4 * q + 3]});
    }
    {
        bf16* H = (bf16*)(ws + WS_H); int m = gw;
        for (; m + 2 * NGW < TOK; m += 3 * NGW) { const int m1 = m + NGW, m2 = m + 2 * NGW;
            rms_row3(m < TP ? A.in[0] + (size_t)m * DM : A.in[1] + (size_t)(m - TP) * DM, m1 < TP ? A.in[0] + (size_t)m1 * DM : A.in[1] + (size_t)(m1 - TP) * DM,
                     m2 < TP ? A.in[0] + (size_t)m2 * DM : A.in[1] + (size_t)(m2 - TP) * DM, A.in[8], H + (size_t)m * DM, H + (size_t)m1 * DM, H + (size_t)m2 * DM, lane); }
        for (; m < TOK; m += NGW) rms_row<false>(m < TP ? A.in[0] + (size_t)m * DM : A.in[1] + (size_t)(m - TP) * DM, A.in[8], H + (size_t)m * DM, lane);
    }
    {
        const int gt = blockIdx.x * NTHREADS + tid, GT = G * NTHREADS;
        for (int i = gt; i < 2112 * 16; i += GT) {
            const int pidx = i >> 4, k = i & 15; const int pos = pidx < 2048 ? pidx : PAST + (pidx - 2048);
            const float inv = exp2f(-(float)k * (13.287712379549449f / 16.f));
            const float ang = (float)pos * inv;
            const float kq = floorf(ang * 0.15915494309189535f);
            float r = fmaf(-kq, 6.2831854820251465f, ang); r = fmaf(-kq, -1.7484555e-7f, r);
            const float rev = r * 0.15915494309189535f;
            ((f32x2*)(ws + WS_CS))[i] = (f32x2){__builtin_amdgcn_cosf(rev), __builtin_amdgcn_sinf(rev)};
        }
    }
    for (int sq = (wave == 0 ? (int)blockIdx.x : NBS * 8); sq < NBS * 8; sq += G) {
        const int b = sq >> 3, h = sq & 7; const float* lf = A.in[4] + (size_t)b * PAST * 8 + h; float* Fo = (float*)(ws + WS_FS) + (size_t)sq * KVS;
        scan_seq<PAST / 64>(lf, Fo, 0.f, lane, scr);
    }
    {
        const size_t gt = (size_t)blockIdx.x * NTHREADS + tid, GT = (size_t)G * NTHREADS;
        cvt_stream(A.in[5], (bf16*)(ws + WS_LATPAST), (size_t)NPAST * 256 / 4, gt, GT);
        cvt_stream(A.in[6], (bf16*)(ws + WS_KRPAST), (size_t)NPAST * 32 / 4, gt, GT);
    }
}

__device__ __forceinline__ void rope4(f32x4& x1, f32x4& x2, const float* cs  ) {
    const f32x4 a = ((const f32x4*)cs)[0], b = ((const f32x4*)cs)[1];
    const f32x4 c = {a.x, a.z, b.x, b.z}, s = {a.y, a.w, b.y, b.w};
    const f32x4 o1 = x1 * c - x2 * s, o2 = x1 * s + x2 * c; x1 = o1; x2 = o2;
}
__device__ __forceinline__ float log_sigmoid(float x) { return fminf(x, 0.f) - log1pf(__expf(-fabsf(x))); }

struct EpiZ {
    static constexpr bool PERM = false, AFTER_DRAIN = false;
    bf16 *qfox, *knew, *vnew, *krnew; float* zbuf; float* out; const float* cs; const float* bfg;
    __device__ __forceinline__ void operator()(const f32x4 (&acc)[2][2][4][2], const pg8::Unit& u, int wr, int wc, int fr, int fq) const {
        const bool smp = u.pm >= TP / 256;
        const int row0 = u.pm * 256 + wr * 64 + fr;
#pragma unroll
        for (int bj = 0; bj < 2; ++bj) {
            const int cg = u.pn * 256 + bj * 128 + wc * 32;
            const int c0 = cg + 4 * fq;
#pragma unroll
            for (int ai = 0; ai < 2; ++ai)
#pragma unroll
                for (int m = 0; m < 4; ++m) {
                    const int row = row0 + ai * 128 + m * 16; const size_t lr = smp ? (size_t)(row - TP) : (size_t)row;
                    f32x4 v0 = acc[ai][bj][m][0], v1 = acc[ai][bj][m][1];
                    if (cg < 512) { const float sc = 0.125f * LOG2E; st_bf4(qfox + (size_t)row * 512 + c0, v0 * sc); st_bf4(qfox + (size_t)row * 512 + c0 + 16, v1 * sc); }
                    else if (cg < 1024) { const int c = c0 - 512; float* o = out + (smp ? O_KS : O_KP) + lr * 512 + c; *(f32x4*)o = v0; *(f32x4*)(o + 16) = v1;
                        st_bf4(knew + (size_t)row * 512 + c, v0); st_bf4(knew + (size_t)row * 512 + c + 16, v1); }
                    else if (cg < 1536) { const int c = c0 - 1024; float* o = out + (smp ? O_VS : O_VP) + lr * 512 + c; *(f32x4*)o = v0; *(f32x4*)(o + 16) = v1;
                        st_bf4(vnew + (size_t)row * 512 + c, v0); st_bf4(vnew + (size_t)row * 512 + c + 16, v1); }
                    else if (cg < 2176) { float* z = zbuf + (size_t)row * ZW + (c0 - 1536); *(f32x4*)z = v0; *(f32x4*)(z + 16) = v1; }
                    else if (cg == 2176) {
                        const int pidx = smp ? 2048 + ((row - TP) & 63) : (row & 2047);
                        rope4(v0, v1, cs + ((size_t)pidx * 16 + 4 * fq) * 2);
                        float* o = out + (smp ? O_KRS : O_KRP) + lr * 32 + 4 * fq; *(f32x4*)o = v0; *(f32x4*)(o + 16) = v1;
                        st_bf4(krnew + (size_t)row * 32 + 4 * fq, v0); st_bf4(krnew + (size_t)row * 32 + 4 * fq + 16, v1);
                    } else if (cg == 2208) {
                        if (fq < 2) { const f32x4 b = *(const f32x4*)(bfg + 4 * fq);
                            f32x4 lf; lf.x = log_sigmoid(v0.x + b.x); lf.y = log_sigmoid(v0.y + b.y); lf.z = log_sigmoid(v0.z + b.z); lf.w = log_sigmoid(v0.w + b.w);
                            *(f32x4*)(out + (smp ? O_LFS : O_LFP) + lr * 8 + 4 * fq) = lf; }
                    }
                }
        }
    }
};
struct EpiBf {
    static constexpr bool PERM = true, AFTER_DRAIN = false;
    bf16* O; int ldc; float sc;
    __device__ __forceinline__ void operator()(const f32x4 (&acc)[2][2][4][2], const pg8::Unit& u, int wr, int wc, int fr, int fq) const {
        const int row0 = u.pm * 256 + wr * 64 + fr;
#pragma unroll
        for (int ai = 0; ai < 2; ++ai)
#pragma unroll
            for (int m = 0; m < 4; ++m) { bf16* rp = O + (size_t)(row0 + ai * 128 + m * 16) * ldc + u.pn * 256 + wc * 32 + 8 * fq;
#pragma unroll
                for (int bj = 0; bj < 2; ++bj) { const f32x4 v0 = acc[ai][bj][m][0] * sc, v1 = acc[ai][bj][m][1] * sc;
                    *(u32x4*)(rp + bj * 128) = (u32x4){pk2(v0.x, v0.y), pk2(v0.z, v0.w), pk2(v1.x, v1.y), pk2(v1.z, v1.w)}; } }
    }
};
constexpr int DN_SL = 8;
template <int NKT  >
struct SplitOrder {
    int G, c;
    __device__ __forceinline__ bool next(int i, pg8::Unit& u) const {
        const int L = i * G + c; if (L >= 256 + 32 * DN_SL) return false;
        const bool full = L < 256; const int r = full ? L : L - 256, x = r & 7, y = r >> 3;
        pg8::Unit t; t.pm = full ? 8 * x + (y & 7) : 64 + x; t.pn = full ? (y >> 3) : (y & 3); const int sl = y >> 2;
        if (NKT == 44) { t.k0 = full ? 0 : (sl < 6 ? 6 * sl : 36 + 4 * (sl - 6)); t.nkt = full ? 44 : (sl < 6 ? 6 : 4); }
        else { t.k0 = full ? 0 : 2 * sl; t.nkt = full ? 16 : 2; }
        t.sl = full ? -1 : sl;
        u = t; return true;
    }
    __device__ __forceinline__ void a_ready(const pg8::Unit&) const {}
    __device__ __forceinline__ void done(const pg8::Unit&) const {}
};
typedef SplitOrder<44> DownOrder;
struct EpiDown {
    static constexpr bool PERM = false, AFTER_DRAIN = false;
    const float* x1; float* x2; float* slab;
    __device__ __forceinline__ void operator()(const f32x4 (&acc)[2][2][4][2], const pg8::Unit& u, int wr, int wc, int fr, int fq) const {
        const int row0 = u.pm * 256 + wr * 64 + fr; const int cb = u.pn * 256 + wc * 32 + 4 * fq;
        if (u.sl >= 0) {
#pragma unroll
            for (int ai = 0; ai < 2; ++ai)
#pragma unroll
                for (int m = 0; m < 4; ++m) { float* op = slab + ((size_t)u.sl * TS + (row0 + ai * 128 + m * 16 - TP)) * DM + cb;
#pragma unroll
                    for (int bj = 0; bj < 2; ++bj)
#pragma unroll
                        for (int n = 0; n < 2; ++n) *(f32x4*)(op + bj * 128 + n * 16) = acc[ai][bj][m][n]; }
            return;
        }
#pragma unroll
        for (int ai = 0; ai < 2; ++ai) {
            f32x4 xb[4][2][2];
#pragma unroll
            for (int m = 0; m < 4; ++m) { const float* bp = x1 + (size_t)(row0 + ai * 128 + m * 16) * DM + cb;
#pragma unroll
                for (int bj = 0; bj < 2; ++bj)
#pragma unroll
                    for (int n = 0; n < 2; ++n) xb[m][bj][n] = *(const f32x4*)(bp + bj * 128 + n * 16); }
#pragma unroll
            for (int m = 0; m < 4; ++m) { float* op = x2 + (size_t)(row0 + ai * 128 + m * 16) * DM + cb;
#pragma unroll
                for (int bj = 0; bj < 2; ++bj)
#pragma unroll
                    for (int n = 0; n < 2; ++n) *(f32x4*)(op + bj * 128 + n * 16) = xb[m][bj][n] + acc[ai][bj][m][n]; }
        }
    }
};
struct EpiOut {
    static constexpr bool PERM = false, AFTER_DRAIN = false;
    const float* b0; const float* b1; float* O; bf16* H; const float* g; float* rowss; float* slab;
    __device__ __forceinline__ void operator()(const f32x4 (&acc)[2][2][4][2], const pg8::Unit& u, int wr, int wc, int fr, int fq) const {
        const int row0 = u.pm * 256 + wr * 64 + fr; const bool smp = u.pm >= TP / 256; const int cb = u.pn * 256 + wc * 32 + 4 * fq;
        if (u.sl >= 0) {
#pragma unroll
            for (int ai = 0; ai < 2; ++ai)
#pragma unroll
                for (int m = 0; m < 4; ++m) { float* sp = slab + ((size_t)u.sl * TS + (row0 + ai * 128 + m * 16 - TP)) * DM + cb;
#pragma unroll
                    for (int bj = 0; bj < 2; ++bj)
#pragma unroll
                        for (int n = 0; n < 2; ++n) *(f32x4*)(sp + bj * 128 + n * 16) = acc[ai][bj][m][n]; }
            return;
        }
        f32x4 gv[2][2];
#pragma unroll
        for (int bj = 0; bj < 2; ++bj)
#pragma unroll
            for (int n = 0; n < 2; ++n) gv[bj][n] = *(const f32x4*)(g + cb + bj * 128 + n * 16);
#pragma unroll
        for (int aim = 0; aim < 4; ++aim) { const int ai = aim >> 1, mb = (aim & 1) * 2;
            f32x4 xb[2][2][2];
#pragma unroll
            for (int mm = 0; mm < 2; ++mm) { const int row = row0 + ai * 128 + (mb + mm) * 16; const float* bp = (smp ? b1 + (size_t)(row - TP) * DM : b0 + (size_t)row * DM) + cb;
#pragma unroll
                for (int bj = 0; bj < 2; ++bj)
#pragma unroll
                    for (int n = 0; n < 2; ++n) xb[mm][bj][n] = *(const f32x4*)(bp + bj * 128 + n * 16); }
#pragma unroll
            for (int mm = 0; mm < 2; ++mm) { const int m = mb + mm; const int row = row0 + ai * 128 + m * 16; float* op = O + (size_t)row * DM + cb; bf16* hp = H + (size_t)row * DM + cb;
                float ss = 0.f;
#pragma unroll
                for (int bj = 0; bj < 2; ++bj)
#pragma unroll
                    for (int n = 0; n < 2; ++n) { const f32x4 x = xb[mm][bj][n] + acc[ai][bj][m][n]; *(f32x4*)(op + bj * 128 + n * 16) = x;
                        ss += (x.x * x.x + x.y * x.y) + (x.z * x.z + x.w * x.w); st_bf4(hp + bj * 128 + n * 16, x * gv[bj][n]); }
                ss += __shfl_xor(ss, 16); ss += __shfl_xor(ss, 32);
                if (fq == 0) rowss[(size_t)row * 16 + u.pn * 4 + wc] = ss;
            }
        }
    }
};
struct EpiRes {
    static constexpr bool PERM = false, AFTER_DRAIN = false;
    const float* b0; const float* b1; float* O;
    __device__ __forceinline__ void operator()(const f32x4 (&acc)[2][2][4][2], const pg8::Unit& u, int wr, int wc, int fr, int fq) const {
        const int row0 = u.pm * 256 + wr * 64 + fr; const bool smp = u.pm >= TP / 256;
#pragma unroll
        for (int ai = 0; ai < 2; ++ai)
#pragma unroll
            for (int m = 0; m < 4; ++m) { const int row = row0 + ai * 128 + m * 16; const int cb = u.pn * 256 + wc * 32 + 4 * fq;
                const float* bp = (smp ? b1 + (size_t)(row - TP) * DM : b0 + (size_t)row * DM) + cb; float* op = O + (size_t)row * DM + cb;
#pragma unroll
                for (int bj = 0; bj < 2; ++bj)
#pragma unroll
                    for (int n = 0; n < 2; ++n) *(f32x4*)(op + bj * 128 + n * 16) = *(const f32x4*)(bp + bj * 128 + n * 16) + acc[ai][bj][m][n]; }
    }
};


__device__ __forceinline__ float silu(float g) { return g * __builtin_amdgcn_rcpf(1.f + fast_exp2(-g * LOG2E)); }
template <int CTRL> __device__ __forceinline__ float dpp_mov(float old, float src) {
    return __builtin_bit_cast(float, __builtin_amdgcn_update_dpp(__builtin_bit_cast(int, old), __builtin_bit_cast(int, src), CTRL, 0xf, 0xf, false)); }
__device__ __forceinline__ f32x4 rows_m1(f32x4 cur, f32x4 prev) { f32x4 o;
#pragma unroll
    for (int e = 0; e < 4; ++e) o[e] = dpp_mov<0x111>(dpp_mov<0x121>(0.f, prev[e]), cur[e]);
    return o; }
__device__ __forceinline__ f32x4 rows_m2(f32x4 cur, f32x4 prev) { f32x4 o;
#pragma unroll
    for (int e = 0; e < 4; ++e) o[e] = dpp_mov<0x112>(dpp_mov<0x122>(0.f, prev[e]), cur[e]);
    return o; }
struct EpiGlu {
    static constexpr bool PERM = false, AFTER_DRAIN = false;
    bf16* act; float* edge; const float* cw; const float* cb; const float* rowss;
    __device__ __forceinline__ void operator()(const f32x4 (&acc)[2][2][4][2], const pg8::Unit& u, int wr, int wc, int fr, int fq) const {
        float rstd[2][4];
#pragma unroll
        for (int ai = 0; ai < 2; ++ai)
#pragma unroll
            for (int m = 0; m < 4; ++m) rstd[ai][m] = rowss[u.pm * 256 + ai * 128 + wr * 64 + m * 16 + fr];
#pragma unroll
        for (int bj = 0; bj < 2; ++bj) {
            const int j = 16 * ((u.pn * 256 + bj * 128 + wc * 32) >> 5) + 4 * fq;
            const f32x4 w0g = *(const f32x4*)(cw + j), w1g = *(const f32x4*)(cw + DFF2 + j), w2g = *(const f32x4*)(cw + 2 * DFF2 + j), bg = *(const f32x4*)(cb + j);
            const f32x4 w0v = *(const f32x4*)(cw + DFF + j), w1v = *(const f32x4*)(cw + DFF2 + DFF + j), w2v = *(const f32x4*)(cw + 2 * DFF2 + DFF + j), bv = *(const f32x4*)(cb + DFF + j);
#pragma unroll
            for (int ai = 0; ai < 2; ++ai) {
                const int blk = u.pm * 4 + ai * 2 + wr; const int row0 = blk * 64 + fr;
#pragma unroll
                for (int m = 0; m < 4; ++m) {
                    const f32x4 gc = acc[ai][bj][m][0] * rstd[ai][m], vc = acc[ai][bj][m][1] * rstd[ai][m];
                    const f32x4 gp = acc[ai][bj][m ? m - 1 : 0][0] * rstd[ai][m ? m - 1 : 0], vp = acc[ai][bj][m ? m - 1 : 0][1] * rstd[ai][m ? m - 1 : 0];
                    const f32x4 g1 = rows_m1(gc, gp), g2 = rows_m2(gc, gp), v1 = rows_m1(vc, vp), v2 = rows_m2(vc, vp);
                    const f32x4 g = bg + w0g * g2 + w1g * g1 + w2g * gc, v = bv + w0v * v2 + w1v * v1 + w2v * vc;
                    f32x4 a; a.x = silu(g.x) * v.x; a.y = silu(g.y) * v.y; a.z = silu(g.z) * v.z; a.w = silu(g.w) * v.w;
                    if (m > 0 || fr >= 2) st_bf4(act + (size_t)(row0 + 16 * m) * DFF + j, a);
                    if (m == 0 && fr < 2) { float* e = edge + ((size_t)blk * 4 + fr) * DFF2; *(f32x4*)(e + j) = gc; *(f32x4*)(e + DFF + j) = vc; }
                    if (m == 3 && fr >= 14) { float* e = edge + ((size_t)blk * 4 + 2 + (fr - 14)) * DFF2; *(f32x4*)(e + j) = gc; *(f32x4*)(e + DFF + j) = vc; }
                }
            }
        }
    }
};

__device__ __forceinline__ void p2_postz(const Args& A, LAS unsigned char* lds) {
    const int tid = threadIdx.x, lane = tid & 63, wave = tid >> 6; const int gw = blockIdx.x * NWAVES + wave, NGW = gridDim.x * NWAVES;
    unsigned char* ws = A.ws; const float* zb = (const float*)(ws + WS_ZBUF);
    f32x2 gq[3]; { for (int j = 0; j < 3; ++j) gq[j] = ((const f32x2*)A.in[11])[lane + 64 * j]; }
    const f32x4 gk = ((const f32x4*)A.in[13])[lane];
    for (int m0 = gw; m0 < TOK; m0 += 3 * NGW) {
        f32x2 v[3][3]; f32x4 c[3]; float sq[3], sk[3]; bool ok[3];
#pragma unroll
        for (int u = 0; u < 3; ++u) { const int m = m0 + u * NGW; ok[u] = m < TOK; const float* z = zb + (size_t)(ok[u] ? m : m0) * ZW;
#pragma unroll
            for (int j = 0; j < 3; ++j) v[u][j] = ((const f32x2*)z)[lane + 64 * j];
            c[u] = ((const f32x4*)(z + 384))[lane]; }
#pragma unroll
        for (int u = 0; u < 3; ++u) { sq[u] = 0.f;
#pragma unroll
            for (int j = 0; j < 3; ++j) sq[u] += v[u][j].x * v[u][j].x + v[u][j].y * v[u][j].y;
            sk[u] = (c[u].x * c[u].x + c[u].y * c[u].y) + (c[u].z * c[u].z + c[u].w * c[u].w); }
#pragma unroll
        for (int o = 1; o < 64; o <<= 1) {
#pragma unroll
            for (int u = 0; u < 3; ++u) { sq[u] += __shfl_xor(sq[u], o); sk[u] += __shfl_xor(sk[u], o); } }
#pragma unroll
        for (int u = 0; u < 3; ++u) if (ok[u]) { const int m = m0 + u * NGW;
            const float rq = rsqrtf(sq[u] * (1.f / 384.f) + EPS), rk = rsqrtf(sk[u] * (1.f / 256.f) + EPS);
            unsigned* o = (unsigned*)((bf16*)(ws + WS_QCN) + (size_t)m * 384);
#pragma unroll
            for (int j = 0; j < 3; ++j) o[lane + 64 * j] = pk2(v[u][j].x * rq * gq[j].x, v[u][j].y * rq * gq[j].y);
            const f32x4 ov = c[u] * rk * gk;
            float* op = A.out + (m < TP ? O_LATP + (size_t)m * 256 : O_LATS + (size_t)(m - TP) * 256); ((f32x4*)op)[lane] = ov;
            st_bf4((bf16*)(ws + WS_LATNEW) + (size_t)m * 256 + 4 * lane, ov); }
    }
    for (int sq = ((gw & 3) == 0 ? (gw >> 2) : 64 + 256); sq < 64 + 256; sq += (NGW >> 2)) {
        if (sq < 64) { const int b = sq >> 3, h = sq & 7; const float* lf = A.out + O_LFP + (size_t)b * SEQ * 8 + h; float* Fo = (float*)(ws + WS_FP) + (size_t)sq * SEQ; scan_seq<SEQ / 64>(lf, Fo, 0.f, lane, (LAS float*)(lds + wave * 16384)); }
        else { const int s2 = sq - 64, b = s2 >> 3, h = s2 & 7; const float* lf = A.out + O_LFS + (size_t)b * DSEQ * 8 + h; float* Fo = (float*)(ws + WS_FS) + (size_t)s2 * KVS;
            const float base = Fo[PAST - 1]; const float v = wave_incl_scan(lf[(size_t)lane * 8], lane); Fo[PAST + lane] = base + v * LOG2E; }
    }
}

__device__ __forceinline__ f32x4 ld_bf4(const bf16* p) { const u32x2 w = *(const u32x2*)p; return (f32x4){bflo(w.x), bfhi(w.x), bflo(w.y), bfhi(w.y)}; }
__device__ __forceinline__ void p8_fixup(const Args& A) {
    int tid = threadIdx.x; asm volatile("" : "+v"(tid)); const int lane = tid & 63, wave = tid >> 6; const int gw = blockIdx.x * NWAVES + wave, NGW = gridDim.x * NWAVES;
    unsigned char* ws = A.ws; const float* __restrict__ EDGE = (const float*)(ws + WS_EDGE); bf16* __restrict__ ACT = (bf16*)(ws + WS_ACT);
    const float* __restrict__ cw = A.in[19]; const float* __restrict__ cb = A.in[20];
    constexpr int NBLK = TOK / 64, NSTRIP = DFF / 256, NIT = NBLK * NSTRIP;
    for (int it0 = gw; it0 < NIT; it0 += 2 * NGW) {
        f32x4 wg[2][4], wv[2][4], pg[2][2], pv[2][2], cg[2][2], cv[2][2], sg[2][2], sv[2][2]; bool ok[2], last[2], smp[2]; int j0[2], tok0[2], bb[2];
#pragma unroll
        for (int u = 0; u < 2; ++u) {
            const int it = it0 + u * NGW; ok[u] = it < NIT; const int itc = ok[u] ? it : it0;
            const int blk = itc / NSTRIP, strip = itc % NSTRIP; j0[u] = strip * 256 + lane * 4; tok0[u] = blk * 64;
            smp[u] = tok0[u] >= TP; const int T = smp[u] ? DSEQ : SEQ; const int lt = smp[u] ? tok0[u] - TP : tok0[u]; bb[u] = lt / T; const int t0 = lt % T; last[u] = (t0 + 64 == T);
#pragma unroll
            for (int k = 0; k < 3; ++k) { wg[u][k] = *(const f32x4*)(cw + k * DFF2 + j0[u]); wv[u][k] = *(const f32x4*)(cw + k * DFF2 + DFF + j0[u]); }
            wg[u][3] = *(const f32x4*)(cb + j0[u]); wv[u][3] = *(const f32x4*)(cb + DFF + j0[u]);
            const float* pe = (t0 == 0) ? (smp[u] ? A.in[7] + (size_t)bb[u] * 2 * DFF2 : EDGE  ) : EDGE + ((size_t)(blk - 1) * 4 + 2) * DFF2;
            const bool zero = (t0 == 0) && !smp[u];
#pragma unroll
            for (int i = 0; i < 2; ++i) { pg[u][i] = *(const f32x4*)(pe + i * DFF2 + j0[u]); pv[u][i] = *(const f32x4*)(pe + i * DFF2 + DFF + j0[u]);
                if (zero) { pg[u][i] = (f32x4){0.f, 0.f, 0.f, 0.f}; pv[u][i] = (f32x4){0.f, 0.f, 0.f, 0.f}; }
                const float* e = EDGE + ((size_t)blk * 4 + i) * DFF2; cg[u][i] = *(const f32x4*)(e + j0[u]); cv[u][i] = *(const f32x4*)(e + DFF + j0[u]);
                const float* e2 = EDGE + ((size_t)blk * 4 + 2 + i) * DFF2; sg[u][i] = *(const f32x4*)(e2 + j0[u]); sv[u][i] = *(const f32x4*)(e2 + DFF + j0[u]); }
        }
#pragma unroll
        for (int u = 0; u < 2; ++u) if (ok[u]) {
            f32x4 g2 = pg[u][0], g1 = pg[u][1], v2 = pv[u][0], v1 = pv[u][1];
#pragma unroll
            for (int i = 0; i < 2; ++i) {
                const f32x4 gc = cg[u][i], vc = cv[u][i];
                const f32x4 g = wg[u][3] + wg[u][0] * g2 + wg[u][1] * g1 + wg[u][2] * gc, v = wv[u][3] + wv[u][0] * v2 + wv[u][1] * v1 + wv[u][2] * vc;
                f32x4 a; a.x = silu(g.x) * v.x; a.y = silu(g.y) * v.y; a.z = silu(g.z) * v.z; a.w = silu(g.w) * v.w;
                st_bf4(ACT + (size_t)(tok0[u] + i) * DFF + j0[u], a);
                g2 = g1; g1 = gc; v2 = v1; v1 = vc;
            }
            if (last[u]) {
#pragma unroll
                for (int i = 0; i < 2; ++i) { float* o = A.out + (smp[u] ? O_CVS : O_CVP) + ((size_t)bb[u] * 2 + i) * DFF2; *(f32x4*)(o + j0[u]) = sg[u][i]; *(f32x4*)(o + DFF + j0[u]) = sv[u][i]; }
            }
        }
    }
}

struct AttnArgs {
    const bf16* Q; int qstride;
    const void *Ka_past, *Ka_new; int kastride;
    const bf16 *Kb_past, *Kb_new; int kbstride;
    const void *V_past, *V_new; int vstride;
    const float *Fq, *Fk;
    bf16* O; int ostride;
    int P, qpos0, nkv;
    const float* cs;
};
__device__ __forceinline__ int crow(int r, int hi) { return (r & 3) + 8 * (r >> 2) + 4 * hi; }
__device__ __forceinline__ s16x4 tr_read(const LAS unsigned char* p) { typedef short v4i16 __attribute__((ext_vector_type(4))); return __builtin_bit_cast(s16x4, __builtin_amdgcn_ds_read_tr16_b64_v4i16((LAS v4i16*)p)); }

template <int DQK, bool FOX, int QS, int KS, bool F32>
__device__ __forceinline__ void attn_unit(const AttnArgs& a, LAS unsigned char* lds_base) {
    LAS unsigned char* const lds = lds_base;
    static_assert(QS * KS == NWAVES, "8 waves");
    constexpr int KRB = (DQK + 8) * 2, VRB = 144, NKK = DQK / 16;
    constexpr int OFF_V = 64 * KS * KRB, OFF_F = OFF_V + 64 * KS * VRB, OFF_Q = OFF_F + 64 * KS * 4, OFF_END = OFF_Q + QS * NKK * 1024;
    constexpr bool QLDS = KS > 1;
    static_assert(OFF_END <= 131072, "attention LDS");
    int tid = threadIdx.x; asm volatile("" : "+v"(tid));
    const int lane = tid & 63, q32 = lane & 31, hi = lane >> 5; const int wid = __builtin_amdgcn_readfirstlane(tid >> 6);
    const int qs = wid % QS, ks = wid / QS;
    const int NT = (a.nkv + 64 * KS - 1) / (64 * KS);
    const int qmin = a.qpos0 + qs * 32, qpos = qmin + q32;
    bf16x8 qf[NKK];
    { const bf16* qp = a.Q + (size_t)(qs * 32 + q32) * a.qstride + hi * 8;
#pragma unroll
      for (int kk = 0; kk < NKK; ++kk) qf[kk] = *(const bf16x8*)(qp + kk * 16); }
    if (DQK == 96) {
        const int pidx = qpos < SEQ ? qpos : SEQ + (qpos - PAST);
        const f32x4* cp = (const f32x4*)(a.cs + ((size_t)pidx * 16 + 8 * hi) * 2);
        const u32x4 w1 = __builtin_bit_cast(u32x4, qf[NKK - 2]), w2 = __builtin_bit_cast(u32x4, qf[NKK - 1]); u32x4 r1, r2;
#pragma unroll
        for (int j = 0; j < 4; ++j) { const f32x4 c = cp[j];
            const float a0 = bflo(w1[j]), a1 = bfhi(w1[j]), b0 = bflo(w2[j]), b1 = bfhi(w2[j]);
            r1[j] = pk2(a0 * c.x - b0 * c.y, a1 * c.z - b1 * c.w); r2[j] = pk2(a0 * c.y + b0 * c.x, a1 * c.w + b1 * c.z); }
        qf[NKK - 2] = __builtin_bit_cast(bf16x8, r1); qf[NKK - 1] = __builtin_bit_cast(bf16x8, r2);
    }
    LAS unsigned char* qlds = lds + OFF_Q + qs * (NKK * 1024) + lane * 16;
    if (QLDS) {
#pragma unroll
        for (int kk = 0; kk < NKK; ++kk) *(LAS bf16x8*)(qlds + kk * 1024) = qf[kk];
    }
    const float fqv = FOX ? a.Fq[qs * 32 + q32] : 0.f;
    float mrun = -1e30f, lsum = 0.f; f32x16 o0 = {}, o1 = {};
    u32x4 rka[KS], rv[F32 ? 1 : KS]; u32x4 rkb[(DQK == 96) ? (KS + 1) / 2 : 1]; float rf = 0.f;
    f32x4 fka[F32 ? KS : 1][2], fva[F32 ? KS : 1][2];
    const int lrow = tid >> 3, lch = tid & 7;
    const int brow = (tid & 255) >> 2, bch = tid & 3;
    auto load_k = [&](int T) {
        const int jT = T * KS * 64; const bool past = jT < a.P; const size_t r0 = (size_t)(past ? jT : jT - a.P);
        if (F32) { const float* kp = (const float*)(past ? a.Ka_past : a.Ka_new) + (r0 + lrow) * a.kastride + lch * 4;
#pragma unroll
            for (int s = 0; s < KS; ++s) if (jT + s * 64 < a.nkv) { const f32x4* p4 = (const f32x4*)(kp + (size_t)s * 64 * a.kastride); fka[F32 ? s : 0][0] = p4[0]; fka[F32 ? s : 0][1] = p4[8]; } }
        else { const bf16* kp = (const bf16*)(past ? a.Ka_past : a.Ka_new) + (r0 + lrow) * a.kastride + lch * 8;
#pragma unroll
            for (int s = 0; s < KS; ++s) if (jT + s * 64 < a.nkv) rka[s] = *(const u32x4*)(kp + (size_t)s * 64 * a.kastride); }
        if (DQK == 96) { const bf16* bp = (past ? a.Kb_past : a.Kb_new) + (r0 + (tid >> 8) * 64 + brow) * a.kbstride + bch * 8;
#pragma unroll
            for (int i = 0; i < (KS + 1) / 2; ++i) { const int s = 2 * i + (tid >> 8); if (s < KS && jT + s * 64 < a.nkv) rkb[i] = *(const u32x4*)(bp + (size_t)i * 128 * a.kbstride); }
        }
        if (FOX) { const int j = jT + tid; if (tid < 64 * KS && j < a.nkv) rf = a.Fk[j]; }
    };
    auto cvt_k = [&]() {
        if (F32) {
#pragma unroll
            for (int s = 0; s < KS; ++s) { const f32x4 k0 = fka[F32 ? s : 0][0], k1 = fka[F32 ? s : 0][1]; rka[s] = (u32x4){pk2(k0.x, k0.y), pk2(k0.z, k0.w), pk2(k1.x, k1.y), pk2(k1.z, k1.w)}; }
        }
    };
    auto load_v = [&](int T) {
        const int jT = T * KS * 64; const bool past = jT < a.P; const size_t r0 = (size_t)(past ? jT : jT - a.P);
        if (F32) { const float* vp = (const float*)(past ? a.V_past : a.V_new) + (r0 + lrow) * a.vstride + lch * 4;
#pragma unroll
            for (int s = 0; s < KS; ++s) if (jT + s * 64 < a.nkv) { const f32x4* p4 = (const f32x4*)(vp + (size_t)s * 64 * a.vstride); fva[F32 ? s : 0][0] = p4[0]; fva[F32 ? s : 0][1] = p4[8]; } }
        else { const bf16* vp = (const bf16*)(past ? a.V_past : a.V_new) + (r0 + lrow) * a.vstride + lch * 8;
#pragma unroll
            for (int s = 0; s < KS; ++s) if (jT + s * 64 < a.nkv) rv[F32 ? 0 : s] = *(const u32x4*)(vp + (size_t)s * 64 * a.vstride); }
    };
    constexpr bool DB = (KS == 1);
    static_assert(!DB || OFF_Q <= 32768, "double buffer stride");
    auto store_tile = [&](int T) {
        LAS unsigned char* const lds = lds_base + (DB ? (T & 1) * 32768 : 0);
#pragma unroll
        for (int s = 0; s < KS; ++s) { const int j0 = (T * KS + s) * 64;
            if (j0 < a.nkv) {
                if (F32) { const f32x4 v0 = fva[F32 ? s : 0][0], v1 = fva[F32 ? s : 0][1]; LAS unsigned char* kr = lds + (s * 64 + lrow) * KRB + lch * 8; LAS unsigned char* vr = lds + OFF_V + (s * 64 + lrow) * VRB + lch * 8;
                    *(LAS u32x2*)kr = (u32x2){rka[s].x, rka[s].y}; *(LAS u32x2*)(kr + 64) = (u32x2){rka[s].z, rka[s].w};
                    *(LAS u32x2*)vr = (u32x2){pk2(v0.x, v0.y), pk2(v0.z, v0.w)}; *(LAS u32x2*)(vr + 64) = (u32x2){pk2(v1.x, v1.y), pk2(v1.z, v1.w)}; }
                else { *(LAS u32x4*)(lds + (s * 64 + lrow) * KRB + lch * 16) = rka[s]; *(LAS u32x4*)(lds + OFF_V + (s * 64 + lrow) * VRB + lch * 16) = rv[F32 ? 0 : s]; } } }
        if (DQK == 96) {
#pragma unroll
            for (int i = 0; i < (KS + 1) / 2; ++i) { const int s = 2 * i + (tid >> 8); const int j0 = (T * KS + s) * 64;
                if (s < KS && j0 < a.nkv) *(LAS u32x4*)(lds + (s * 64 + brow) * KRB + 128 + bch * 16) = rkb[i]; }
        }
        if (FOX) { if (tid < 64 * KS) *(LAS float*)(lds + OFF_F + tid * 4) = rf; }
    };
    load_k(0); cvt_k(); load_v(0);
    const LAS unsigned char* kbase0 = lds + (ks * 64 + q32) * KRB + hi * 16;
    const LAS unsigned char* vbase0 = lds + OFF_V + (ks * 64 + 4 * hi + ((lane & 15) >> 2)) * VRB + (16 * ((lane >> 4) & 1) + 4 * (lane & 3)) * 2;
    const LAS unsigned char* fbase0 = lds + OFF_F + (ks * 64 + 4 * hi) * 4;
    if (DB) { store_tile(0); __syncthreads(); }
    for (int T = 0; T < NT; ++T) {
        if (!DB) { __syncthreads(); store_tile(T); __syncthreads(); }
        const int bo = DB ? (T & 1) * 32768 : 0;
        const LAS unsigned char* kbase = kbase0 + bo; const LAS unsigned char* vbase = vbase0 + bo; const LAS unsigned char* fbase = fbase0 + bo;
        if (T + 1 < NT) load_k(T + 1);
        __builtin_amdgcn_sched_barrier(0);
        const int tt = T * KS + ks; const int j0 = tt * 64;
        const bool valid = (j0 < a.nkv) && (FOX ? (j0 <= qmin + 31) : (tt <= (qmin >> 6)));
        bf16x8 pb[4];
        if (valid) {
            f32x16 p0 = {}, p1 = {};
#pragma unroll
            for (int kk = 0; kk < NKK; ++kk) {
                const bf16x8 k0 = *(const LAS bf16x8*)(kbase + kk * 32), k1 = *(const LAS bf16x8*)(kbase + 32 * KRB + kk * 32);
                const bf16x8 qv = QLDS ? *(const LAS bf16x8*)(qlds + kk * 1024) : qf[kk];
                p0 = __builtin_amdgcn_mfma_f32_32x32x16_bf16(k0, qv, p0, 0, 0, 0);
                p1 = __builtin_amdgcn_mfma_f32_32x32x16_bf16(k1, qv, p1, 0, 0, 0);
            }
            if (FOX) {
#pragma unroll
                for (int g = 0; g < 4; ++g) { const f32x4 f0 = *(const LAS f32x4*)(fbase + g * 32), f1 = *(const LAS f32x4*)(fbase + 128 + g * 32);
#pragma unroll
                    for (int e = 0; e < 4; ++e) { p0[4 * g + e] += fqv - f0[e]; p1[4 * g + e] += fqv - f1[e]; } }
                if (j0 + 63 > qmin) {
#pragma unroll
                    for (int r = 0; r < 16; ++r) { const int kv = j0 + crow(r, hi); if (kv > qpos) p0[r] = -1e30f; if (kv + 32 > qpos) p1[r] = -1e30f; }
                }
            }
            float mt = fmaxf(p0[0], p1[0]);
#pragma unroll
            for (int r = 1; r < 16; ++r) mt = fmaxf(mt, fmaxf(p0[r], p1[r]));
            mt = fmaxf(mt, __shfl_xor(mt, 32));
            const float mnew = fmaxf(mrun, mt), alpha = fast_exp2(mrun - mnew); mrun = mnew;
            float ps = 0.f;
#pragma unroll
            for (int r = 0; r < 16; ++r) { p0[r] = fast_exp2(p0[r] - mnew); p1[r] = fast_exp2(p1[r] - mnew); ps += p0[r] + p1[r]; }
            lsum = lsum * alpha + ps;
            if (__builtin_amdgcn_ballot_w64(alpha != 1.f)) { o0 = o0 * alpha; o1 = o1 * alpha; }
#pragma unroll
            for (int s = 0; s < 2; ++s) {
                u32x4 w0 = {pk2(p0[8 * s], p0[8 * s + 1]), pk2(p0[8 * s + 2], p0[8 * s + 3]), pk2(p0[8 * s + 4], p0[8 * s + 5]), pk2(p0[8 * s + 6], p0[8 * s + 7])};
                u32x4 w1 = {pk2(p1[8 * s], p1[8 * s + 1]), pk2(p1[8 * s + 2], p1[8 * s + 3]), pk2(p1[8 * s + 4], p1[8 * s + 5]), pk2(p1[8 * s + 6], p1[8 * s + 7])};
                pb[s] = __builtin_bit_cast(bf16x8, w0); pb[2 + s] = __builtin_bit_cast(bf16x8, w1);
            }
        }
        __builtin_amdgcn_sched_barrier(0);
        if (T + 1 < NT) { cvt_k(); load_v(T + 1); }
        __builtin_amdgcn_sched_barrier(0);
        if (valid) {
#pragma unroll
            for (int kst = 0; kst < 4; ++kst) {
                const LAS unsigned char* vp = vbase + 16 * kst * VRB;
                const s16x4 a0l = tr_read(vp), a0h = tr_read(vp + 8 * VRB), a1l = tr_read(vp + 64), a1h = tr_read(vp + 64 + 8 * VRB);
                const bf16x8 A0 = {a0l[0], a0l[1], a0l[2], a0l[3], a0h[0], a0h[1], a0h[2], a0h[3]}, A1 = {a1l[0], a1l[1], a1l[2], a1l[3], a1h[0], a1h[1], a1h[2], a1h[3]};
                o0 = __builtin_amdgcn_mfma_f32_32x32x16_bf16(A0, pb[kst], o0, 0, 0, 0);
                o1 = __builtin_amdgcn_mfma_f32_32x32x16_bf16(A1, pb[kst], o1, 0, 0, 0);
            }
        }
        if (DB) { if (T + 1 < NT) store_tile(T + 1); __syncthreads(); }
    }
    lsum += __shfl_xor(lsum, 32);
    if (KS == 1) {
        const float inv = 1.f / lsum; bf16* op = a.O + (size_t)(qs * 32 + q32) * a.ostride + 4 * hi;
#pragma unroll
        for (int g = 0; g < 4; ++g) { st_bf4(op + 8 * g, (f32x4){o0[4 * g] * inv, o0[4 * g + 1] * inv, o0[4 * g + 2] * inv, o0[4 * g + 3] * inv});
            st_bf4(op + 32 + 8 * g, (f32x4){o1[4 * g] * inv, o1[4 * g + 1] * inv, o1[4 * g + 2] * inv, o1[4 * g + 3] * inv}); }
    } else {
        __syncthreads();
        LAS float* osc = (LAS float*)lds + wid * 2048;
        LAS float* msc = (LAS float*)(lds + 65536) + wid * 32; LAS float* lsc = (LAS float*)(lds + 65536 + 1024) + wid * 32;
#pragma unroll
        for (int r = 0; r < 16; ++r) { osc[r * 64 + lane] = o0[r]; osc[(16 + r) * 64 + lane] = o1[r]; }
        if (hi == 0) { msc[q32] = mrun; lsc[q32] = lsum; }
        __syncthreads();
        if (ks == 0) {
            float mk[KS], M = -1e30f;
#pragma unroll
            for (int k = 0; k < KS; ++k) { mk[k] = ((LAS float*)(lds + 65536))[(k * QS + qs) * 32 + q32]; M = fmaxf(M, mk[k]); }
            float L = 0.f; f32x16 t0 = {}, t1 = {};
#pragma unroll 1
            for (int k = 0; k < KS; ++k) { const float w = fast_exp2(((LAS float*)(lds + 65536))[(k * QS + qs) * 32 + q32] - M); L += w * ((LAS float*)(lds + 65536 + 1024))[(k * QS + qs) * 32 + q32];
                const LAS float* os = (LAS float*)lds + (k * QS + qs) * 2048;
#pragma unroll
                for (int r = 0; r < 16; ++r) { t0[r] += w * os[r * 64 + lane]; t1[r] += w * os[(16 + r) * 64 + lane]; } }
            const float inv = 1.f / L; bf16* op = a.O + (size_t)(qs * 32 + q32) * a.ostride + 4 * hi;
#pragma unroll
            for (int g = 0; g < 4; ++g) { st_bf4(op + 8 * g, (f32x4){t0[4 * g] * inv, t0[4 * g + 1] * inv, t0[4 * g + 2] * inv, t0[4 * g + 3] * inv});
                st_bf4(op + 32 + 8 * g, (f32x4){t1[4 * g] * inv, t1[4 * g + 1] * inv, t1[4 * g + 2] * inv, t1[4 * g + 3] * inv}); }
        }
    }
    __syncthreads();
}


struct Attn2Args {
    const bf16* Q[2]; int qstride;
    const bf16* Ka; int kastride; const bf16* Kb; int kbstride; const bf16* V; int vstride;
    const float* Fk; bf16* O[2]; int ostride; int qpos0[2]; int nkv[2]; const float* cs;
};
template <int DQK, bool FOX, int NG>
__device__ __forceinline__ void attn_unit2(const Attn2Args& a, LAS unsigned char* lds) {
    constexpr int KRB = (DQK + 8) * 2, VRB = 144, NKK = DQK / 16, OFF_V = 64 * KRB, OFF_F = OFF_V + 64 * VRB, BUF = 32768;
    static_assert(OFF_F + 256 <= BUF, "tile buffer");
    int tid = threadIdx.x; asm volatile("" : "+v"(tid));
    const int lane = tid & 63, q32 = lane & 31, hi = lane >> 5; const int wid = __builtin_amdgcn_readfirstlane(tid >> 6);
    int qmin[NG], qpos[NG]; bf16x8 qf[NG][NKK]; float mrun[NG], lsum[NG]; f32x16 o0[NG], o1[NG];
#pragma unroll
    for (int g = 0; g < NG; ++g) {
        qmin[g] = a.qpos0[g] + wid * 32; qpos[g] = qmin[g] + q32; mrun[g] = -1e30f; lsum[g] = 0.f; o0[g] = f32x16{}; o1[g] = f32x16{};
        const bf16* qp = a.Q[g] + (size_t)(wid * 32 + q32) * a.qstride + hi * 8;
#pragma unroll
        for (int kk = 0; kk < NKK; ++kk) qf[g][kk] = *(const bf16x8*)(qp + kk * 16);
        if (DQK == 96) {
            const f32x4* cp = (const f32x4*)(a.cs + ((size_t)qpos[g] * 16 + 8 * hi) * 2);
            const u32x4 w1 = __builtin_bit_cast(u32x4, qf[g][NKK - 2]), w2 = __builtin_bit_cast(u32x4, qf[g][NKK - 1]); u32x4 r1, r2;
#pragma unroll
            for (int j = 0; j < 4; ++j) { const f32x4 c = cp[j]; const float a0 = bflo(w1[j]), a1 = bfhi(w1[j]), b0 = bflo(w2[j]), b1 = bfhi(w2[j]);
                r1[j] = pk2(a0 * c.x - b0 * c.y, a1 * c.z - b1 * c.w); r2[j] = pk2(a0 * c.y + b0 * c.x, a1 * c.w + b1 * c.z); }
            qf[g][NKK - 2] = __builtin_bit_cast(bf16x8, r1); qf[g][NKK - 1] = __builtin_bit_cast(bf16x8, r2);
        }
    }
    const int NT = a.nkv[NG - 1] / 64;
    struct Stage { u32x4 ka, v, kb; float f; }; Stage st0, st1;
    const int lrow = tid >> 3, lch = tid & 7, brow = (tid & 255) >> 2, bch = tid & 3;
    auto load_t = [&](int T, Stage& st) {
        st.ka = *(const u32x4*)(a.Ka + (size_t)(T * 64 + lrow) * a.kastride + lch * 8);
        st.v = *(const u32x4*)(a.V + (size_t)(T * 64 + lrow) * a.vstride + lch * 8);
        if (DQK == 96) { if (tid < 256) st.kb = *(const u32x4*)(a.Kb + (size_t)(T * 64 + brow) * a.kbstride + bch * 8); }
        if (FOX) { if (tid < 64) st.f = a.Fk[T * 64 + tid]; }
    };
    auto store_tile = [&](int T, const Stage& st) {
        LAS unsigned char* b = lds + (T & 1) * BUF;
        *(LAS u32x4*)(b + lrow * KRB + lch * 16) = st.ka; *(LAS u32x4*)(b + OFF_V + lrow * VRB + lch * 16) = st.v;
        if (DQK == 96) { if (tid < 256) *(LAS u32x4*)(b + brow * KRB + 128 + bch * 16) = st.kb; }
        if (FOX) { if (tid < 64) *(LAS float*)(b + OFF_F + tid * 4) = st.f; }
    };
    load_t(0, st0); if (NT > 1) load_t(1, st1);
    const LAS unsigned char* kbase0 = lds + q32 * KRB + hi * 16;
    const LAS unsigned char* vbase0 = lds + OFF_V + (4 * hi + ((lane & 15) >> 2)) * VRB + (16 * ((lane >> 4) & 1) + 4 * (lane & 3)) * 2;
    const LAS unsigned char* fbase0 = lds + OFF_F + (4 * hi) * 4;
    store_tile(0, st0); __syncthreads();
    auto step = [&](int T, Stage& stL  , const Stage& stS  ) {
        const int bo = (T & 1) * BUF; const LAS unsigned char* kbase = kbase0 + bo; const LAS unsigned char* vbase = vbase0 + bo; const LAS unsigned char* fbase = fbase0 + bo;
        if (T + 2 < NT) load_t(T + 2, stL);
        __builtin_amdgcn_sched_barrier(0);
        const int j0 = T * 64; bool valid[NG]; bool any = false;
#pragma unroll
        for (int g = 0; g < NG; ++g) { valid[g] = (j0 < a.nkv[g]) && (FOX ? (j0 <= qmin[g] + 31) : (T <= (qmin[g] >> 6))); any = any || valid[g]; }
        bf16x8 pb[NG][4];
        if (any) {
            f32x16 p0[NG], p1[NG];
            if (FOX) {
                f32x16 b0, b1;
#pragma unroll
                for (int q = 0; q < 4; ++q) { const f32x4 f0 = *(const LAS f32x4*)(fbase + q * 32), f1 = *(const LAS f32x4*)(fbase + 128 + q * 32);
#pragma unroll
                    for (int e = 0; e < 4; ++e) { b0[4 * q + e] = -f0[e]; b1[4 * q + e] = -f1[e]; } }
#pragma unroll
                for (int g = 0; g < NG; ++g) { p0[g] = b0; p1[g] = b1; }
            } else {
#pragma unroll
                for (int g = 0; g < NG; ++g) { p0[g] = f32x16{}; p1[g] = f32x16{}; } }
#pragma unroll
            for (int kk = 0; kk < NKK; ++kk) {
                const bf16x8 k0 = *(const LAS bf16x8*)(kbase + kk * 32), k1 = *(const LAS bf16x8*)(kbase + 32 * KRB + kk * 32);
#pragma unroll
                for (int g = 0; g < NG; ++g) if (valid[g]) {
                    p0[g] = __builtin_amdgcn_mfma_f32_32x32x16_bf16(k0, qf[g][kk], p0[g], 0, 0, 0);
                    p1[g] = __builtin_amdgcn_mfma_f32_32x32x16_bf16(k1, qf[g][kk], p1[g], 0, 0, 0); }
            }
#pragma unroll
            for (int g = 0; g < NG; ++g) if (valid[g]) {
                if (FOX && j0 + 63 > qmin[g]) {
#pragma unroll
                    for (int r = 0; r < 16; ++r) { const int kv = j0 + crow(r, hi); if (kv > qpos[g]) p0[g][r] = -1e30f; if (kv + 32 > qpos[g]) p1[g][r] = -1e30f; }
                }
                float mt = fmaxf(p0[g][0], p1[g][0]);
#pragma unroll
                for (int r = 1; r < 16; ++r) mt = fmaxf(mt, fmaxf(p0[g][r], p1[g][r]));
                mt = fmaxf(mt, __shfl_xor(mt, 32));
                const float mnew = fmaxf(mrun[g], mt), alpha = fast_exp2(mrun[g] - mnew); mrun[g] = mnew;
                float ps = 0.f;
#pragma unroll
                for (int r = 0; r < 16; ++r) { p0[g][r] = fast_exp2(p0[g][r] - mnew); p1[g][r] = fast_exp2(p1[g][r] - mnew); ps += p0[g][r] + p1[g][r]; }
                lsum[g] = lsum[g] * alpha + ps; if (__builtin_amdgcn_ballot_w64(alpha != 1.f)) { o0[g] = o0[g] * alpha; o1[g] = o1[g] * alpha; }
#pragma unroll
                for (int s = 0; s < 2; ++s) {
                    u32x4 w0 = {pk2(p0[g][8 * s], p0[g][8 * s + 1]), pk2(p0[g][8 * s + 2], p0[g][8 * s + 3]), pk2(p0[g][8 * s + 4], p0[g][8 * s + 5]), pk2(p0[g][8 * s + 6], p0[g][8 * s + 7])};
                    u32x4 w1 = {pk2(p1[g][8 * s], p1[g][8 * s + 1]), pk2(p1[g][8 * s + 2], p1[g][8 * s + 3]), pk2(p1[g][8 * s + 4], p1[g][8 * s + 5]), pk2(p1[g][8 * s + 6], p1[g][8 * s + 7])};
                    pb[g][s] = __builtin_bit_cast(bf16x8, w0); pb[g][2 + s] = __builtin_bit_cast(bf16x8, w1);
                }
            }
        }
        if (any) {
#pragma unroll
            for (int kst = 0; kst < 4; ++kst) {
                const LAS unsigned char* vp = vbase + 16 * kst * VRB;
                const s16x4 a0l = tr_read(vp), a0h = tr_read(vp + 8 * VRB), a1l = tr_read(vp + 64), a1h = tr_read(vp + 64 + 8 * VRB);
                const bf16x8 A0 = {a0l[0], a0l[1], a0l[2], a0l[3], a0h[0], a0h[1], a0h[2], a0h[3]}, A1 = {a1l[0], a1l[1], a1l[2], a1l[3], a1h[0], a1h[1], a1h[2], a1h[3]};
#pragma unroll
                for (int g = 0; g < NG; ++g) if (valid[g]) {
                    o0[g] = __builtin_amdgcn_mfma_f32_32x32x16_bf16(A0, pb[g][kst], o0[g], 0, 0, 0);
                    o1[g] = __builtin_amdgcn_mfma_f32_32x32x16_bf16(A1, pb[g][kst], o1[g], 0, 0, 0); }
            }
        }
        if (T + 1 < NT) store_tile(T + 1, stS);
        __syncthreads();
    };
    for (int T = 0; T < NT; T += 2) { step(T, st0, st1); if (T + 1 < NT) step(T + 1, st1, st0); }
#pragma unroll
    for (int g = 0; g < NG; ++g) {
        const float l = lsum[g] + __shfl_xor(lsum[g], 32); const float inv = 1.f / l; bf16* op = a.O[g] + (size_t)(wid * 32 + q32) * a.ostride + 4 * hi;
#pragma unroll
        for (int q = 0; q < 4; ++q) { st_bf4(op + 8 * q, (f32x4){o0[g][4 * q] * inv, o0[g][4 * q + 1] * inv, o0[g][4 * q + 2] * inv, o0[g][4 * q + 3] * inv});
            st_bf4(op + 32 + 8 * q, (f32x4){o1[g][4 * q] * inv, o1[g][4 * q + 1] * inv, o1[g][4 * q + 2] * inv, o1[g][4 * q + 3] * inv}); }
    }
    __syncthreads();
}

struct AbsArgs { const bf16* Qlat; const bf16* Qrope; const bf16 *Lat_past, *Lat_new, *Kr_past, *Kr_new; const bf16* WuvT; bf16* O; const float* cs; };
__device__ __forceinline__ void mla_abs_unit(const AbsArgs& a, LAS unsigned char* lds) {
    constexpr int RB = 592, OFF_Q = 128 * RB, NKK = 18, NT = (KVS + 127) / 128;
    int tid = threadIdx.x; asm volatile("" : "+v"(tid));
    const int lane = tid & 63, q32 = lane & 31, hi = lane >> 5; const int wid = __builtin_amdgcn_readfirstlane(tid >> 6);
    const int qs = wid & 1, ks = wid >> 1;
    LAS unsigned char* qlds = lds + OFF_Q + qs * (NKK * 1024) + lane * 16;
    { const bf16* qp = a.Qlat + (size_t)(qs * 32 + q32) * 2048 + hi * 8;
#pragma unroll
      for (int kk = 0; kk < 16; ++kk) *(LAS bf16x8*)(qlds + kk * 1024) = *(const bf16x8*)(qp + kk * 16);
      const bf16* rp = a.Qrope + (size_t)(qs * 32 + q32) * 768 + hi * 8;
      const u32x4 w1 = *(const u32x4*)rp, w2 = *(const u32x4*)(rp + 16); u32x4 r1, r2;
      const f32x4* cp = (const f32x4*)(a.cs + ((size_t)(SEQ + qs * 32 + q32) * 16 + 8 * hi) * 2);
#pragma unroll
      for (int j = 0; j < 4; ++j) { const f32x4 c = cp[j]; const float a0 = bflo(w1[j]), a1 = bfhi(w1[j]), b0 = bflo(w2[j]), b1 = bfhi(w2[j]);
          r1[j] = pk2(a0 * c.x - b0 * c.y, a1 * c.z - b1 * c.w); r2[j] = pk2(a0 * c.y + b0 * c.x, a1 * c.w + b1 * c.z); }
      *(LAS u32x4*)(qlds + 16 * 1024) = r1; *(LAS u32x4*)(qlds + 17 * 1024) = r2; }
    float mrun = -1e30f, lsum = 0.f; f32x16 o[8] = {};
    u32x4 rl[8], rk;
    const int lrow = tid >> 5, lch = tid & 31, krow = tid >> 2, kch = tid & 3;
    auto load_t = [&](int T) {
        const int jT = T * 128; const bool past = jT < PAST; const size_t r0 = (size_t)(past ? jT : jT - PAST);
        const bf16* lp = (past ? a.Lat_past : a.Lat_new) + (r0 + lrow) * 256 + lch * 8;
#pragma unroll
        for (int i = 0; i < 8; ++i) if (jT + 16 * i < KVS) rl[i] = *(const u32x4*)(lp + (size_t)i * 16 * 256);
        if (jT + krow < KVS) rk = *(const u32x4*)((past ? a.Kr_past : a.Kr_new) + (r0 + krow) * 32 + kch * 8);
    };
    auto store_t = [&](int T) {
        const int jT = T * 128;
#pragma unroll
        for (int i = 0; i < 8; ++i) if (jT + 16 * i < KVS) *(LAS u32x4*)(lds + (lrow + 16 * i) * RB + lch * 16) = rl[i];
        if (jT + krow < KVS) *(LAS u32x4*)(lds + krow * RB + 512 + kch * 16) = rk;
    };
    load_t(0);
    const LAS unsigned char* kbase = lds + (ks * 32 + q32) * RB + hi * 16;
    const LAS unsigned char* vbase = lds + (ks * 32 + 4 * hi + ((lane & 15) >> 2)) * RB + (16 * ((lane >> 4) & 1) + 4 * (lane & 3)) * 2;
    for (int T = 0; T < NT; ++T) {
        __syncthreads();
        store_t(T);
        __syncthreads();
        if (T + 1 < NT) load_t(T + 1);
        __builtin_amdgcn_sched_barrier(0);
        if (T * 128 + ks * 32 < KVS) {
            f32x16 p0 = {}, pq = {};
#pragma unroll
            for (int kk = 0; kk < NKK; kk += 2) {
                const bf16x8 k0 = *(const LAS bf16x8*)(kbase + kk * 32); const bf16x8 qv = *(const LAS bf16x8*)(qlds + kk * 1024);
                const bf16x8 k1 = *(const LAS bf16x8*)(kbase + (kk + 1) * 32); const bf16x8 qw = *(const LAS bf16x8*)(qlds + (kk + 1) * 1024);
                p0 = __builtin_amdgcn_mfma_f32_32x32x16_bf16(k0, qv, p0, 0, 0, 0);
                pq = __builtin_amdgcn_mfma_f32_32x32x16_bf16(k1, qw, pq, 0, 0, 0);
            }
            p0 = p0 + pq;
            float mt = p0[0];
#pragma unroll
            for (int r = 1; r < 16; ++r) mt = fmaxf(mt, p0[r]);
            mt = fmaxf(mt, __shfl_xor(mt, 32));
            const float mnew = fmaxf(mrun, mt), alpha = fast_exp2(mrun - mnew); mrun = mnew;
            float ps = 0.f;
#pragma unroll
            for (int r = 0; r < 16; ++r) { p0[r] = fast_exp2(p0[r] - mnew); ps += p0[r]; }
            lsum = lsum * alpha + ps;
            if (__builtin_amdgcn_ballot_w64(alpha != 1.f)) {
#pragma unroll
                for (int dt = 0; dt < 8; ++dt) o[dt] = o[dt] * alpha; }
            bf16x8 pb[2];
#pragma unroll
            for (int s = 0; s < 2; ++s) {
                u32x4 w0 = {pk2(p0[8 * s], p0[8 * s + 1]), pk2(p0[8 * s + 2], p0[8 * s + 3]), pk2(p0[8 * s + 4], p0[8 * s + 5]), pk2(p0[8 * s + 6], p0[8 * s + 7])};
                pb[s] = __builtin_bit_cast(bf16x8, w0);
            }
#pragma unroll
            for (int kst = 0; kst < 2; ++kst) {
                const LAS unsigned char* vp = vbase + 16 * kst * RB;
#pragma unroll
                for (int dt = 0; dt < 8; ++dt) { const s16x4 al = tr_read(vp + dt * 64), ah = tr_read(vp + dt * 64 + 8 * RB);
                    const bf16x8 Af = {al[0], al[1], al[2], al[3], ah[0], ah[1], ah[2], ah[3]};
                    o[dt] = __builtin_amdgcn_mfma_f32_32x32x16_bf16(Af, pb[kst], o[dt], 0, 0, 0); }
            }
        }
    }
    lsum += __shfl_xor(lsum, 32);
    LAS float* msc = (LAS float*)(lds + 131072 + 4096);
    LAS float* lsc = msc + 256;
#pragma unroll 1
    for (int rnd = 0; rnd < 2; ++rnd) {
        const int half = rnd == 0 ? 2 : 1;
        __syncthreads();
        if (ks >= half && ks < 2 * half) { LAS float* osc = (LAS float*)lds + ((ks - half) * 2 + qs) * 8192;
#pragma unroll
            for (int dt = 0; dt < 8; ++dt)
#pragma unroll
                for (int r = 0; r < 16; ++r) osc[(dt * 16 + r) * 64 + lane] = o[dt][r];
            if (hi == 0) { msc[wid * 32 + q32] = mrun; lsc[wid * 32 + q32] = lsum; } }
        __syncthreads();
        if (ks < half) { const LAS float* osc = (const LAS float*)lds + (ks * 2 + qs) * 8192; const int pw = (ks + half) * 2 + qs;
            const float m2 = msc[pw * 32 + q32], l2 = lsc[pw * 32 + q32]; const float M = fmaxf(mrun, m2), w1 = fast_exp2(mrun - M), w2 = fast_exp2(m2 - M);
            lsum = w1 * lsum + w2 * l2; mrun = M;
#pragma unroll
            for (int dt = 0; dt < 8; ++dt)
#pragma unroll
                for (int r = 0; r < 16; ++r) o[dt][r] = w1 * o[dt][r] + w2 * osc[(dt * 16 + r) * 64 + lane]; }
    }
    if (ks == 0) {
        const float inv = 1.f / lsum; f32x16 t0 = {}, t1 = {};
        const bf16* wrow0 = a.WuvT + (size_t)q32 * 256 + 4 * hi; const bf16* wrow1 = wrow0 + 32 * 256;
#pragma unroll
        for (int sub = 0; sub < 8; ++sub)
#pragma unroll
            for (int s = 0; s < 2; ++s) {
                const u32x4 wv = {pk2(o[sub][8 * s] * inv, o[sub][8 * s + 1] * inv), pk2(o[sub][8 * s + 2] * inv, o[sub][8 * s + 3] * inv), pk2(o[sub][8 * s + 4] * inv, o[sub][8 * s + 5] * inv), pk2(o[sub][8 * s + 6] * inv, o[sub][8 * s + 7] * inv)};
                const bf16x8 Bf = __builtin_bit_cast(bf16x8, wv); const int c0 = 32 * sub + 16 * s;
                const s16x4 a0l = *(const s16x4*)(wrow0 + c0), a0h = *(const s16x4*)(wrow0 + c0 + 8), a1l = *(const s16x4*)(wrow1 + c0), a1h = *(const s16x4*)(wrow1 + c0 + 8);
                const bf16x8 A0 = {a0l[0], a0l[1], a0l[2], a0l[3], a0h[0], a0h[1], a0h[2], a0h[3]}, A1 = {a1l[0], a1l[1], a1l[2], a1l[3], a1h[0], a1h[1], a1h[2], a1h[3]};
                t0 = __builtin_amdgcn_mfma_f32_32x32x16_bf16(A0, Bf, t0, 0, 0, 0);
                t1 = __builtin_amdgcn_mfma_f32_32x32x16_bf16(A1, Bf, t1, 0, 0, 0);
            }
        bf16* op = a.O + (size_t)(qs * 32 + q32) * 1024 + 4 * hi;
#pragma unroll
        for (int g = 0; g < 4; ++g) { st_bf4(op + 8 * g, (f32x4){t0[4 * g], t0[4 * g + 1], t0[4 * g + 2], t0[4 * g + 3]}); st_bf4(op + 32 + 8 * g, (f32x4){t1[4 * g], t1[4 * g + 1], t1[4 * g + 2], t1[4 * g + 3]}); }
    }
    __syncthreads();
}

__device__ __forceinline__ void p4_attention(const Args& A, LAS unsigned char* lds) {
    unsigned char* ws = A.ws; const int G = gridDim.x;
    const bf16* QFOX = (const bf16*)(ws + WS_QFOX); const bf16* KNEW = (const bf16*)(ws + WS_KNEW); const bf16* VNEW = (const bf16*)(ws + WS_VNEW);
    const bf16* QMLA = (const bf16*)(ws + WS_QMLA); const bf16* KVNEW = (const bf16*)(ws + WS_KVNEW);
    const bf16* KRNEW = (const bf16*)(ws + WS_KRNEW); const bf16* KRPAST = (const bf16*)(ws + WS_KRPAST);
    const float* FS = (const float*)(ws + WS_FS); const float* FP = (const float*)(ws + WS_FP); bf16* MIXED = (bf16*)(ws + WS_MIXED);
    const int rot = (blockIdx.x >> 6) & 3;
#pragma unroll 1
    for (int pass = 0; pass < 4; ++pass) {
    const int job = (pass + rot) & 3;
    if (job == 0) {
    for (int p = blockIdx.x; p < 256; p += G) {
        const int bh = p >> 2, s = p & 3, b = bh >> 3, h = bh & 7; const size_t tb = (size_t)b * SEQ;
        Attn2Args a; a.cs = (const float*)(ws + WS_CS); a.qstride = 512; a.Ka = KNEW + tb * 512 + h * 64; a.kastride = 512; a.Kb = nullptr; a.kbstride = 0;
        a.V = VNEW + tb * 512 + h * 64; a.vstride = 512; a.Fk = FP + (size_t)bh * SEQ; a.ostride = 1024;
        for (int i = 0; i < 2; ++i) { const int t0 = 256 * (i ? 7 - s : s); a.Q[i] = QFOX + (tb + t0) * 512 + h * 64; a.O[i] = MIXED + (tb + t0) * 1024 + h * 64; a.qpos0[i] = t0; a.nkv[i] = t0 + 256; }
        attn_unit2<64, true, 2>(a, lds);
    }
    } else if (job == 1) {
    for (int p = blockIdx.x; p < 256; p += G) {
        const int bh = p >> 2, s = 3 - (p & 3), b = bh >> 3, h = bh & 7; const size_t tb = (size_t)b * SEQ;
        Attn2Args a; a.cs = (const float*)(ws + WS_CS); a.qstride = 768; a.Ka = KVNEW + tb * 1024 + h * 64; a.kastride = 1024; a.Kb = KRNEW + tb * 32; a.kbstride = 32;
        a.V = KVNEW + tb * 1024 + 512 + h * 64; a.vstride = 1024; a.Fk = nullptr; a.ostride = 1024;
        for (int i = 0; i < 2; ++i) { const int t0 = 256 * (i ? 7 - s : s); a.Q[0] = QMLA + (tb + t0) * 768 + h * 96; a.O[0] = MIXED + (tb + t0) * 1024 + 512 + h * 64; a.qpos0[0] = t0; a.nkv[0] = t0 + 256;
            a.Q[1] = a.Q[0]; a.O[1] = a.O[0]; a.qpos0[1] = t0; a.nkv[1] = t0 + 256;
            attn_unit2<96, false, 1>(a, lds); }
    }
    } else if (job == 2) {
    for (int p = blockIdx.x; p < 256; p += G) {
        const int b = p >> 3, h = p & 7; const size_t tok0 = (size_t)TP + (size_t)b * DSEQ, pb = (size_t)b * PAST;
        AttnArgs a; a.cs = (const float*)(ws + WS_CS); a.Q = QFOX + tok0 * 512 + h * 64; a.qstride = 512;
        a.Ka_past = A.in[2] + pb * 512 + h * 64; a.Ka_new = A.out + O_KS + (size_t)b * DSEQ * 512 + h * 64; a.kastride = 512; a.Kb_past = a.Kb_new = nullptr; a.kbstride = 0;
        a.V_past = A.in[3] + pb * 512 + h * 64; a.V_new = A.out + O_VS + (size_t)b * DSEQ * 512 + h * 64; a.vstride = 512;
        a.Fq = FS + (size_t)p * KVS + PAST; a.Fk = FS + (size_t)p * KVS; a.O = MIXED + tok0 * 1024 + h * 64; a.ostride = 1024; a.P = PAST; a.qpos0 = PAST; a.nkv = KVS;
        attn_unit<64, true, 2, 4, true>(a, lds);
    }
    } else {
    for (int p = blockIdx.x; p < 256; p += G) {
        const int b = (p & 7) * 4 + (p >> 6), h = (p >> 3) & 7; const size_t tok0 = (size_t)TP + (size_t)b * DSEQ, pb = (size_t)b * PAST;
        AbsArgs a; a.Qlat = (const bf16*)(ws + WS_QLAT) + (size_t)b * DSEQ * 2048 + h * 256; a.Qrope = QMLA + tok0 * 768 + h * 96 + 64;
        a.Lat_past = (const bf16*)(ws + WS_LATPAST) + pb * 256; a.Lat_new = (const bf16*)(ws + WS_LATNEW) + tok0 * 256;
        a.Kr_past = KRPAST + pb * 32; a.Kr_new = KRNEW + tok0 * 32; a.WuvT = (const bf16*)(ws + WS_WKV) + (size_t)(512 + h * 64) * 256;
        a.O = MIXED + tok0 * 1024 + 512 + h * 64; a.cs = (const float*)(ws + WS_CS);
        mla_abs_unit(a, lds);
    }
    }
    }
}

template <class Epi> __device__ __forceinline__ void run_gemm(LAS unsigned char* lds, const bf16* Am, const bf16* Bt, int M, int N, int K, const Epi& E, int cu_shift = 0) {
    pg8::Gemm g{Am, Bt, M, N, K}; pg8::StaticOrder S; S.init(M, N, K, (int)gridDim.x, (int)((blockIdx.x + cu_shift) % gridDim.x));
    pg8::gemm_phase<Epi, pg8::StaticOrder, true, true>(lds, g, S, E);
}

__global__ void __launch_bounds__(NTHREADS, 2) fwd_kernel(Args A, int ph_lo, int ph_hi) {
    extern __shared__ __attribute__((aligned(16))) unsigned char lds_raw[];
    LAS unsigned char* lds = (LAS unsigned char*)lds_raw;
    unsigned char* ws = A.ws;
    if (threadIdx.x < 64) ((LAS unsigned*)(lds + 131072))[threadIdx.x] = 0u;
    __syncthreads();
    XcdBarrier bar = xcd_barrier_post((unsigned*)(ws + WS_CTL), (volatile LAS unsigned*)(lds + 131072 + 32));
#ifndef PH_MASK
#define PH_MASK 0xffff
#endif
#define IN(k) (((PH_MASK >> (k)) & 1) && ph_lo <= (k) && (k) < ph_hi)
#define SEAM(k) do { if (IN(k) && IN((k) + 1)) xcd_barrier(bar); } while (0)
#ifndef REP0
#define REP0 1
#endif
#ifndef REP4
#define REP4 1
#endif
#ifndef REP8
#define REP8 1
#endif
#ifndef REP1
#define REP1 1
#endif
#ifndef REP7
#define REP7 1
#endif
#ifndef REP9
#define REP9 1
#endif
    if (IN(0)) { for (int rep = 0; rep < REP0; ++rep) { p0_prologue(A, lds); __syncthreads(); } }
    SEAM(0);
    if (IN(1)) {
        EpiZ E{(bf16*)(ws + WS_QFOX), (bf16*)(ws + WS_KNEW), (bf16*)(ws + WS_VNEW), (bf16*)(ws + WS_KRNEW), (float*)(ws + WS_ZBUF), A.out, (const float*)(ws + WS_CS), A.in[10]};
        run_gemm(lds, (const bf16*)(ws + WS_H), (const bf16*)(ws + WS_WIN), TOK, NZ, DM, E);
    }
    SEAM(1);
    if (IN(2)) { p2_postz(A, lds); __syncthreads(); }
    SEAM(2);
    if (IN(3)) {
        EpiBf E{(bf16*)(ws + WS_QMLA), 768, 0.10206207261596575f * LOG2E};
        run_gemm(lds, (const bf16*)(ws + WS_QCN), (const bf16*)(ws + WS_WQ), TOK, 768, 384, E);
        EpiBf E2{(bf16*)(ws + WS_KVNEW), 1024, 1.f};
        run_gemm(lds, (const bf16*)(ws + WS_LATNEW), (const bf16*)(ws + WS_WKV), TP, 1024, 256, E2);
        EpiBf E3{(bf16*)(ws + WS_QLAT), 2048, 0.10206207261596575f * LOG2E};
        run_gemm(lds, (const bf16*)(ws + WS_QCN) + (size_t)TP * 384, (const bf16*)(ws + WS_WQA), TS, 2048, 384, E3, 64);
    }
    SEAM(3);
    if (IN(4)) { for (int rep = 0; rep < REP4; ++rep) p4_attention(A, lds); }
    SEAM(4);
    if (IN(5)) {
        pg8::Gemm g{(const bf16*)(ws + WS_MIXED), (const bf16*)(ws + WS_WOUT), TOK, DM, DM}; SplitOrder<16> S{(int)gridDim.x, (int)blockIdx.x};
        EpiOut E{A.in[0], A.in[1], (float*)(ws + WS_X1), (bf16*)(ws + WS_H), A.in[17], (float*)(ws + WS_ROWSS), (float*)(ws + WS_SLAB)};
        pg8::gemm_phase<EpiOut, SplitOrder<16>, true, true>(lds, g, S, E);
    }
    if (IN(5) && IN(7)) xcd_barrier(bar);
    if (IN(5)) {
        int t2 = threadIdx.x; asm volatile("" : "+v"(t2)); const int lane = t2 & 63, gw = blockIdx.x * NWAVES + (t2 >> 6), NGW = gridDim.x * NWAVES;
        for (int r = gw; r < TS; r += NGW) {
            const f32x4* xr = (const f32x4*)(A.in[1] + (size_t)r * DM) + lane; f32x4 v[4];
#pragma unroll
            for (int j = 0; j < 4; ++j) v[j] = xr[64 * j];
#pragma unroll
            for (int k = 0; k < DN_SL; ++k) { const f32x4* sr = (const f32x4*)((const float*)(ws + WS_SLAB) + ((size_t)k * TS + r) * DM) + lane;
#pragma unroll
                for (int j = 0; j < 4; ++j) v[j] += sr[64 * j]; }
            float ss = 0.f; const size_t row = (size_t)TP + r;
#pragma unroll
            for (int j = 0; j < 4; ++j) { ss += (v[j].x * v[j].x + v[j].y * v[j].y) + (v[j].z * v[j].z + v[j].w * v[j].w); ((f32x4*)((float*)(ws + WS_X1) + row * DM))[64 * j + lane] = v[j];
                const f32x4 gq = ((const f32x4*)A.in[17])[64 * j + lane]; const f32x4 o = v[j] * gq; ((u32x2*)((bf16*)(ws + WS_H) + row * DM))[64 * j + lane] = (u32x2){pk2(o.x, o.y), pk2(o.z, o.w)}; }
            ss = wave_sum(ss);
            if (lane == 0) ((float*)(ws + WS_RSTD))[row] = rsqrtf(ss * (1.f / DM) + EPS);
        }
        for (int r = blockIdx.x * NTHREADS + t2; r < TP; r += gridDim.x * NTHREADS) {
            const f32x4* rp = (const f32x4*)((const float*)(ws + WS_ROWSS) + (size_t)r * 16); const f32x4 t = (rp[0] + rp[1]) + (rp[2] + rp[3]);
            ((float*)(ws + WS_RSTD))[r] = rsqrtf(((t.x + t.y) + (t.z + t.w)) * (1.f / DM) + EPS);
        }
    }
    if (IN(5) && IN(7)) xcd_barrier(bar);
    if (IN(7)) { EpiGlu E{(bf16*)(ws + WS_ACT), (float*)(ws + WS_EDGE), A.in[19], A.in[20], (const float*)(ws + WS_RSTD)}; run_gemm(lds, (const bf16*)(ws + WS_H), (const bf16*)(ws + WS_WUP), TOK, DFF2, DM, E); }
    SEAM(7);
    if (IN(8)) p8_fixup(A);
    SEAM(8);
    if (IN(9)) {
        pg8::Gemm g{(const bf16*)(ws + WS_ACT), (const bf16*)(ws + WS_WDOWN), TOK, DM, DFF}; DownOrder S{(int)gridDim.x, (int)blockIdx.x};
        EpiDown E{(const float*)(ws + WS_X1), (float*)(ws + WS_X2), (float*)(ws + WS_SLAB)};
        pg8::gemm_phase<EpiDown, DownOrder, true, true>(lds, g, S, E);
    }
    SEAM(9);
    if (IN(10)) { int t2 = threadIdx.x; asm volatile("" : "+v"(t2)); const int lane = t2 & 63, gw = blockIdx.x * NWAVES + (t2 >> 6), NGW = gridDim.x * NWAVES;
        for (int m = gw; m < TOK; m += NGW) {
            if (m < TP) rms_row<true>((const float*)(ws + WS_X2) + (size_t)m * DM, A.in[22], A.out + (size_t)m * DM, lane);
            else rms_row<true>((const float*)(ws + WS_X1) + (size_t)m * DM, A.in[22], A.out + (size_t)m * DM, lane, (const float*)(ws + WS_SLAB) + (size_t)(m - TP) * DM, DN_SL, (size_t)TS * DM); } }
#undef IN
#undef SEAM
}

#ifndef N_LAUNCHES
#define N_LAUNCHES 1
#endif
extern "C" void kernel_launch(void* const* d_in, const int* in_sizes, int n_in, void* d_out, int out_size, void* d_ws, size_t ws_size, hipStream_t stream) {
    static int grid = 0;
    if (grid == 0) {
        if (n_in != 23 || (size_t)out_size != O_END || ws_size < WS_END) { fprintf(stderr, "kernel_launch: unexpected shapes: n_in %d out %d ws %zu (need %zu)\n", n_in, out_size, ws_size, (size_t)WS_END); grid = -1; return; }
        int dev = 0, cus = 0, per_cu = 0;
        (void)hipGetDevice(&dev); (void)hipDeviceGetAttribute(&cus, hipDeviceAttributeMultiprocessorCount, dev);
        if (hipFuncSetAttribute((const void*)fwd_kernel, hipFuncAttributeMaxDynamicSharedMemorySize, LDS_BYTES) != hipSuccess) { fprintf(stderr, "hipFuncSetAttribute failed\n"); grid = -1; return; }
        if (hipOccupancyMaxActiveBlocksPerMultiprocessor(&per_cu, (const void*)fwd_kernel, NTHREADS, LDS_BYTES) != hipSuccess || per_cu < 1) { fprintf(stderr, "occupancy query: %d\n", per_cu); per_cu = 1; }
        (void)hipGetLastError();
        grid = cus * 1;
    }
    if (grid < 0) return;
    if (hipMemsetAsync((char*)d_ws + WS_CTL, 0, CTL_BYTES, stream) != hipSuccess) { fprintf(stderr, "memset failed\n"); return; }
    Args a{};
    for (int i = 0; i < 23; ++i) a.in[i] = (const float*)d_in[i];
    a.out = (float*)d_out; a.ws = (unsigned char*)d_ws;
    if (N_LAUNCHES == 1) {
        hipLaunchKernelGGL(fwd_kernel, dim3(grid), dim3(NTHREADS), LDS_BYTES, stream, a, 0, 11);
    } else {
        for (int k = 0; k < 11; ++k) hipLaunchKernelGGL(fwd_kernel, dim3(grid), dim3(NTHREADS), LDS_BYTES, stream, a, k, k + 1);
    }
}
```

```cpp
#include <hip/hip_runtime.h>
#include <cstdio>
#include <cstdint>
namespace pg8 {
#define PG8_LAS __attribute__((address_space(3)))
typedef unsigned short bf16_t;
typedef short bf16x8 __attribute__((ext_vector_type(8)));
typedef float f32x4 __attribute__((ext_vector_type(4)));
typedef unsigned u32x4 __attribute__((ext_vector_type(4)));
constexpr int BM = 256, BK = 64, HALF = 128, HTB = HALF * BK * 2  , STAGE_BYTES = 8 * HTB, NXCD = 8, WGM = 8;

__host__ __device__ __forceinline__ int lds_byte(int r, int c) { const int st = (r >> 4) * 2 + (c >> 5), rr = r & 15, cc = c & 31, ob = rr * 64 + cc * 2; return st * 1024 + (ob ^ (((ob >> 9) & 1) << 5)); }
__host__ __device__ __forceinline__ void stage_rc(int b, int& R, int& C) { const int st = b / 1024, sb = b % 1024, swz = sb ^ (((sb >> 9) & 1) << 5); R = (st >> 1) * 16 + swz / 64; C = (st & 1) * 32 + (swz % 64) / 2; }
__host__ __device__ __forceinline__ int perm32(int rho) { const int n = rho >> 4, i = rho & 15; return 8 * (i >> 2) + 4 * n + (i & 3); }

struct Unit { int pm, pn, k0, nkt, sl; };
struct Gemm { const bf16_t* A; const bf16_t* Bt; int M, N, K; };

struct StaticOrder {
    int nM, nN, nwg, G, c, nkt;
    __host__ __device__ void init(int M, int N, int K, int G_, int c_) { nM = M / BM; nN = N / BM; nwg = nM * nN; G = G_; c = c_; nkt = K / BK; }
    __host__ __device__ bool next(int i, Unit& u) const {
        const long L = (long)i * G + c; if (L >= nwg) return false;
        int wgid = (int)L; { const int q = nwg / NXCD, r = nwg % NXCD, xcd = wgid % NXCD, off = wgid / NXCD; wgid = (xcd < r ? xcd * (q + 1) : r * (q + 1) + (xcd - r) * q) + off; }
        const int nig = WGM * nN, gid = wgid / nig, fm = gid * WGM, gsz = (nM - fm) < WGM ? (nM - fm) : WGM;
        u.pm = fm + ((wgid % nig) % gsz); u.pn = (wgid % nig) / gsz; u.k0 = 0; u.nkt = nkt; u.sl = -1; return true;
    }
    __device__ __forceinline__ void a_ready(const Unit&) const {}
    __device__ __forceinline__ void done(const Unit&) const {}
};

template <class Epi, class Sched, bool ALIGN_EPI = false, bool SP2 = false>
__device__ __forceinline__ void gemm_phase(PG8_LAS unsigned char* lds, const Gemm g, const Sched& S, const Epi& E) {
    const int tid = threadIdx.x, wid = __builtin_amdgcn_readfirstlane(tid >> 6), lane = tid & 63, wr = wid >> 2, wc = wid & 3, fr = lane & 15, fq = lane >> 4;
    const int K = g.K;
    unsigned voffA[2], voffB[2];
#pragma unroll
    for (int i = 0; i < 2; ++i) { int R, C; stage_rc(tid * 16 + i * 8192, R, C); const int Rb = Epi::PERM ? ((R & ~31) + perm32(R & 31)) : R;
        voffA[i] = (unsigned)(R * K + C) * 2u; voffB[i] = (unsigned)(Rb * K + C) * 2u; }
    const size_t kstep = (size_t)(BK * 2);
    const size_t hstep = (size_t)HALF * K * 2;
    const size_t tstep = 2 * hstep;
    const unsigned ldsw = (unsigned)wid * 1024u;
    const int aoff = lds_byte(wr * 64 + fr, fq * 8), boff = lds_byte(wc * 32 + fr, fq * 8);
#define PG8_SA(b, h) (((b) * 2 + (h)) * HTB)
#define PG8_SB(b, h) ((4 + (b) * 2 + (h)) * HTB)
#define PG8_STAGE(bufoff, gbase, voff) do { _Pragma("unroll") for (int _i = 0; _i < 2; ++_i) \
        __builtin_amdgcn_global_load_lds((const unsigned*)((const char*)(gbase) + (voff)[_i]), (PG8_LAS unsigned*)(lds + (bufoff) + ldsw + _i * 8192), 16, 0, 0); } while (0)
#define PG8_LDA(dst, b, h) do { _Pragma("unroll") for (int m = 0; m < 4; ++m) _Pragma("unroll") for (int k = 0; k < 2; ++k) dst[m][k] = *(const PG8_LAS bf16x8*)(lds + PG8_SA(b, h) + aoff + m * 2048 + k * 1024); } while (0)
#define PG8_LDB(dst, b, h) do { _Pragma("unroll") for (int n = 0; n < 2; ++n) _Pragma("unroll") for (int k = 0; k < 2; ++k) dst[n][k] = *(const PG8_LAS bf16x8*)(lds + PG8_SB(b, h) + boff + n * 2048 + k * 1024); } while (0)
#define PG8_MMA(ai, bj, At, Bt) do { __builtin_amdgcn_s_setprio(1); _Pragma("unroll") for (int m = 0; m < 4; ++m) _Pragma("unroll") for (int n = 0; n < 2; ++n) _Pragma("unroll") for (int k = 0; k < 2; ++k) \
        acc[ai][bj][m][n] = __builtin_amdgcn_mfma_f32_16x16x32_bf16(Bt[n][k], At[m][k], acc[ai][bj][m][n], 0, 0, 0); __builtin_amdgcn_s_setprio(0); } while (0)
#define PG8_WAIT_V(n) asm volatile("s_waitcnt vmcnt(" #n ")" ::: "memory")
#define PG8_WAIT_L(n) asm volatile("s_waitcnt lgkmcnt(" #n ")" ::: "memory")
#define PG8_BAR __builtin_amdgcn_s_barrier()
#define PG8_SCHED __builtin_amdgcn_sched_barrier(0)
    Unit cur{}, nxt{}; int ui = 0;
    if (!S.next(0, cur)) return;
    f32x4 acc[2][2][4][2];
#pragma unroll
    for (int a = 0; a < 2; ++a)
#pragma unroll
        for (int b = 0; b < 2; ++b)
#pragma unroll
            for (int m = 0; m < 4; ++m)
#pragma unroll
                for (int n = 0; n < 2; ++n) acc[a][b][m][n] = (f32x4){0.f, 0.f, 0.f, 0.f};
    bf16x8 At[4][2], B0[2][2], B1[2][2];
    const char* cA = (const char*)g.A + (size_t)cur.pm * tstep + (size_t)cur.k0 * kstep; const char* cB = (const char*)g.Bt + (size_t)cur.pn * tstep + (size_t)cur.k0 * kstep;
    S.a_ready(cur);
    if constexpr (SP2) {
        PG8_STAGE(PG8_SB(0, 0), cB, voffB); PG8_STAGE(PG8_SB(0, 1), cB + hstep, voffB); PG8_STAGE(PG8_SA(0, 0), cA, voffA); PG8_STAGE(PG8_SA(0, 1), cA + hstep, voffA);
        if (wr == 1) PG8_BAR;
        PG8_WAIT_V(2); PG8_BAR;
        PG8_STAGE(PG8_SB(1, 0), cB + kstep, voffB); PG8_STAGE(PG8_SA(1, 0), cA + kstep, voffA); PG8_STAGE(PG8_SB(1, 1), cB + hstep + kstep, voffB);
        PG8_WAIT_V(6); PG8_BAR;
    } else {
        PG8_STAGE(PG8_SB(0, 0), cB, voffB); PG8_STAGE(PG8_SA(0, 0), cA, voffA); PG8_STAGE(PG8_SB(0, 1), cB + hstep, voffB); PG8_STAGE(PG8_SA(0, 1), cA + hstep, voffA);
        if (wr == 1) PG8_BAR;
        PG8_WAIT_V(4); PG8_BAR;
        PG8_STAGE(PG8_SB(1, 0), cB + kstep, voffB); PG8_STAGE(PG8_SA(1, 0), cA + kstep, voffA); PG8_STAGE(PG8_SB(1, 1), cB + hstep + kstep, voffB);
        PG8_WAIT_V(6); PG8_BAR;
    }
    for (;;) {
        const bool has_next = S.next(ui + 1, nxt);
        const char* nA = has_next ? (const char*)g.A + (size_t)nxt.pm * tstep + (size_t)nxt.k0 * kstep : cA; const char* nB = has_next ? (const char*)g.Bt + (size_t)nxt.pn * tstep + (size_t)nxt.k0 * kstep : cB;
        const int nt = cur.nkt;
        for (int t = 0; t < nt; t += 2) {
            const bool last = (t == nt - 2);
            const char* a1 = cA + (size_t)(t + 1) * kstep;
            const char* a2 = last ? nA : cA + (size_t)(t + 2) * kstep; const char* b2 = last ? nB : cB + (size_t)(t + 2) * kstep;
            const char* a3 = a2 + kstep; const char* b3 = b2 + kstep;
            if (last && has_next) S.a_ready(nxt);
            if constexpr (SP2) {
            PG8_LDB(B0, 0, 0); PG8_LDB(B1, 0, 1); PG8_SCHED; PG8_LDA(At, 0, 0); PG8_STAGE(PG8_SA(1, 1), a1 + hstep, voffA);
            PG8_WAIT_V(8); PG8_WAIT_L(0); PG8_BAR; PG8_MMA(0, 0, At, B0); PG8_MMA(0, 1, At, B1); PG8_BAR; PG8_SCHED;
            PG8_LDA(At, 0, 1); PG8_STAGE(PG8_SB(0, 0), b2, voffB); PG8_STAGE(PG8_SB(0, 1), b2 + hstep, voffB); PG8_STAGE(PG8_SA(0, 0), a2, voffA);
            PG8_WAIT_V(8); PG8_WAIT_L(0); PG8_BAR; PG8_MMA(1, 0, At, B0); PG8_MMA(1, 1, At, B1); PG8_BAR; PG8_SCHED;
            PG8_LDB(B0, 1, 0); PG8_LDB(B1, 1, 1); PG8_SCHED; PG8_LDA(At, 1, 0); PG8_STAGE(PG8_SA(0, 1), a2 + hstep, voffA);
            PG8_WAIT_V(8); PG8_WAIT_L(0); PG8_BAR; PG8_MMA(0, 0, At, B0); PG8_MMA(0, 1, At, B1); PG8_BAR; PG8_SCHED;
            PG8_LDA(At, 1, 1); PG8_STAGE(PG8_SB(1, 0), b3, voffB); PG8_STAGE(PG8_SB(1, 1), b3 + hstep, voffB); PG8_STAGE(PG8_SA(1, 0), a3, voffA);
            PG8_WAIT_V(8); PG8_WAIT_L(0); PG8_BAR; PG8_MMA(1, 0, At, B0); PG8_MMA(1, 1, At, B1); PG8_BAR; PG8_SCHED;
            } else {
            PG8_LDB(B0, 0, 0); PG8_SCHED; PG8_LDA(At, 0, 0); PG8_STAGE(PG8_SA(1, 1), a1 + hstep, voffA);
            PG8_WAIT_L(8); PG8_BAR; PG8_WAIT_L(0); PG8_MMA(0, 0, At, B0); PG8_BAR; PG8_SCHED;
            PG8_LDB(B1, 0, 1); PG8_STAGE(PG8_SB(0, 0), b2, voffB);
            PG8_BAR; PG8_WAIT_L(0); PG8_MMA(0, 1, At, B1); PG8_BAR;
            PG8_LDA(At, 0, 1); PG8_STAGE(PG8_SA(0, 0), a2, voffA);
            PG8_BAR; PG8_WAIT_L(0); PG8_MMA(1, 0, At, B0); PG8_BAR; PG8_SCHED;
            PG8_STAGE(PG8_SB(0, 1), b2 + hstep, voffB);
            PG8_WAIT_V(6); PG8_BAR; PG8_MMA(1, 1, At, B1); PG8_BAR;
            PG8_LDB(B0, 1, 0); PG8_SCHED; PG8_LDA(At, 1, 0); PG8_STAGE(PG8_SA(0, 1), a2 + hstep, voffA);
            PG8_WAIT_L(8); PG8_BAR; PG8_WAIT_L(0); PG8_MMA(0, 0, At, B0); PG8_BAR; PG8_SCHED;
            PG8_LDB(B1, 1, 1); PG8_STAGE(PG8_SB(1, 0), b3, voffB);
            PG8_BAR; PG8_WAIT_L(0); PG8_MMA(0, 1, At, B1); PG8_BAR;
            PG8_LDA(At, 1, 1); PG8_STAGE(PG8_SA(1, 0), a3, voffA);
            PG8_BAR; PG8_WAIT_L(0); PG8_MMA(1, 0, At, B0); PG8_BAR; PG8_SCHED;
            PG8_STAGE(PG8_SB(1, 1), b3 + hstep, voffB);
            PG8_WAIT_V(6); PG8_BAR; PG8_MMA(1, 1, At, B1); PG8_BAR;
            }
        }
        if constexpr (ALIGN_EPI) { if (wr == 0) PG8_BAR; }
        if constexpr (!Epi::AFTER_DRAIN) { E(acc, cur, wr, wc, fr, fq); S.done(cur); }
        if (!has_next) break;
#pragma unroll
        for (int a = 0; a < 2; ++a)
#pragma unroll
            for (int b = 0; b < 2; ++b)
#pragma unroll
                for (int m = 0; m < 4; ++m)
#pragma unroll
                    for (int n = 0; n < 2; ++n) acc[a][b][m][n] = (f32x4){0.f, 0.f, 0.f, 0.f};
        cur = nxt; cA = nA; cB = nB; ++ui;
        if constexpr (ALIGN_EPI) { if (wr == 1) PG8_BAR; }
    }
    PG8_WAIT_V(0);
    if constexpr (!ALIGN_EPI) { if (wr == 0) PG8_BAR; }
    PG8_BAR;
    if constexpr (Epi::AFTER_DRAIN) { E.fused(acc, cur, wr, wc, fr, fq, lds, wid, lane); S.done(cur); }
#undef PG8_SA
#undef PG8_SB
#undef PG8_STAGE
#undef PG8_LDA
#undef PG8_LDB
#undef PG8_MMA
#undef PG8_WAIT_V
#undef PG8_WAIT_L
#undef PG8_BAR
#undef PG8_SCHED
}
}

#define LAS __attribute__((address_space(3)))
typedef unsigned short bf16;
typedef short bf16x8 __attribute__((ext_vector_type(8)));
typedef short s16x4 __attribute__((ext_vector_type(4)));
typedef float f32x4 __attribute__((ext_vector_type(4)));
typedef float f32x2 __attribute__((ext_vector_type(2)));
typedef float f32x16 __attribute__((ext_vector_type(16)));
typedef unsigned u32x4 __attribute__((ext_vector_type(4)));
typedef unsigned u32x2 __attribute__((ext_vector_type(2)));

constexpr int DM = 1024, SEQ = 2048, NBP = 8, DSEQ = 64, NBS = 32, PAST = 4096;
constexpr int TP = NBP * SEQ, TS = NBS * DSEQ, TOK = TP + TS;
constexpr int NPAST = NBS * PAST;
constexpr int KVS = PAST + DSEQ;
constexpr int DIN = 2216, NZ = 2304, ZW = 640;
constexpr int DFF = 2816, DFF2 = 5632;
constexpr float LOG2E = 1.4426950408889634f;
constexpr float EPS = 1e-6f;
constexpr int NTHREADS = 512, NWAVES = 8;
constexpr int LDS_BYTES = 147456;

constexpr size_t O_YP = 0, O_YS = O_YP + (size_t)TP * DM, O_KP = O_YS + (size_t)TS * DM, O_VP = O_KP + (size_t)TP * 512, O_LFP = O_VP + (size_t)TP * 512,
                 O_LATP = O_LFP + (size_t)TP * 8, O_KRP = O_LATP + (size_t)TP * 256, O_CVP = O_KRP + (size_t)TP * 32, O_KS = O_CVP + (size_t)NBP * 2 * DFF2,
                 O_VS = O_KS + (size_t)TS * 512, O_LFS = O_VS + (size_t)TS * 512, O_LATS = O_LFS + (size_t)TS * 8, O_KRS = O_LATS + (size_t)TS * 256,
                 O_CVS = O_KRS + (size_t)TS * 32, O_END = O_CVS + (size_t)NBS * 2 * DFF2;

constexpr size_t MiB = 1u << 20;
constexpr size_t WS_CTL = 0, CTL_BYTES = 16384;
constexpr size_t WS_WIN = 1 * MiB, WS_WQ = 6 * MiB, WS_WKV = 7 * MiB, WS_WOUT = 8 * MiB, WS_WUP = 10 * MiB, WS_WDOWN = 21 * MiB, WS_CS = 27 * MiB,
                 WS_FS = 28 * MiB, WS_FP = 33 * MiB, WS_H = 34 * MiB, WS_QFOX = 70 * MiB, WS_KNEW = 88 * MiB, WS_VNEW = 106 * MiB, WS_ZBUF = 124 * MiB,
                 WS_QCN = 169 * MiB, WS_LATNEW = 183 * MiB, WS_KRNEW = 192 * MiB, WS_QMLA = 194 * MiB, WS_KVNEW = 221 * MiB, WS_MIXED = 257 * MiB,
                 WS_X1 = 293 * MiB, WS_X2 = 124 * MiB  , WS_LATPAST = 365 * MiB, WS_KRPAST = 429 * MiB, WS_KPAST = 437 * MiB,
                 WS_VPAST = 565 * MiB, WS_SLAB = 565 * MiB  , WS_KVPAST = 693 * MiB, WS_EDGE = 693 * MiB  , WS_ACT = 437 * MiB  , WS_WQA = 949 * MiB, WS_QLAT = 951 * MiB, WS_ROWSS = 959 * MiB  , WS_RSTD = 960 * MiB + 512 * 1024  , WS_END = 961 * MiB;

struct Args {
    const float* in[23];
    float* out;
    unsigned char* ws;
};

__device__ __forceinline__ unsigned pk2(float lo, float hi) { typedef __bf16 bf2 __attribute__((ext_vector_type(2))); f32x2 v = {lo, hi}; bf2 b = __builtin_convertvector(v, bf2); return __builtin_bit_cast(unsigned, b); }
__device__ __forceinline__ float bflo(unsigned w) { return __builtin_bit_cast(float, w << 16); }
__device__ __forceinline__ float bfhi(unsigned w) { return __builtin_bit_cast(float, w & 0xffff0000u); }
__device__ __forceinline__ float wave_sum(float v) {
#pragma unroll
    for (int o = 1; o < 64; o <<= 1) v += __shfl_xor(v, o);
    return v;
}
__device__ __forceinline__ void st_bf4(bf16* p, f32x4 v) { *(u32x2*)p = (u32x2){pk2(v.x, v.y), pk2(v.z, v.w)}; }
__device__ __forceinline__ void lds_wait() { asm volatile("s_waitcnt lgkmcnt(0)" ::: "memory"); }
__device__ __forceinline__ float fast_exp2(float x) { return __builtin_amdgcn_exp2f(x); }

#define XB_TMO      128
#define XB_XCNT(j)  (256  + 64 * (j))
#define XB_XSUB(j)  (1280 + 64 * (j))
#define XB_XGEN(j)  (2304 + 64 * (j))
#define XB_TOP      3328
#define XB_TOPGEN   3392
#define XCD_BAR_WORDS 3456
#define XB_SPIN_CAP (1u << 18)

__device__ __forceinline__ unsigned xb_ld(unsigned* p)              { return __hip_atomic_load(p, __ATOMIC_RELAXED, __HIP_MEMORY_SCOPE_AGENT); }
__device__ __forceinline__ unsigned xb_add(unsigned* p, unsigned v) { return __hip_atomic_fetch_add(p, v, __ATOMIC_RELAXED, __HIP_MEMORY_SCOPE_AGENT); }
__device__ __forceinline__ unsigned xb_xcc_id() { return (unsigned)__builtin_amdgcn_s_getreg((3 << 11) | 20) & 0xFu; }
#define XB_SPIN(cond, bar) do { unsigned _sp = 0; while (cond) { __builtin_amdgcn_s_sleep(1); \
    if ((++_sp & 255u) == 0u) { if (xb_ld(&(bar)[XB_TMO])) break; if (_sp > XB_SPIN_CAP) { atomicAdd(&(bar)[XB_TMO], 1u); break; } } } } while (0)

struct XcdBarrier {
    unsigned* bar; unsigned x;
    volatile LAS unsigned* st;
};

__device__ __forceinline__ XcdBarrier xcd_barrier_post(unsigned* bar, volatile LAS unsigned* st) {
    XcdBarrier b; b.bar = bar; b.x = xb_xcc_id(); b.st = st;
    if (threadIdx.x == 0) (void)xb_add(&bar[XB_XCNT(b.x)], 1u);
    return b;
}
__device__ __forceinline__ void xcd_barrier_complete(unsigned* bar, unsigned x, unsigned& nloc, unsigned& nx) {
    const unsigned G = gridDim.x * gridDim.y * gridDim.z;
    unsigned sum, cnt, mine, sp = 0u;
    for (;;) {
        sum = 0u; cnt = 0u; mine = 0u;
#pragma unroll
        for (unsigned j = 0; j < 16; ++j) { const unsigned c = xb_ld(&bar[XB_XCNT(j)]); sum += c; cnt += (c > 0u) ? 1u : 0u; mine = (j == x) ? c : mine; }
        if (sum == G) break;
        __builtin_amdgcn_s_sleep(1);
        if ((++sp & 255u) == 0u) { if (xb_ld(&bar[XB_TMO])) break; if (sp > XB_SPIN_CAP) { atomicAdd(&bar[XB_TMO], 1u); break; } }
    }
    nloc = mine > 0u ? mine : 1u; nx = cnt > 0u ? cnt : 1u;
}

__device__ __forceinline__ void xcd_barrier(const XcdBarrier& b) {
    asm volatile("s_waitcnt vmcnt(0)" ::: "memory");
    __syncthreads();
    if (threadIdx.x == 0) {
        unsigned* bar = b.bar;
        __builtin_amdgcn_s_waitcnt(0);
        unsigned nloc = b.st[0], nx = b.st[1];
        if (nloc == 0u) { xcd_barrier_complete(bar, b.x, nloc, nx); b.st[0] = nloc; b.st[1] = nx; }
        const unsigned old = xb_add(&bar[XB_XSUB(b.x)], 1u);
        const unsigned gen = old / nloc;
        if (old + 1u == (gen + 1u) * nloc) {
            __builtin_amdgcn_fence(__ATOMIC_RELEASE, "agent");
            asm volatile("s_waitcnt vmcnt(0)" ::: "memory");
            const unsigned og = xb_add(&bar[XB_TOP], 1u);
            const unsigned tg = og / nx;
            if (og + 1u == (tg + 1u) * nx) xb_add(&bar[XB_TOPGEN], 1u);
            else XB_SPIN(xb_ld(&bar[XB_TOPGEN]) == tg, bar);
            __builtin_amdgcn_fence(__ATOMIC_ACQUIRE, "agent");
            xb_add(&bar[XB_XGEN(b.x)], 1u);
            asm volatile("s_waitcnt vmcnt(0)" ::: "memory");
        } else {
            XB_SPIN(xb_ld(&bar[XB_XGEN(b.x)]) == gen, bar);
            __builtin_amdgcn_fence(__ATOMIC_ACQUIRE, "agent");
            asm volatile("s_waitcnt vmcnt(0)" ::: "memory");
        }
    }
    __syncthreads();
}

template <int MODE> __device__ __forceinline__ int srccol(int n) {
    if (MODE == 0) return n;
    if (MODE == 2) return ((n & 16) ? DFF : 0) + 16 * (n >> 5) + (n & 15);
    if (n < 1536) return n;
    if (n < 1920) return 1544 + (n - 1536);
    if (n < 2176) return 1928 + (n - 1920);
    if (n < 2208) return 2184 + (n - 2176);
    if (n < 2216) return 1536 + (n - 2208);
    return -1;
}
template <int MODE>
__device__ __forceinline__ void tr_item(const float* W, int K, int Nsrc, int Ndst, bf16* WT, int row_off, LAS float* scr, int item, int lane) {
    const int nblk = Ndst / 32, kb = item / nblk, nb = item % nblk, k0 = 64 * kb, n0 = 32 * nb;
    const int sc = srccol<MODE>(n0 + (lane & 31));
    float wv[32];
#pragma unroll
    for (int i = 0; i < 32; ++i) { const int kk = 2 * i + (lane >> 5); wv[i] = W[(size_t)(k0 + kk) * Nsrc + (sc >= 0 ? sc : 0)]; }
#pragma unroll
    for (int i = 0; i < 32; ++i) { const int kk = 2 * i + (lane >> 5); scr[kk * 33 + (lane & 31)] = sc >= 0 ? wv[i] : 0.f; }
    lds_wait();
    const int c = lane & 7;
#pragma unroll
    for (int j = 0; j < 4; ++j) { const int n = (lane >> 3) + 8 * j; const LAS float* s = scr + (8 * c) * 33 + n;
        u32x4 o; o.x = pk2(s[0 * 33], s[1 * 33]); o.y = pk2(s[2 * 33], s[3 * 33]); o.z = pk2(s[4 * 33], s[5 * 33]); o.w = pk2(s[6 * 33], s[7 * 33]);
        *(u32x4*)(WT + (size_t)(row_off + n0 + n) * K + k0 + 8 * c) = o; }
    lds_wait();
}
template <bool OUTF, int NSLAB = 0>
__device__ __forceinline__ void rms_row(const float* xrow, const float* g, void* orow, int lane, const float* slab = nullptr, size_t slab_stride = 0) {
    const f32x4* xr = (const f32x4*)xrow + lane; const f32x4* gr = (const f32x4*)g + lane;
    f32x4 v[4]; float s = 0.f;
#pragma unroll
    for (int j = 0; j < 4; ++j) v[j] = xr[64 * j];
    if (NSLAB > 0) { f32x4 sv[NSLAB > 0 ? NSLAB : 1][4];
#pragma unroll
        for (int k = 0; k < NSLAB; ++k) { const f32x4* sr = (const f32x4*)(slab + (size_t)k * slab_stride) + lane;
#pragma unroll
            for (int j = 0; j < 4; ++j) sv[k][j] = sr[64 * j]; }
#pragma unroll
        for (int k = 0; k < NSLAB; ++k)
#pragma unroll
            for (int j = 0; j < 4; ++j) v[j] += sv[k][j]; }
#pragma unroll
    for (int j = 0; j < 4; ++j) { s += (v[j].x * v[j].x + v[j].y * v[j].y) + (v[j].z * v[j].z + v[j].w * v[j].w); }
    const float rstd = rsqrtf(wave_sum(s) * (1.f / DM) + EPS);
#pragma unroll
    for (int j = 0; j < 4; ++j) { const f32x4 gv = gr[64 * j]; const f32x4 o = v[j] * rstd * gv;
        if (OUTF) ((f32x4*)orow)[64 * j + lane] = o;
        else ((u32x2*)orow)[64 * j + lane] = (u32x2){pk2(o.x, o.y), pk2(o.z, o.w)}; }
}
__device__ __forceinline__ void rms_row3(const float* x0, const float* x1, const float* x2, const float* g, bf16* o0, bf16* o1, bf16* o2, int lane) {
    const f32x4* xp[3] = {(const f32x4*)x0 + lane, (const f32x4*)x1 + lane, (const f32x4*)x2 + lane}; bf16* op[3] = {o0, o1, o2};
    f32x4 v[3][4]; float ss[3];
#pragma unroll
    for (int u = 0; u < 3; ++u)
#pragma unroll
        for (int j = 0; j < 4; ++j) v[u][j] = xp[u][64 * j];
#pragma unroll
    for (int u = 0; u < 3; ++u) { ss[u] = 0.f;
#pragma unroll
        for (int j = 0; j < 4; ++j) ss[u] += (v[u][j].x * v[u][j].x + v[u][j].y * v[u][j].y) + (v[u][j].z * v[u][j].z + v[u][j].w * v[u][j].w); }
#pragma unroll
    for (int o = 1; o < 64; o <<= 1) {
#pragma unroll
        for (int u = 0; u < 3; ++u) ss[u] += __shfl_xor(ss[u], o); }
#pragma unroll
    for (int j = 0; j < 4; ++j) { const f32x4 gv = ((const f32x4*)g)[64 * j + lane];
#pragma unroll
        for (int u = 0; u < 3; ++u) { const f32x4 o = v[u][j] * rsqrtf(ss[u] * (1.f / DM) + EPS) * gv; ((u32x2*)op[u])[64 * j + lane] = (u32x2){pk2(o.x, o.y), pk2(o.z, o.w)}; } }
}
__device__ __forceinline__ void cvt_stream(const float* src, bf16* dst, size_t n4, size_t gtid, size_t gthreads) {
    size_t i = gtid;
    for (; i + 7 * gthreads < n4; i += 8 * gthreads) {
        f32x4 v[8];
#pragma unroll
        for (int k = 0; k < 8; ++k) v[k] = __builtin_nontemporal_load((const f32x4*)src + i + k * gthreads);
#pragma unroll
        for (int k = 0; k < 8; ++k) ((u32x2*)dst)[i + k * gthreads] = (u32x2){pk2(v[k].x, v[k].y), pk2(v[k].z, v[k].w)};
    }
    for (; i < n4; i += gthreads) { const f32x4 v = ((const f32x4*)src)[i]; ((u32x2*)dst)[i] = (u32x2){pk2(v.x, v.y), pk2(v.z, v.w)}; }
}
__device__ __forceinline__ float wave_incl_scan(float v, int lane) {
#pragma unroll
    for (int o = 1; o < 64; o <<= 1) { const float t = __shfl_up(v, o); if (lane >= o) v += t; }
    return v;
}

template <int NCH>
__device__ __forceinline__ void scan_seq(const float* src, float* dst, float base, int lane, LAS float* scr) {
    float v[NCH];
#pragma unroll
    for (int c = 0; c < NCH; ++c) v[c] = src[(size_t)(64 * c + lane) * 8];
#pragma unroll
    for (int c = 0; c < NCH; ++c) { v[c] = wave_incl_scan(v[c], lane); if (lane == 63) scr[c] = v[c]; }
    lds_wait();
    const float st = wave_incl_scan(lane < NCH ? scr[lane] : 0.f, lane);
    lds_wait();
#pragma unroll
    for (int c = 0; c < NCH; ++c) { const float carry = c ? __builtin_bit_cast(float, __builtin_amdgcn_readlane(__builtin_bit_cast(int, st), c ? c - 1 : 0)) : 0.f; dst[64 * c + lane] = (v[c] + carry + base) * LOG2E; }
}
__device__ __forceinline__ void p0_prologue(const Args& A, LAS unsigned char* lds) {
    const int tid = threadIdx.x, lane = tid & 63, wave = tid >> 6;
    const int G = gridDim.x, gw = blockIdx.x * NWAVES + wave, NGW = G * NWAVES;
    unsigned char* ws = A.ws;
    LAS float* scr = (LAS float*)(lds + wave * 16384);
    constexpr int I_IN = (DM / 64) * (NZ / 32), I_Q = (384 / 64) * (768 / 32), I_UK = (256 / 64) * (512 / 32), I_OUT = (DM / 64) * (DM / 32),
                  I_UP = (DM / 64) * (DFF2 / 32), I_DN = (DFF / 64) * (DM / 32);
    constexpr int NITEMS = I_IN + I_Q + 2 * I_UK + I_OUT + I_UP + I_DN;
    for (int it = gw; it < NITEMS; it += NGW) {
        int r = it;
        if (r < I_IN) { tr_item<1>(A.in[9], DM, DIN, NZ, (bf16*)(ws + WS_WIN), 0, scr, r, lane); continue; } r -= I_IN;
        if (r < I_Q) { tr_item<0>(A.in[12], 384, 768, 768, (bf16*)(ws + WS_WQ), 0, scr, r, lane); continue; } r -= I_Q;
        if (r < I_UK) { tr_item<0>(A.in[14], 256, 512, 512, (bf16*)(ws + WS_WKV), 0, scr, r, lane); continue; } r -= I_UK;
        if (r < I_UK) { tr_item<0>(A.in[15], 256, 512, 512, (bf16*)(ws + WS_WKV), 512, scr, r, lane); continue; } r -= I_UK;
        if (r < I_OUT) { tr_item<0>(A.in[16], DM, DM, DM, (bf16*)(ws + WS_WOUT), 0, scr, r, lane); continue; } r -= I_OUT;
        if (r < I_UP) { tr_item<2>(A.in[18], DM, DFF2, DFF2, (bf16*)(ws + WS_WUP), 0, scr, r, lane); continue; } r -= I_UP;
        tr_item<0>(A.in[21], DFF, DM, DM, (bf16*)(ws + WS_WDOWN), 0, scr, r, lane);
    }
    for (int it = gw; it < 8 * 12 * 8; it += NGW) {
        const int h = it / 96, kt = (it % 96) / 8, ct = it % 8; const int r32 = lane & 31, hi2 = lane >> 5;
        const float* wq = A.in[12] + (size_t)(kt * 32 + r32) * 768 + h * 96 + 8 * hi2; const float* uk = A.in[14] + (size_t)(ct * 32 + r32) * 512 + h * 64 + 8 * hi2;
        f32x16 acc = {};
#pragma unroll
        for (int st = 0; st < 4; ++st) {
            const f32x4 a0 = *(const f32x4*)(wq + 16 * st), a1 = *(const f32x4*)(wq + 16 * st + 4), b0 = *(const f32x4*)(uk + 16 * st), b1 = *(const f32x4*)(uk + 16 * st + 4);
            const u32x4 aw = {pk2(a0.x, a0.y), pk2(a0.z, a0.w), pk2(a1.x, a1.y), pk2(a1.z, a1.w)}, bw = {pk2(b0.x, b0.y), pk2(b0.z, b0.w), pk2(b1.x, b1.y), pk2(b1.z, b1.w)};
            acc = __builtin_amdgcn_mfma_f32_32x32x16_bf16(__builtin_bit_cast(bf16x8, aw), __builtin_bit_cast(bf16x8, bw), acc, 0, 0, 0);
        }
        bf16* o = (bf16*)(ws + WS_WQA) + (size_t)(h * 256 + ct * 32 + r32) * 384 + kt * 32 + 4 * hi2;
#pragma unroll
        for (int q = 0; q < 4; ++q) st_bf4(o + 8 * q, (f32x4){acc[4 * q], acc[4 * q + 1], acc[4 * q + 2], acc[4 * q + 3]});
    }
    {
        bf16* H = (bf16*)(ws + WS_H); int m = gw;
        for (; m + 2 * NGW < TOK; m += 3 * NGW) { const int m1 = m + NGW, m2 = m + 2 * NGW;
            rms_row3(m < TP ? A.in[0] + (size_t)m * DM : A.in[1] + (size_t)(m - TP) * DM, m1 < TP ? A.in[0] + (size_t)m1 * DM : A.in[1] + (size_t)(m1 - TP) * DM,
                     m2 < TP ? A.in[0] + (size_t)m2 * DM : A.in[1] + (size_t)(m2 - TP) * DM, A.in[8], H + (size_t)m * DM, H + (size_t)m1 * DM, H + (size_t)m2 * DM, lane); }
        for (; m < TOK; m += NGW) rms_row<false>(m < TP ? A.in[0] + (size_t)m * DM : A.in[1] + (size_t)(m - TP) * DM, A.in[8], H + (size_t)m * DM, lane);
    }
    {
        const int gt = blockIdx.x * NTHREADS + tid, GT = G * NTHREADS;
        for (int i = gt; i < 2112 * 16; i += GT) {
            const int pidx = i >> 4, k = i & 15; const int pos = pidx < 2048 ? pidx : PAST + (pidx - 2048);
            const float inv = exp2f(-(float)k * (13.287712379549449f / 16.f));
            const float ang = (float)pos * inv;
            const float kq = floorf(ang * 0.15915494309189535f);
            float r = fmaf(-kq, 6.2831854820251465f, ang); r = fmaf(-kq, -1.7484555e-7f, r);
            const float rev = r * 0.15915494309189535f;
            ((f32x2*)(ws + WS_CS))[i] = (f32x2){__builtin_amdgcn_cosf(rev), __builtin_amdgcn_sinf(rev)};
        }
    }
    for (int sq = (wave == 0 ? (int)blockIdx.x : NBS * 8); sq < NBS * 8; sq += G) {
        const int b = sq >> 3, h = sq & 7; const float* lf = A.in[4] + (size_t)b * PAST * 8 + h; float* Fo = (float*)(ws + WS_FS) + (size_t)sq * KVS;
        scan_seq<PAST / 64>(lf, Fo, 0.f, lane, scr);
    }
    {
        const size_t gt = (size_t)blockIdx.x * NTHREADS + tid, GT = (size_t)G * NTHREADS;
        cvt_stream(A.in[5], (bf16*)(ws + WS_LATPAST), (size_t)NPAST * 256 / 4, gt, GT);
        cvt_stream(A.in[6], (bf16*)(ws + WS_KRPAST), (size_t)NPAST * 32 / 4, gt, GT);
    }
}

__device__ __forceinline__ void rope4_calc(f32x4& x1, f32x4& x2, float pos, const f32x4 inv) {
    f32x4 c, sn;
#pragma unroll
    for (int e = 0; e < 4; ++e) { const float ang = pos * inv[e]; const float kq = floorf(ang * 0.15915494309189535f);
        float r = fmaf(-kq, 6.2831854820251465f, ang); r = fmaf(-kq, -1.7484555e-7f, r); const float rev = r * 0.15915494309189535f;
        c[e] = __builtin_amdgcn_cosf(rev); sn[e] = __builtin_amdgcn_sinf(rev); }
    const f32x4 o1 = x1 * c - x2 * sn, o2 = x1 * sn + x2 * c; x1 = o1; x2 = o2;
}
__device__ __forceinline__ void rope4(f32x4& x1, f32x4& x2, const float* cs  ) {
    const f32x4 a = ((const f32x4*)cs)[0], b = ((const f32x4*)cs)[1];
    const f32x4 c = {a.x, a.z, b.x, b.z}, s = {a.y, a.w, b.y, b.w};
    const f32x4 o1 = x1 * c - x2 * s, o2 = x1 * s + x2 * c; x1 = o1; x2 = o2;
}
__device__ __forceinline__ float log_sigmoid(float x) { return fminf(x, 0.f) - log1pf(__expf(-fabsf(x))); }

struct EpiZ {
    static constexpr bool PERM = false, AFTER_DRAIN = false;
    bf16 *qfox, *knew, *vnew, *krnew; float* zbuf; float* out; const float* cs; const float* bfg;
    __device__ __forceinline__ void operator()(const f32x4 (&acc)[2][2][4][2], const pg8::Unit& u, int wr, int wc, int fr, int fq) const {
        const bool smp = u.pm >= TP / 256;
        const int row0 = u.pm * 256 + wr * 64 + fr;
#pragma unroll
        for (int bj = 0; bj < 2; ++bj) {
            const int cg = u.pn * 256 + bj * 128 + wc * 32;
            const int c0 = cg + 4 * fq;
#pragma unroll
            for (int ai = 0; ai < 2; ++ai)
#pragma unroll
                for (int m = 0; m < 4; ++m) {
                    const int row = row0 + ai * 128 + m * 16; const size_t lr = smp ? (size_t)(row - TP) : (size_t)row;
                    f32x4 v0 = acc[ai][bj][m][0], v1 = acc[ai][bj][m][1];
                    if (cg < 512) { const float sc = 0.125f * LOG2E; st_bf4(qfox + (size_t)row * 512 + c0, v0 * sc); st_bf4(qfox + (size_t)row * 512 + c0 + 16, v1 * sc); }
                    else if (cg < 1024) { const int c = c0 - 512; float* o = out + (smp ? O_KS : O_KP) + lr * 512 + c; *(f32x4*)o = v0; *(f32x4*)(o + 16) = v1;
                        st_bf4(knew + (size_t)row * 512 + c, v0); st_bf4(knew + (size_t)row * 512 + c + 16, v1); }
                    else if (cg < 1536) { const int c = c0 - 1024; float* o = out + (smp ? O_VS : O_VP) + lr * 512 + c; *(f32x4*)o = v0; *(f32x4*)(o + 16) = v1;
                        st_bf4(vnew + (size_t)row * 512 + c, v0); st_bf4(vnew + (size_t)row * 512 + c + 16, v1); }
                    else if (cg < 2176) { float* z = zbuf + (size_t)row * ZW + (c0 - 1536); *(f32x4*)z = v0; *(f32x4*)(z + 16) = v1; }
                    else if (cg == 2176) {
                        const int pidx = smp ? 2048 + ((row - TP) & 63) : (row & 2047);
                        rope4_calc(v0, v1, (float)(pidx < SEQ ? pidx : PAST + (pidx - SEQ)), (f32x4){exp2f(-(float)(4 * fq) * (13.287712379549449f / 16.f)), exp2f(-(float)(4 * fq + 1) * (13.287712379549449f / 16.f)), exp2f(-(float)(4 * fq + 2) * (13.287712379549449f / 16.f)), exp2f(-(float)(4 * fq + 3) * (13.287712379549449f / 16.f))});
                        float* o = out + (smp ? O_KRS : O_KRP) + lr * 32 + 4 * fq; *(f32x4*)o = v0; *(f32x4*)(o + 16) = v1;
                        st_bf4(krnew + (size_t)row * 32 + 4 * fq, v0); st_bf4(krnew + (size_t)row * 32 + 4 * fq + 16, v1);
                    } else if (cg == 2208) {
                        if (fq < 2) { const f32x4 b = *(const f32x4*)(bfg + 4 * fq);
                            f32x4 lf; lf.x = log_sigmoid(v0.x + b.x); lf.y = log_sigmoid(v0.y + b.y); lf.z = log_sigmoid(v0.z + b.z); lf.w = log_sigmoid(v0.w + b.w);
                            *(f32x4*)(out + (smp ? O_LFS : O_LFP) + lr * 8 + 4 * fq) = lf; }
                    }
                }
        }
    }
};
struct EpiBf {
    static constexpr bool PERM = true, AFTER_DRAIN = false;
    bf16* O; int ldc; float sc;
    __device__ __forceinline__ void operator()(const f32x4 (&acc)[2][2][4][2], const pg8::Unit& u, int wr, int wc, int fr, int fq) const {
        const int row0 = u.pm * 256 + wr * 64 + fr;
#pragma unroll
        for (int ai = 0; ai < 2; ++ai)
#pragma unroll
            for (int m = 0; m < 4; ++m) { bf16* rp = O + (size_t)(row0 + ai * 128 + m * 16) * ldc + u.pn * 256 + wc * 32 + 8 * fq;
#pragma unroll
                for (int bj = 0; bj < 2; ++bj) { const f32x4 v0 = acc[ai][bj][m][0] * sc, v1 = acc[ai][bj][m][1] * sc;
                    *(u32x4*)(rp + bj * 128) = (u32x4){pk2(v0.x, v0.y), pk2(v0.z, v0.w), pk2(v1.x, v1.y), pk2(v1.z, v1.w)}; } }
    }
};
constexpr int DN_SL = 8;
template <int NKT  >
struct SplitOrder {
    int G, c;
    __device__ __forceinline__ bool next(int i, pg8::Unit& u) const {
        const int L = i * G + c; if (L >= 256 + 32 * DN_SL) return false;
        const bool full = L < 256; const int r = full ? L : L - 256, x = r & 7, y = r >> 3;
        pg8::Unit t; t.pm = full ? 8 * x + (y & 7) : 64 + x; t.pn = full ? (y >> 3) : (y & 3); const int sl = y >> 2;
        if (NKT == 44) { t.k0 = full ? 0 : (sl < 6 ? 6 * sl : 36 + 4 * (sl - 6)); t.nkt = full ? 44 : (sl < 6 ? 6 : 4); }
        else { t.k0 = full ? 0 : 2 * sl; t.nkt = full ? 16 : 2; }
        t.sl = full ? -1 : sl;
        u = t; return true;
    }
    __device__ __forceinline__ void a_ready(const pg8::Unit&) const {}
    __device__ __forceinline__ void done(const pg8::Unit&) const {}
};
typedef SplitOrder<44> DownOrder;
struct EpiDown {
    static constexpr bool PERM = false, AFTER_DRAIN = false;
    const float* x1; float* x2; float* slab;
    __device__ __forceinline__ void operator()(const f32x4 (&acc)[2][2][4][2], const pg8::Unit& u, int wr, int wc, int fr, int fq) const {
        const int row0 = u.pm * 256 + wr * 64 + fr; const int cb = u.pn * 256 + wc * 32 + 4 * fq;
        if (u.sl >= 0) {
#pragma unroll
            for (int ai = 0; ai < 2; ++ai)
#pragma unroll
                for (int m = 0; m < 4; ++m) { float* op = slab + ((size_t)u.sl * TS + (row0 + ai * 128 + m * 16 - TP)) * DM + cb;
#pragma unroll
                    for (int bj = 0; bj < 2; ++bj)
#pragma unroll
                        for (int n = 0; n < 2; ++n) *(f32x4*)(op + bj * 128 + n * 16) = acc[ai][bj][m][n]; }
            return;
        }
#pragma unroll
        for (int ai = 0; ai < 2; ++ai) {
            f32x4 xb[4][2][2];
#pragma unroll
            for (int m = 0; m < 4; ++m) { const float* bp = x1 + (size_t)(row0 + ai * 128 + m * 16) * DM + cb;
#pragma unroll
                for (int bj = 0; bj < 2; ++bj)
#pragma unroll
                    for (int n = 0; n < 2; ++n) xb[m][bj][n] = *(const f32x4*)(bp + bj * 128 + n * 16); }
#pragma unroll
            for (int m = 0; m < 4; ++m) { float* op = x2 + (size_t)(row0 + ai * 128 + m * 16) * DM + cb;
#pragma unroll
                for (int bj = 0; bj < 2; ++bj)
#pragma unroll
                    for (int n = 0; n < 2; ++n) *(f32x4*)(op + bj * 128 + n * 16) = xb[m][bj][n] + acc[ai][bj][m][n]; }
        }
    }
};
struct EpiOut {
    static constexpr bool PERM = false, AFTER_DRAIN = false;
    const float* b0; const float* b1; float* O; bf16* H; const float* g; float* rowss; float* slab;
    __device__ __forceinline__ void operator()(const f32x4 (&acc)[2][2][4][2], const pg8::Unit& u, int wr, int wc, int fr, int fq) const {
        const int row0 = u.pm * 256 + wr * 64 + fr; const bool smp = u.pm >= TP / 256; const int cb = u.pn * 256 + wc * 32 + 4 * fq;
        if (u.sl >= 0) {
#pragma unroll
            for (int ai = 0; ai < 2; ++ai)
#pragma unroll
                for (int m = 0; m < 4; ++m) { float* sp = slab + ((size_t)u.sl * TS + (row0 + ai * 128 + m * 16 - TP)) * DM + cb;
#pragma unroll
                    for (int bj = 0; bj < 2; ++bj)
#pragma unroll
                        for (int n = 0; n < 2; ++n) *(f32x4*)(sp + bj * 128 + n * 16) = acc[ai][bj][m][n]; }
            return;
        }
        f32x4 gv[2][2];
#pragma unroll
        for (int bj = 0; bj < 2; ++bj)
#pragma unroll
            for (int n = 0; n < 2; ++n) gv[bj][n] = *(const f32x4*)(g + cb + bj * 128 + n * 16);
#pragma unroll
        for (int aim = 0; aim < 4; ++aim) { const int ai = aim >> 1, mb = (aim & 1) * 2;
            f32x4 xb[2][2][2];
#pragma unroll
            for (int mm = 0; mm < 2; ++mm) { const int row = row0 + ai * 128 + (mb + mm) * 16; const float* bp = (smp ? b1 + (size_t)(row - TP) * DM : b0 + (size_t)row * DM) + cb;
#pragma unroll
                for (int bj = 0; bj < 2; ++bj)
#pragma unroll
                    for (int n = 0; n < 2; ++n) xb[mm][bj][n] = *(const f32x4*)(bp + bj * 128 + n * 16); }
#pragma unroll
            for (int mm = 0; mm < 2; ++mm) { const int m = mb + mm; const int row = row0 + ai * 128 + m * 16; float* op = O + (size_t)row * DM + cb; bf16* hp = H + (size_t)row * DM + cb;
                float ss = 0.f;
#pragma unroll
                for (int bj = 0; bj < 2; ++bj)
#pragma unroll
                    for (int n = 0; n < 2; ++n) { const f32x4 x = xb[mm][bj][n] + acc[ai][bj][m][n]; *(f32x4*)(op + bj * 128 + n * 16) = x;
                        ss += (x.x * x.x + x.y * x.y) + (x.z * x.z + x.w * x.w); st_bf4(hp + bj * 128 + n * 16, x * gv[bj][n]); }
                ss += __shfl_xor(ss, 16); ss += __shfl_xor(ss, 32);
                if (fq == 0) rowss[(size_t)row * 16 + u.pn * 4 + wc] = ss;
            }
        }
    }
};
struct EpiRes {
    static constexpr bool PERM = false, AFTER_DRAIN = false;
    const float* b0; const float* b1; float* O;
    __device__ __forceinline__ void operator()(const f32x4 (&acc)[2][2][4][2], const pg8::Unit& u, int wr, int wc, int fr, int fq) const {
        const int row0 = u.pm * 256 + wr * 64 + fr; const bool smp = u.pm >= TP / 256;
#pragma unroll
        for (int ai = 0; ai < 2; ++ai)
#pragma unroll
            for (int m = 0; m < 4; ++m) { const int row = row0 + ai * 128 + m * 16; const int cb = u.pn * 256 + wc * 32 + 4 * fq;
                const float* bp = (smp ? b1 + (size_t)(row - TP) * DM : b0 + (size_t)row * DM) + cb; float* op = O + (size_t)row * DM + cb;
#pragma unroll
                for (int bj = 0; bj < 2; ++bj)
#pragma unroll
                    for (int n = 0; n < 2; ++n) *(f32x4*)(op + bj * 128 + n * 16) = *(const f32x4*)(bp + bj * 128 + n * 16) + acc[ai][bj][m][n]; }
    }
};


__device__ __forceinline__ float silu(float g) { return g * __builtin_amdgcn_rcpf(1.f + fast_exp2(-g * LOG2E)); }
template <int CTRL> __device__ __forceinline__ float dpp_mov(float old, float src) {
    return __builtin_bit_cast(float, __builtin_amdgcn_update_dpp(__builtin_bit_cast(int, old), __builtin_bit_cast(int, src), CTRL, 0xf, 0xf, false)); }
__device__ __forceinline__ f32x4 rows_m1(f32x4 cur, f32x4 prev) { f32x4 o;
#pragma unroll
    for (int e = 0; e < 4; ++e) o[e] = dpp_mov<0x111>(dpp_mov<0x121>(0.f, prev[e]), cur[e]);
    return o; }
__device__ __forceinline__ f32x4 rows_m2(f32x4 cur, f32x4 prev) { f32x4 o;
#pragma unroll
    for (int e = 0; e < 4; ++e) o[e] = dpp_mov<0x112>(dpp_mov<0x122>(0.f, prev[e]), cur[e]);
    return o; }
struct EpiGlu {
    static constexpr bool PERM = false, AFTER_DRAIN = false;
    bf16* act; float* edge; const float* cw; const float* cb; const float* rowss;
    __device__ __forceinline__ void operator()(const f32x4 (&acc)[2][2][4][2], const pg8::Unit& u, int wr, int wc, int fr, int fq) const {
        float rstd[2][4];
#pragma unroll
        for (int ai = 0; ai < 2; ++ai)
#pragma unroll
            for (int m = 0; m < 4; ++m) rstd[ai][m] = rowss[u.pm * 256 + ai * 128 + wr * 64 + m * 16 + fr];
#pragma unroll
        for (int bj = 0; bj < 2; ++bj) {
            const int j = 16 * ((u.pn * 256 + bj * 128 + wc * 32) >> 5) + 4 * fq;
            const f32x4 w0g = *(const f32x4*)(cw + j), w1g = *(const f32x4*)(cw + DFF2 + j), w2g = *(const f32x4*)(cw + 2 * DFF2 + j), bg = *(const f32x4*)(cb + j);
            const f32x4 w0v = *(const f32x4*)(cw + DFF + j), w1v = *(const f32x4*)(cw + DFF2 + DFF + j), w2v = *(const f32x4*)(cw + 2 * DFF2 + DFF + j), bv = *(const f32x4*)(cb + DFF + j);
#pragma unroll
            for (int ai = 0; ai < 2; ++ai) {
                const int blk = u.pm * 4 + ai * 2 + wr; const int row0 = blk * 64 + fr;
#pragma unroll
                for (int m = 0; m < 4; ++m) {
                    const f32x4 gc = acc[ai][bj][m][0] * rstd[ai][m], vc = acc[ai][bj][m][1] * rstd[ai][m];
                    const f32x4 gp = acc[ai][bj][m ? m - 1 : 0][0] * rstd[ai][m ? m - 1 : 0], vp = acc[ai][bj][m ? m - 1 : 0][1] * rstd[ai][m ? m - 1 : 0];
                    const f32x4 g1 = rows_m1(gc, gp), g2 = rows_m2(gc, gp), v1 = rows_m1(vc, vp), v2 = rows_m2(vc, vp);
                    const f32x4 g = bg + w0g * g2 + w1g * g1 + w2g * gc, v = bv + w0v * v2 + w1v * v1 + w2v * vc;
                    f32x4 a; a.x = silu(g.x) * v.x; a.y = silu(g.y) * v.y; a.z = silu(g.z) * v.z; a.w = silu(g.w) * v.w;
                    if (m > 0 || fr >= 2) st_bf4(act + (size_t)(row0 + 16 * m) * DFF + j, a);
                    if (m == 0 && fr < 2) { float* e = edge + ((size_t)blk * 4 + fr) * DFF2; *(f32x4*)(e + j) = gc; *(f32x4*)(e + DFF + j) = vc; }
                    if (m == 3 && fr >= 14) { float* e = edge + ((size_t)blk * 4 + 2 + (fr - 14)) * DFF2; *(f32x4*)(e + j) = gc; *(f32x4*)(e + DFF + j) = vc; }
                }
            }
        }
    }
};

__device__ __forceinline__ void p2_postz(const Args& A, LAS unsigned char* lds) {
    const int tid = threadIdx.x, lane = tid & 63, wave = tid >> 6; const int gw = blockIdx.x * NWAVES + wave, NGW = gridDim.x * NWAVES;
    unsigned char* ws = A.ws; const float* zb = (const float*)(ws + WS_ZBUF);
    f32x2 gq[3]; { for (int j = 0; j < 3; ++j) gq[j] = ((const f32x2*)A.in[11])[lane + 64 * j]; }
    const f32x4 gk = ((const f32x4*)A.in[13])[lane];
    for (int m0 = gw; m0 < TOK; m0 += 3 * NGW) {
        f32x2 v[3][3]; f32x4 c[3]; float sq[3], sk[3]; bool ok[3];
#pragma unroll
        for (int u = 0; u < 3; ++u) { const int m = m0 + u * NGW; ok[u] = m < TOK; const float* z = zb + (size_t)(ok[u] ? m : m0) * ZW;
#pragma unroll
            for (int j = 0; j < 3; ++j) v[u][j] = ((const f32x2*)z)[lane + 64 * j];
            c[u] = ((const f32x4*)(z + 384))[lane]; }
#pragma unroll
        for (int u = 0; u < 3; ++u) { sq[u] = 0.f;
#pragma unroll
            for (int j = 0; j < 3; ++j) sq[u] += v[u][j].x * v[u][j].x + v[u][j].y * v[u][j].y;
            sk[u] = (c[u].x * c[u].x + c[u].y * c[u].y) + (c[u].z * c[u].z + c[u].w * c[u].w); }
#pragma unroll
        for (int o = 1; o < 64; o <<= 1) {
#pragma unroll
            for (int u = 0; u < 3; ++u) { sq[u] += __shfl_xor(sq[u], o); sk[u] += __shfl_xor(sk[u], o); } }
#pragma unroll
        for (int u = 0; u < 3; ++u) if (ok[u]) { const int m = m0 + u * NGW;
            const float rq = rsqrtf(sq[u] * (1.f / 384.f) + EPS), rk = rsqrtf(sk[u] * (1.f / 256.f) + EPS);
            unsigned* o = (unsigned*)((bf16*)(ws + WS_QCN) + (size_t)m * 384);
#pragma unroll
            for (int j = 0; j < 3; ++j) o[lane + 64 * j] = pk2(v[u][j].x * rq * gq[j].x, v[u][j].y * rq * gq[j].y);
            const f32x4 ov = c[u] * rk * gk;
            float* op = A.out + (m < TP ? O_LATP + (size_t)m * 256 : O_LATS + (size_t)(m - TP) * 256); ((f32x4*)op)[lane] = ov;
            st_bf4((bf16*)(ws + WS_LATNEW) + (size_t)m * 256 + 4 * lane, ov); }
    }
    for (int sq = ((gw & 3) == 0 ? (gw >> 2) : 64 + 256); sq < 64 + 256; sq += (NGW >> 2)) {
        if (sq < 64) { const int b = sq >> 3, h = sq & 7; const float* lf = A.out + O_LFP + (size_t)b * SEQ * 8 + h; float* Fo = (float*)(ws + WS_FP) + (size_t)sq * SEQ; scan_seq<SEQ / 64>(lf, Fo, 0.f, lane, (LAS float*)(lds + wave * 16384)); }
        else { const int s2 = sq - 64, b = s2 >> 3, h = s2 & 7; const float* lf = A.out + O_LFS + (size_t)b * DSEQ * 8 + h; float* Fo = (float*)(ws + WS_FS) + (size_t)s2 * KVS;
            const float base = Fo[PAST - 1]; const float v = wave_incl_scan(lf[(size_t)lane * 8], lane); Fo[PAST + lane] = base + v * LOG2E; }
    }
}

__device__ __forceinline__ f32x4 ld_bf4(const bf16* p) { const u32x2 w = *(const u32x2*)p; return (f32x4){bflo(w.x), bfhi(w.x), bflo(w.y), bfhi(w.y)}; }
__device__ __forceinline__ void p8_fixup(const Args& A) {
    int tid = threadIdx.x; asm volatile("" : "+v"(tid)); const int lane = tid & 63, wave = tid >> 6; const int gw = blockIdx.x * NWAVES + wave, NGW = gridDim.x * NWAVES;
    unsigned char* ws = A.ws; const float* __restrict__ EDGE = (const float*)(ws + WS_EDGE); bf16* __restrict__ ACT = (bf16*)(ws + WS_ACT);
    const float* __restrict__ cw = A.in[19]; const float* __restrict__ cb = A.in[20];
    constexpr int NBLK = TOK / 64, NSTRIP = DFF / 256, NIT = NBLK * NSTRIP;
    for (int it0 = gw; it0 < NIT; it0 += 2 * NGW) {
        f32x4 wg[2][4], wv[2][4], pg[2][2], pv[2][2], cg[2][2], cv[2][2], sg[2][2], sv[2][2]; bool ok[2], last[2], smp[2]; int j0[2], tok0[2], bb[2];
#pragma unroll
        for (int u = 0; u < 2; ++u) {
            const int it = it0 + u * NGW; ok[u] = it < NIT; const int itc = ok[u] ? it : it0;
            const int blk = itc / NSTRIP, strip = itc % NSTRIP; j0[u] = strip * 256 + lane * 4; tok0[u] = blk * 64;
            smp[u] = tok0[u] >= TP; const int T = smp[u] ? DSEQ : SEQ; const int lt = smp[u] ? tok0[u] - TP : tok0[u]; bb[u] = lt / T; const int t0 = lt % T; last[u] = (t0 + 64 == T);
#pragma unroll
            for (int k = 0; k < 3; ++k) { wg[u][k] = *(const f32x4*)(cw + k * DFF2 + j0[u]); wv[u][k] = *(const f32x4*)(cw + k * DFF2 + DFF + j0[u]); }
            wg[u][3] = *(const f32x4*)(cb + j0[u]); wv[u][3] = *(const f32x4*)(cb + DFF + j0[u]);
            const float* pe = (t0 == 0) ? (smp[u] ? A.in[7] + (size_t)bb[u] * 2 * DFF2 : EDGE  ) : EDGE + ((size_t)(blk - 1) * 4 + 2) * DFF2;
            const bool zero = (t0 == 0) && !smp[u];
#pragma unroll
            for (int i = 0; i < 2; ++i) { pg[u][i] = *(const f32x4*)(pe + i * DFF2 + j0[u]); pv[u][i] = *(const f32x4*)(pe + i * DFF2 + DFF + j0[u]);
                if (zero) { pg[u][i] = (f32x4){0.f, 0.f, 0.f, 0.f}; pv[u][i] = (f32x4){0.f, 0.f, 0.f, 0.f}; }
                const float* e = EDGE + ((size_t)blk * 4 + i) * DFF2; cg[u][i] = *(const f32x4*)(e + j0[u]); cv[u][i] = *(const f32x4*)(e + DFF + j0[u]);
                const float* e2 = EDGE + ((size_t)blk * 4 + 2 + i) * DFF2; sg[u][i] = *(const f32x4*)(e2 + j0[u]); sv[u][i] = *(const f32x4*)(e2 + DFF + j0[u]); }
        }
#pragma unroll
        for (int u = 0; u < 2; ++u) if (ok[u]) {
            f32x4 g2 = pg[u][0], g1 = pg[u][1], v2 = pv[u][0], v1 = pv[u][1];
#pragma unroll
            for (int i = 0; i < 2; ++i) {
                const f32x4 gc = cg[u][i], vc = cv[u][i];
                const f32x4 g = wg[u][3] + wg[u][0] * g2 + wg[u][1] * g1 + wg[u][2] * gc, v = wv[u][3] + wv[u][0] * v2 + wv[u][1] * v1 + wv[u][2] * vc;
                f32x4 a; a.x = silu(g.x) * v.x; a.y = silu(g.y) * v.y; a.z = silu(g.z) * v.z; a.w = silu(g.w) * v.w;
                st_bf4(ACT + (size_t)(tok0[u] + i) * DFF + j0[u], a);
                g2 = g1; g1 = gc; v2 = v1; v1 = vc;
            }
            if (last[u]) {
#pragma unroll
                for (int i = 0; i < 2; ++i) { float* o = A.out + (smp[u] ? O_CVS : O_CVP) + ((size_t)bb[u] * 2 + i) * DFF2; *(f32x4*)(o + j0[u]) = sg[u][i]; *(f32x4*)(o + DFF + j0[u]) = sv[u][i]; }
            }
        }
    }
}

struct AttnArgs {
    const bf16* Q; int qstride;
    const void *Ka_past, *Ka_new; int kastride;
    const bf16 *Kb_past, *Kb_new; int kbstride;
    const void *V_past, *V_new; int vstride;
    const float *Fq, *Fk;
    bf16* O; int ostride;
    int P, qpos0, nkv;
    const float* cs;
};
__device__ __forceinline__ int crow(int r, int hi) { return (r & 3) + 8 * (r >> 2) + 4 * hi; }
__device__ __forceinline__ s16x4 tr_read(const LAS unsigned char* p) { typedef short v4i16 __attribute__((ext_vector_type(4))); return __builtin_bit_cast(s16x4, __builtin_amdgcn_ds_read_tr16_b64_v4i16((LAS v4i16*)p)); }

template <int DQK, bool FOX, int QS, int KS, bool F32>
__device__ __forceinline__ void attn_unit(const AttnArgs& a, LAS unsigned char* lds_base) {
    LAS unsigned char* const lds = lds_base;
    static_assert(QS * KS == NWAVES, "8 waves");
    constexpr int KRB = (DQK + 8) * 2, VRB = 144, NKK = DQK / 16;
    constexpr int OFF_V = 64 * KS * KRB, OFF_F = OFF_V + 64 * KS * VRB, OFF_Q = OFF_F + 64 * KS * 4, OFF_END = OFF_Q + QS * NKK * 1024;
    constexpr bool QLDS = KS > 1;
    static_assert(OFF_END <= 131072, "attention LDS");
    int tid = threadIdx.x; asm volatile("" : "+v"(tid));
    const int lane = tid & 63, q32 = lane & 31, hi = lane >> 5; const int wid = __builtin_amdgcn_readfirstlane(tid >> 6);
    const int qs = wid % QS, ks = wid / QS;
    const int NT = (a.nkv + 64 * KS - 1) / (64 * KS);
    const int qmin = a.qpos0 + qs * 32, qpos = qmin + q32;
    bf16x8 qf[NKK];
    { const bf16* qp = a.Q + (size_t)(qs * 32 + q32) * a.qstride + hi * 8;
#pragma unroll
      for (int kk = 0; kk < NKK; ++kk) qf[kk] = *(const bf16x8*)(qp + kk * 16); }
    if (DQK == 96) {
        const int pidx = qpos < SEQ ? qpos : SEQ + (qpos - PAST);
        const f32x4* cp = (const f32x4*)(a.cs + ((size_t)pidx * 16 + 8 * hi) * 2);
        const u32x4 w1 = __builtin_bit_cast(u32x4, qf[NKK - 2]), w2 = __builtin_bit_cast(u32x4, qf[NKK - 1]); u32x4 r1, r2;
#pragma unroll
        for (int j = 0; j < 4; ++j) { const f32x4 c = cp[j];
            const float a0 = bflo(w1[j]), a1 = bfhi(w1[j]), b0 = bflo(w2[j]), b1 = bfhi(w2[j]);
            r1[j] = pk2(a0 * c.x - b0 * c.y, a1 * c.z - b1 * c.w); r2[j] = pk2(a0 * c.y + b0 * c.x, a1 * c.w + b1 * c.z); }
        qf[NKK - 2] = __builtin_bit_cast(bf16x8, r1); qf[NKK - 1] = __builtin_bit_cast(bf16x8, r2);
    }
    LAS unsigned char* qlds = lds + OFF_Q + qs * (NKK * 1024) + lane * 16;
    if (QLDS) {
#pragma unroll
        for (int kk = 0; kk < NKK; ++kk) *(LAS bf16x8*)(qlds + kk * 1024) = qf[kk];
    }
    const float fqv = FOX ? a.Fq[qs * 32 + q32] : 0.f;
    float mrun = -1e30f, lsum = 0.f; f32x16 o0 = {}, o1 = {};
    u32x4 rka[KS], rv[F32 ? 1 : KS]; u32x4 rkb[(DQK == 96) ? (KS + 1) / 2 : 1]; float rf = 0.f;
    f32x4 fka[F32 ? KS : 1][2], fva[F32 ? KS : 1][2];
    const int lrow = tid >> 3, lch = tid & 7;
    const int brow = (tid & 255) >> 2, bch = tid & 3;
    auto load_k = [&](int T) {
        const int jT = T * KS * 64; const bool past = jT < a.P; const size_t r0 = (size_t)(past ? jT : jT - a.P);
        if (F32) { const float* kp = (const float*)(past ? a.Ka_past : a.Ka_new) + (r0 + lrow) * a.kastride + lch * 4;
#pragma unroll
            for (int s = 0; s < KS; ++s) if (jT + s * 64 < a.nkv) { const f32x4* p4 = (const f32x4*)(kp + (size_t)s * 64 * a.kastride); fka[F32 ? s : 0][0] = p4[0]; fka[F32 ? s : 0][1] = p4[8]; } }
        else { const bf16* kp = (const bf16*)(past ? a.Ka_past : a.Ka_new) + (r0 + lrow) * a.kastride + lch * 8;
#pragma unroll
            for (int s = 0; s < KS; ++s) if (jT + s * 64 < a.nkv) rka[s] = *(const u32x4*)(kp + (size_t)s * 64 * a.kastride); }
        if (DQK == 96) { const bf16* bp = (past ? a.Kb_past : a.Kb_new) + (r0 + (tid >> 8) * 64 + brow) * a.kbstride + bch * 8;
#pragma unroll
            for (int i = 0; i < (KS + 1) / 2; ++i) { const int s = 2 * i + (tid >> 8); if (s < KS && jT + s * 64 < a.nkv) rkb[i] = *(const u32x4*)(bp + (size_t)i * 128 * a.kbstride); }
        }
        if (FOX) { const int j = jT + tid; if (tid < 64 * KS && j < a.nkv) rf = a.Fk[j]; }
    };
    auto cvt_k = [&]() {
        if (F32) {
#pragma unroll
            for (int s = 0; s < KS; ++s) { const f32x4 k0 = fka[F32 ? s : 0][0], k1 = fka[F32 ? s : 0][1]; rka[s] = (u32x4){pk2(k0.x, k0.y), pk2(k0.z, k0.w), pk2(k1.x, k1.y), pk2(k1.z, k1.w)}; }
        }
    };
    auto load_v = [&](int T) {
        const int jT = T * KS * 64; const bool past = jT < a.P; const size_t r0 = (size_t)(past ? jT : jT - a.P);
        if (F32) { const float* vp = (const float*)(past ? a.V_past : a.V_new) + (r0 + lrow) * a.vstride + lch * 4;
#pragma unroll
            for (int s = 0; s < KS; ++s) if (jT + s * 64 < a.nkv) { const f32x4* p4 = (const f32x4*)(vp + (size_t)s * 64 * a.vstride); fva[F32 ? s : 0][0] = p4[0]; fva[F32 ? s : 0][1] = p4[8]; } }
        else { const bf16* vp = (const bf16*)(past ? a.V_past : a.V_new) + (r0 + lrow) * a.vstride + lch * 8;
#pragma unroll
            for (int s = 0; s < KS; ++s) if (jT + s * 64 < a.nkv) rv[F32 ? 0 : s] = *(const u32x4*)(vp + (size_t)s * 64 * a.vstride); }
    };
    constexpr bool DB = (KS == 1);
    static_assert(!DB || OFF_Q <= 32768, "double buffer stride");
    auto store_tile = [&](int T) {
        LAS unsigned char* const lds = lds_base + (DB ? (T & 1) * 32768 : 0);
#pragma unroll
        for (int s = 0; s < KS; ++s) { const int j0 = (T * KS + s) * 64;
            if (j0 < a.nkv) {
                if (F32) { const f32x4 v0 = fva[F32 ? s : 0][0], v1 = fva[F32 ? s : 0][1]; LAS unsigned char* kr = lds + (s * 64 + lrow) * KRB + lch * 8; LAS unsigned char* vr = lds + OFF_V + (s * 64 + lrow) * VRB + lch * 8;
                    *(LAS u32x2*)kr = (u32x2){rka[s].x, rka[s].y}; *(LAS u32x2*)(kr + 64) = (u32x2){rka[s].z, rka[s].w};
                    *(LAS u32x2*)vr = (u32x2){pk2(v0.x, v0.y), pk2(v0.z, v0.w)}; *(LAS u32x2*)(vr + 64) = (u32x2){pk2(v1.x, v1.y), pk2(v1.z, v1.w)}; }
                else { *(LAS u32x4*)(lds + (s * 64 + lrow) * KRB + lch * 16) = rka[s]; *(LAS u32x4*)(lds + OFF_V + (s * 64 + lrow) * VRB + lch * 16) = rv[F32 ? 0 : s]; } } }
        if (DQK == 96) {
#pragma unroll
            for (int i = 0; i < (KS + 1) / 2; ++i) { const int s = 2 * i + (tid >> 8); const int j0 = (T * KS + s) * 64;
                if (s < KS && j0 < a.nkv) *(LAS u32x4*)(lds + (s * 64 + brow) * KRB + 128 + bch * 16) = rkb[i]; }
        }
        if (FOX) { if (tid < 64 * KS) *(LAS float*)(lds + OFF_F + tid * 4) = rf; }
    };
    load_k(0); cvt_k(); load_v(0);
    const LAS unsigned char* kbase0 = lds + (ks * 64 + q32) * KRB + hi * 16;
    const LAS unsigned char* vbase0 = lds + OFF_V + (ks * 64 + 4 * hi + ((lane & 15) >> 2)) * VRB + (16 * ((lane >> 4) & 1) + 4 * (lane & 3)) * 2;
    const LAS unsigned char* fbase0 = lds + OFF_F + (ks * 64 + 4 * hi) * 4;
    if (DB) { store_tile(0); __syncthreads(); }
    for (int T = 0; T < NT; ++T) {
        if (!DB) { __syncthreads(); store_tile(T); __syncthreads(); }
        const int bo = DB ? (T & 1) * 32768 : 0;
        const LAS unsigned char* kbase = kbase0 + bo; const LAS unsigned char* vbase = vbase0 + bo; const LAS unsigned char* fbase = fbase0 + bo;
        if (T + 1 < NT) load_k(T + 1);
        __builtin_amdgcn_sched_barrier(0);
        const int tt = T * KS + ks; const int j0 = tt * 64;
        const bool valid = (j0 < a.nkv) && (FOX ? (j0 <= qmin + 31) : (tt <= (qmin >> 6)));
        bf16x8 pb[4];
        if (valid) {
            f32x16 p0 = {}, p1 = {};
#pragma unroll
            for (int kk = 0; kk < NKK; ++kk) {
                const bf16x8 k0 = *(const LAS bf16x8*)(kbase + kk * 32), k1 = *(const LAS bf16x8*)(kbase + 32 * KRB + kk * 32);
                const bf16x8 qv = QLDS ? *(const LAS bf16x8*)(qlds + kk * 1024) : qf[kk];
                p0 = __builtin_amdgcn_mfma_f32_32x32x16_bf16(k0, qv, p0, 0, 0, 0);
                p1 = __builtin_amdgcn_mfma_f32_32x32x16_bf16(k1, qv, p1, 0, 0, 0);
            }
            if (FOX) {
#pragma unroll
                for (int g = 0; g < 4; ++g) { const f32x4 f0 = *(const LAS f32x4*)(fbase + g * 32), f1 = *(const LAS f32x4*)(fbase + 128 + g * 32);
#pragma unroll
                    for (int e = 0; e < 4; ++e) { p0[4 * g + e] += fqv - f0[e]; p1[4 * g + e] += fqv - f1[e]; } }
                if (j0 + 63 > qmin) {
#pragma unroll
                    for (int r = 0; r < 16; ++r) { const int kv = j0 + crow(r, hi); if (kv > qpos) p0[r] = -1e30f; if (kv + 32 > qpos) p1[r] = -1e30f; }
                }
            }
            float mt = fmaxf(p0[0], p1[0]);
#pragma unroll
            for (int r = 1; r < 16; ++r) mt = fmaxf(mt, fmaxf(p0[r], p1[r]));
            mt = fmaxf(mt, __shfl_xor(mt, 32));
            const float mnew = fmaxf(mrun, mt), alpha = fast_exp2(mrun - mnew); mrun = mnew;
            float ps = 0.f;
#pragma unroll
            for (int r = 0; r < 16; ++r) { p0[r] = fast_exp2(p0[r] - mnew); p1[r] = fast_exp2(p1[r] - mnew); ps += p0[r] + p1[r]; }
            lsum = lsum * alpha + ps;
            if (__builtin_amdgcn_ballot_w64(alpha != 1.f)) { o0 = o0 * alpha; o1 = o1 * alpha; }
#pragma unroll
            for (int s = 0; s < 2; ++s) {
                u32x4 w0 = {pk2(p0[8 * s], p0[8 * s + 1]), pk2(p0[8 * s + 2], p0[8 * s + 3]), pk2(p0[8 * s + 4], p0[8 * s + 5]), pk2(p0[8 * s + 6], p0[8 * s + 7])};
                u32x4 w1 = {pk2(p1[8 * s], p1[8 * s + 1]), pk2(p1[8 * s + 2], p1[8 * s + 3]), pk2(p1[8 * s + 4], p1[8 * s + 5]), pk2(p1[8 * s + 6], p1[8 * s + 7])};
                pb[s] = __builtin_bit_cast(bf16x8, w0); pb[2 + s] = __builtin_bit_cast(bf16x8, w1);
            }
        }
        __builtin_amdgcn_sched_barrier(0);
        if (T + 1 < NT) { cvt_k(); load_v(T + 1); }
        __builtin_amdgcn_sched_barrier(0);
        if (valid) {
#pragma unroll
            for (int kst = 0; kst < 4; ++kst) {
                const LAS unsigned char* vp = vbase + 16 * kst * VRB;
                const s16x4 a0l = tr_read(vp), a0h = tr_read(vp + 8 * VRB), a1l = tr_read(vp + 64), a1h = tr_read(vp + 64 + 8 * VRB);
                const bf16x8 A0 = {a0l[0], a0l[1], a0l[2], a0l[3], a0h[0], a0h[1], a0h[2], a0h[3]}, A1 = {a1l[0], a1l[1], a1l[2], a1l[3], a1h[0], a1h[1], a1h[2], a1h[3]};
                o0 = __builtin_amdgcn_mfma_f32_32x32x16_bf16(A0, pb[kst], o0, 0, 0, 0);
                o1 = __builtin_amdgcn_mfma_f32_32x32x16_bf16(A1, pb[kst], o1, 0, 0, 0);
            }
        }
        if (DB) { if (T + 1 < NT) store_tile(T + 1); __syncthreads(); }
    }
    lsum += __shfl_xor(lsum, 32);
    if (KS == 1) {
        const float inv = 1.f / lsum; bf16* op = a.O + (size_t)(qs * 32 + q32) * a.ostride + 4 * hi;
#pragma unroll
        for (int g = 0; g < 4; ++g) { st_bf4(op + 8 * g, (f32x4){o0[4 * g] * inv, o0[4 * g + 1] * inv, o0[4 * g + 2] * inv, o0[4 * g + 3] * inv});
            st_bf4(op + 32 + 8 * g, (f32x4){o1[4 * g] * inv, o1[4 * g + 1] * inv, o1[4 * g + 2] * inv, o1[4 * g + 3] * inv}); }
    } else {
        __syncthreads();
        LAS float* osc = (LAS float*)lds + wid * 2048;
        LAS float* msc = (LAS float*)(lds + 65536) + wid * 32; LAS float* lsc = (LAS float*)(lds + 65536 + 1024) + wid * 32;
#pragma unroll
        for (int r = 0; r < 16; ++r) { osc[r * 64 + lane] = o0[r]; osc[(16 + r) * 64 + lane] = o1[r]; }
        if (hi == 0) { msc[q32] = mrun; lsc[q32] = lsum; }
        __syncthreads();
        if (ks == 0) {
            float mk[KS], M = -1e30f;
#pragma unroll
            for (int k = 0; k < KS; ++k) { mk[k] = ((LAS float*)(lds + 65536))[(k * QS + qs) * 32 + q32]; M = fmaxf(M, mk[k]); }
            float L = 0.f; f32x16 t0 = {}, t1 = {};
#pragma unroll 1
            for (int k = 0; k < KS; ++k) { const float w = fast_exp2(((LAS float*)(lds + 65536))[(k * QS + qs) * 32 + q32] - M); L += w * ((LAS float*)(lds + 65536 + 1024))[(k * QS + qs) * 32 + q32];
                const LAS float* os = (LAS float*)lds + (k * QS + qs) * 2048;
#pragma unroll
                for (int r = 0; r < 16; ++r) { t0[r] += w * os[r * 64 + lane]; t1[r] += w * os[(16 + r) * 64 + lane]; } }
            const float inv = 1.f / L; bf16* op = a.O + (size_t)(qs * 32 + q32) * a.ostride + 4 * hi;
#pragma unroll
            for (int g = 0; g < 4; ++g) { st_bf4(op + 8 * g, (f32x4){t0[4 * g] * inv, t0[4 * g + 1] * inv, t0[4 * g + 2] * inv, t0[4 * g + 3] * inv});
                st_bf4(op + 32 + 8 * g, (f32x4){t1[4 * g] * inv, t1[4 * g + 1] * inv, t1[4 * g + 2] * inv, t1[4 * g + 3] * inv}); }
        }
    }
    __syncthreads();
}


struct Attn2Args {
    const bf16* Q[2]; int qstride;
    const bf16* Ka; int kastride; const bf16* Kb; int kbstride; const bf16* V; int vstride;
    const float* Fk; bf16* O[2]; int ostride; int qpos0[2]; int nkv[2]; const float* cs;
};
template <int DQK, bool FOX, int NG>
__device__ __forceinline__ void attn_unit2(const Attn2Args& a, LAS unsigned char* lds) {
    constexpr int KRB = (DQK + 8) * 2, VRB = 144, NKK = DQK / 16, OFF_V = 64 * KRB, OFF_F = OFF_V + 64 * VRB, BUF = 32768;
    static_assert(OFF_F + 256 <= BUF, "tile buffer");
    int tid = threadIdx.x; asm volatile("" : "+v"(tid));
    const int lane = tid & 63, q32 = lane & 31, hi = lane >> 5; const int wid = __builtin_amdgcn_readfirstlane(tid >> 6);
    int qmin[NG], qpos[NG]; bf16x8 qf[NG][NKK]; float mrun[NG], lsum[NG]; f32x16 o0[NG], o1[NG];
#pragma unroll
    for (int g = 0; g < NG; ++g) {
        qmin[g] = a.qpos0[g] + wid * 32; qpos[g] = qmin[g] + q32; mrun[g] = -1e30f; lsum[g] = 0.f; o0[g] = f32x16{}; o1[g] = f32x16{};
        const bf16* qp = a.Q[g] + (size_t)(wid * 32 + q32) * a.qstride + hi * 8;
#pragma unroll
        for (int kk = 0; kk < NKK; ++kk) qf[g][kk] = *(const bf16x8*)(qp + kk * 16);
        if (DQK == 96) {
            const f32x4* cp = (const f32x4*)(a.cs + ((size_t)qpos[g] * 16 + 8 * hi) * 2);
            const u32x4 w1 = __builtin_bit_cast(u32x4, qf[g][NKK - 2]), w2 = __builtin_bit_cast(u32x4, qf[g][NKK - 1]); u32x4 r1, r2;
#pragma unroll
            for (int j = 0; j < 4; ++j) { const f32x4 c = cp[j]; const float a0 = bflo(w1[j]), a1 = bfhi(w1[j]), b0 = bflo(w2[j]), b1 = bfhi(w2[j]);
                r1[j] = pk2(a0 * c.x - b0 * c.y, a1 * c.z - b1 * c.w); r2[j] = pk2(a0 * c.y + b0 * c.x, a1 * c.w + b1 * c.z); }
            qf[g][NKK - 2] = __builtin_bit_cast(bf16x8, r1); qf[g][NKK - 1] = __builtin_bit_cast(bf16x8, r2);
        }
    }
    const int NT = a.nkv[NG - 1] / 64;
    struct Stage { u32x4 ka, v, kb; float f; }; Stage st0, st1;
    const int lrow = tid >> 3, lch = tid & 7, brow = (tid & 255) >> 2, bch = tid & 3;
    auto load_t = [&](int T, Stage& st) {
        st.ka = *(const u32x4*)(a.Ka + (size_t)(T * 64 + lrow) * a.kastride + lch * 8);
        st.v = *(const u32x4*)(a.V + (size_t)(T * 64 + lrow) * a.vstride + lch * 8);
        if (DQK == 96) { if (tid < 256) st.kb = *(const u32x4*)(a.Kb + (size_t)(T * 64 + brow) * a.kbstride + bch * 8); }
        if (FOX) { if (tid < 64) st.f = a.Fk[T * 64 + tid]; }
    };
    auto store_tile = [&](int T, const Stage& st) {
        LAS unsigned char* b = lds + (T & 1) * BUF;
        *(LAS u32x4*)(b + lrow * KRB + lch * 16) = st.ka; *(LAS u32x4*)(b + OFF_V + lrow * VRB + lch * 16) = st.v;
        if (DQK == 96) { if (tid < 256) *(LAS u32x4*)(b + brow * KRB + 128 + bch * 16) = st.kb; }
        if (FOX) { if (tid < 64) *(LAS float*)(b + OFF_F + tid * 4) = st.f; }
    };
    load_t(0, st0); if (NT > 1) load_t(1, st1);
    const LAS unsigned char* kbase0 = lds + q32 * KRB + hi * 16;
    const LAS unsigned char* vbase0 = lds + OFF_V + (4 * hi + ((lane & 15) >> 2)) * VRB + (16 * ((lane >> 4) & 1) + 4 * (lane & 3)) * 2;
    const LAS unsigned char* fbase0 = lds + OFF_F + (4 * hi) * 4;
    store_tile(0, st0); __syncthreads();
    auto step = [&](int T, Stage& stL  , const Stage& stS  ) {
        const int bo = (T & 1) * BUF; const LAS unsigned char* kbase = kbase0 + bo; const LAS unsigned char* vbase = vbase0 + bo; const LAS unsigned char* fbase = fbase0 + bo;
        if (T + 2 < NT) load_t(T + 2, stL);
        __builtin_amdgcn_sched_barrier(0);
        const int j0 = T * 64; bool valid[NG]; bool any = false;
#pragma unroll
        for (int g = 0; g < NG; ++g) { valid[g] = (j0 < a.nkv[g]) && (FOX ? (j0 <= qmin[g] + 31) : (T <= (qmin[g] >> 6))); any = any || valid[g]; }
        bf16x8 pb[NG][4];
        if (any) {
            f32x16 p0[NG], p1[NG];
            if (FOX) {
                f32x16 b0, b1;
#pragma unroll
                for (int q = 0; q < 4; ++q) { const f32x4 f0 = *(const LAS f32x4*)(fbase + q * 32), f1 = *(const LAS f32x4*)(fbase + 128 + q * 32);
#pragma unroll
                    for (int e = 0; e < 4; ++e) { b0[4 * q + e] = -f0[e]; b1[4 * q + e] = -f1[e]; } }
#pragma unroll
                for (int g = 0; g < NG; ++g) { p0[g] = b0; p1[g] = b1; }
            } else {
#pragma unroll
                for (int g = 0; g < NG; ++g) { p0[g] = f32x16{}; p1[g] = f32x16{}; } }
#pragma unroll
            for (int kk = 0; kk < NKK; ++kk) {
                const bf16x8 k0 = *(const LAS bf16x8*)(kbase + kk * 32), k1 = *(const LAS bf16x8*)(kbase + 32 * KRB + kk * 32);
#pragma unroll
                for (int g = 0; g < NG; ++g) if (valid[g]) {
                    p0[g] = __builtin_amdgcn_mfma_f32_32x32x16_bf16(k0, qf[g][kk], p0[g], 0, 0, 0);
                    p1[g] = __builtin_amdgcn_mfma_f32_32x32x16_bf16(k1, qf[g][kk], p1[g], 0, 0, 0); }
            }
#pragma unroll
            for (int g = 0; g < NG; ++g) if (valid[g]) {
                if (FOX && j0 + 63 > qmin[g]) {
#pragma unroll
                    for (int r = 0; r < 16; ++r) { const int kv = j0 + crow(r, hi); if (kv > qpos[g]) p0[g][r] = -1e30f; if (kv + 32 > qpos[g]) p1[g][r] = -1e30f; }
                }
                float mt = fmaxf(p0[g][0], p1[g][0]);
#pragma unroll
                for (int r = 1; r < 16; ++r) mt = fmaxf(mt, fmaxf(p0[g][r], p1[g][r]));
                mt = fmaxf(mt, __shfl_xor(mt, 32));
                const float mnew = fmaxf(mrun[g], mt), alpha = fast_exp2(mrun[g] - mnew); mrun[g] = mnew;
                float ps = 0.f;
#pragma unroll
                for (int r = 0; r < 16; ++r) { p0[g][r] = fast_exp2(p0[g][r] - mnew); p1[g][r] = fast_exp2(p1[g][r] - mnew); ps += p0[g][r] + p1[g][r]; }
                lsum[g] = lsum[g] * alpha + ps; if (__builtin_amdgcn_ballot_w64(alpha != 1.f)) { o0[g] = o0[g] * alpha; o1[g] = o1[g] * alpha; }
#pragma unroll
                for (int s = 0; s < 2; ++s) {
                    u32x4 w0 = {pk2(p0[g][8 * s], p0[g][8 * s + 1]), pk2(p0[g][8 * s + 2], p0[g][8 * s + 3]), pk2(p0[g][8 * s + 4], p0[g][8 * s + 5]), pk2(p0[g][8 * s + 6], p0[g][8 * s + 7])};
                    u32x4 w1 = {pk2(p1[g][8 * s], p1[g][8 * s + 1]), pk2(p1[g][8 * s + 2], p1[g][8 * s + 3]), pk2(p1[g][8 * s + 4], p1[g][8 * s + 5]), pk2(p1[g][8 * s + 6], p1[g][8 * s + 7])};
                    pb[g][s] = __builtin_bit_cast(bf16x8, w0); pb[g][2 + s] = __builtin_bit_cast(bf16x8, w1);
                }
            }
        }
        if (any) {
#pragma unroll
            for (int kst = 0; kst < 4; ++kst) {
                const LAS unsigned char* vp = vbase + 16 * kst * VRB;
                const s16x4 a0l = tr_read(vp), a0h = tr_read(vp + 8 * VRB), a1l = tr_read(vp + 64), a1h = tr_read(vp + 64 + 8 * VRB);
                const bf16x8 A0 = {a0l[0], a0l[1], a0l[2], a0l[3], a0h[0], a0h[1], a0h[2], a0h[3]}, A1 = {a1l[0], a1l[1], a1l[2], a1l[3], a1h[0], a1h[1], a1h[2], a1h[3]};
#pragma unroll
                for (int g = 0; g < NG; ++g) if (valid[g]) {
                    o0[g] = __builtin_amdgcn_mfma_f32_32x32x16_bf16(A0, pb[g][kst], o0[g], 0, 0, 0);
                    o1[g] = __builtin_amdgcn_mfma_f32_32x32x16_bf16(A1, pb[g][kst], o1[g], 0, 0, 0); }
            }
        }
        if (T + 1 < NT) store_tile(T + 1, stS);
        __syncthreads();
    };
    for (int T = 0; T < NT; T += 2) { step(T, st0, st1); if (T + 1 < NT) step(T + 1, st1, st0); }
#pragma unroll
    for (int g = 0; g < NG; ++g) {
        const float l = lsum[g] + __shfl_xor(lsum[g], 32); const float inv = 1.f / l; bf16* op = a.O[g] + (size_t)(wid * 32 + q32) * a.ostride + 4 * hi;
#pragma unroll
        for (int q = 0; q < 4; ++q) { st_bf4(op + 8 * q, (f32x4){o0[g][4 * q] * inv, o0[g][4 * q + 1] * inv, o0[g][4 * q + 2] * inv, o0[g][4 * q + 3] * inv});
            st_bf4(op + 32 + 8 * q, (f32x4){o1[g][4 * q] * inv, o1[g][4 * q + 1] * inv, o1[g][4 * q + 2] * inv, o1[g][4 * q + 3] * inv}); }
    }
    __syncthreads();
}

struct AbsArgs { const bf16* Qlat; const bf16* Qrope; const bf16 *Lat_past, *Lat_new, *Kr_past, *Kr_new; const bf16* WuvT; bf16* O; const float* cs; };
__device__ __forceinline__ void mla_abs_unit(const AbsArgs& a, LAS unsigned char* lds) {
    constexpr int RB = 592, OFF_Q = 128 * RB, NKK = 18, NT = (KVS + 127) / 128;
    int tid = threadIdx.x; asm volatile("" : "+v"(tid));
    const int lane = tid & 63, q32 = lane & 31, hi = lane >> 5; const int wid = __builtin_amdgcn_readfirstlane(tid >> 6);
    const int qs = wid & 1, ks = wid >> 1;
    LAS unsigned char* qlds = lds + OFF_Q + qs * (NKK * 1024) + lane * 16;
    { const bf16* qp = a.Qlat + (size_t)(qs * 32 + q32) * 2048 + hi * 8;
#pragma unroll
      for (int kk = 0; kk < 16; ++kk) *(LAS bf16x8*)(qlds + kk * 1024) = *(const bf16x8*)(qp + kk * 16);
      const bf16* rp = a.Qrope + (size_t)(qs * 32 + q32) * 768 + hi * 8;
      const u32x4 w1 = *(const u32x4*)rp, w2 = *(const u32x4*)(rp + 16); u32x4 r1, r2;
      const f32x4* cp = (const f32x4*)(a.cs + ((size_t)(SEQ + qs * 32 + q32) * 16 + 8 * hi) * 2);
#pragma unroll
      for (int j = 0; j < 4; ++j) { const f32x4 c = cp[j]; const float a0 = bflo(w1[j]), a1 = bfhi(w1[j]), b0 = bflo(w2[j]), b1 = bfhi(w2[j]);
          r1[j] = pk2(a0 * c.x - b0 * c.y, a1 * c.z - b1 * c.w); r2[j] = pk2(a0 * c.y + b0 * c.x, a1 * c.w + b1 * c.z); }
      *(LAS u32x4*)(qlds + 16 * 1024) = r1; *(LAS u32x4*)(qlds + 17 * 1024) = r2; }
    float mrun = -1e30f, lsum = 0.f; f32x16 o[8] = {};
    u32x4 rl[8], rk;
    const int lrow = tid >> 5, lch = tid & 31, krow = tid >> 2, kch = tid & 3;
    auto load_t = [&](int T) {
        const int jT = T * 128; const bool past = jT < PAST; const size_t r0 = (size_t)(past ? jT : jT - PAST);
        const bf16* lp = (past ? a.Lat_past : a.Lat_new) + (r0 + lrow) * 256 + lch * 8;
#pragma unroll
        for (int i = 0; i < 8; ++i) if (jT + 16 * i < KVS) rl[i] = *(const u32x4*)(lp + (size_t)i * 16 * 256);
        if (jT + krow < KVS) rk = *(const u32x4*)((past ? a.Kr_past : a.Kr_new) + (r0 + krow) * 32 + kch * 8);
    };
    auto store_t = [&](int T) {
        const int jT = T * 128;
#pragma unroll
        for (int i = 0; i < 8; ++i) if (jT + 16 * i < KVS) *(LAS u32x4*)(lds + (lrow + 16 * i) * RB + lch * 16) = rl[i];
        if (jT + krow < KVS) *(LAS u32x4*)(lds + krow * RB + 512 + kch * 16) = rk;
    };
    load_t(0);
    const LAS unsigned char* kbase = lds + (ks * 32 + q32) * RB + hi * 16;
    const LAS unsigned char* vbase = lds + (ks * 32 + 4 * hi + ((lane & 15) >> 2)) * RB + (16 * ((lane >> 4) & 1) + 4 * (lane & 3)) * 2;
    for (int T = 0; T < NT; ++T) {
        __syncthreads();
        store_t(T);
        __syncthreads();
        if (T + 1 < NT) load_t(T + 1);
        __builtin_amdgcn_sched_barrier(0);
        if (T * 128 + ks * 32 < KVS) {
            f32x16 p0 = {}, pq = {};
#pragma unroll
            for (int kk = 0; kk < NKK; kk += 2) {
                const bf16x8 k0 = *(const LAS bf16x8*)(kbase + kk * 32); const bf16x8 qv = *(const LAS bf16x8*)(qlds + kk * 1024);
                const bf16x8 k1 = *(const LAS bf16x8*)(kbase + (kk + 1) * 32); const bf16x8 qw = *(const LAS bf16x8*)(qlds + (kk + 1) * 1024);
                p0 = __builtin_amdgcn_mfma_f32_32x32x16_bf16(k0, qv, p0, 0, 0, 0);
                pq = __builtin_amdgcn_mfma_f32_32x32x16_bf16(k1, qw, pq, 0, 0, 0);
            }
            p0 = p0 + pq;
            float mt = p0[0];
#pragma unroll
            for (int r = 1; r < 16; ++r) mt = fmaxf(mt, p0[r]);
            mt = fmaxf(mt, __shfl_xor(mt, 32));
            const float mnew = fmaxf(mrun, mt), alpha = fast_exp2(mrun - mnew); mrun = mnew;
            float ps = 0.f;
#pragma unroll
            for (int r = 0; r < 16; ++r) { p0[r] = fast_exp2(p0[r] - mnew); ps += p0[r]; }
            lsum = lsum * alpha + ps;
            if (__builtin_amdgcn_ballot_w64(alpha != 1.f)) {
#pragma unroll
                for (int dt = 0; dt < 8; ++dt) o[dt] = o[dt] * alpha; }
            bf16x8 pb[2];
#pragma unroll
            for (int s = 0; s < 2; ++s) {
                u32x4 w0 = {pk2(p0[8 * s], p0[8 * s + 1]), pk2(p0[8 * s + 2], p0[8 * s + 3]), pk2(p0[8 * s + 4], p0[8 * s + 5]), pk2(p0[8 * s + 6], p0[8 * s + 7])};
                pb[s] = __builtin_bit_cast(bf16x8, w0);
            }
#pragma unroll
            for (int kst = 0; kst < 2; ++kst) {
                const LAS unsigned char* vp = vbase + 16 * kst * RB;
#pragma unroll
                for (int dt = 0; dt < 8; ++dt) { const s16x4 al = tr_read(vp + dt * 64), ah = tr_read(vp + dt * 64 + 8 * RB);
                    const bf16x8 Af = {al[0], al[1], al[2], al[3], ah[0], ah[1], ah[2], ah[3]};
                    o[dt] = __builtin_amdgcn_mfma_f32_32x32x16_bf16(Af, pb[kst], o[dt], 0, 0, 0); }
            }
        }
    }
    lsum += __shfl_xor(lsum, 32);
    LAS float* msc = (LAS float*)(lds + 131072 + 4096);
    LAS float* lsc = msc + 256;
#pragma unroll 1
    for (int rnd = 0; rnd < 2; ++rnd) {
        const int half = rnd == 0 ? 2 : 1;
        __syncthreads();
        if (ks >= half && ks < 2 * half) { LAS float* osc = (LAS float*)lds + ((ks - half) * 2 + qs) * 8192;
#pragma unroll
            for (int dt = 0; dt < 8; ++dt)
#pragma unroll
                for (int r = 0; r < 16; ++r) osc[(dt * 16 + r) * 64 + lane] = o[dt][r];
            if (hi == 0) { msc[wid * 32 + q32] = mrun; lsc[wid * 32 + q32] = lsum; } }
        __syncthreads();
        if (ks < half) { const LAS float* osc = (const LAS float*)lds + (ks * 2 + qs) * 8192; const int pw = (ks + half) * 2 + qs;
            const float m2 = msc[pw * 32 + q32], l2 = lsc[pw * 32 + q32]; const float M = fmaxf(mrun, m2), w1 = fast_exp2(mrun - M), w2 = fast_exp2(m2 - M);
            lsum = w1 * lsum + w2 * l2; mrun = M;
#pragma unroll
            for (int dt = 0; dt < 8; ++dt)
#pragma unroll
                for (int r = 0; r < 16; ++r) o[dt][r] = w1 * o[dt][r] + w2 * osc[(dt * 16 + r) * 64 + lane]; }
    }
    if (ks == 0) {
        const float inv = 1.f / lsum; f32x16 t0 = {}, t1 = {};
        const bf16* wrow0 = a.WuvT + (size_t)q32 * 256 + 4 * hi; const bf16* wrow1 = wrow0 + 32 * 256;
#pragma unroll
        for (int sub = 0; sub < 8; ++sub)
#pragma unroll
            for (int s = 0; s < 2; ++s) {
                const u32x4 wv = {pk2(o[sub][8 * s] * inv, o[sub][8 * s + 1] * inv), pk2(o[sub][8 * s + 2] * inv, o[sub][8 * s + 3] * inv), pk2(o[sub][8 * s + 4] * inv, o[sub][8 * s + 5] * inv), pk2(o[sub][8 * s + 6] * inv, o[sub][8 * s + 7] * inv)};
                const bf16x8 Bf = __builtin_bit_cast(bf16x8, wv); const int c0 = 32 * sub + 16 * s;
                const s16x4 a0l = *(const s16x4*)(wrow0 + c0), a0h = *(const s16x4*)(wrow0 + c0 + 8), a1l = *(const s16x4*)(wrow1 + c0), a1h = *(const s16x4*)(wrow1 + c0 + 8);
                const bf16x8 A0 = {a0l[0], a0l[1], a0l[2], a0l[3], a0h[0], a0h[1], a0h[2], a0h[3]}, A1 = {a1l[0], a1l[1], a1l[2], a1l[3], a1h[0], a1h[1], a1h[2], a1h[3]};
                t0 = __builtin_amdgcn_mfma_f32_32x32x16_bf16(A0, Bf, t0, 0, 0, 0);
                t1 = __builtin_amdgcn_mfma_f32_32x32x16_bf16(A1, Bf, t1, 0, 0, 0);
            }
        bf16* op = a.O + (size_t)(qs * 32 + q32) * 1024 + 4 * hi;
#pragma unroll
        for (int g = 0; g < 4; ++g) { st_bf4(op + 8 * g, (f32x4){t0[4 * g], t0[4 * g + 1], t0[4 * g + 2], t0[4 * g + 3]}); st_bf4(op + 32 + 8 * g, (f32x4){t1[4 * g], t1[4 * g + 1], t1[4 * g + 2], t1[4 * g + 3]}); }
    }
    __syncthreads();
}

__device__ __forceinline__ void p4_attention(const Args& A, LAS unsigned char* lds) {
    unsigned char* ws = A.ws; const int G = gridDim.x;
    const bf16* QFOX = (const bf16*)(ws + WS_QFOX); const bf16* KNEW = (const bf16*)(ws + WS_KNEW); const bf16* VNEW = (const bf16*)(ws + WS_VNEW);
    const bf16* QMLA = (const bf16*)(ws + WS_QMLA); const bf16* KVNEW = (const bf16*)(ws + WS_KVNEW);
    const bf16* KRNEW = (const bf16*)(ws + WS_KRNEW); const bf16* KRPAST = (const bf16*)(ws + WS_KRPAST);
    const float* FS = (const float*)(ws + WS_FS); const float* FP = (const float*)(ws + WS_FP); bf16* MIXED = (bf16*)(ws + WS_MIXED);
    const int rot = (blockIdx.x >> 6) & 3;
#pragma unroll 1
    for (int pass = 0; pass < 4; ++pass) {
    const int job = (pass + rot) & 3;
    if (job == 0) {
    for (int p = blockIdx.x; p < 256; p += G) {
        const int bh = p >> 2, s = p & 3, b = bh >> 3, h = bh & 7; const size_t tb = (size_t)b * SEQ;
        Attn2Args a; a.cs = (const float*)(ws + WS_CS); a.qstride = 512; a.Ka = KNEW + tb * 512 + h * 64; a.kastride = 512; a.Kb = nullptr; a.kbstride = 0;
        a.V = VNEW + tb * 512 + h * 64; a.vstride = 512; a.Fk = FP + (size_t)bh * SEQ; a.ostride = 1024;
        for (int i = 0; i < 2; ++i) { const int t0 = 256 * (i ? 7 - s : s); a.Q[i] = QFOX + (tb + t0) * 512 + h * 64; a.O[i] = MIXED + (tb + t0) * 1024 + h * 64; a.qpos0[i] = t0; a.nkv[i] = t0 + 256; }
        attn_unit2<64, true, 2>(a, lds);
    }
    } else if (job == 1) {
    for (int p = blockIdx.x; p < 256; p += G) {
        const int bh = p >> 2, s = 3 - (p & 3), b = bh >> 3, h = bh & 7; const size_t tb = (size_t)b * SEQ;
        Attn2Args a; a.cs = (const float*)(ws + WS_CS); a.qstride = 768; a.Ka = KVNEW + tb * 1024 + h * 64; a.kastride = 1024; a.Kb = KRNEW + tb * 32; a.kbstride = 32;
        a.V = KVNEW + tb * 1024 + 512 + h * 64; a.vstride = 1024; a.Fk = nullptr; a.ostride = 1024;
        for (int i = 0; i < 2; ++i) { const int t0 = 256 * (i ? 7 - s : s); a.Q[0] = QMLA + (tb + t0) * 768 + h * 96; a.O[0] = MIXED + (tb + t0) * 1024 + 512 + h * 64; a.qpos0[0] = t0; a.nkv[0] = t0 + 256;
            a.Q[1] = a.Q[0]; a.O[1] = a.O[0]; a.qpos0[1] = t0; a.nkv[1] = t0 + 256;
            attn_unit2<96, false, 1>(a, lds); }
    }
    } else if (job == 2) {
    for (int p = blockIdx.x; p < 256; p += G) {
        const int b = p >> 3, h = p & 7; const size_t tok0 = (size_t)TP + (size_t)b * DSEQ, pb = (size_t)b * PAST;
        AttnArgs a; a.cs = (const float*)(ws + WS_CS); a.Q = QFOX + tok0 * 512 + h * 64; a.qstride = 512;
        a.Ka_past = A.in[2] + pb * 512 + h * 64; a.Ka_new = A.out + O_KS + (size_t)b * DSEQ * 512 + h * 64; a.kastride = 512; a.Kb_past = a.Kb_new = nullptr; a.kbstride = 0;
        a.V_past = A.in[3] + pb * 512 + h * 64; a.V_new = A.out + O_VS + (size_t)b * DSEQ * 512 + h * 64; a.vstride = 512;
        a.Fq = FS + (size_t)p * KVS + PAST; a.Fk = FS + (size_t)p * KVS; a.O = MIXED + tok0 * 1024 + h * 64; a.ostride = 1024; a.P = PAST; a.qpos0 = PAST; a.nkv = KVS;
        attn_unit<64, true, 2, 4, true>(a, lds);
    }
    } else {
    for (int p = blockIdx.x; p < 256; p += G) {
        const int b = (p & 7) * 4 + (p >> 6), h = (p >> 3) & 7; const size_t tok0 = (size_t)TP + (size_t)b * DSEQ, pb = (size_t)b * PAST;
        AbsArgs a; a.Qlat = (const bf16*)(ws + WS_QLAT) + (size_t)b * DSEQ * 2048 + h * 256; a.Qrope = QMLA + tok0 * 768 + h * 96 + 64;
        a.Lat_past = (const bf16*)(ws + WS_LATPAST) + pb * 256; a.Lat_new = (const bf16*)(ws + WS_LATNEW) + tok0 * 256;
        a.Kr_past = KRPAST + pb * 32; a.Kr_new = KRNEW + tok0 * 32; a.WuvT = (const bf16*)(ws + WS_WKV) + (size_t)(512 + h * 64) * 256;
        a.O = MIXED + tok0 * 1024 + 512 + h * 64; a.cs = (const float*)(ws + WS_CS);
        mla_abs_unit(a, lds);
    }
    }
    }
}

template <class Epi> __device__ __forceinline__ void run_gemm(LAS unsigned char* lds, const bf16* Am, const bf16* Bt, int M, int N, int K, const Epi& E, int cu_shift = 0) {
    pg8::Gemm g{Am, Bt, M, N, K}; pg8::StaticOrder S; S.init(M, N, K, (int)gridDim.x, (int)((blockIdx.x + cu_shift) % gridDim.x));
    pg8::gemm_phase<Epi, pg8::StaticOrder, true, true>(lds, g, S, E);
}

__global__ void __launch_bounds__(NTHREADS, 2) fwd_kernel(Args A, int ph_lo, int ph_hi) {
    extern __shared__ __attribute__((aligned(16))) unsigned char lds_raw[];
    LAS unsigned char* lds = (LAS unsigned char*)lds_raw;
    unsigned char* ws = A.ws;
    if (threadIdx.x < 64) ((LAS unsigned*)(lds + 131072))[threadIdx.x] = 0u;
    __syncthreads();
    XcdBarrier bar = xcd_barrier_post((unsigned*)(ws + WS_CTL), (volatile LAS unsigned*)(lds + 131072 + 32));
#ifndef PH_MASK
#define PH_MASK 0xffff
#endif
#define IN(k) (((PH_MASK >> (k)) & 1) && ph_lo <= (k) && (k) < ph_hi)
#define SEAM(k) do { if (IN(k) && IN((k) + 1)) xcd_barrier(bar); } while (0)
#ifndef REP0
#define REP0 1
#endif
#ifndef REP4
#define REP4 1
#endif
#ifndef REP8
#define REP8 1
#endif
#ifndef REP1
#define REP1 1
#endif
#ifndef REP7
#define REP7 1
#endif
#ifndef REP9
#define REP9 1
#endif
    if (IN(0)) { for (int rep = 0; rep < REP0; ++rep) { p0_prologue(A, lds); __syncthreads(); } }
    SEAM(0);
    if (IN(1)) {
        EpiZ E{(bf16*)(ws + WS_QFOX), (bf16*)(ws + WS_KNEW), (bf16*)(ws + WS_VNEW), (bf16*)(ws + WS_KRNEW), (float*)(ws + WS_ZBUF), A.out, (const float*)(ws + WS_CS), A.in[10]};
        run_gemm(lds, (const bf16*)(ws + WS_H), (const bf16*)(ws + WS_WIN), TOK, NZ, DM, E);
    }
    SEAM(1);
    if (IN(2)) { p2_postz(A, lds); __syncthreads(); }
    SEAM(2);
    if (IN(3)) {
        EpiBf E{(bf16*)(ws + WS_QMLA), 768, 0.10206207261596575f * LOG2E};
        run_gemm(lds, (const bf16*)(ws + WS_QCN), (const bf16*)(ws + WS_WQ), TOK, 768, 384, E);
        EpiBf E2{(bf16*)(ws + WS_KVNEW), 1024, 1.f};
        run_gemm(lds, (const bf16*)(ws + WS_LATNEW), (const bf16*)(ws + WS_WKV), TP, 1024, 256, E2);
        EpiBf E3{(bf16*)(ws + WS_QLAT), 2048, 0.10206207261596575f * LOG2E};
        run_gemm(lds, (const bf16*)(ws + WS_QCN) + (size_t)TP * 384, (const bf16*)(ws + WS_WQA), TS, 2048, 384, E3, 64);
    }
    SEAM(3);
    if (IN(4)) { for (int rep = 0; rep < REP4; ++rep) p4_attention(A, lds); }
    SEAM(4);
    if (IN(5)) {
        pg8::Gemm g{(const bf16*)(ws + WS_MIXED), (const bf16*)(ws + WS_WOUT), TOK, DM, DM}; SplitOrder<16> S{(int)gridDim.x, (int)blockIdx.x};
        EpiOut E{A.in[0], A.in[1], (float*)(ws + WS_X1), (bf16*)(ws + WS_H), A.in[17], (float*)(ws + WS_ROWSS), (float*)(ws + WS_SLAB)};
        pg8::gemm_phase<EpiOut, SplitOrder<16>, true, true>(lds, g, S, E);
    }
    if (IN(5) && IN(7)) xcd_barrier(bar);
    if (IN(5)) {
        int t2 = threadIdx.x; asm volatile("" : "+v"(t2)); const int lane = t2 & 63, gw = blockIdx.x * NWAVES + (t2 >> 6), NGW = gridDim.x * NWAVES;
        for (int r = gw; r < TS; r += NGW) {
            const f32x4* xr = (const f32x4*)(A.in[1] + (size_t)r * DM) + lane; f32x4 v[4];
#pragma unroll
            for (int j = 0; j < 4; ++j) v[j] = xr[64 * j];
#pragma unroll
            for (int k = 0; k < DN_SL; ++k) { const f32x4* sr = (const f32x4*)((const float*)(ws + WS_SLAB) + ((size_t)k * TS + r) * DM) + lane;
#pragma unroll
                for (int j = 0; j < 4; ++j) v[j] += sr[64 * j]; }
            float ss = 0.f; const size_t row = (size_t)TP + r;
#pragma unroll
            for (int j = 0; j < 4; ++j) { ss += (v[j].x * v[j].x + v[j].y * v[j].y) + (v[j].z * v[j].z + v[j].w * v[j].w); ((f32x4*)((float*)(ws + WS_X1) + row * DM))[64 * j + lane] = v[j];
                const f32x4 gq = ((const f32x4*)A.in[17])[64 * j + lane]; const f32x4 o = v[j] * gq; ((u32x2*)((bf16*)(ws + WS_H) + row * DM))[64 * j + lane] = (u32x2){pk2(o.x, o.y), pk2(o.z, o.w)}; }
            ss = wave_sum(ss);
            if (lane == 0) ((float*)(ws + WS_RSTD))[row] = rsqrtf(ss * (1.f / DM) + EPS);
        }
        for (int r = blockIdx.x * NTHREADS + t2; r < TP; r += gridDim.x * NTHREADS) {
            const f32x4* rp = (const f32x4*)((const float*)(ws + WS_ROWSS) + (size_t)r * 16); const f32x4 t = (rp[0] + rp[1]) + (rp[2] + rp[3]);
            ((float*)(ws + WS_RSTD))[r] = rsqrtf(((t.x + t.y) + (t.z + t.w)) * (1.f / DM) + EPS);
        }
    }
    if (IN(5) && IN(7)) xcd_barrier(bar);
    if (IN(7)) { EpiGlu E{(bf16*)(ws + WS_ACT), (float*)(ws + WS_EDGE), A.in[19], A.in[20], (const float*)(ws + WS_RSTD)}; run_gemm(lds, (const bf16*)(ws + WS_H), (const bf16*)(ws + WS_WUP), TOK, DFF2, DM, E); }
    SEAM(7);
    if (IN(8)) p8_fixup(A);
    SEAM(8);
    if (IN(9)) {
        pg8::Gemm g{(const bf16*)(ws + WS_ACT), (const bf16*)(ws + WS_WDOWN), TOK, DM, DFF}; DownOrder S{(int)gridDim.x, (int)blockIdx.x};
        EpiDown E{(const float*)(ws + WS_X1), (float*)(ws + WS_X2), (float*)(ws + WS_SLAB)};
        pg8::gemm_phase<EpiDown, DownOrder, true, true>(lds, g, S, E);
    }
    SEAM(9);
    if (IN(10)) { int t2 = threadIdx.x; asm volatile("" : "+v"(t2)); const int lane = t2 & 63, gw = blockIdx.x * NWAVES + (t2 >> 6), NGW = gridDim.x * NWAVES;
        for (int m = gw; m < TOK; m += NGW) {
            if (m < TP) rms_row<true>((const float*)(ws + WS_X2) + (size_t)m * DM, A.in[22], A.out + (size_t)m * DM, lane);
            else rms_row<true, DN_SL>((const float*)(ws + WS_X1) + (size_t)m * DM, A.in[22], A.out + (size_t)m * DM, lane, (const float*)(ws + WS_SLAB) + (size_t)(m - TP) * DM, (size_t)TS * DM); } }
#undef IN
#undef SEAM
}

#ifndef N_LAUNCHES
#define N_LAUNCHES 1
#endif
extern "C" void kernel_launch(void* const* d_in, const int* in_sizes, int n_in, void* d_out, int out_size, void* d_ws, size_t ws_size, hipStream_t stream) {
    static int grid = 0;
    if (grid == 0) {
        if (n_in != 23 || (size_t)out_size != O_END || ws_size < WS_END) { fprintf(stderr, "kernel_launch: unexpected shapes: n_in %d out %d ws %zu (need %zu)\n", n_in, out_size, ws_size, (size_t)WS_END); grid = -1; return; }
        int dev = 0, cus = 0, per_cu = 0;
        (void)hipGetDevice(&dev); (void)hipDeviceGetAttribute(&cus, hipDeviceAttributeMultiprocessorCount, dev);
        if (hipFuncSetAttribute((const void*)fwd_kernel, hipFuncAttributeMaxDynamicSharedMemorySize, LDS_BYTES) != hipSuccess) { fprintf(stderr, "hipFuncSetAttribute failed\n"); grid = -1; return; }
        if (hipOccupancyMaxActiveBlocksPerMultiprocessor(&per_cu, (const void*)fwd_kernel, NTHREADS, LDS_BYTES) != hipSuccess || per_cu < 1) { fprintf(stderr, "occupancy query: %d\n", per_cu); per_cu = 1; }
        (void)hipGetLastError();
        grid = cus * 1;
    }
    if (grid < 0) return;
    if (hipMemsetAsync((char*)d_ws + WS_CTL, 0, CTL_BYTES, stream) != hipSuccess) { fprintf(stderr, "memset failed\n"); return; }
    Args a{};
    for (int i = 0; i < 23; ++i) a.in[i] = (const float*)d_in[i];
    a.out = (float*)d_out; a.ws = (unsigned char*)d_ws;
    if (N_LAUNCHES == 1) {
        hipLaunchKernelGGL(fwd_kernel, dim3(grid), dim3(NTHREADS), LDS_BYTES, stream, a, 0, 11);
    } else {
        for (int k = 0; k < 11; ++k) hipLaunchKernelGGL(fwd_kernel, dim3(grid), dim3(NTHREADS), LDS_BYTES, stream, a, k, k + 1);
    }
}
```

```cpp
#include <hip/hip_runtime.h>
#include <cstdio>
#include <cstdint>
namespace pg8 {
#define PG8_LAS __attribute__((address_space(3)))
typedef unsigned short bf16_t;
typedef short bf16x8 __attribute__((ext_vector_type(8)));
typedef float f32x4 __attribute__((ext_vector_type(4)));
typedef unsigned u32x4 __attribute__((ext_vector_type(4)));
constexpr int BM = 256, BK = 64, HALF = 128, HTB = HALF * BK * 2  , STAGE_BYTES = 8 * HTB, NXCD = 8, WGM = 8;

__host__ __device__ __forceinline__ int lds_byte(int r, int c) { const int st = (r >> 4) * 2 + (c >> 5), rr = r & 15, cc = c & 31, ob = rr * 64 + cc * 2; return st * 1024 + (ob ^ (((ob >> 9) & 1) << 5)); }
__host__ __device__ __forceinline__ void stage_rc(int b, int& R, int& C) { const int st = b / 1024, sb = b % 1024, swz = sb ^ (((sb >> 9) & 1) << 5); R = (st >> 1) * 16 + swz / 64; C = (st & 1) * 32 + (swz % 64) / 2; }
__host__ __device__ __forceinline__ int perm32(int rho) { const int n = rho >> 4, i = rho & 15; return 8 * (i >> 2) + 4 * n + (i & 3); }

struct Unit { int pm, pn, k0, nkt, sl; };
struct Gemm { const bf16_t* A; const bf16_t* Bt; int M, N, K; };

struct StaticOrder {
    int nM, nN, nwg, G, c, nkt;
    __host__ __device__ void init(int M, int N, int K, int G_, int c_) { nM = M / BM; nN = N / BM; nwg = nM * nN; G = G_; c = c_; nkt = K / BK; }
    __host__ __device__ bool next(int i, Unit& u) const {
        const long L = (long)i * G + c; if (L >= nwg) return false;
        int wgid = (int)L; { const int q = nwg / NXCD, r = nwg % NXCD, xcd = wgid % NXCD, off = wgid / NXCD; wgid = (xcd < r ? xcd * (q + 1) : r * (q + 1) + (xcd - r) * q) + off; }
        const int nig = WGM * nN, gid = wgid / nig, fm = gid * WGM, gsz = (nM - fm) < WGM ? (nM - fm) : WGM;
        u.pm = fm + ((wgid % nig) % gsz); u.pn = (wgid % nig) / gsz; u.k0 = 0; u.nkt = nkt; u.sl = -1; return true;
    }
    __device__ __forceinline__ void a_ready(const Unit&) const {}
    __device__ __forceinline__ void done(const Unit&) const {}
};

template <class Epi, class Sched, bool ALIGN_EPI = false, bool SP2 = false>
__device__ __forceinline__ void gemm_phase(PG8_LAS unsigned char* lds, const Gemm g, const Sched& S, const Epi& E) {
    const int tid = threadIdx.x, wid = __builtin_amdgcn_readfirstlane(tid >> 6), lane = tid & 63, wr = wid >> 2, wc = wid & 3, fr = lane & 15, fq = lane >> 4;
    const int K = g.K;
    unsigned voffA[2], voffB[2];
#pragma unroll
    for (int i = 0; i < 2; ++i) { int R, C; stage_rc(tid * 16 + i * 8192, R, C); const int Rb = Epi::PERM ? ((R & ~31) + perm32(R & 31)) : R;
        voffA[i] = (unsigned)(R * K + C) * 2u; voffB[i] = (unsigned)(Rb * K + C) * 2u; }
    const size_t kstep = (size_t)(BK * 2);
    const size_t hstep = (size_t)HALF * K * 2;
    const size_t tstep = 2 * hstep;
    const unsigned ldsw = (unsigned)wid * 1024u;
    const int aoff = lds_byte(wr * 64 + fr, fq * 8), boff = lds_byte(wc * 32 + fr, fq * 8);
#define PG8_SA(b, h) (((b) * 2 + (h)) * HTB)
#define PG8_SB(b, h) ((4 + (b) * 2 + (h)) * HTB)
#define PG8_STAGE(bufoff, gbase, voff) do { _Pragma("unroll") for (int _i = 0; _i < 2; ++_i) \
        __builtin_amdgcn_global_load_lds((const unsigned*)((const char*)(gbase) + (voff)[_i]), (PG8_LAS unsigned*)(lds + (bufoff) + ldsw + _i * 8192), 16, 0, 0); } while (0)
#define PG8_LDA(dst, b, h) do { _Pragma("unroll") for (int m = 0; m < 4; ++m) _Pragma("unroll") for (int k = 0; k < 2; ++k) dst[m][k] = *(const PG8_LAS bf16x8*)(lds + PG8_SA(b, h) + aoff + m * 2048 + k * 1024); } while (0)
#define PG8_LDB(dst, b, h) do { _Pragma("unroll") for (int n = 0; n < 2; ++n) _Pragma("unroll") for (int k = 0; k < 2; ++k) dst[n][k] = *(const PG8_LAS bf16x8*)(lds + PG8_SB(b, h) + boff + n * 2048 + k * 1024); } while (0)
#define PG8_MMA(ai, bj, At, Bt) do { __builtin_amdgcn_s_setprio(1); _Pragma("unroll") for (int m = 0; m < 4; ++m) _Pragma("unroll") for (int n = 0; n < 2; ++n) _Pragma("unroll") for (int k = 0; k < 2; ++k) \
        acc[ai][bj][m][n] = __builtin_amdgcn_mfma_f32_16x16x32_bf16(Bt[n][k], At[m][k], acc[ai][bj][m][n], 0, 0, 0); __builtin_amdgcn_s_setprio(0); } while (0)
#define PG8_WAIT_V(n) asm volatile("s_waitcnt vmcnt(" #n ")" ::: "memory")
#define PG8_WAIT_L(n) asm volatile("s_waitcnt lgkmcnt(" #n ")" ::: "memory")
#define PG8_BAR __builtin_amdgcn_s_barrier()
#define PG8_SCHED __builtin_amdgcn_sched_barrier(0)
    Unit cur{}, nxt{}; int ui = 0;
    if (!S.next(0, cur)) return;
    f32x4 acc[2][2][4][2];
#pragma unroll
    for (int a = 0; a < 2; ++a)
#pragma unroll
        for (int b = 0; b < 2; ++b)
#pragma unroll
            for (int m = 0; m < 4; ++m)
#pragma unroll
                for (int n = 0; n < 2; ++n) acc[a][b][m][n] = (f32x4){0.f, 0.f, 0.f, 0.f};
    bf16x8 At[4][2], B0[2][2], B1[2][2];
    const char* cA = (const char*)g.A + (size_t)cur.pm * tstep + (size_t)cur.k0 * kstep; const char* cB = (const char*)g.Bt + (size_t)cur.pn * tstep + (size_t)cur.k0 * kstep;
    S.a_ready(cur);
    if constexpr (SP2) {
        PG8_STAGE(PG8_SB(0, 0), cB, voffB); PG8_STAGE(PG8_SB(0, 1), cB + hstep, voffB); PG8_STAGE(PG8_SA(0, 0), cA, voffA); PG8_STAGE(PG8_SA(0, 1), cA + hstep, voffA);
        if (wr == 1) PG8_BAR;
        PG8_WAIT_V(2); PG8_BAR;
        PG8_STAGE(PG8_SB(1, 0), cB + kstep, voffB); PG8_STAGE(PG8_SA(1, 0), cA + kstep, voffA); PG8_STAGE(PG8_SB(1, 1), cB + hstep + kstep, voffB);
        PG8_WAIT_V(6); PG8_BAR;
    } else {
        PG8_STAGE(PG8_SB(0, 0), cB, voffB); PG8_STAGE(PG8_SA(0, 0), cA, voffA); PG8_STAGE(PG8_SB(0, 1), cB + hstep, voffB); PG8_STAGE(PG8_SA(0, 1), cA + hstep, voffA);
        if (wr == 1) PG8_BAR;
        PG8_WAIT_V(4); PG8_BAR;
        PG8_STAGE(PG8_SB(1, 0), cB + kstep, voffB); PG8_STAGE(PG8_SA(1, 0), cA + kstep, voffA); PG8_STAGE(PG8_SB(1, 1), cB + hstep + kstep, voffB);
        PG8_WAIT_V(6); PG8_BAR;
    }
    for (;;) {
        const bool has_next = S.next(ui + 1, nxt);
        const char* nA = has_next ? (const char*)g.A + (size_t)nxt.pm * tstep + (size_t)nxt.k0 * kstep : cA; const char* nB = has_next ? (const char*)g.Bt + (size_t)nxt.pn * tstep + (size_t)nxt.k0 * kstep : cB;
        const int nt = cur.nkt;
        for (int t = 0; t < nt; t += 2) {
            const bool last = (t == nt - 2);
            const char* a1 = cA + (size_t)(t + 1) * kstep;
            const char* a2 = last ? nA : cA + (size_t)(t + 2) * kstep; const char* b2 = last ? nB : cB + (size_t)(t + 2) * kstep;
            const char* a3 = a2 + kstep; const char* b3 = b2 + kstep;
            if (last && has_next) S.a_ready(nxt);
            if constexpr (SP2) {
            PG8_LDB(B0, 0, 0); PG8_LDB(B1, 0, 1); PG8_SCHED; PG8_LDA(At, 0, 0); PG8_STAGE(PG8_SA(1, 1), a1 + hstep, voffA);
            PG8_WAIT_V(8); PG8_WAIT_L(0); PG8_BAR; PG8_MMA(0, 0, At, B0); PG8_MMA(0, 1, At, B1); PG8_BAR; PG8_SCHED;
            PG8_LDA(At, 0, 1); PG8_STAGE(PG8_SB(0, 0), b2, voffB); PG8_STAGE(PG8_SB(0, 1), b2 + hstep, voffB); PG8_STAGE(PG8_SA(0, 0), a2, voffA);
            PG8_WAIT_V(8); PG8_WAIT_L(0); PG8_BAR; PG8_MMA(1, 0, At, B0); PG8_MMA(1, 1, At, B1); PG8_BAR; PG8_SCHED;
            PG8_LDB(B0, 1, 0); PG8_LDB(B1, 1, 1); PG8_SCHED; PG8_LDA(At, 1, 0); PG8_STAGE(PG8_SA(0, 1), a2 + hstep, voffA);
            PG8_WAIT_V(8); PG8_WAIT_L(0); PG8_BAR; PG8_MMA(0, 0, At, B0); PG8_MMA(0, 1, At, B1); PG8_BAR; PG8_SCHED;
            PG8_LDA(At, 1, 1); PG8_STAGE(PG8_SB(1, 0), b3, voffB); PG8_STAGE(PG8_SB(1, 1), b3 + hstep, voffB); PG8_STAGE(PG8_SA(1, 0), a3, voffA);
            PG8_WAIT_V(8); PG8_WAIT_L(0); PG8_BAR; PG8_MMA(1, 0, At, B0); PG8_MMA(1, 1, At, B1); PG8_BAR; PG8_SCHED;
            } else {
            PG8_LDB(B0, 0, 0); PG8_SCHED; PG8_LDA(At, 0, 0); PG8_STAGE(PG8_SA(1, 1), a1 + hstep, voffA);
            PG8_WAIT_L(8); PG8_BAR; PG8_WAIT_L(0); PG8_MMA(0, 0, At, B0); PG8_BAR; PG8_SCHED;
            PG8_LDB(B1, 0, 1); PG8_STAGE(PG8_SB(0, 0), b2, voffB);
            PG8_BAR; PG8_WAIT_L(0); PG8_MMA(0, 1, At, B1); PG8_BAR;
            PG8_LDA(At, 0, 1); PG8_STAGE(PG8_SA(0, 0), a2, voffA);
            PG8_BAR; PG8_WAIT_L(0); PG8_MMA(1, 0, At, B0); PG8_BAR; PG8_SCHED;
            PG8_STAGE(PG8_SB(0, 1), b2 + hstep, voffB);
            PG8_WAIT_V(6); PG8_BAR; PG8_MMA(1, 1, At, B1); PG8_BAR;
            PG8_LDB(B0, 1, 0); PG8_SCHED; PG8_LDA(At, 1, 0); PG8_STAGE(PG8_SA(0, 1), a2 + hstep, voffA);
            PG8_WAIT_L(8); PG8_BAR; PG8_WAIT_L(0); PG8_MMA(0, 0, At, B0); PG8_BAR; PG8_SCHED;
            PG8_LDB(B1, 1, 1); PG8_STAGE(PG8_SB(1, 0), b3, voffB);
            PG8_BAR; PG8_WAIT_L(0); PG8_MMA(0, 1, At, B1); PG8_BAR;
            PG8_LDA(At, 1, 1); PG8_STAGE(PG8_SA(1, 0), a3, voffA);
            PG8_BAR; PG8_WAIT_L(0); PG8_MMA(1, 0, At, B0); PG8_BAR; PG8_SCHED;
            PG8_STAGE(PG8_SB(1, 1), b3 + hstep, voffB);
            PG8_WAIT_V(6); PG8_BAR; PG8_MMA(1, 1, At, B1); PG8_BAR;
            }
        }
        if constexpr (ALIGN_EPI) { if (wr == 0) PG8_BAR; }
        if constexpr (!Epi::AFTER_DRAIN) { E(acc, cur, wr, wc, fr, fq); S.done(cur); }
        if (!has_next) break;
#pragma unroll
        for (int a = 0; a < 2; ++a)
#pragma unroll
            for (int b = 0; b < 2; ++b)
#pragma unroll
                for (int m = 0; m < 4; ++m)
#pragma unroll
                    for (int n = 0; n < 2; ++n) acc[a][b][m][n] = (f32x4){0.f, 0.f, 0.f, 0.f};
        cur = nxt; cA = nA; cB = nB; ++ui;
        if constexpr (ALIGN_EPI) { if (wr == 1) PG8_BAR; }
    }
    PG8_WAIT_V(0);
    if constexpr (!ALIGN_EPI) { if (wr == 0) PG8_BAR; }
    PG8_BAR;
    if constexpr (Epi::AFTER_DRAIN) { E.fused(acc, cur, wr, wc, fr, fq, lds, wid, lane); S.done(cur); }
#undef PG8_SA
#undef PG8_SB
#undef PG8_STAGE
#undef PG8_LDA
#undef PG8_LDB
#undef PG8_MMA
#undef PG8_WAIT_V
#undef PG8_WAIT_L
#undef PG8_BAR
#undef PG8_SCHED
}
}

#define LAS __attribute__((address_space(3)))
typedef unsigned short bf16;
typedef short bf16x8 __attribute__((ext_vector_type(8)));
typedef short s16x4 __attribute__((ext_vector_type(4)));
typedef float f32x4 __attribute__((ext_vector_type(4)));
typedef float f32x2 __attribute__((ext_vector_type(2)));
typedef float f32x16 __attribute__((ext_vector_type(16)));
typedef unsigned u32x4 __attribute__((ext_vector_type(4)));
typedef unsigned u32x2 __attribute__((ext_vector_type(2)));

constexpr int DM = 1024, SEQ = 2048, NBP = 8, DSEQ = 64, NBS = 32, PAST = 4096;
constexpr int TP = NBP * SEQ, TS = NBS * DSEQ, TOK = TP + TS;
constexpr int NPAST = NBS * PAST;
constexpr int KVS = PAST + DSEQ;
constexpr int DIN = 2216, NZ = 2304, ZW = 640;
constexpr int DFF = 2816, DFF2 = 5632;
constexpr float LOG2E = 1.4426950408889634f;
constexpr float EPS = 1e-6f;
constexpr int NTHREADS = 512, NWAVES = 8;
constexpr int LDS_BYTES = 147456;

constexpr size_t O_YP = 0, O_YS = O_YP + (size_t)TP * DM, O_KP = O_YS + (size_t)TS * DM, O_VP = O_KP + (size_t)TP * 512, O_LFP = O_VP + (size_t)TP * 512,
                 O_LATP = O_LFP + (size_t)TP * 8, O_KRP = O_LATP + (size_t)TP * 256, O_CVP = O_KRP + (size_t)TP * 32, O_KS = O_CVP + (size_t)NBP * 2 * DFF2,
                 O_VS = O_KS + (size_t)TS * 512, O_LFS = O_VS + (size_t)TS * 512, O_LATS = O_LFS + (size_t)TS * 8, O_KRS = O_LATS + (size_t)TS * 256,
                 O_CVS = O_KRS + (size_t)TS * 32, O_END = O_CVS + (size_t)NBS * 2 * DFF2;

constexpr size_t MiB = 1u << 20;
constexpr size_t WS_CTL = 0, CTL_BYTES = 16384;
constexpr size_t WS_WIN = 1 * MiB, WS_WQ = 6 * MiB, WS_WKV = 7 * MiB, WS_WOUT = 8 * MiB, WS_WUP = 10 * MiB, WS_WDOWN = 21 * MiB, WS_CS = 27 * MiB,
                 WS_FS = 28 * MiB, WS_FP = 33 * MiB, WS_H = 34 * MiB, WS_QFOX = 70 * MiB, WS_KNEW = 88 * MiB, WS_VNEW = 106 * MiB, WS_ZBUF = 124 * MiB,
                 WS_QCN = 169 * MiB, WS_LATNEW = 183 * MiB, WS_KRNEW = 192 * MiB, WS_QMLA = 194 * MiB, WS_KVNEW = 221 * MiB, WS_MIXED = 257 * MiB,
                 WS_X1 = 293 * MiB, WS_X2 = 124 * MiB  , WS_LATPAST = 365 * MiB, WS_KRPAST = 429 * MiB, WS_KPAST = 437 * MiB,
                 WS_VPAST = 565 * MiB, WS_SLAB = 565 * MiB  , WS_KVPAST = 693 * MiB, WS_EDGE = 693 * MiB  , WS_ACT = 437 * MiB  , WS_WQA = 949 * MiB, WS_QLAT = 951 * MiB, WS_ROWSS = 959 * MiB  , WS_RSTD = 960 * MiB + 512 * 1024  , WS_END = 961 * MiB;

struct Args {
    const float* in[23];
    float* out;
    unsigned char* ws;
};

__device__ __forceinline__ unsigned pk2(float lo, float hi) { typedef __bf16 bf2 __attribute__((ext_vector_type(2))); f32x2 v = {lo, hi}; bf2 b = __builtin_convertvector(v, bf2); return __builtin_bit_cast(unsigned, b); }
__device__ __forceinline__ float bflo(unsigned w) { return __builtin_bit_cast(float, w << 16); }
__device__ __forceinline__ float bfhi(unsigned w) { return __builtin_bit_cast(float, w & 0xffff0000u); }
__device__ __forceinline__ float wave_sum(float v) {
#pragma unroll
    for (int o = 1; o < 64; o <<= 1) v += __shfl_xor(v, o);
    return v;
}
__device__ __forceinline__ void st_bf4(bf16* p, f32x4 v) { *(u32x2*)p = (u32x2){pk2(v.x, v.y), pk2(v.z, v.w)}; }
__device__ __forceinline__ void lds_wait() { asm volatile("s_waitcnt lgkmcnt(0)" ::: "memory"); }
__device__ __forceinline__ float fast_exp2(float x) { return __builtin_amdgcn_exp2f(x); }

#define XB_TMO      128
#define XB_XCNT(j)  (256  + 64 * (j))
#define XB_XSUB(j)  (1280 + 64 * (j))
#define XB_XGEN(j)  (2304 + 64 * (j))
#define XB_TOP      3328
#define XB_TOPGEN   3392
#define XCD_BAR_WORDS 3456
#define XB_SPIN_CAP (1u << 18)

__device__ __forceinline__ unsigned xb_ld(unsigned* p)              { return __hip_atomic_load(p, __ATOMIC_RELAXED, __HIP_MEMORY_SCOPE_AGENT); }
__device__ __forceinline__ unsigned xb_add(unsigned* p, unsigned v) { return __hip_atomic_fetch_add(p, v, __ATOMIC_RELAXED, __HIP_MEMORY_SCOPE_AGENT); }
__device__ __forceinline__ unsigned xb_xcc_id() { return (unsigned)__builtin_amdgcn_s_getreg((3 << 11) | 20) & 0xFu; }
#define XB_SPIN(cond, bar) do { unsigned _sp = 0; while (cond) { __builtin_amdgcn_s_sleep(1); \
    if ((++_sp & 255u) == 0u) { if (xb_ld(&(bar)[XB_TMO])) break; if (_sp > XB_SPIN_CAP) { atomicAdd(&(bar)[XB_TMO], 1u); break; } } } } while (0)

struct XcdBarrier {
    unsigned* bar; unsigned x;
    volatile LAS unsigned* st;
};

__device__ __forceinline__ XcdBarrier xcd_barrier_post(unsigned* bar, volatile LAS unsigned* st) {
    XcdBarrier b; b.bar = bar; b.x = xb_xcc_id(); b.st = st;
    if (threadIdx.x == 0) (void)xb_add(&bar[XB_XCNT(b.x)], 1u);
    return b;
}
__device__ __forceinline__ void xcd_barrier_complete(unsigned* bar, unsigned x, unsigned& nloc, unsigned& nx) {
    const unsigned G = gridDim.x * gridDim.y * gridDim.z;
    unsigned sum, cnt, mine, sp = 0u;
    for (;;) {
        sum = 0u; cnt = 0u; mine = 0u;
#pragma unroll
        for (unsigned j = 0; j < 16; ++j) { const unsigned c = xb_ld(&bar[XB_XCNT(j)]); sum += c; cnt += (c > 0u) ? 1u : 0u; mine = (j == x) ? c : mine; }
        if (sum == G) break;
        __builtin_amdgcn_s_sleep(1);
        if ((++sp & 255u) == 0u) { if (xb_ld(&bar[XB_TMO])) break; if (sp > XB_SPIN_CAP) { atomicAdd(&bar[XB_TMO], 1u); break; } }
    }
    nloc = mine > 0u ? mine : 1u; nx = cnt > 0u ? cnt : 1u;
}

__device__ __forceinline__ void xcd_barrier(const XcdBarrier& b) {
    asm volatile("s_waitcnt vmcnt(0)" ::: "memory");
    __syncthreads();
    if (threadIdx.x == 0) {
        unsigned* bar = b.bar;
        __builtin_amdgcn_s_waitcnt(0);
        unsigned nloc = b.st[0], nx = b.st[1];
        if (nloc == 0u) { xcd_barrier_complete(bar, b.x, nloc, nx); b.st[0] = nloc; b.st[1] = nx; }
        const unsigned old = xb_add(&bar[XB_XSUB(b.x)], 1u);
        const unsigned gen = old / nloc;
        if (old + 1u == (gen + 1u) * nloc) {
            __builtin_amdgcn_fence(__ATOMIC_RELEASE, "agent");
            asm volatile("s_waitcnt vmcnt(0)" ::: "memory");
            const unsigned og = xb_add(&bar[XB_TOP], 1u);
            const unsigned tg = og / nx;
            if (og + 1u == (tg + 1u) * nx) xb_add(&bar[XB_TOPGEN], 1u);
            else XB_SPIN(xb_ld(&bar[XB_TOPGEN]) == tg, bar);
            __builtin_amdgcn_fence(__ATOMIC_ACQUIRE, "agent");
            xb_add(&bar[XB_XGEN(b.x)], 1u);
            asm volatile("s_waitcnt vmcnt(0)" ::: "memory");
        } else {
            XB_SPIN(xb_ld(&bar[XB_XGEN(b.x)]) == gen, bar);
            __builtin_amdgcn_fence(__ATOMIC_ACQUIRE, "agent");
            asm volatile("s_waitcnt vmcnt(0)" ::: "memory");
        }
    }
    __syncthreads();
}

template <int MODE> __device__ __forceinline__ int srccol(int n) {
    if (MODE == 0) return n;
    if (MODE == 2) return ((n & 16) ? DFF : 0) + 16 * (n >> 5) + (n & 15);
    if (n < 1536) return n;
    if (n < 1920) return 1544 + (n - 1536);
    if (n < 2176) return 1928 + (n - 1920);
    if (n < 2208) return 2184 + (n - 2176);
    if (n < 2216) return 1536 + (n - 2208);
    return -1;
}
template <int MODE>
__device__ __forceinline__ void tr_item(const float* W, int K, int Nsrc, int Ndst, bf16* WT, int row_off, LAS float* scr, int item, int lane) {
    const int nblk = Ndst / 32, kb = item / nblk, nb = item % nblk, k0 = 64 * kb, n0 = 32 * nb;
    const int sc = srccol<MODE>(n0 + (lane & 31));
    float wv[32];
#pragma unroll
    for (int i = 0; i < 32; ++i) { const int kk = 2 * i + (lane >> 5); wv[i] = W[(size_t)(k0 + kk) * Nsrc + (sc >= 0 ? sc : 0)]; }
#pragma unroll
    for (int i = 0; i < 32; ++i) { const int kk = 2 * i + (lane >> 5); scr[kk * 33 + (lane & 31)] = sc >= 0 ? wv[i] : 0.f; }
    lds_wait();
    const int c = lane & 7;
#pragma unroll
    for (int j = 0; j < 4; ++j) { const int n = (lane >> 3) + 8 * j; const LAS float* s = scr + (8 * c) * 33 + n;
        u32x4 o; o.x = pk2(s[0 * 33], s[1 * 33]); o.y = pk2(s[2 * 33], s[3 * 33]); o.z = pk2(s[4 * 33], s[5 * 33]); o.w = pk2(s[6 * 33], s[7 * 33]);
        *(u32x4*)(WT + (size_t)(row_off + n0 + n) * K + k0 + 8 * c) = o; }
    lds_wait();
}
template <bool OUTF, int NSLAB = 0>
__device__ __forceinline__ void rms_row(const float* xrow, const float* g, void* orow, int lane, const float* slab = nullptr, size_t slab_stride = 0) {
    const f32x4* xr = (const f32x4*)xrow + lane; const f32x4* gr = (const f32x4*)g + lane;
    f32x4 v[4]; float s = 0.f;
#pragma unroll
    for (int j = 0; j < 4; ++j) v[j] = xr[64 * j];
    if (NSLAB > 0) { f32x4 sv[NSLAB > 0 ? NSLAB : 1][4];
#pragma unroll
        for (int k = 0; k < NSLAB; ++k) { const f32x4* sr = (const f32x4*)(slab + (size_t)k * slab_stride) + lane;
#pragma unroll
            for (int j = 0; j < 4; ++j) sv[k][j] = sr[64 * j]; }
#pragma unroll
        for (int k = 0; k < NSLAB; ++k)
#pragma unroll
            for (int j = 0; j < 4; ++j) v[j] += sv[k][j]; }
#pragma unroll
    for (int j = 0; j < 4; ++j) { s += (v[j].x * v[j].x + v[j].y * v[j].y) + (v[j].z * v[j].z + v[j].w * v[j].w); }
    const float rstd = rsqrtf(wave_sum(s) * (1.f / DM) + EPS);
#pragma unroll
    for (int j = 0; j < 4; ++j) { const f32x4 gv = gr[64 * j]; const f32x4 o = v[j] * rstd * gv;
        if (OUTF) ((f32x4*)orow)[64 * j + lane] = o;
        else ((u32x2*)orow)[64 * j + lane] = (u32x2){pk2(o.x, o.y), pk2(o.z, o.w)}; }
}
__device__ __forceinline__ void rms_row3(const float* x0, const float* x1, const float* x2, const float* g, bf16* o0, bf16* o1, bf16* o2, int lane) {
    const f32x4* xp[3] = {(const f32x4*)x0 + lane, (const f32x4*)x1 + lane, (const f32x4*)x2 + lane}; bf16* op[3] = {o0, o1, o2};
    f32x4 v[3][4]; float ss[3];
#pragma unroll
    for (int u = 0; u < 3; ++u)
#pragma unroll
        for (int j = 0; j < 4; ++j) v[u][j] = xp[u][64 * j];
#pragma unroll
    for (int u = 0; u < 3; ++u) { ss[u] = 0.f;
#pragma unroll
        for (int j = 0; j < 4; ++j) ss[u] += (v[u][j].x * v[u][j].x + v[u][j].y * v[u][j].y) + (v[u][j].z * v[u][j].z + v[u][j].w * v[u][j].w); }
#pragma unroll
    for (int o = 1; o < 64; o <<= 1) {
#pragma unroll
        for (int u = 0; u < 3; ++u) ss[u] += __shfl_xor(ss[u], o); }
#pragma unroll
    for (int j = 0; j < 4; ++j) { const f32x4 gv = ((const f32x4*)g)[64 * j + lane];
#pragma unroll
        for (int u = 0; u < 3; ++u) { const f32x4 o = v[u][j] * rsqrtf(ss[u] * (1.f / DM) + EPS) * gv; ((u32x2*)op[u])[64 * j + lane] = (u32x2){pk2(o.x, o.y), pk2(o.z, o.w)}; } }
}
__device__ __forceinline__ void cvt_stream(const float* src, bf16* dst, size_t n4, size_t gtid, size_t gthreads) {
    size_t i = gtid;
    for (; i + 7 * gthreads < n4; i += 8 * gthreads) {
        f32x4 v[8];
#pragma unroll
        for (int k = 0; k < 8; ++k) v[k] = __builtin_nontemporal_load((const f32x4*)src + i + k * gthreads);
#pragma unroll
        for (int k = 0; k < 8; ++k) ((u32x2*)dst)[i + k * gthreads] = (u32x2){pk2(v[k].x, v[k].y), pk2(v[k].z, v[k].w)};
    }
    for (; i < n4; i += gthreads) { const f32x4 v = ((const f32x4*)src)[i]; ((u32x2*)dst)[i] = (u32x2){pk2(v.x, v.y), pk2(v.z, v.w)}; }
}
__device__ __forceinline__ float wave_incl_scan(float v, int lane) {
#pragma unroll
    for (int o = 1; o < 64; o <<= 1) { const float t = __shfl_up(v, o); if (lane >= o) v += t; }
    return v;
}

template <int NCH>
__device__ __forceinline__ void scan_seq(const float* src, float* dst, float base, int lane, LAS float* scr) {
    float v[NCH];
#pragma unroll
    for (int c = 0; c < NCH; ++c) v[c] = src[(size_t)(64 * c + lane) * 8];
#pragma unroll
    for (int c = 0; c < NCH; ++c) { v[c] = wave_incl_scan(v[c], lane); if (lane == 63) scr[c] = v[c]; }
    lds_wait();
    const float st = wave_incl_scan(lane < NCH ? scr[lane] : 0.f, lane);
    lds_wait();
#pragma unroll
    for (int c = 0; c < NCH; ++c) { const float carry = c ? __builtin_bit_cast(float, __builtin_amdgcn_readlane(__builtin_bit_cast(int, st), c ? c - 1 : 0)) : 0.f; dst[64 * c + lane] = (v[c] + carry + base) * LOG2E; }
}
__device__ __forceinline__ void p0_prologue(const Args& A, LAS unsigned char* lds) {
    const int tid = threadIdx.x, lane = tid & 63, wave = tid >> 6;
    const int G = gridDim.x, gw = blockIdx.x * NWAVES + wave, NGW = G * NWAVES;
    unsigned char* ws = A.ws;
    LAS float* scr = (LAS float*)(lds + wave * 16384);
    constexpr int I_IN = (DM / 64) * (NZ / 32), I_Q = (384 / 64) * (768 / 32), I_UK = (256 / 64) * (512 / 32), I_OUT = (DM / 64) * (DM / 32),
                  I_UP = (DM / 64) * (DFF2 / 32), I_DN = (DFF / 64) * (DM / 32);
    constexpr int NITEMS = I_IN + I_Q + 2 * I_UK + I_OUT + I_UP + I_DN;
    for (int it = gw; it < NITEMS; it += NGW) {
        int r = it;
        if (r < I_IN) { tr_item<1>(A.in[9], DM, DIN, NZ, (bf16*)(ws + WS_WIN), 0, scr, r, lane); continue; } r -= I_IN;
        if (r < I_Q) { tr_item<0>(A.in[12], 384, 768, 768, (bf16*)(ws + WS_WQ), 0, scr, r, lane); continue; } r -= I_Q;
        if (r < I_UK) { tr_item<0>(A.in[14], 256, 512, 512, (bf16*)(ws + WS_WKV), 0, scr, r, lane); continue; } r -= I_UK;
        if (r < I_UK) { tr_item<0>(A.in[15], 256, 512, 512, (bf16*)(ws + WS_WKV), 512, scr, r, lane); continue; } r -= I_UK;
        if (r < I_OUT) { tr_item<0>(A.in[16], DM, DM, DM, (bf16*)(ws + WS_WOUT), 0, scr, r, lane); continue; } r -= I_OUT;
        if (r < I_UP) { tr_item<2>(A.in[18], DM, DFF2, DFF2, (bf16*)(ws + WS_WUP), 0, scr, r, lane); continue; } r -= I_UP;
        tr_item<0>(A.in[21], DFF, DM, DM, (bf16*)(ws + WS_WDOWN), 0, scr, r, lane);
    }
    for (int it = gw; it < 8 * 12 * 8; it += NGW) {
        const int h = it / 96, kt = (it % 96) / 8, ct = it % 8; const int r32 = lane & 31, hi2 = lane >> 5;
        const float* wq = A.in[12] + (size_t)(kt * 32 + r32) * 768 + h * 96 + 8 * hi2; const float* uk = A.in[14] + (size_t)(ct * 32 + r32) * 512 + h * 64 + 8 * hi2;
        f32x16 acc = {};
#pragma unroll
        for (int st = 0; st < 4; ++st) {
            const f32x4 a0 = *(const f32x4*)(wq + 16 * st), a1 = *(const f32x4*)(wq + 16 * st + 4), b0 = *(const f32x4*)(uk + 16 * st), b1 = *(const f32x4*)(uk + 16 * st + 4);
            const u32x4 aw = {pk2(a0.x, a0.y), pk2(a0.z, a0.w), pk2(a1.x, a1.y), pk2(a1.z, a1.w)}, bw = {pk2(b0.x, b0.y), pk2(b0.z, b0.w), pk2(b1.x, b1.y), pk2(b1.z, b1.w)};
            acc = __builtin_amdgcn_mfma_f32_32x32x16_bf16(__builtin_bit_cast(bf16x8, aw), __builtin_bit_cast(bf16x8, bw), acc, 0, 0, 0);
        }
        bf16* o = (bf16*)(ws + WS_WQA) + (size_t)(h * 256 + ct * 32 + r32) * 384 + kt * 32 + 4 * hi2;
#pragma unroll
        for (int q = 0; q < 4; ++q) st_bf4(o + 8 * q, (f32x4){acc[4 * q], acc[4 * q + 1], acc[4 * q + 2], acc[4 * q + 3]});
    }
    {
        bf16* H = (bf16*)(ws + WS_H); int m = gw;
        for (; m + 2 * NGW < TOK; m += 3 * NGW) { const int m1 = m + NGW, m2 = m + 2 * NGW;
            rms_row3(m < TP ? A.in[0] + (size_t)m * DM : A.in[1] + (size_t)(m - TP) * DM, m1 < TP ? A.in[0] + (size_t)m1 * DM : A.in[1] + (size_t)(m1 - TP) * DM,
                     m2 < TP ? A.in[0] + (size_t)m2 * DM : A.in[1] + (size_t)(m2 - TP) * DM, A.in[8], H + (size_t)m * DM, H + (size_t)m1 * DM, H + (size_t)m2 * DM, lane); }
        for (; m < TOK; m += NGW) rms_row<false>(m < TP ? A.in[0] + (size_t)m * DM : A.in[1] + (size_t)(m - TP) * DM, A.in[8], H + (size_t)m * DM, lane);
    }
    {
        const int gt = blockIdx.x * NTHREADS + tid, GT = G * NTHREADS;
        for (int i = gt; i < 2112 * 16; i += GT) {
            const int pidx = i >> 4, k = i & 15; const int pos = pidx < 2048 ? pidx : PAST + (pidx - 2048);
            const float inv = exp2f(-(float)k * (13.287712379549449f / 16.f));
            const float ang = (float)pos * inv;
            const float kq = floorf(ang * 0.15915494309189535f);
            float r = fmaf(-kq, 6.2831854820251465f, ang); r = fmaf(-kq, -1.7484555e-7f, r);
            const float rev = r * 0.15915494309189535f;
            ((f32x2*)(ws + WS_CS))[i] = (f32x2){__builtin_amdgcn_cosf(rev), __builtin_amdgcn_sinf(rev)};
        }
    }
    for (int sq = (wave == 0 ? (int)blockIdx.x : NBS * 8); sq < NBS * 8; sq += G) {
        const int b = sq >> 3, h = sq & 7; const float* lf = A.in[4] + (size_t)b * PAST * 8 + h; float* Fo = (float*)(ws + WS_FS) + (size_t)sq * KVS;
        scan_seq<PAST / 64>(lf, Fo, 0.f, lane, scr);
    }
    {
        const size_t gt = (size_t)blockIdx.x * NTHREADS + tid, GT = (size_t)G * NTHREADS;
        cvt_stream(A.in[5], (bf16*)(ws + WS_LATPAST), (size_t)NPAST * 256 / 4, gt, GT);
        cvt_stream(A.in[6], (bf16*)(ws + WS_KRPAST), (size_t)NPAST * 32 / 4, gt, GT);
    }
}

__device__ __forceinline__ void rope4_calc(f32x4& x1, f32x4& x2, float pos, const f32x4 inv) {
    f32x4 c, sn;
#pragma unroll
    for (int e = 0; e < 4; ++e) { const float ang = pos * inv[e]; const float kq = floorf(ang * 0.15915494309189535f);
        float r = fmaf(-kq, 6.2831854820251465f, ang); r = fmaf(-kq, -1.7484555e-7f, r); const float rev = r * 0.15915494309189535f;
        c[e] = __builtin_amdgcn_cosf(rev); sn[e] = __builtin_amdgcn_sinf(rev); }
    const f32x4 o1 = x1 * c - x2 * sn, o2 = x1 * sn + x2 * c; x1 = o1; x2 = o2;
}
__device__ __forceinline__ void rope4(f32x4& x1, f32x4& x2, const float* cs  ) {
    const f32x4 a = ((const f32x4*)cs)[0], b = ((const f32x4*)cs)[1];
    const f32x4 c = {a.x, a.z, b.x, b.z}, s = {a.y, a.w, b.y, b.w};
    const f32x4 o1 = x1 * c - x2 * s, o2 = x1 * s + x2 * c; x1 = o1; x2 = o2;
}
__device__ __forceinline__ float log_sigmoid(float x) { return fminf(x, 0.f) - 0.6931471805599453f * __builtin_amdgcn_logf(1.f + fast_exp2(-fabsf(x) * LOG2E)); }

struct EpiZ {
    static constexpr bool PERM = false, AFTER_DRAIN = false;
    bf16 *qfox, *knew, *vnew, *krnew; float* zbuf; float* out; const float* cs; const float* bfg;
    __device__ __forceinline__ void operator()(const f32x4 (&acc)[2][2][4][2], const pg8::Unit& u, int wr, int wc, int fr, int fq) const {
        const bool smp = u.pm >= TP / 256;
        const int row0 = u.pm * 256 + wr * 64 + fr;
#pragma unroll
        for (int bj = 0; bj < 2; ++bj) {
            const int cg = u.pn * 256 + bj * 128 + wc * 32;
            const int c0 = cg + 4 * fq;
#pragma unroll
            for (int ai = 0; ai < 2; ++ai)
#pragma unroll
                for (int m = 0; m < 4; ++m) {
                    const int row = row0 + ai * 128 + m * 16; const size_t lr = smp ? (size_t)(row - TP) : (size_t)row;
                    f32x4 v0 = acc[ai][bj][m][0], v1 = acc[ai][bj][m][1];
                    if (cg < 512) { const float sc = 0.125f * LOG2E; st_bf4(qfox + (size_t)row * 512 + c0, v0 * sc); st_bf4(qfox + (size_t)row * 512 + c0 + 16, v1 * sc); }
                    else if (cg < 1024) { const int c = c0 - 512; float* o = out + (smp ? O_KS : O_KP) + lr * 512 + c; *(f32x4*)o = v0; *(f32x4*)(o + 16) = v1;
                        st_bf4(knew + (size_t)row * 512 + c, v0); st_bf4(knew + (size_t)row * 512 + c + 16, v1); }
                    else if (cg < 1536) { const int c = c0 - 1024; float* o = out + (smp ? O_VS : O_VP) + lr * 512 + c; *(f32x4*)o = v0; *(f32x4*)(o + 16) = v1;
                        st_bf4(vnew + (size_t)row * 512 + c, v0); st_bf4(vnew + (size_t)row * 512 + c + 16, v1); }
                    else if (cg < 2176) { float* z = zbuf + (size_t)row * ZW + (c0 - 1536); *(f32x4*)z = v0; *(f32x4*)(z + 16) = v1; }
                    else if (cg == 2176) {
                        const int pidx = smp ? 2048 + ((row - TP) & 63) : (row & 2047);
                        rope4_calc(v0, v1, (float)(pidx < SEQ ? pidx : PAST + (pidx - SEQ)), (f32x4){exp2f(-(float)(4 * fq) * (13.287712379549449f / 16.f)), exp2f(-(float)(4 * fq + 1) * (13.287712379549449f / 16.f)), exp2f(-(float)(4 * fq + 2) * (13.287712379549449f / 16.f)), exp2f(-(float)(4 * fq + 3) * (13.287712379549449f / 16.f))});
                        float* o = out + (smp ? O_KRS : O_KRP) + lr * 32 + 4 * fq; *(f32x4*)o = v0; *(f32x4*)(o + 16) = v1;
                        st_bf4(krnew + (size_t)row * 32 + 4 * fq, v0); st_bf4(krnew + (size_t)row * 32 + 4 * fq + 16, v1);
                    } else if (cg == 2208) {
                        if (fq < 2) { const f32x4 b = *(const f32x4*)(bfg + 4 * fq);
                            f32x4 lf; lf.x = log_sigmoid(v0.x + b.x); lf.y = log_sigmoid(v0.y + b.y); lf.z = log_sigmoid(v0.z + b.z); lf.w = log_sigmoid(v0.w + b.w);
                            *(f32x4*)(out + (smp ? O_LFS : O_LFP) + lr * 8 + 4 * fq) = lf; }
                    }
                }
        }
    }
};
struct EpiBf {
    static constexpr bool PERM = true, AFTER_DRAIN = false;
    bf16* O; int ldc; float sc;
    __device__ __forceinline__ void operator()(const f32x4 (&acc)[2][2][4][2], const pg8::Unit& u, int wr, int wc, int fr, int fq) const {
        const int row0 = u.pm * 256 + wr * 64 + fr;
#pragma unroll
        for (int ai = 0; ai < 2; ++ai)
#pragma unroll
            for (int m = 0; m < 4; ++m) { bf16* rp = O + (size_t)(row0 + ai * 128 + m * 16) * ldc + u.pn * 256 + wc * 32 + 8 * fq;
#pragma unroll
                for (int bj = 0; bj < 2; ++bj) { const f32x4 v0 = acc[ai][bj][m][0] * sc, v1 = acc[ai][bj][m][1] * sc;
                    *(u32x4*)(rp + bj * 128) = (u32x4){pk2(v0.x, v0.y), pk2(v0.z, v0.w), pk2(v1.x, v1.y), pk2(v1.z, v1.w)}; } }
    }
};
constexpr int DN_SL = 8;
template <int NKT  >
struct SplitOrder {
    int G, c;
    __device__ __forceinline__ bool next(int i, pg8::Unit& u) const {
        const int L = i * G + c; if (L >= 256 + 32 * DN_SL) return false;
        const bool full = L < 256; const int r = full ? L : L - 256, x = r & 7, y = r >> 3;
        pg8::Unit t; t.pm = full ? 8 * x + (y & 7) : 64 + x; t.pn = full ? (y >> 3) : (y & 3); const int sl = y >> 2;
        if (NKT == 44) { t.k0 = full ? 0 : (sl < 6 ? 6 * sl : 36 + 4 * (sl - 6)); t.nkt = full ? 44 : (sl < 6 ? 6 : 4); }
        else { t.k0 = full ? 0 : 2 * sl; t.nkt = full ? 16 : 2; }
        t.sl = full ? -1 : sl;
        u = t; return true;
    }
    __device__ __forceinline__ void a_ready(const pg8::Unit&) const {}
    __device__ __forceinline__ void done(const pg8::Unit&) const {}
};
typedef SplitOrder<44> DownOrder;
struct EpiDown {
    static constexpr bool PERM = false, AFTER_DRAIN = false;
    const float* x1; float* x2; float* slab;
    __device__ __forceinline__ void operator()(const f32x4 (&acc)[2][2][4][2], const pg8::Unit& u, int wr, int wc, int fr, int fq) const {
        const int row0 = u.pm * 256 + wr * 64 + fr; const int cb = u.pn * 256 + wc * 32 + 4 * fq;
        if (u.sl >= 0) {
#pragma unroll
            for (int ai = 0; ai < 2; ++ai)
#pragma unroll
                for (int m = 0; m < 4; ++m) { float* op = slab + ((size_t)u.sl * TS + (row0 + ai * 128 + m * 16 - TP)) * DM + cb;
#pragma unroll
                    for (int bj = 0; bj < 2; ++bj)
#pragma unroll
                        for (int n = 0; n < 2; ++n) *(f32x4*)(op + bj * 128 + n * 16) = acc[ai][bj][m][n]; }
            return;
        }
#pragma unroll
        for (int ai = 0; ai < 2; ++ai) {
            f32x4 xb[4][2][2];
#pragma unroll
            for (int m = 0; m < 4; ++m) { const float* bp = x1 + (size_t)(row0 + ai * 128 + m * 16) * DM + cb;
#pragma unroll
                for (int bj = 0; bj < 2; ++bj)
#pragma unroll
                    for (int n = 0; n < 2; ++n) xb[m][bj][n] = *(const f32x4*)(bp + bj * 128 + n * 16); }
#pragma unroll
            for (int m = 0; m < 4; ++m) { float* op = x2 + (size_t)(row0 + ai * 128 + m * 16) * DM + cb;
#pragma unroll
                for (int bj = 0; bj < 2; ++bj)
#pragma unroll
                    for (int n = 0; n < 2; ++n) *(f32x4*)(op + bj * 128 + n * 16) = xb[m][bj][n] + acc[ai][bj][m][n]; }
        }
    }
};
struct EpiOut {
    static constexpr bool PERM = false, AFTER_DRAIN = false;
    const float* b0; const float* b1; float* O; bf16* H; const float* g; float* rowss; float* slab;
    __device__ __forceinline__ void operator()(const f32x4 (&acc)[2][2][4][2], const pg8::Unit& u, int wr, int wc, int fr, int fq) const {
        const int row0 = u.pm * 256 + wr * 64 + fr; const bool smp = u.pm >= TP / 256; const int cb = u.pn * 256 + wc * 32 + 4 * fq;
        if (u.sl >= 0) {
#pragma unroll
            for (int ai = 0; ai < 2; ++ai)
#pragma unroll
                for (int m = 0; m < 4; ++m) { float* sp = slab + ((size_t)u.sl * TS + (row0 + ai * 128 + m * 16 - TP)) * DM + cb;
#pragma unroll
                    for (int bj = 0; bj < 2; ++bj)
#pragma unroll
                        for (int n = 0; n < 2; ++n) *(f32x4*)(sp + bj * 128 + n * 16) = acc[ai][bj][m][n]; }
            return;
        }
        f32x4 gv[2][2];
#pragma unroll
        for (int bj = 0; bj < 2; ++bj)
#pragma unroll
            for (int n = 0; n < 2; ++n) gv[bj][n] = *(const f32x4*)(g + cb + bj * 128 + n * 16);
#pragma unroll
        for (int aim = 0; aim < 4; ++aim) { const int ai = aim >> 1, mb = (aim & 1) * 2;
            f32x4 xb[2][2][2];
#pragma unroll
            for (int mm = 0; mm < 2; ++mm) { const int row = row0 + ai * 128 + (mb + mm) * 16; const float* bp = (smp ? b1 + (size_t)(row - TP) * DM : b0 + (size_t)row * DM) + cb;
#pragma unroll
                for (int bj = 0; bj < 2; ++bj)
#pragma unroll
                    for (int n = 0; n < 2; ++n) xb[mm][bj][n] = *(const f32x4*)(bp + bj * 128 + n * 16); }
#pragma unroll
            for (int mm = 0; mm < 2; ++mm) { const int m = mb + mm; const int row = row0 + ai * 128 + m * 16; float* op = O + (size_t)row * DM + cb; bf16* hp = H + (size_t)row * DM + cb;
                float ss = 0.f;
#pragma unroll
                for (int bj = 0; bj < 2; ++bj)
#pragma unroll
                    for (int n = 0; n < 2; ++n) { const f32x4 x = xb[mm][bj][n] + acc[ai][bj][m][n]; *(f32x4*)(op + bj * 128 + n * 16) = x;
                        ss += (x.x * x.x + x.y * x.y) + (x.z * x.z + x.w * x.w); st_bf4(hp + bj * 128 + n * 16, x * gv[bj][n]); }
                ss += __shfl_xor(ss, 16); ss += __shfl_xor(ss, 32);
                if (fq == 0) rowss[(size_t)row * 16 + u.pn * 4 + wc] = ss;
            }
        }
    }
};
struct EpiRes {
    static constexpr bool PERM = false, AFTER_DRAIN = false;
    const float* b0; const float* b1; float* O;
    __device__ __forceinline__ void operator()(const f32x4 (&acc)[2][2][4][2], const pg8::Unit& u, int wr, int wc, int fr, int fq) const {
        const int row0 = u.pm * 256 + wr * 64 + fr; const bool smp = u.pm >= TP / 256;
#pragma unroll
        for (int ai = 0; ai < 2; ++ai)
#pragma unroll
            for (int m = 0; m < 4; ++m) { const int row = row0 + ai * 128 + m * 16; const int cb = u.pn * 256 + wc * 32 + 4 * fq;
                const float* bp = (smp ? b1 + (size_t)(row - TP) * DM : b0 + (size_t)row * DM) + cb; float* op = O + (size_t)row * DM + cb;
#pragma unroll
                for (int bj = 0; bj < 2; ++bj)
#pragma unroll
                    for (int n = 0; n < 2; ++n) *(f32x4*)(op + bj * 128 + n * 16) = *(const f32x4*)(bp + bj * 128 + n * 16) + acc[ai][bj][m][n]; }
    }
};


__device__ __forceinline__ float silu(float g) { return g * __builtin_amdgcn_rcpf(1.f + fast_exp2(-g * LOG2E)); }
template <int CTRL> __device__ __forceinline__ float dpp_mov(float old, float src) {
    return __builtin_bit_cast(float, __builtin_amdgcn_update_dpp(__builtin_bit_cast(int, old), __builtin_bit_cast(int, src), CTRL, 0xf, 0xf, false)); }
__device__ __forceinline__ f32x4 rows_m1(f32x4 cur, f32x4 prev) { f32x4 o;
#pragma unroll
    for (int e = 0; e < 4; ++e) o[e] = dpp_mov<0x111>(dpp_mov<0x121>(0.f, prev[e]), cur[e]);
    return o; }
__device__ __forceinline__ f32x4 rows_m2(f32x4 cur, f32x4 prev) { f32x4 o;
#pragma unroll
    for (int e = 0; e < 4; ++e) o[e] = dpp_mov<0x112>(dpp_mov<0x122>(0.f, prev[e]), cur[e]);
    return o; }
struct EpiGlu {
    static constexpr bool PERM = false, AFTER_DRAIN = false;
    bf16* act; float* edge; const float* cw; const float* cb; const float* rowss;
    __device__ __forceinline__ void operator()(const f32x4 (&acc)[2][2][4][2], const pg8::Unit& u, int wr, int wc, int fr, int fq) const {
        float rstd[2][4];
#pragma unroll
        for (int ai = 0; ai < 2; ++ai)
#pragma unroll
            for (int m = 0; m < 4; ++m) rstd[ai][m] = rowss[u.pm * 256 + ai * 128 + wr * 64 + m * 16 + fr];
#pragma unroll
        for (int bj = 0; bj < 2; ++bj) {
            const int j = 16 * ((u.pn * 256 + bj * 128 + wc * 32) >> 5) + 4 * fq;
            const f32x4 w0g = *(const f32x4*)(cw + j), w1g = *(const f32x4*)(cw + DFF2 + j), w2g = *(const f32x4*)(cw + 2 * DFF2 + j), bg = *(const f32x4*)(cb + j);
            const f32x4 w0v = *(const f32x4*)(cw + DFF + j), w1v = *(const f32x4*)(cw + DFF2 + DFF + j), w2v = *(const f32x4*)(cw + 2 * DFF2 + DFF + j), bv = *(const f32x4*)(cb + DFF + j);
#pragma unroll
            for (int ai = 0; ai < 2; ++ai) {
                const int blk = u.pm * 4 + ai * 2 + wr; const int row0 = blk * 64 + fr;
#pragma unroll
                for (int m = 0; m < 4; ++m) {
                    const f32x4 gc = acc[ai][bj][m][0] * rstd[ai][m], vc = acc[ai][bj][m][1] * rstd[ai][m];
                    const f32x4 gp = acc[ai][bj][m ? m - 1 : 0][0] * rstd[ai][m ? m - 1 : 0], vp = acc[ai][bj][m ? m - 1 : 0][1] * rstd[ai][m ? m - 1 : 0];
                    const f32x4 g1 = rows_m1(gc, gp), g2 = rows_m2(gc, gp), v1 = rows_m1(vc, vp), v2 = rows_m2(vc, vp);
                    const f32x4 g = bg + w0g * g2 + w1g * g1 + w2g * gc, v = bv + w0v * v2 + w1v * v1 + w2v * vc;
                    f32x4 a; a.x = silu(g.x) * v.x; a.y = silu(g.y) * v.y; a.z = silu(g.z) * v.z; a.w = silu(g.w) * v.w;
                    if (m > 0 || fr >= 2) st_bf4(act + (size_t)(row0 + 16 * m) * DFF + j, a);
                    if (m == 0 && fr < 2) { float* e = edge + ((size_t)blk * 4 + fr) * DFF2; *(f32x4*)(e + j) = gc; *(f32x4*)(e + DFF + j) = vc; }
                    if (m == 3 && fr >= 14) { float* e = edge + ((size_t)blk * 4 + 2 + (fr - 14)) * DFF2; *(f32x4*)(e + j) = gc; *(f32x4*)(e + DFF + j) = vc; }
                }
            }
        }
    }
};

__device__ __forceinline__ void p2_postz(const Args& A, LAS unsigned char* lds) {
    const int tid = threadIdx.x, lane = tid & 63, wave = tid >> 6; const int gw = blockIdx.x * NWAVES + wave, NGW = gridDim.x * NWAVES;
    unsigned char* ws = A.ws; const float* zb = (const float*)(ws + WS_ZBUF);
    f32x2 gq[3]; { for (int j = 0; j < 3; ++j) gq[j] = ((const f32x2*)A.in[11])[lane + 64 * j]; }
    const f32x4 gk = ((const f32x4*)A.in[13])[lane];
    for (int m0 = gw; m0 < TOK; m0 += 3 * NGW) {
        f32x2 v[3][3]; f32x4 c[3]; float sq[3], sk[3]; bool ok[3];
#pragma unroll
        for (int u = 0; u < 3; ++u) { const int m = m0 + u * NGW; ok[u] = m < TOK; const float* z = zb + (size_t)(ok[u] ? m : m0) * ZW;
#pragma unroll
            for (int j = 0; j < 3; ++j) v[u][j] = ((const f32x2*)z)[lane + 64 * j];
            c[u] = ((const f32x4*)(z + 384))[lane]; }
#pragma unroll
        for (int u = 0; u < 3; ++u) { sq[u] = 0.f;
#pragma unroll
            for (int j = 0; j < 3; ++j) sq[u] += v[u][j].x * v[u][j].x + v[u][j].y * v[u][j].y;
            sk[u] = (c[u].x * c[u].x + c[u].y * c[u].y) + (c[u].z * c[u].z + c[u].w * c[u].w); }
#pragma unroll
        for (int o = 1; o < 64; o <<= 1) {
#pragma unroll
            for (int u = 0; u < 3; ++u) { sq[u] += __shfl_xor(sq[u], o); sk[u] += __shfl_xor(sk[u], o); } }
#pragma unroll
        for (int u = 0; u < 3; ++u) if (ok[u]) { const int m = m0 + u * NGW;
            const float rq = rsqrtf(sq[u] * (1.f / 384.f) + EPS), rk = rsqrtf(sk[u] * (1.f / 256.f) + EPS);
            unsigned* o = (unsigned*)((bf16*)(ws + WS_QCN) + (size_t)m * 384);
#pragma unroll
            for (int j = 0; j < 3; ++j) o[lane + 64 * j] = pk2(v[u][j].x * rq * gq[j].x, v[u][j].y * rq * gq[j].y);
            const f32x4 ov = c[u] * rk * gk;
            float* op = A.out + (m < TP ? O_LATP + (size_t)m * 256 : O_LATS + (size_t)(m - TP) * 256); ((f32x4*)op)[lane] = ov;
            st_bf4((bf16*)(ws + WS_LATNEW) + (size_t)m * 256 + 4 * lane, ov); }
    }
    for (int sq = ((gw & 3) == 0 ? (gw >> 2) : 64 + 256); sq < 64 + 256; sq += (NGW >> 2)) {
        if (sq < 64) { const int b = sq >> 3, h = sq & 7; const float* lf = A.out + O_LFP + (size_t)b * SEQ * 8 + h; float* Fo = (float*)(ws + WS_FP) + (size_t)sq * SEQ; scan_seq<SEQ / 64>(lf, Fo, 0.f, lane, (LAS float*)(lds + wave * 16384)); }
        else { const int s2 = sq - 64, b = s2 >> 3, h = s2 & 7; const float* lf = A.out + O_LFS + (size_t)b * DSEQ * 8 + h; float* Fo = (float*)(ws + WS_FS) + (size_t)s2 * KVS;
            const float base = Fo[PAST - 1]; const float v = wave_incl_scan(lf[(size_t)lane * 8], lane); Fo[PAST + lane] = base + v * LOG2E; }
    }
}

__device__ __forceinline__ f32x4 ld_bf4(const bf16* p) { const u32x2 w = *(const u32x2*)p; return (f32x4){bflo(w.x), bfhi(w.x), bflo(w.y), bfhi(w.y)}; }
__device__ __forceinline__ void p8_fixup(const Args& A) {
    int tid = threadIdx.x; asm volatile("" : "+v"(tid)); const int lane = tid & 63, wave = tid >> 6; const int gw = blockIdx.x * NWAVES + wave, NGW = gridDim.x * NWAVES;
    unsigned char* ws = A.ws; const float* __restrict__ EDGE = (const float*)(ws + WS_EDGE); bf16* __restrict__ ACT = (bf16*)(ws + WS_ACT);
    const float* __restrict__ cw = A.in[19]; const float* __restrict__ cb = A.in[20];
    constexpr int NBLK = TOK / 64, NSTRIP = DFF / 256, NIT = NBLK * NSTRIP;
    for (int it0 = gw; it0 < NIT; it0 += 2 * NGW) {
        f32x4 wg[2][4], wv[2][4], pg[2][2], pv[2][2], cg[2][2], cv[2][2], sg[2][2], sv[2][2]; bool ok[2], last[2], smp[2]; int j0[2], tok0[2], bb[2];
#pragma unroll
        for (int u = 0; u < 2; ++u) {
            const int it = it0 + u * NGW; ok[u] = it < NIT; const int itc = ok[u] ? it : it0;
            const int blk = itc / NSTRIP, strip = itc % NSTRIP; j0[u] = strip * 256 + lane * 4; tok0[u] = blk * 64;
            smp[u] = tok0[u] >= TP; const int T = smp[u] ? DSEQ : SEQ; const int lt = smp[u] ? tok0[u] - TP : tok0[u]; bb[u] = lt / T; const int t0 = lt % T; last[u] = (t0 + 64 == T);
#pragma unroll
            for (int k = 0; k < 3; ++k) { wg[u][k] = *(const f32x4*)(cw + k * DFF2 + j0[u]); wv[u][k] = *(const f32x4*)(cw + k * DFF2 + DFF + j0[u]); }
            wg[u][3] = *(const f32x4*)(cb + j0[u]); wv[u][3] = *(const f32x4*)(cb + DFF + j0[u]);
            const float* pe = (t0 == 0) ? (smp[u] ? A.in[7] + (size_t)bb[u] * 2 * DFF2 : EDGE  ) : EDGE + ((size_t)(blk - 1) * 4 + 2) * DFF2;
            const bool zero = (t0 == 0) && !smp[u];
#pragma unroll
            for (int i = 0; i < 2; ++i) { pg[u][i] = *(const f32x4*)(pe + i * DFF2 + j0[u]); pv[u][i] = *(const f32x4*)(pe + i * DFF2 + DFF + j0[u]);
                if (zero) { pg[u][i] = (f32x4){0.f, 0.f, 0.f, 0.f}; pv[u][i] = (f32x4){0.f, 0.f, 0.f, 0.f}; }
                const float* e = EDGE + ((size_t)blk * 4 + i) * DFF2; cg[u][i] = *(const f32x4*)(e + j0[u]); cv[u][i] = *(const f32x4*)(e + DFF + j0[u]);
                const float* e2 = EDGE + ((size_t)blk * 4 + 2 + i) * DFF2; sg[u][i] = *(const f32x4*)(e2 + j0[u]); sv[u][i] = *(const f32x4*)(e2 + DFF + j0[u]); }
        }
#pragma unroll
        for (int u = 0; u < 2; ++u) if (ok[u]) {
            f32x4 g2 = pg[u][0], g1 = pg[u][1], v2 = pv[u][0], v1 = pv[u][1];
#pragma unroll
            for (int i = 0; i < 2; ++i) {
                const f32x4 gc = cg[u][i], vc = cv[u][i];
                const f32x4 g = wg[u][3] + wg[u][0] * g2 + wg[u][1] * g1 + wg[u][2] * gc, v = wv[u][3] + wv[u][0] * v2 + wv[u][1] * v1 + wv[u][2] * vc;
                f32x4 a; a.x = silu(g.x) * v.x; a.y = silu(g.y) * v.y; a.z = silu(g.z) * v.z; a.w = silu(g.w) * v.w;
                st_bf4(ACT + (size_t)(tok0[u] + i) * DFF + j0[u], a);
                g2 = g1; g1 = gc; v2 = v1; v1 = vc;
            }
            if (last[u]) {
#pragma unroll
                for (int i = 0; i < 2; ++i) { float* o = A.out + (smp[u] ? O_CVS : O_CVP) + ((size_t)bb[u] * 2 + i) * DFF2; *(f32x4*)(o + j0[u]) = sg[u][i]; *(f32x4*)(o + DFF + j0[u]) = sv[u][i]; }
            }
        }
    }
}

struct AttnArgs {
    const bf16* Q; int qstride;
    const void *Ka_past, *Ka_new; int kastride;
    const bf16 *Kb_past, *Kb_new; int kbstride;
    const void *V_past, *V_new; int vstride;
    const float *Fq, *Fk;
    bf16* O; int ostride;
    int P, qpos0, nkv;
    const float* cs;
};
__device__ __forceinline__ int crow(int r, int hi) { return (r & 3) + 8 * (r >> 2) + 4 * hi; }
__device__ __forceinline__ s16x4 tr_read(const LAS unsigned char* p) { typedef short v4i16 __attribute__((ext_vector_type(4))); return __builtin_bit_cast(s16x4, __builtin_amdgcn_ds_read_tr16_b64_v4i16((LAS v4i16*)p)); }

template <int DQK, bool FOX, int QS, int KS, bool F32>
__device__ __forceinline__ void attn_unit(const AttnArgs& a, LAS unsigned char* lds_base) {
    LAS unsigned char* const lds = lds_base;
    static_assert(QS * KS == NWAVES, "8 waves");
    constexpr int KRB = (DQK + 8) * 2, VRB = 144, NKK = DQK / 16;
    constexpr int OFF_V = 64 * KS * KRB, OFF_F = OFF_V + 64 * KS * VRB, OFF_Q = OFF_F + 64 * KS * 4, OFF_END = OFF_Q + QS * NKK * 1024;
    constexpr bool QLDS = KS > 1;
    static_assert(OFF_END <= 131072, "attention LDS");
    int tid = threadIdx.x; asm volatile("" : "+v"(tid));
    const int lane = tid & 63, q32 = lane & 31, hi = lane >> 5; const int wid = __builtin_amdgcn_readfirstlane(tid >> 6);
    const int qs = wid % QS, ks = wid / QS;
    const int NT = (a.nkv + 64 * KS - 1) / (64 * KS);
    const int qmin = a.qpos0 + qs * 32, qpos = qmin + q32;
    bf16x8 qf[NKK];
    { const bf16* qp = a.Q + (size_t)(qs * 32 + q32) * a.qstride + hi * 8;
#pragma unroll
      for (int kk = 0; kk < NKK; ++kk) qf[kk] = *(const bf16x8*)(qp + kk * 16); }
    if (DQK == 96) {
        const int pidx = qpos < SEQ ? qpos : SEQ + (qpos - PAST);
        const f32x4* cp = (const f32x4*)(a.cs + ((size_t)pidx * 16 + 8 * hi) * 2);
        const u32x4 w1 = __builtin_bit_cast(u32x4, qf[NKK - 2]), w2 = __builtin_bit_cast(u32x4, qf[NKK - 1]); u32x4 r1, r2;
#pragma unroll
        for (int j = 0; j < 4; ++j) { const f32x4 c = cp[j];
            const float a0 = bflo(w1[j]), a1 = bfhi(w1[j]), b0 = bflo(w2[j]), b1 = bfhi(w2[j]);
            r1[j] = pk2(a0 * c.x - b0 * c.y, a1 * c.z - b1 * c.w); r2[j] = pk2(a0 * c.y + b0 * c.x, a1 * c.w + b1 * c.z); }
        qf[NKK - 2] = __builtin_bit_cast(bf16x8, r1); qf[NKK - 1] = __builtin_bit_cast(bf16x8, r2);
    }
    LAS unsigned char* qlds = lds + OFF_Q + qs * (NKK * 1024) + lane * 16;
    if (QLDS) {
#pragma unroll
        for (int kk = 0; kk < NKK; ++kk) *(LAS bf16x8*)(qlds + kk * 1024) = qf[kk];
    }
    const float fqv = FOX ? a.Fq[qs * 32 + q32] : 0.f;
    float mrun = -1e30f, lsum = 0.f; f32x16 o0 = {}, o1 = {};
    u32x4 rka[KS], rv[F32 ? 1 : KS]; u32x4 rkb[(DQK == 96) ? (KS + 1) / 2 : 1]; float rf = 0.f;
    f32x4 fka[F32 ? KS : 1][2], fva[F32 ? KS : 1][2];
    const int lrow = tid >> 3, lch = tid & 7;
    const int brow = (tid & 255) >> 2, bch = tid & 3;
    auto load_k = [&](int T) {
        const int jT = T * KS * 64; const bool past = jT < a.P; const size_t r0 = (size_t)(past ? jT : jT - a.P);
        if (F32) { const float* kp = (const float*)(past ? a.Ka_past : a.Ka_new) + (r0 + lrow) * a.kastride + lch * 4;
#pragma unroll
            for (int s = 0; s < KS; ++s) if (jT + s * 64 < a.nkv) { const f32x4* p4 = (const f32x4*)(kp + (size_t)s * 64 * a.kastride); fka[F32 ? s : 0][0] = p4[0]; fka[F32 ? s : 0][1] = p4[8]; } }
        else { const bf16* kp = (const bf16*)(past ? a.Ka_past : a.Ka_new) + (r0 + lrow) * a.kastride + lch * 8;
#pragma unroll
            for (int s = 0; s < KS; ++s) if (jT + s * 64 < a.nkv) rka[s] = *(const u32x4*)(kp + (size_t)s * 64 * a.kastride); }
        if (DQK == 96) { const bf16* bp = (past ? a.Kb_past : a.Kb_new) + (r0 + (tid >> 8) * 64 + brow) * a.kbstride + bch * 8;
#pragma unroll
            for (int i = 0; i < (KS + 1) / 2; ++i) { const int s = 2 * i + (tid >> 8); if (s < KS && jT + s * 64 < a.nkv) rkb[i] = *(const u32x4*)(bp + (size_t)i * 128 * a.kbstride); }
        }
        if (FOX) { const int j = jT + tid; if (tid < 64 * KS && j < a.nkv) rf = a.Fk[j]; }
    };
    auto cvt_k = [&]() {
        if (F32) {
#pragma unroll
            for (int s = 0; s < KS; ++s) { const f32x4 k0 = fka[F32 ? s : 0][0], k1 = fka[F32 ? s : 0][1]; rka[s] = (u32x4){pk2(k0.x, k0.y), pk2(k0.z, k0.w), pk2(k1.x, k1.y), pk2(k1.z, k1.w)}; }
        }
    };
    auto load_v = [&](int T) {
        const int jT = T * KS * 64; const bool past = jT < a.P; const size_t r0 = (size_t)(past ? jT : jT - a.P);
        if (F32) { const float* vp = (const float*)(past ? a.V_past : a.V_new) + (r0 + lrow) * a.vstride + lch * 4;
#pragma unroll
            for (int s = 0; s < KS; ++s) if (jT + s * 64 < a.nkv) { const f32x4* p4 = (const f32x4*)(vp + (size_t)s * 64 * a.vstride); fva[F32 ? s : 0][0] = p4[0]; fva[F32 ? s : 0][1] = p4[8]; } }
        else { const bf16* vp = (const bf16*)(past ? a.V_past : a.V_new) + (r0 + lrow) * a.vstride + lch * 8;
#pragma unroll
            for (int s = 0; s < KS; ++s) if (jT + s * 64 < a.nkv) rv[F32 ? 0 : s] = *(const u32x4*)(vp + (size_t)s * 64 * a.vstride); }
    };
    constexpr bool DB = (KS == 1);
    static_assert(!DB || OFF_Q <= 32768, "double buffer stride");
    auto store_tile = [&](int T) {
        LAS unsigned char* const lds = lds_base + (DB ? (T & 1) * 32768 : 0);
#pragma unroll
        for (int s = 0; s < KS; ++s) { const int j0 = (T * KS + s) * 64;
            if (j0 < a.nkv) {
                if (F32) { const f32x4 v0 = fva[F32 ? s : 0][0], v1 = fva[F32 ? s : 0][1]; LAS unsigned char* kr = lds + (s * 64 + lrow) * KRB + lch * 8; LAS unsigned char* vr = lds + OFF_V + (s * 64 + lrow) * VRB + lch * 8;
                    *(LAS u32x2*)kr = (u32x2){rka[s].x, rka[s].y}; *(LAS u32x2*)(kr + 64) = (u32x2){rka[s].z, rka[s].w};
                    *(LAS u32x2*)vr = (u32x2){pk2(v0.x, v0.y), pk2(v0.z, v0.w)}; *(LAS u32x2*)(vr + 64) = (u32x2){pk2(v1.x, v1.y), pk2(v1.z, v1.w)}; }
                else { *(LAS u32x4*)(lds + (s * 64 + lrow) * KRB + lch * 16) = rka[s]; *(LAS u32x4*)(lds + OFF_V + (s * 64 + lrow) * VRB + lch * 16) = rv[F32 ? 0 : s]; } } }
        if (DQK == 96) {
#pragma unroll
            for (int i = 0; i < (KS + 1) / 2; ++i) { const int s = 2 * i + (tid >> 8); const int j0 = (T * KS + s) * 64;
                if (s < KS && j0 < a.nkv) *(LAS u32x4*)(lds + (s * 64 + brow) * KRB + 128 + bch * 16) = rkb[i]; }
        }
        if (FOX) { if (tid < 64 * KS) *(LAS float*)(lds + OFF_F + tid * 4) = rf; }
    };
    load_k(0); cvt_k(); load_v(0);
    const LAS unsigned char* kbase0 = lds + (ks * 64 + q32) * KRB + hi * 16;
    const LAS unsigned char* vbase0 = lds + OFF_V + (ks * 64 + 4 * hi + ((lane & 15) >> 2)) * VRB + (16 * ((lane >> 4) & 1) + 4 * (lane & 3)) * 2;
    const LAS unsigned char* fbase0 = lds + OFF_F + (ks * 64 + 4 * hi) * 4;
    if (DB) { store_tile(0); __syncthreads(); }
    for (int T = 0; T < NT; ++T) {
        if (!DB) { __syncthreads(); store_tile(T); __syncthreads(); }
        const int bo = DB ? (T & 1) * 32768 : 0;
        const LAS unsigned char* kbase = kbase0 + bo; const LAS unsigned char* vbase = vbase0 + bo; const LAS unsigned char* fbase = fbase0 + bo;
        if (T + 1 < NT) load_k(T + 1);
        __builtin_amdgcn_sched_barrier(0);
        const int tt = T * KS + ks; const int j0 = tt * 64;
        const bool valid = (j0 < a.nkv) && (FOX ? (j0 <= qmin + 31) : (tt <= (qmin >> 6)));
        bf16x8 pb[4];
        if (valid) {
            f32x16 p0 = {}, p1 = {};
#pragma unroll
            for (int kk = 0; kk < NKK; ++kk) {
                const bf16x8 k0 = *(const LAS bf16x8*)(kbase + kk * 32), k1 = *(const LAS bf16x8*)(kbase + 32 * KRB + kk * 32);
                const bf16x8 qv = QLDS ? *(const LAS bf16x8*)(qlds + kk * 1024) : qf[kk];
                p0 = __builtin_amdgcn_mfma_f32_32x32x16_bf16(k0, qv, p0, 0, 0, 0);
                p1 = __builtin_amdgcn_mfma_f32_32x32x16_bf16(k1, qv, p1, 0, 0, 0);
            }
            if (FOX) {
#pragma unroll
                for (int g = 0; g < 4; ++g) { const f32x4 f0 = *(const LAS f32x4*)(fbase + g * 32), f1 = *(const LAS f32x4*)(fbase + 128 + g * 32);
#pragma unroll
                    for (int e = 0; e < 4; ++e) { p0[4 * g + e] += fqv - f0[e]; p1[4 * g + e] += fqv - f1[e]; } }
                if (j0 + 63 > qmin) {
#pragma unroll
                    for (int r = 0; r < 16; ++r) { const int kv = j0 + crow(r, hi); if (kv > qpos) p0[r] = -1e30f; if (kv + 32 > qpos) p1[r] = -1e30f; }
                }
            }
            float mt = fmaxf(p0[0], p1[0]);
#pragma unroll
            for (int r = 1; r < 16; ++r) mt = fmaxf(mt, fmaxf(p0[r], p1[r]));
            mt = fmaxf(mt, __shfl_xor(mt, 32));
            const float mnew = fmaxf(mrun, mt), alpha = fast_exp2(mrun - mnew); mrun = mnew;
            float ps = 0.f;
#pragma unroll
            for (int r = 0; r < 16; ++r) { p0[r] = fast_exp2(p0[r] - mnew); p1[r] = fast_exp2(p1[r] - mnew); ps += p0[r] + p1[r]; }
            lsum = lsum * alpha + ps;
            if (__builtin_amdgcn_ballot_w64(alpha != 1.f)) { o0 = o0 * alpha; o1 = o1 * alpha; }
#pragma unroll
            for (int s = 0; s < 2; ++s) {
                u32x4 w0 = {pk2(p0[8 * s], p0[8 * s + 1]), pk2(p0[8 * s + 2], p0[8 * s + 3]), pk2(p0[8 * s + 4], p0[8 * s + 5]), pk2(p0[8 * s + 6], p0[8 * s + 7])};
                u32x4 w1 = {pk2(p1[8 * s], p1[8 * s + 1]), pk2(p1[8 * s + 2], p1[8 * s + 3]), pk2(p1[8 * s + 4], p1[8 * s + 5]), pk2(p1[8 * s + 6], p1[8 * s + 7])};
                pb[s] = __builtin_bit_cast(bf16x8, w0); pb[2 + s] = __builtin_bit_cast(bf16x8, w1);
            }
        }
        __builtin_amdgcn_sched_barrier(0);
        if (T + 1 < NT) { cvt_k(); load_v(T + 1); }
        __builtin_amdgcn_sched_barrier(0);
        if (valid) {
#pragma unroll
            for (int kst = 0; kst < 4; ++kst) {
                const LAS unsigned char* vp = vbase + 16 * kst * VRB;
                const s16x4 a0l = tr_read(vp), a0h = tr_read(vp + 8 * VRB), a1l = tr_read(vp + 64), a1h = tr_read(vp + 64 + 8 * VRB);
                const bf16x8 A0 = {a0l[0], a0l[1], a0l[2], a0l[3], a0h[0], a0h[1], a0h[2], a0h[3]}, A1 = {a1l[0], a1l[1], a1l[2], a1l[3], a1h[0], a1h[1], a1h[2], a1h[3]};
                o0 = __builtin_amdgcn_mfma_f32_32x32x16_bf16(A0, pb[kst], o0, 0, 0, 0);
                o1 = __builtin_amdgcn_mfma_f32_32x32x16_bf16(A1, pb[kst], o1, 0, 0, 0);
            }
        }
        if (DB) { if (T + 1 < NT) store_tile(T + 1); __syncthreads(); }
    }
    lsum += __shfl_xor(lsum, 32);
    if (KS == 1) {
        const float inv = 1.f / lsum; bf16* op = a.O + (size_t)(qs * 32 + q32) * a.ostride + 4 * hi;
#pragma unroll
        for (int g = 0; g < 4; ++g) { st_bf4(op + 8 * g, (f32x4){o0[4 * g] * inv, o0[4 * g + 1] * inv, o0[4 * g + 2] * inv, o0[4 * g + 3] * inv});
            st_bf4(op + 32 + 8 * g, (f32x4){o1[4 * g] * inv, o1[4 * g + 1] * inv, o1[4 * g + 2] * inv, o1[4 * g + 3] * inv}); }
    } else {
        __syncthreads();
        LAS float* osc = (LAS float*)lds + wid * 2048;
        LAS float* msc = (LAS float*)(lds + 65536) + wid * 32; LAS float* lsc = (LAS float*)(lds + 65536 + 1024) + wid * 32;
#pragma unroll
        for (int r = 0; r < 16; ++r) { osc[r * 64 + lane] = o0[r]; osc[(16 + r) * 64 + lane] = o1[r]; }
        if (hi == 0) { msc[q32] = mrun; lsc[q32] = lsum; }
        __syncthreads();
        if (ks == 0) {
            float mk[KS], M = -1e30f;
#pragma unroll
            for (int k = 0; k < KS; ++k) { mk[k] = ((LAS float*)(lds + 65536))[(k * QS + qs) * 32 + q32]; M = fmaxf(M, mk[k]); }
            float L = 0.f; f32x16 t0 = {}, t1 = {};
#pragma unroll 1
            for (int k = 0; k < KS; ++k) { const float w = fast_exp2(((LAS float*)(lds + 65536))[(k * QS + qs) * 32 + q32] - M); L += w * ((LAS float*)(lds + 65536 + 1024))[(k * QS + qs) * 32 + q32];
                const LAS float* os = (LAS float*)lds + (k * QS + qs) * 2048;
#pragma unroll
                for (int r = 0; r < 16; ++r) { t0[r] += w * os[r * 64 + lane]; t1[r] += w * os[(16 + r) * 64 + lane]; } }
            const float inv = 1.f / L; bf16* op = a.O + (size_t)(qs * 32 + q32) * a.ostride + 4 * hi;
#pragma unroll
            for (int g = 0; g < 4; ++g) { st_bf4(op + 8 * g, (f32x4){t0[4 * g] * inv, t0[4 * g + 1] * inv, t0[4 * g + 2] * inv, t0[4 * g + 3] * inv});
                st_bf4(op + 32 + 8 * g, (f32x4){t1[4 * g] * inv, t1[4 * g + 1] * inv, t1[4 * g + 2] * inv, t1[4 * g + 3] * inv}); }
        }
    }
    __syncthreads();
}


struct Attn2Args {
    const bf16* Q[2]; int qstride;
    const bf16* Ka; int kastride; const bf16* Kb; int kbstride; const bf16* V; int vstride;
    const float* Fk; bf16* O[2]; int ostride; int qpos0[2]; int nkv[2]; const float* cs;
};
template <int DQK, bool FOX, int NG>
__device__ __forceinline__ void attn_unit2(const Attn2Args& a, LAS unsigned char* lds) {
    constexpr int KRB = (DQK + 8) * 2, VRB = 144, NKK = DQK / 16, OFF_V = 64 * KRB, OFF_F = OFF_V + 64 * VRB, BUF = 32768;
    static_assert(OFF_F + 256 <= BUF, "tile buffer");
    int tid = threadIdx.x; asm volatile("" : "+v"(tid));
    const int lane = tid & 63, q32 = lane & 31, hi = lane >> 5; const int wid = __builtin_amdgcn_readfirstlane(tid >> 6);
    int qmin[NG], qpos[NG]; bf16x8 qf[NG][NKK]; float mrun[NG], lsum[NG]; f32x16 o0[NG], o1[NG];
#pragma unroll
    for (int g = 0; g < NG; ++g) {
        qmin[g] = a.qpos0[g] + wid * 32; qpos[g] = qmin[g] + q32; mrun[g] = -1e30f; lsum[g] = 0.f; o0[g] = f32x16{}; o1[g] = f32x16{};
        const bf16* qp = a.Q[g] + (size_t)(wid * 32 + q32) * a.qstride + hi * 8;
#pragma unroll
        for (int kk = 0; kk < NKK; ++kk) qf[g][kk] = *(const bf16x8*)(qp + kk * 16);
        if (DQK == 96) {
            const f32x4* cp = (const f32x4*)(a.cs + ((size_t)qpos[g] * 16 + 8 * hi) * 2);
            const u32x4 w1 = __builtin_bit_cast(u32x4, qf[g][NKK - 2]), w2 = __builtin_bit_cast(u32x4, qf[g][NKK - 1]); u32x4 r1, r2;
#pragma unroll
            for (int j = 0; j < 4; ++j) { const f32x4 c = cp[j]; const float a0 = bflo(w1[j]), a1 = bfhi(w1[j]), b0 = bflo(w2[j]), b1 = bfhi(w2[j]);
                r1[j] = pk2(a0 * c.x - b0 * c.y, a1 * c.z - b1 * c.w); r2[j] = pk2(a0 * c.y + b0 * c.x, a1 * c.w + b1 * c.z); }
            qf[g][NKK - 2] = __builtin_bit_cast(bf16x8, r1); qf[g][NKK - 1] = __builtin_bit_cast(bf16x8, r2);
        }
    }
    const int NT = a.nkv[NG - 1] / 64;
    struct Stage { u32x4 ka, v, kb; float f; }; Stage st0, st1;
    const int lrow = tid >> 3, lch = tid & 7, brow = (tid & 255) >> 2, bch = tid & 3;
    auto load_t = [&](int T, Stage& st) {
        st.ka = *(const u32x4*)(a.Ka + (size_t)(T * 64 + lrow) * a.kastride + lch * 8);
        st.v = *(const u32x4*)(a.V + (size_t)(T * 64 + lrow) * a.vstride + lch * 8);
        if (DQK == 96) { if (tid < 256) st.kb = *(const u32x4*)(a.Kb + (size_t)(T * 64 + brow) * a.kbstride + bch * 8); }
        if (FOX) { if (tid < 64) st.f = a.Fk[T * 64 + tid]; }
    };
    auto store_tile = [&](int T, const Stage& st) {
        LAS unsigned char* b = lds + (T & 1) * BUF;
        *(LAS u32x4*)(b + lrow * KRB + lch * 16) = st.ka; *(LAS u32x4*)(b + OFF_V + lrow * VRB + lch * 16) = st.v;
        if (DQK == 96) { if (tid < 256) *(LAS u32x4*)(b + brow * KRB + 128 + bch * 16) = st.kb; }
        if (FOX) { if (tid < 64) *(LAS float*)(b + OFF_F + tid * 4) = st.f; }
    };
    load_t(0, st0); if (NT > 1) load_t(1, st1);
    const LAS unsigned char* kbase0 = lds + q32 * KRB + hi * 16;
    const LAS unsigned char* vbase0 = lds + OFF_V + (4 * hi + ((lane & 15) >> 2)) * VRB + (16 * ((lane >> 4) & 1) + 4 * (lane & 3)) * 2;
    const LAS unsigned char* fbase0 = lds + OFF_F + (4 * hi) * 4;
    store_tile(0, st0); __syncthreads();
    auto step = [&](int T, Stage& stL  , const Stage& stS  ) {
        const int bo = (T & 1) * BUF; const LAS unsigned char* kbase = kbase0 + bo; const LAS unsigned char* vbase = vbase0 + bo; const LAS unsigned char* fbase = fbase0 + bo;
        if (T + 2 < NT) load_t(T + 2, stL);
        __builtin_amdgcn_sched_barrier(0);
        const int j0 = T * 64; bool valid[NG]; bool any = false;
#pragma unroll
        for (int g = 0; g < NG; ++g) { valid[g] = (j0 < a.nkv[g]) && (FOX ? (j0 <= qmin[g] + 31) : (T <= (qmin[g] >> 6))); any = any || valid[g]; }
        bf16x8 pb[NG][4];
        if (any) {
            f32x16 p0[NG], p1[NG];
            if (FOX) {
                f32x16 b0, b1;
#pragma unroll
                for (int q = 0; q < 4; ++q) { const f32x4 f0 = *(const LAS f32x4*)(fbase + q * 32), f1 = *(const LAS f32x4*)(fbase + 128 + q * 32);
#pragma unroll
                    for (int e = 0; e < 4; ++e) { b0[4 * q + e] = -f0[e]; b1[4 * q + e] = -f1[e]; } }
#pragma unroll
                for (int g = 0; g < NG; ++g) { p0[g] = b0; p1[g] = b1; }
            } else {
#pragma unroll
                for (int g = 0; g < NG; ++g) { p0[g] = f32x16{}; p1[g] = f32x16{}; } }
#pragma unroll
            for (int kk = 0; kk < NKK; ++kk) {
                const bf16x8 k0 = *(const LAS bf16x8*)(kbase + kk * 32), k1 = *(const LAS bf16x8*)(kbase + 32 * KRB + kk * 32);
#pragma unroll
                for (int g = 0; g < NG; ++g) if (valid[g]) {
                    p0[g] = __builtin_amdgcn_mfma_f32_32x32x16_bf16(k0, qf[g][kk], p0[g], 0, 0, 0);
                    p1[g] = __builtin_amdgcn_mfma_f32_32x32x16_bf16(k1, qf[g][kk], p1[g], 0, 0, 0); }
            }
#pragma unroll
            for (int g = 0; g < NG; ++g) if (valid[g]) {
                if (FOX && j0 + 63 > qmin[g]) {
#pragma unroll
                    for (int r = 0; r < 16; ++r) { const int kv = j0 + crow(r, hi); if (kv > qpos[g]) p0[g][r] = -1e30f; if (kv + 32 > qpos[g]) p1[g][r] = -1e30f; }
                }
                float mt = fmaxf(p0[g][0], p1[g][0]);
#pragma unroll
                for (int r = 1; r < 16; ++r) mt = fmaxf(mt, fmaxf(p0[g][r], p1[g][r]));
                mt = fmaxf(mt, __shfl_xor(mt, 32));
                const float mnew = fmaxf(mrun[g], mt), alpha = fast_exp2(mrun[g] - mnew); mrun[g] = mnew;
                float ps = 0.f;
#pragma unroll
                for (int r = 0; r < 16; ++r) { p0[g][r] = fast_exp2(p0[g][r] - mnew); p1[g][r] = fast_exp2(p1[g][r] - mnew); ps += p0[g][r] + p1[g][r]; }
                lsum[g] = lsum[g] * alpha + ps; if (__builtin_amdgcn_ballot_w64(alpha != 1.f)) { o0[g] = o0[g] * alpha; o1[g] = o1[g] * alpha; }
#pragma unroll
                for (int s = 0; s < 2; ++s) {
                    u32x4 w0 = {pk2(p0[g][8 * s], p0[g][8 * s + 1]), pk2(p0[g][8 * s + 2], p0[g][8 * s + 3]), pk2(p0[g][8 * s + 4], p0[g][8 * s + 5]), pk2(p0[g][8 * s + 6], p0[g][8 * s + 7])};
                    u32x4 w1 = {pk2(p1[g][8 * s], p1[g][8 * s + 1]), pk2(p1[g][8 * s + 2], p1[g][8 * s + 3]), pk2(p1[g][8 * s + 4], p1[g][8 * s + 5]), pk2(p1[g][8 * s + 6], p1[g][8 * s + 7])};
                    pb[g][s] = __builtin_bit_cast(bf16x8, w0); pb[g][2 + s] = __builtin_bit_cast(bf16x8, w1);
                }
            }
        }
        if (any) {
#pragma unroll
            for (int kst = 0; kst < 4; ++kst) {
                const LAS unsigned char* vp = vbase + 16 * kst * VRB;
                const s16x4 a0l = tr_read(vp), a0h = tr_read(vp + 8 * VRB), a1l = tr_read(vp + 64), a1h = tr_read(vp + 64 + 8 * VRB);
                const bf16x8 A0 = {a0l[0], a0l[1], a0l[2], a0l[3], a0h[0], a0h[1], a0h[2], a0h[3]}, A1 = {a1l[0], a1l[1], a1l[2], a1l[3], a1h[0], a1h[1], a1h[2], a1h[3]};
#pragma unroll
                for (int g = 0; g < NG; ++g) if (valid[g]) {
                    o0[g] = __builtin_amdgcn_mfma_f32_32x32x16_bf16(A0, pb[g][kst], o0[g], 0, 0, 0);
                    o1[g] = __builtin_amdgcn_mfma_f32_32x32x16_bf16(A1, pb[g][kst], o1[g], 0, 0, 0); }
            }
        }
        if (T + 1 < NT) store_tile(T + 1, stS);
        __syncthreads();
    };
    for (int T = 0; T < NT; T += 2) { step(T, st0, st1); if (T + 1 < NT) step(T + 1, st1, st0); }
#pragma unroll
    for (int g = 0; g < NG; ++g) {
        const float l = lsum[g] + __shfl_xor(lsum[g], 32); const float inv = 1.f / l; bf16* op = a.O[g] + (size_t)(wid * 32 + q32) * a.ostride + 4 * hi;
#pragma unroll
        for (int q = 0; q < 4; ++q) { st_bf4(op + 8 * q, (f32x4){o0[g][4 * q] * inv, o0[g][4 * q + 1] * inv, o0[g][4 * q + 2] * inv, o0[g][4 * q + 3] * inv});
            st_bf4(op + 32 + 8 * q, (f32x4){o1[g][4 * q] * inv, o1[g][4 * q + 1] * inv, o1[g][4 * q + 2] * inv, o1[g][4 * q + 3] * inv}); }
    }
    __syncthreads();
}

struct AbsArgs { const bf16* Qlat; const bf16* Qrope; const bf16 *Lat_past, *Lat_new, *Kr_past, *Kr_new; const bf16* WuvT; bf16* O; const float* cs; };
__device__ __forceinline__ void mla_abs_unit(const AbsArgs& a, LAS unsigned char* lds) {
    constexpr int RB = 592, OFF_Q = 128 * RB, NKK = 18, NT = (KVS + 127) / 128;
    int tid = threadIdx.x; asm volatile("" : "+v"(tid));
    const int lane = tid & 63, q32 = lane & 31, hi = lane >> 5; const int wid = __builtin_amdgcn_readfirstlane(tid >> 6);
    const int qs = wid & 1, ks = wid >> 1;
    LAS unsigned char* qlds = lds + OFF_Q + qs * (NKK * 1024) + lane * 16;
    { const bf16* qp = a.Qlat + (size_t)(qs * 32 + q32) * 2048 + hi * 8;
#pragma unroll
      for (int kk = 0; kk < 16; ++kk) *(LAS bf16x8*)(qlds + kk * 1024) = *(const bf16x8*)(qp + kk * 16);
      const bf16* rp = a.Qrope + (size_t)(qs * 32 + q32) * 768 + hi * 8;
      const u32x4 w1 = *(const u32x4*)rp, w2 = *(const u32x4*)(rp + 16); u32x4 r1, r2;
      const f32x4* cp = (const f32x4*)(a.cs + ((size_t)(SEQ + qs * 32 + q32) * 16 + 8 * hi) * 2);
#pragma unroll
      for (int j = 0; j < 4; ++j) { const f32x4 c = cp[j]; const float a0 = bflo(w1[j]), a1 = bfhi(w1[j]), b0 = bflo(w2[j]), b1 = bfhi(w2[j]);
          r1[j] = pk2(a0 * c.x - b0 * c.y, a1 * c.z - b1 * c.w); r2[j] = pk2(a0 * c.y + b0 * c.x, a1 * c.w + b1 * c.z); }
      *(LAS u32x4*)(qlds + 16 * 1024) = r1; *(LAS u32x4*)(qlds + 17 * 1024) = r2; }
    float mrun = -1e30f, lsum = 0.f; f32x16 o[8] = {};
    u32x4 rl[8], rk;
    const int lrow = tid >> 5, lch = tid & 31, krow = tid >> 2, kch = tid & 3;
    auto load_t = [&](int T) {
        const int jT = T * 128; const bool past = jT < PAST; const size_t r0 = (size_t)(past ? jT : jT - PAST);
        const bf16* lp = (past ? a.Lat_past : a.Lat_new) + (r0 + lrow) * 256 + lch * 8;
#pragma unroll
        for (int i = 0; i < 8; ++i) if (jT + 16 * i < KVS) rl[i] = *(const u32x4*)(lp + (size_t)i * 16 * 256);
        if (jT + krow < KVS) rk = *(const u32x4*)((past ? a.Kr_past : a.Kr_new) + (r0 + krow) * 32 + kch * 8);
    };
    auto store_t = [&](int T) {
        const int jT = T * 128;
#pragma unroll
        for (int i = 0; i < 8; ++i) if (jT + 16 * i < KVS) *(LAS u32x4*)(lds + (lrow + 16 * i) * RB + lch * 16) = rl[i];
        if (jT + krow < KVS) *(LAS u32x4*)(lds + krow * RB + 512 + kch * 16) = rk;
    };
    load_t(0);
    const LAS unsigned char* kbase = lds + (ks * 32 + q32) * RB + hi * 16;
    const LAS unsigned char* vbase = lds + (ks * 32 + 4 * hi + ((lane & 15) >> 2)) * RB + (16 * ((lane >> 4) & 1) + 4 * (lane & 3)) * 2;
    for (int T = 0; T < NT; ++T) {
        __syncthreads();
        store_t(T);
        __syncthreads();
        if (T + 1 < NT) load_t(T + 1);
        __builtin_amdgcn_sched_barrier(0);
        if (T * 128 + ks * 32 < KVS) {
            f32x16 p0 = {}, pq = {};
#pragma unroll
            for (int kk = 0; kk < NKK; kk += 2) {
                const bf16x8 k0 = *(const LAS bf16x8*)(kbase + kk * 32); const bf16x8 qv = *(const LAS bf16x8*)(qlds + kk * 1024);
                const bf16x8 k1 = *(const LAS bf16x8*)(kbase + (kk + 1) * 32); const bf16x8 qw = *(const LAS bf16x8*)(qlds + (kk + 1) * 1024);
                p0 = __builtin_amdgcn_mfma_f32_32x32x16_bf16(k0, qv, p0, 0, 0, 0);
                pq = __builtin_amdgcn_mfma_f32_32x32x16_bf16(k1, qw, pq, 0, 0, 0);
            }
            p0 = p0 + pq;
            float mt = p0[0];
#pragma unroll
            for (int r = 1; r < 16; ++r) mt = fmaxf(mt, p0[r]);
            mt = fmaxf(mt, __shfl_xor(mt, 32));
            const float mnew = fmaxf(mrun, mt), alpha = fast_exp2(mrun - mnew); mrun = mnew;
            float ps = 0.f;
#pragma unroll
            for (int r = 0; r < 16; ++r) { p0[r] = fast_exp2(p0[r] - mnew); ps += p0[r]; }
            lsum = lsum * alpha + ps;
            if (__builtin_amdgcn_ballot_w64(alpha != 1.f)) {
#pragma unroll
                for (int dt = 0; dt < 8; ++dt) o[dt] = o[dt] * alpha; }
            bf16x8 pb[2];
#pragma unroll
            for (int s = 0; s < 2; ++s) {
                u32x4 w0 = {pk2(p0[8 * s], p0[8 * s + 1]), pk2(p0[8 * s + 2], p0[8 * s + 3]), pk2(p0[8 * s + 4], p0[8 * s + 5]), pk2(p0[8 * s + 6], p0[8 * s + 7])};
                pb[s] = __builtin_bit_cast(bf16x8, w0);
            }
#pragma unroll
            for (int kst = 0; kst < 2; ++kst) {
                const LAS unsigned char* vp = vbase + 16 * kst * RB;
#pragma unroll
                for (int dt = 0; dt < 8; ++dt) { const s16x4 al = tr_read(vp + dt * 64), ah = tr_read(vp + dt * 64 + 8 * RB);
                    const bf16x8 Af = {al[0], al[1], al[2], al[3], ah[0], ah[1], ah[2], ah[3]};
                    o[dt] = __builtin_amdgcn_mfma_f32_32x32x16_bf16(Af, pb[kst], o[dt], 0, 0, 0); }
            }
        }
    }
    lsum += __shfl_xor(lsum, 32);
    LAS float* msc = (LAS float*)(lds + 131072 + 4096);
    LAS float* lsc = msc + 256;
#pragma unroll 1
    for (int rnd = 0; rnd < 2; ++rnd) {
        const int half = rnd == 0 ? 2 : 1;
        __syncthreads();
        if (ks >= half && ks < 2 * half) { LAS float* osc = (LAS float*)lds + ((ks - half) * 2 + qs) * 8192;
#pragma unroll
            for (int dt = 0; dt < 8; ++dt)
#pragma unroll
                for (int r = 0; r < 16; ++r) osc[(dt * 16 + r) * 64 + lane] = o[dt][r];
            if (hi == 0) { msc[wid * 32 + q32] = mrun; lsc[wid * 32 + q32] = lsum; } }
        __syncthreads();
        if (ks < half) { const LAS float* osc = (const LAS float*)lds + (ks * 2 + qs) * 8192; const int pw = (ks + half) * 2 + qs;
            const float m2 = msc[pw * 32 + q32], l2 = lsc[pw * 32 + q32]; const float M = fmaxf(mrun, m2), w1 = fast_exp2(mrun - M), w2 = fast_exp2(m2 - M);
            lsum = w1 * lsum + w2 * l2; mrun = M;
#pragma unroll
            for (int dt = 0; dt < 8; ++dt)
#pragma unroll
                for (int r = 0; r < 16; ++r) o[dt][r] = w1 * o[dt][r] + w2 * osc[(dt * 16 + r) * 64 + lane]; }
    }
    if (ks == 0) {
        const float inv = 1.f / lsum; f32x16 t0 = {}, t1 = {};
        const bf16* wrow0 = a.WuvT + (size_t)q32 * 256 + 4 * hi; const bf16* wrow1 = wrow0 + 32 * 256;
#pragma unroll
        for (int sub = 0; sub < 8; ++sub)
#pragma unroll
            for (int s = 0; s < 2; ++s) {
                const u32x4 wv = {pk2(o[sub][8 * s] * inv, o[sub][8 * s + 1] * inv), pk2(o[sub][8 * s + 2] * inv, o[sub][8 * s + 3] * inv), pk2(o[sub][8 * s + 4] * inv, o[sub][8 * s + 5] * inv), pk2(o[sub][8 * s + 6] * inv, o[sub][8 * s + 7] * inv)};
                const bf16x8 Bf = __builtin_bit_cast(bf16x8, wv); const int c0 = 32 * sub + 16 * s;
                const s16x4 a0l = *(const s16x4*)(wrow0 + c0), a0h = *(const s16x4*)(wrow0 + c0 + 8), a1l = *(const s16x4*)(wrow1 + c0), a1h = *(const s16x4*)(wrow1 + c0 + 8);
                const bf16x8 A0 = {a0l[0], a0l[1], a0l[2], a0l[3], a0h[0], a0h[1], a0h[2], a0h[3]}, A1 = {a1l[0], a1l[1], a1l[2], a1l[3], a1h[0], a1h[1], a1h[2], a1h[3]};
                t0 = __builtin_amdgcn_mfma_f32_32x32x16_bf16(A0, Bf, t0, 0, 0, 0);
                t1 = __builtin_amdgcn_mfma_f32_32x32x16_bf16(A1, Bf, t1, 0, 0, 0);
            }
        bf16* op = a.O + (size_t)(qs * 32 + q32) * 1024 + 4 * hi;
#pragma unroll
        for (int g = 0; g < 4; ++g) { st_bf4(op + 8 * g, (f32x4){t0[4 * g], t0[4 * g + 1], t0[4 * g + 2], t0[4 * g + 3]}); st_bf4(op + 32 + 8 * g, (f32x4){t1[4 * g], t1[4 * g + 1], t1[4 * g + 2], t1[4 * g + 3]}); }
    }
    __syncthreads();
}

__device__ __forceinline__ void p4_attention(const Args& A, LAS unsigned char* lds) {
    unsigned char* ws = A.ws; const int G = gridDim.x;
    const bf16* QFOX = (const bf16*)(ws + WS_QFOX); const bf16* KNEW = (const bf16*)(ws + WS_KNEW); const bf16* VNEW = (const bf16*)(ws + WS_VNEW);
    const bf16* QMLA = (const bf16*)(ws + WS_QMLA); const bf16* KVNEW = (const bf16*)(ws + WS_KVNEW);
    const bf16* KRNEW = (const bf16*)(ws + WS_KRNEW); const bf16* KRPAST = (const bf16*)(ws + WS_KRPAST);
    const float* FS = (const float*)(ws + WS_FS); const float* FP = (const float*)(ws + WS_FP); bf16* MIXED = (bf16*)(ws + WS_MIXED);
    const int rot = (blockIdx.x >> 6) & 3;
#pragma unroll 1
    for (int pass = 0; pass < 4; ++pass) {
    const int job = (pass + rot) & 3;
    if (job == 0) {
    for (int p = blockIdx.x; p < 256; p += G) {
        const int bh = p >> 2, s = p & 3, b = bh >> 3, h = bh & 7; const size_t tb = (size_t)b * SEQ;
        Attn2Args a; a.cs = (const float*)(ws + WS_CS); a.qstride = 512; a.Ka = KNEW + tb * 512 + h * 64; a.kastride = 512; a.Kb = nullptr; a.kbstride = 0;
        a.V = VNEW + tb * 512 + h * 64; a.vstride = 512; a.Fk = FP + (size_t)bh * SEQ; a.ostride = 1024;
        for (int i = 0; i < 2; ++i) { const int t0 = 256 * (i ? 7 - s : s); a.Q[i] = QFOX + (tb + t0) * 512 + h * 64; a.O[i] = MIXED + (tb + t0) * 1024 + h * 64; a.qpos0[i] = t0; a.nkv[i] = t0 + 256; }
        attn_unit2<64, true, 2>(a, lds);
    }
    } else if (job == 1) {
    for (int p = blockIdx.x; p < 256; p += G) {
        const int bh = p >> 2, s = 3 - (p & 3), b = bh >> 3, h = bh & 7; const size_t tb = (size_t)b * SEQ;
        Attn2Args a; a.cs = (const float*)(ws + WS_CS); a.qstride = 768; a.Ka = KVNEW + tb * 1024 + h * 64; a.kastride = 1024; a.Kb = KRNEW + tb * 32; a.kbstride = 32;
        a.V = KVNEW + tb * 1024 + 512 + h * 64; a.vstride = 1024; a.Fk = nullptr; a.ostride = 1024;
        for (int i = 0; i < 2; ++i) { const int t0 = 256 * (i ? 7 - s : s); a.Q[0] = QMLA + (tb + t0) * 768 + h * 96; a.O[0] = MIXED + (tb + t0) * 1024 + 512 + h * 64; a.qpos0[0] = t0; a.nkv[0] = t0 + 256;
            a.Q[1] = a.Q[0]; a.O[1] = a.O[0]; a.qpos0[1] = t0; a.nkv[1] = t0 + 256;
            attn_unit2<96, false, 1>(a, lds); }
    }
    } else if (job == 2) {
    for (int p = blockIdx.x; p < 256; p += G) {
        const int b = p >> 3, h = p & 7; const size_t tok0 = (size_t)TP + (size_t)b * DSEQ, pb = (size_t)b * PAST;
        AttnArgs a; a.cs = (const float*)(ws + WS_CS); a.Q = QFOX + tok0 * 512 + h * 64; a.qstride = 512;
        a.Ka_past = A.in[2] + pb * 512 + h * 64; a.Ka_new = A.out + O_KS + (size_t)b * DSEQ * 512 + h * 64; a.kastride = 512; a.Kb_past = a.Kb_new = nullptr; a.kbstride = 0;
        a.V_past = A.in[3] + pb * 512 + h * 64; a.V_new = A.out + O_VS + (size_t)b * DSEQ * 512 + h * 64; a.vstride = 512;
        a.Fq = FS + (size_t)p * KVS + PAST; a.Fk = FS + (size_t)p * KVS; a.O = MIXED + tok0 * 1024 + h * 64; a.ostride = 1024; a.P = PAST; a.qpos0 = PAST; a.nkv = KVS;
        attn_unit<64, true, 2, 4, true>(a, lds);
    }
    } else {
    for (int p = blockIdx.x; p < 256; p += G) {
        const int b = (p & 7) * 4 + (p >> 6), h = (p >> 3) & 7; const size_t tok0 = (size_t)TP + (size_t)b * DSEQ, pb = (size_t)b * PAST;
        AbsArgs a; a.Qlat = (const bf16*)(ws + WS_QLAT) + (size_t)b * DSEQ * 2048 + h * 256; a.Qrope = QMLA + tok0 * 768 + h * 96 + 64;
        a.Lat_past = (const bf16*)(ws + WS_LATPAST) + pb * 256; a.Lat_new = (const bf16*)(ws + WS_LATNEW) + tok0 * 256;
        a.Kr_past = KRPAST + pb * 32; a.Kr_new = KRNEW + tok0 * 32; a.WuvT = (const bf16*)(ws + WS_WKV) + (size_t)(512 + h * 64) * 256;
        a.O = MIXED + tok0 * 1024 + 512 + h * 64; a.cs = (const float*)(ws + WS_CS);
        mla_abs_unit(a, lds);
    }
    }
    }
}

template <class Epi> __device__ __forceinline__ void run_gemm(LAS unsigned char* lds, const bf16* Am, const bf16* Bt, int M, int N, int K, const Epi& E, int cu_shift = 0) {
    pg8::Gemm g{Am, Bt, M, N, K}; pg8::StaticOrder S; S.init(M, N, K, (int)gridDim.x, (int)((blockIdx.x + cu_shift) % gridDim.x));
    pg8::gemm_phase<Epi, pg8::StaticOrder, true, true>(lds, g, S, E);
}

__global__ void __launch_bounds__(NTHREADS, 2) fwd_kernel(Args A, int ph_lo, int ph_hi) {
    extern __shared__ __attribute__((aligned(16))) unsigned char lds_raw[];
    LAS unsigned char* lds = (LAS unsigned char*)lds_raw;
    unsigned char* ws = A.ws;
    if (threadIdx.x < 64) ((LAS unsigned*)(lds + 131072))[threadIdx.x] = 0u;
    __syncthreads();
    XcdBarrier bar = xcd_barrier_post((unsigned*)(ws + WS_CTL), (volatile LAS unsigned*)(lds + 131072 + 32));
#ifndef PH_MASK
#define PH_MASK 0xffff
#endif
#define IN(k) (((PH_MASK >> (k)) & 1) && ph_lo <= (k) && (k) < ph_hi)
#define SEAM(k) do { if (IN(k) && IN((k) + 1)) xcd_barrier(bar); } while (0)
#ifndef REP0
#define REP0 1
#endif
#ifndef REP4
#define REP4 1
#endif
#ifndef REP8
#define REP8 1
#endif
#ifndef REP1
#define REP1 1
#endif
#ifndef REP7
#define REP7 1
#endif
#ifndef REP9
#define REP9 1
#endif
    if (IN(0)) { for (int rep = 0; rep < REP0; ++rep) { p0_prologue(A, lds); __syncthreads(); } }
    SEAM(0);
    if (IN(1)) {
        EpiZ E{(bf16*)(ws + WS_QFOX), (bf16*)(ws + WS_KNEW), (bf16*)(ws + WS_VNEW), (bf16*)(ws + WS_KRNEW), (float*)(ws + WS_ZBUF), A.out, (const float*)(ws + WS_CS), A.in[10]};
        run_gemm(lds, (const bf16*)(ws + WS_H), (const bf16*)(ws + WS_WIN), TOK, NZ, DM, E);
    }
    SEAM(1);
    if (IN(2)) { p2_postz(A, lds); __syncthreads(); }
    SEAM(2);
    if (IN(3)) {
        EpiBf E{(bf16*)(ws + WS_QMLA), 768, 0.10206207261596575f * LOG2E};
        run_gemm(lds, (const bf16*)(ws + WS_QCN), (const bf16*)(ws + WS_WQ), TOK, 768, 384, E);
        EpiBf E2{(bf16*)(ws + WS_KVNEW), 1024, 1.f};
        run_gemm(lds, (const bf16*)(ws + WS_LATNEW), (const bf16*)(ws + WS_WKV), TP, 1024, 256, E2);
        EpiBf E3{(bf16*)(ws + WS_QLAT), 2048, 0.10206207261596575f * LOG2E};
        run_gemm(lds, (const bf16*)(ws + WS_QCN) + (size_t)TP * 384, (const bf16*)(ws + WS_WQA), TS, 2048, 384, E3, 64);
    }
    SEAM(3);
    if (IN(4)) { for (int rep = 0; rep < REP4; ++rep) p4_attention(A, lds); }
    SEAM(4);
    if (IN(5)) {
        pg8::Gemm g{(const bf16*)(ws + WS_MIXED), (const bf16*)(ws + WS_WOUT), TOK, DM, DM}; SplitOrder<16> S{(int)gridDim.x, (int)blockIdx.x};
        EpiOut E{A.in[0], A.in[1], (float*)(ws + WS_X1), (bf16*)(ws + WS_H), A.in[17], (float*)(ws + WS_ROWSS), (float*)(ws + WS_SLAB)};
        pg8::gemm_phase<EpiOut, SplitOrder<16>, true, true>(lds, g, S, E);
    }
    if (IN(5) && IN(7)) xcd_barrier(bar);
    if (IN(5)) {
        int t2 = threadIdx.x; asm volatile("" : "+v"(t2)); const int lane = t2 & 63, gw = blockIdx.x * NWAVES + (t2 >> 6), NGW = gridDim.x * NWAVES;
        for (int r = gw; r < TS; r += NGW) {
            const f32x4* xr = (const f32x4*)(A.in[1] + (size_t)r * DM) + lane; f32x4 v[4];
#pragma unroll
            for (int j = 0; j < 4; ++j) v[j] = xr[64 * j];
#pragma unroll
            for (int k = 0; k < DN_SL; ++k) { const f32x4* sr = (const f32x4*)((const float*)(ws + WS_SLAB) + ((size_t)k * TS + r) * DM) + lane;
#pragma unroll
                for (int j = 0; j < 4; ++j) v[j] += sr[64 * j]; }
            float ss = 0.f; const size_t row = (size_t)TP + r;
#pragma unroll
            for (int j = 0; j < 4; ++j) { ss += (v[j].x * v[j].x + v[j].y * v[j].y) + (v[j].z * v[j].z + v[j].w * v[j].w); ((f32x4*)((float*)(ws + WS_X1) + row * DM))[64 * j + lane] = v[j];
                const f32x4 gq = ((const f32x4*)A.in[17])[64 * j + lane]; const f32x4 o = v[j] * gq; ((u32x2*)((bf16*)(ws + WS_H) + row * DM))[64 * j + lane] = (u32x2){pk2(o.x, o.y), pk2(o.z, o.w)}; }
            ss = wave_sum(ss);
            if (lane == 0) ((float*)(ws + WS_RSTD))[row] = rsqrtf(ss * (1.f / DM) + EPS);
        }
        for (int r = blockIdx.x * NTHREADS + t2; r < TP; r += gridDim.x * NTHREADS) {
            const f32x4* rp = (const f32x4*)((const float*)(ws + WS_ROWSS) + (size_t)r * 16); const f32x4 t = (rp[0] + rp[1]) + (rp[2] + rp[3]);
            ((float*)(ws + WS_RSTD))[r] = rsqrtf(((t.x + t.y) + (t.z + t.w)) * (1.f / DM) + EPS);
        }
    }
    if (IN(5) && IN(7)) xcd_barrier(bar);
    if (IN(7)) { EpiGlu E{(bf16*)(ws + WS_ACT), (float*)(ws + WS_EDGE), A.in[19], A.in[20], (const float*)(ws + WS_RSTD)}; run_gemm(lds, (const bf16*)(ws + WS_H), (const bf16*)(ws + WS_WUP), TOK, DFF2, DM, E); }
    SEAM(7);
    if (IN(8)) p8_fixup(A);
    SEAM(8);
    if (IN(9)) {
        pg8::Gemm g{(const bf16*)(ws + WS_ACT), (const bf16*)(ws + WS_WDOWN), TOK, DM, DFF}; DownOrder S{(int)gridDim.x, (int)blockIdx.x};
        EpiDown E{(const float*)(ws + WS_X1), (float*)(ws + WS_X2), (float*)(ws + WS_SLAB)};
        pg8::gemm_phase<EpiDown, DownOrder, true, true>(lds, g, S, E);
    }
    SEAM(9);
    if (IN(10)) { int t2 = threadIdx.x; asm volatile("" : "+v"(t2)); const int lane = t2 & 63, gw = blockIdx.x * NWAVES + (t2 >> 6), NGW = gridDim.x * NWAVES;
        for (int m = gw; m < TOK; m += NGW) {
            if (m < TP) rms_row<true>((const float*)(ws + WS_X2) + (size_t)m * DM, A.in[22], A.out + (size_t)m * DM, lane);
            else rms_row<true, DN_SL>((const float*)(ws + WS_X1) + (size_t)m * DM, A.in[22], A.out + (size_t)m * DM, lane, (const float*)(ws + WS_SLAB) + (size_t)(m - TP) * DM, (size_t)TS * DM); } }
#undef IN
#undef SEAM
}

#ifndef N_LAUNCHES
#define N_LAUNCHES 1
#endif
extern "C" void kernel_launch(void* const* d_in, const int* in_sizes, int n_in, void* d_out, int out_size, void* d_ws, size_t ws_size, hipStream_t stream) {
    static int grid = 0;
    if (grid == 0) {
        if (n_in != 23 || (size_t)out_size != O_END || ws_size < WS_END) { fprintf(stderr, "kernel_launch: unexpected shapes: n_in %d out %d ws %zu (need %zu)\n", n_in, out_size, ws_size, (size_t)WS_END); grid = -1; return; }
        int dev = 0, cus = 0, per_cu = 0;
        (void)hipGetDevice(&dev); (void)hipDeviceGetAttribute(&cus, hipDeviceAttributeMultiprocessorCount, dev);
        if (hipFuncSetAttribute((const void*)fwd_kernel, hipFuncAttributeMaxDynamicSharedMemorySize, LDS_BYTES) != hipSuccess) { fprintf(stderr, "hipFuncSetAttribute failed\n"); grid = -1; return; }
        if (hipOccupancyMaxActiveBlocksPerMultiprocessor(&per_cu, (const void*)fwd_kernel, NTHREADS, LDS_BYTES) != hipSuccess || per_cu < 1) { fprintf(stderr, "occupancy query: %d\n", per_cu); per_cu = 1; }
        (void)hipGetLastError();
        grid = cus * 1;
    }
    if (grid < 0) return;
    if (hipMemsetAsync((char*)d_ws + WS_CTL, 0, CTL_BYTES, stream) != hipSuccess) { fprintf(stderr, "memset failed\n"); return; }
    Args a{};
    for (int i = 0; i < 23; ++i) a.in[i] = (const float*)d_in[i];
    a.out = (float*)d_out; a.ws = (unsigned char*)d_ws;
    if (N_LAUNCHES == 1) {
        hipLaunchKernelGGL(fwd_kernel, dim3(grid), dim3(NTHREADS), LDS_BYTES, stream, a, 0, 11);
    } else {
        for (int k = 0; k < 11; ++k) hipLaunchKernelGGL(fwd_kernel, dim3(grid), dim3(NTHREADS), LDS_BYTES, stream, a, k, k + 1);
    }
}
```
